# Optimizing an MI355X kernel written in HIP

```python
import math
import jax, jax.numpy as jnp
from jax import lax
import numpy as np

D_MODEL = 1024
BATCH = 1
SEQ = 16384
DEPTH = 1
DEC_BATCH = 16
DEC_SEQ = 16
PAST_LEN = 1024

CHUNK = 64
D_MIX = D_MODEL
D_POOL = D_MIX // 2
D_SSM = D_MIX - D_POOL
POOL_WINDOWS = (2, 4, 8, 16)
N_POOL_GROUPS = len(POOL_WINDOWS)
POOL_GW = D_POOL // N_POOL_GROUPS
POOL_HIST = max(POOL_WINDOWS) - 1
SSM_GROUP = 16
N_SSM_GROUPS = D_SSM // SSM_GROUP
SSM_STATE = 64
DT_MIN = 1e-3
DT_MAX = 1e-1
N_MEM = 256
MEM_HEADS = 4
MEM_HEAD_DIM = D_MODEL // MEM_HEADS
D_FF = 4 * D_MODEL
EPS = 1e-6

kernel_name = "hybrid_pool_s5_stream_encoder_step"


def rmsnorm(x, g):
    xf = x.astype(jnp.float32)
    y = xf * lax.rsqrt(jnp.mean(xf * xf, axis=-1, keepdims=True) + EPS)
    return (y * g.astype(jnp.float32)).astype(x.dtype)


def pool_mixer(u, hist, pos0, w_pool, pool_scale):
    S = u.shape[1]
    u_ext = jnp.concatenate([hist.astype(u.dtype), u], axis=1)
    uf = u_ext.astype(jnp.float32)
    c = jnp.pad(jnp.cumsum(uf, axis=1), ((0, 0), (1, 0), (0, 0)))
    cnt_pos = pos0 + jnp.arange(S) + 1
    cur = uf[:, POOL_HIST:]
    outs = []
    for g, w in enumerate(POOL_WINDOWS):
        sl = slice(g * POOL_GW, (g + 1) * POOL_GW)
        cg = c[..., sl]
        hi = POOL_HIST + 1
        win_sum = cg[:, hi:hi + S] - cg[:, hi - w:hi - w + S]
        cnt = jnp.minimum(cnt_pos, w).astype(jnp.float32)[None, :, None]
        pooled = win_sum / cnt - cur[..., sl]
        outs.append(jnp.einsum('bsc,cd->bsd', pooled, w_pool[g].astype(jnp.float32)))
    y = jnp.concatenate(outs, axis=-1) * pool_scale.astype(jnp.float32)
    return y.astype(u.dtype), u_ext[:, -POOL_HIST:]


def s5_mixer(u, h0_re, h0_im, a_re, a_im, b_re, b_im, c_re, c_im, d_skip, log_dt, w_glu, b_glu):
    B, S, _ = u.shape
    f32 = jnp.float32
    uf = u.astype(f32).reshape(B, S, N_SSM_GROUPS, SSM_GROUP)
    A = lax.complex(a_re.astype(f32), a_im.astype(f32))
    dt = jnp.exp(log_dt.astype(f32))[:, None]
    a_bar = jnp.exp(A * dt)
    b_bar = ((a_bar - 1.0) / A)[..., None] * lax.complex(b_re.astype(f32), b_im.astype(f32))
    bu = jnp.einsum('gph,bsgh->bsgp', b_bar, uf.astype(jnp.complex64))
    h0 = lax.complex(h0_re.astype(f32), h0_im.astype(f32))
    bu = bu.at[:, 0].add(a_bar * h0)
    a_seq = jnp.broadcast_to(a_bar, bu.shape)

    def combine(left, right):
        al, bl = left
        ar, br = right
        return ar * al, ar * bl + br

    _, h = lax.associative_scan(combine, (a_seq, bu), axis=1)
    cm = lax.complex(c_re.astype(f32), c_im.astype(f32))
    y = jnp.einsum('ghp,bsgp->bsgh', cm, h).real + d_skip.astype(f32) * uf
    y = jax.nn.gelu(y.reshape(B, S, D_SSM))
    y = y * jax.nn.sigmoid(y @ w_glu.astype(f32) + b_glu.astype(f32))
    h_last = h[:, -1]
    return y.astype(u.dtype), h_last.real.astype(h0_re.dtype), h_last.imag.astype(h0_im.dtype)


def mem_kv(mem, g_mem, w_k, w_v):
    B = mem.shape[0]
    m = rmsnorm(mem, g_mem)
    k = (m @ w_k).reshape(B, N_MEM, MEM_HEADS, MEM_HEAD_DIM)
    v = (m @ w_v).reshape(B, N_MEM, MEM_HEADS, MEM_HEAD_DIM)
    return k, v


def cross_attn(h, k, v, w_q, w_o):
    B, S, _ = h.shape
    q = (h @ w_q).reshape(B, S, MEM_HEADS, MEM_HEAD_DIM)
    s = jnp.einsum('bshd,bnhd->bhsn', q, k).astype(jnp.float32) * (MEM_HEAD_DIM ** -0.5)
    p = jax.nn.softmax(s, axis=-1).astype(v.dtype)
    o = jnp.einsum('bhsn,bnhd->bshd', p, v).reshape(B, S, MEM_HEADS * MEM_HEAD_DIM)
    return o @ w_o


def layer(x, pool_hist, pos0, h0_re, h0_im, mk, mv,
          g_mix, w_in, w_pool, pool_scale, a_re, a_im, b_re, b_im, c_re, c_im, d_skip, log_dt,
          w_glu, b_glu, w_out, g_xattn, w_q, w_o, g_mlp, w_up, w_down):
    h = rmsnorm(x, g_mix)
    z = h @ w_in
    y_pool, new_hist = pool_mixer(z[..., :D_POOL], pool_hist, pos0, w_pool, pool_scale)
    y_ssm, hr, hi = s5_mixer(z[..., D_POOL:], h0_re, h0_im, a_re, a_im, b_re, b_im,
                             c_re, c_im, d_skip, log_dt, w_glu, b_glu)
    x = x + jnp.concatenate([y_pool, y_ssm], axis=-1) @ w_out
    x = x + cross_attn(rmsnorm(x, g_xattn), mk, mv, w_q, w_o)
    hm = rmsnorm(x, g_mlp)
    x = x + jnp.square(jax.nn.relu(hm @ w_up)) @ w_down
    return x, new_hist, hr, hi


def setup_inputs(seed: int = 0) -> dict:
    key = jax.random.key(seed)
    ks = iter(jax.random.split(key, 48))
    f32 = jnp.float32

    def nrm(shape, scale):
        return jax.random.normal(next(ks), shape, f32) * scale

    L, G, P, H = DEPTH, N_SSM_GROUPS, SSM_STATE, SSM_GROUP
    n = jnp.arange(P, dtype=f32)
    inp = {
        "x_prompt": nrm((BATCH, SEQ, D_MODEL), 1.0),
        "x_sample": nrm((DEC_BATCH, DEC_SEQ, D_MODEL), 1.0),
        "cache_mem_k": nrm((L, DEC_BATCH, N_MEM, MEM_HEADS, MEM_HEAD_DIM), 1.0),
        "cache_mem_v": nrm((L, DEC_BATCH, N_MEM, MEM_HEADS, MEM_HEAD_DIM), 1.0),
        "state_pool": nrm((L, DEC_BATCH, POOL_HIST, D_POOL), 1.0),
        "state_ssm_re": nrm((L, DEC_BATCH, G, P), 0.1),
        "state_ssm_im": nrm((L, DEC_BATCH, G, P), 0.1),
        "mem_prompt": nrm((BATCH, N_MEM, D_MODEL), 1.0),
        "g_mix": 1.0 + nrm((L, D_MODEL), 0.02),
        "w_in": nrm((L, D_MODEL, D_MIX), D_MODEL ** -0.5),
        "w_pool": nrm((L, N_POOL_GROUPS, POOL_GW, POOL_GW), POOL_GW ** -0.5),
        "pool_scale": 1.0 + nrm((L, D_POOL), 0.1),
        "ssm_a_re": -0.5 + nrm((L, G, P), 0.01),
        "ssm_a_im": math.pi * n + nrm((L, G, P), 0.01),
        "ssm_b_re": nrm((L, G, P, H), (2.0 * H) ** -0.5),
        "ssm_b_im": nrm((L, G, P, H), (2.0 * H) ** -0.5),
        "ssm_c_re": nrm((L, G, H, P), (2.0 * P) ** -0.5 * 4.0),
        "ssm_c_im": nrm((L, G, H, P), (2.0 * P) ** -0.5 * 4.0),
        "ssm_d": nrm((L, G, H), 1.0),
        "ssm_log_dt": jax.random.uniform(next(ks), (L, G), f32, math.log(DT_MIN), math.log(DT_MAX)),
        "w_glu": nrm((L, D_SSM, D_SSM), D_SSM ** -0.5),
        "b_glu": nrm((L, D_SSM), 0.02),
        "w_out": nrm((L, D_MIX, D_MODEL), D_MIX ** -0.5),
        "g_xattn": 1.0 + nrm((L, D_MODEL), 0.02),
        "g_mem": 1.0 + nrm((L, D_MODEL), 0.02),
        "w_q": nrm((L, D_MODEL, MEM_HEADS * MEM_HEAD_DIM), D_MODEL ** -0.5),
        "w_k": nrm((L, D_MODEL, MEM_HEADS * MEM_HEAD_DIM), D_MODEL ** -0.5),
        "w_v": nrm((L, D_MODEL, MEM_HEADS * MEM_HEAD_DIM), D_MODEL ** -0.5),
        "w_o": nrm((L, MEM_HEADS * MEM_HEAD_DIM, D_MODEL), D_MODEL ** -0.5),
        "g_mlp": 1.0 + nrm((L, D_MODEL), 0.02),
        "w_up": nrm((L, D_MODEL, D_FF), D_MODEL ** -0.5),
        "w_down": nrm((L, D_FF, D_MODEL), D_FF ** -0.5),
        "g_final": 1.0 + nrm((D_MODEL,), 0.02),
    }
    return inp


def reference(x_prompt, x_sample, cache_mem_k, cache_mem_v, state_pool, state_ssm_re, state_ssm_im,
              mem_prompt, g_mix, w_in, w_pool, pool_scale, ssm_a_re, ssm_a_im, ssm_b_re, ssm_b_im,
              ssm_c_re, ssm_c_im, ssm_d, ssm_log_dt, w_glu, b_glu, w_out, g_xattn, g_mem,
              w_q, w_k, w_v, w_o, g_mlp, w_up, w_down, g_final):
    xp, xs = x_prompt, x_sample
    Bp = x_prompt.shape[0]
    mk_p, mv_p, pool_p, sre_p, sim_p = [], [], [], [], []
    pool_s, sre_s, sim_s = [], [], []
    for l in range(DEPTH):
        wts = (g_mix[l], w_in[l], w_pool[l], pool_scale[l], ssm_a_re[l], ssm_a_im[l],
               ssm_b_re[l], ssm_b_im[l], ssm_c_re[l], ssm_c_im[l], ssm_d[l], ssm_log_dt[l],
               w_glu[l], b_glu[l], w_out[l], g_xattn[l], w_q[l], w_o[l], g_mlp[l], w_up[l], w_down[l])
        mk, mv = mem_kv(mem_prompt, g_mem[l], w_k[l], w_v[l])
        hist0 = jnp.zeros((Bp, POOL_HIST, D_POOL), xp.dtype)
        zs = jnp.zeros((Bp, N_SSM_GROUPS, SSM_STATE), state_ssm_re.dtype)
        xp, ph, hr, hi = layer(xp, hist0, 0, zs, zs, mk, mv, *wts)
        mk_p.append(mk); mv_p.append(mv); pool_p.append(ph); sre_p.append(hr); sim_p.append(hi)
        xs, sh, shr, shi = layer(xs, state_pool[l], PAST_LEN, state_ssm_re[l], state_ssm_im[l],
                                 cache_mem_k[l], cache_mem_v[l], *wts)
        pool_s.append(sh); sre_s.append(shr); sim_s.append(shi)
    y_prompt = rmsnorm(xp, g_final)
    y_sample = rmsnorm(xs, g_final)
    return (y_prompt, y_sample,
            jnp.stack(mk_p), jnp.stack(mv_p), jnp.stack(pool_p), jnp.stack(sre_p), jnp.stack(sim_p),
            jnp.stack(pool_s), jnp.stack(sre_s), jnp.stack(sim_s))
```

```cpp
#include <hip/hip_runtime.h>
#include <hip/hip_cooperative_groups.h>
#include <cstdio>
#include <cstdint>
namespace cg = cooperative_groups;

#define LAS __attribute__((address_space(3)))
typedef unsigned short bf16_t;
typedef short bf16x8 __attribute__((ext_vector_type(8)));
typedef float f32x4 __attribute__((ext_vector_type(4)));
typedef float f32x2 __attribute__((ext_vector_type(2)));
typedef unsigned u32x4 __attribute__((ext_vector_type(4)));
typedef unsigned u32x2 __attribute__((ext_vector_type(2)));

constexpr int D = 1024, SEQ = 16384, NSAMP = 256, M = SEQ + NSAMP, DFF = 4096, DPOOL = 512, DSSM = 512;
constexpr int NG = 32, NP = 64, NH = 16, TC = 16, NCH = M / TC  , NCHP = 1280, KY = 384;
constexpr int NMEM = 256, HD = 256, NHEAD = 4;
constexpr float EPS = 1e-6f;
constexpr float QSCALE = 0.0625f * 1.4426950408889634f;

constexpr size_t O_Y = 0, O_MK = (size_t)M * D, O_MV = O_MK + 262144, O_POOLP = O_MV + 262144, O_SREP = O_POOLP + 7680, O_SIMP = O_SREP + 2048,
                 O_POOLS = O_SIMP + 2048, O_SRES = O_POOLS + 122880, O_SIMS = O_SRES + 32768, O_END = O_SIMS + 32768;

constexpr size_t MiB = 1u << 20;
constexpr size_t WS_WIN = 0, WS_WOUT = 2 * MiB, WS_WQ = 4 * MiB, WS_WKV = 6 * MiB, WS_WO = 10 * MiB, WS_WUP = 12 * MiB, WS_WDOWN = 20 * MiB,
                 WS_WGLU = 28 * MiB, WS_WPOOL = 28 * MiB + 512 * 1024, WS_MN = 29 * MiB, WS_KB = 29 * MiB + 512 * 1024, WS_VT = 30 * MiB,
                 WS_AP = 30 * MiB + 512 * 1024,
                 WS_BB = WS_AP + 320 * 1024,
                 WS_KLAG = WS_BB + 256 * 1024,
                 WS_SS = WS_KLAG + 512 * 1024,
                 WS_WB = 32 * MiB,
                 WS_WY = 36 * MiB,
                 WS_E = 42 * MiB,
                 WS_UH = 62 * MiB,
                 WS_ZP = 92 * MiB,
                 WS_T0 = 109 * MiB, WS_T1 = 142 * MiB, WS_T2 = 175 * MiB, WS_END = 208 * MiB,
                 WS_U = 42 * MiB;
static_assert(WS_SS + 3 * M * 4 <= WS_WB, "misc region");
static_assert(WS_U + (size_t)M * DFF * 2 <= WS_T2, "U overlay");

__device__ __forceinline__ unsigned f2bf(float f) { unsigned u = __builtin_bit_cast(unsigned, f); return (u + 0x7fffu + ((u >> 16) & 1u)) >> 16; }
__device__ __forceinline__ unsigned pk2(float lo, float hi) { return f2bf(lo) | (f2bf(hi) << 16); }
__device__ __forceinline__ float bf2f(unsigned b) { return __builtin_bit_cast(float, b << 16); }
__device__ __forceinline__ unsigned cvt_pk_bf16(float lo, float hi) { unsigned r; asm volatile("v_cvt_pk_bf16_f32 %0, %1, %2" : "=v"(r) : "v"(lo), "v"(hi)); return r; }
#define LDS_WAIT() asm volatile("s_waitcnt lgkmcnt(0)" ::: "memory")
__device__ __forceinline__ int lane_id() { int l; asm volatile("v_mbcnt_lo_u32_b32 %0, -1, 0\n\tv_mbcnt_hi_u32_b32 %0, -1, %0" : "=v"(l)); return l; }
__device__ __forceinline__ int tidx(int wv) { return wv * 64 + lane_id(); }
__device__ __forceinline__ float shfl_x(float v, int lane, int mask) { return __builtin_bit_cast(float, __builtin_amdgcn_ds_bpermute((lane ^ mask) << 2, __builtin_bit_cast(int, v))); }

namespace pg8 {
constexpr int BM = 256, BK = 64, HALF = 128, HTB = HALF * BK * 2, STAGE_BYTES = 8 * HTB, NXCD = 8, WGM = 8;
__host__ __device__ __forceinline__ int lds_byte(int r, int c) { const int st = (r >> 4) * 2 + (c >> 5), rr = r & 15, cc = c & 31, ob = rr * 64 + cc * 2; return st * 1024 + (ob ^ (((ob >> 9) & 1) << 5)); }
__host__ __device__ __forceinline__ void stage_rc(int b, int& R, int& C) { const int st = b / 1024, sb = b % 1024, swz = sb ^ (((sb >> 9) & 1) << 5); R = (st >> 1) * 16 + swz / 64; C = (st & 1) * 32 + (swz % 64) / 2; }
__host__ __device__ __forceinline__ int perm32(int rho) { const int n = rho >> 4, i = rho & 15; return 8 * (i >> 2) + 4 * n + (i & 3); }

struct Unit { int pm, pn, z; };
struct Gemm { const char* A; const char* B; int lda, ldb; size_t sAz, sBz; int K; };
struct Order {
    int nM, nN, nZ, G, c;
    __device__ void init(int nM_, int nN_, int nZ_, int G_, int c_) { nM = nM_; nN = nN_; nZ = nZ_; G = G_; c = c_; }
    __device__ bool next(int i, Unit& u) const {
        const int per = nM * nN, nwg = per * nZ; const long L = (long)i * G + c; if (L >= nwg) return false;
        int wgid = (int)L; { const int q = nwg / NXCD, r = nwg % NXCD, xcd = wgid % NXCD, off = wgid / NXCD; wgid = (xcd < r ? xcd * (q + 1) : r * (q + 1) + (xcd - r) * q) + off; }
        u.z = wgid / per; const int l = wgid % per;
        const int nig = WGM * nN, gid = l / nig, fm = gid * WGM, gsz = (nM - fm) < WGM ? (nM - fm) : WGM;
        u.pm = fm + ((l % nig) % gsz); u.pn = (l % nig) / gsz; return true;
    }
};

template <class Epi>
__device__ __forceinline__ void gemm_phase(LAS unsigned char* lds, const Gemm g, const Order& S, Epi& E, int wv) {
    const int tid = tidx(wv), wid = __builtin_amdgcn_readfirstlane(tid >> 6), lane = tid & 63, wr = wid >> 2, wc = wid & 3, fr = lane & 15, fq = lane >> 4;
    const int nt = g.K / BK;
    unsigned voffA[2], voffB[2];
#pragma unroll
    for (int i = 0; i < 2; ++i) { int R, C; stage_rc(tid * 16 + i * 8192, R, C); const int Rb = Epi::PERM ? ((R & ~31) + perm32(R & 31)) : R;
        voffA[i] = (unsigned)(R * g.lda + C) * 2u; voffB[i] = (unsigned)(Rb * g.ldb + C) * 2u; }
    const size_t kstep = (size_t)(BK * 2);
    const size_t hA = (size_t)HALF * g.lda * 2, hB = (size_t)HALF * g.ldb * 2;
    const unsigned ldsw = (unsigned)wid * 1024u;
    const int aoff = lds_byte(wr * 64 + fr, fq * 8), boff = lds_byte(wc * 32 + fr, fq * 8);
#define PG8_SA(b, h) (((b) * 2 + (h)) * HTB)
#define PG8_SB(b, h) ((4 + (b) * 2 + (h)) * HTB)
#define PG8_STAGE(bufoff, gbase, voff) do { _Pragma("unroll") for (int _i = 0; _i < 2; ++_i) \
        __builtin_amdgcn_global_load_lds((const unsigned*)((const char*)(gbase) + (voff)[_i]), (LAS unsigned*)(lds + (bufoff) + ldsw + _i * 8192), 16, 0, 0); } while (0)
#define PG8_LDA(dst, b, h) do { _Pragma("unroll") for (int m = 0; m < 4; ++m) _Pragma("unroll") for (int k = 0; k < 2; ++k) dst[m][k] = *(const LAS bf16x8*)(lds + PG8_SA(b, h) + aoff + m * 2048 + k * 1024); } while (0)
#define PG8_LDB(dst, b, h) do { _Pragma("unroll") for (int n = 0; n < 2; ++n) _Pragma("unroll") for (int k = 0; k < 2; ++k) dst[n][k] = *(const LAS bf16x8*)(lds + PG8_SB(b, h) + boff + n * 2048 + k * 1024); } while (0)
#define PG8_MMA(ai, bj, At, Bt) do { __builtin_amdgcn_s_setprio(1); _Pragma("unroll") for (int m = 0; m < 4; ++m) _Pragma("unroll") for (int n = 0; n < 2; ++n) _Pragma("unroll") for (int k = 0; k < 2; ++k) \
        acc[ai][bj][m][n] = __builtin_amdgcn_mfma_f32_16x16x32_bf16(Bt[n][k], At[m][k], acc[ai][bj][m][n], 0, 0, 0); __builtin_amdgcn_s_setprio(0); } while (0)
#define PG8_WAIT_V(n) asm volatile("s_waitcnt vmcnt(" #n ")" ::: "memory")
#define PG8_WAIT_L(n) asm volatile("s_waitcnt lgkmcnt(" #n ")" ::: "memory")
#define PG8_BAR __builtin_amdgcn_s_barrier()
#define PG8_SCHED __builtin_amdgcn_sched_barrier(0)
    Unit cur, nxt; int ui = 0;
    if (!S.next(0, cur)) return;
    f32x4 acc[2][2][4][2];
#pragma unroll
    for (int a = 0; a < 2; ++a)
#pragma unroll
        for (int b = 0; b < 2; ++b)
#pragma unroll
            for (int m = 0; m < 4; ++m)
#pragma unroll
                for (int n = 0; n < 2; ++n) acc[a][b][m][n] = (f32x4){0.f, 0.f, 0.f, 0.f};
    bf16x8 At[4][2], B0[2][2], B1[2][2];
    const char* cA = g.A + (size_t)cur.z * g.sAz + (size_t)cur.pm * 2 * hA; const char* cB = g.B + (size_t)cur.z * g.sBz + (size_t)cur.pn * 2 * hB;
    PG8_STAGE(PG8_SB(0, 0), cB, voffB); PG8_STAGE(PG8_SB(0, 1), cB + hB, voffB); PG8_STAGE(PG8_SA(0, 0), cA, voffA); PG8_STAGE(PG8_SA(0, 1), cA + hA, voffA);
    if (wr == 1) PG8_BAR;
    PG8_WAIT_V(2); PG8_BAR;
    PG8_STAGE(PG8_SB(1, 0), cB + kstep, voffB); PG8_STAGE(PG8_SA(1, 0), cA + kstep, voffA); PG8_STAGE(PG8_SB(1, 1), cB + hB + kstep, voffB);
    PG8_WAIT_V(6); PG8_BAR;
    for (;;) {
        const bool has_next = S.next(ui + 1, nxt);
        const char* nA = has_next ? g.A + (size_t)nxt.z * g.sAz + (size_t)nxt.pm * 2 * hA : cA; const char* nB = has_next ? g.B + (size_t)nxt.z * g.sBz + (size_t)nxt.pn * 2 * hB : cB;
        for (int t = 0; t < nt; t += 2) {
            const bool last = (t == nt - 2);
            const char* a1 = cA + (size_t)(t + 1) * kstep;
            const char* a2 = last ? nA : cA + (size_t)(t + 2) * kstep; const char* b2 = last ? nB : cB + (size_t)(t + 2) * kstep;
            const char* a3 = a2 + kstep; const char* b3 = b2 + kstep;
            PG8_LDB(B0, 0, 0); PG8_LDB(B1, 0, 1); PG8_SCHED; PG8_LDA(At, 0, 0); PG8_STAGE(PG8_SA(1, 1), a1 + hA, voffA);
            PG8_WAIT_V(8); PG8_WAIT_L(0); PG8_BAR; PG8_MMA(0, 0, At, B0); PG8_MMA(0, 1, At, B1); PG8_BAR; PG8_SCHED;
            PG8_LDA(At, 0, 1); PG8_STAGE(PG8_SB(0, 0), b2, voffB); PG8_STAGE(PG8_SB(0, 1), b2 + hB, voffB); PG8_STAGE(PG8_SA(0, 0), a2, voffA);
            PG8_WAIT_V(8); PG8_WAIT_L(0); PG8_BAR; PG8_MMA(1, 0, At, B0); PG8_MMA(1, 1, At, B1); PG8_BAR; PG8_SCHED;
            PG8_LDB(B0, 1, 0); PG8_LDB(B1, 1, 1); PG8_SCHED; PG8_LDA(At, 1, 0); PG8_STAGE(PG8_SA(0, 1), a2 + hA, voffA);
            PG8_WAIT_V(8); PG8_WAIT_L(0); PG8_BAR; PG8_MMA(0, 0, At, B0); PG8_MMA(0, 1, At, B1); PG8_BAR; PG8_SCHED;
            PG8_LDA(At, 1, 1); PG8_STAGE(PG8_SB(1, 0), b3, voffB); PG8_STAGE(PG8_SB(1, 1), b3 + hB, voffB); PG8_STAGE(PG8_SA(1, 0), a3, voffA);
            PG8_WAIT_V(8); PG8_WAIT_L(0); PG8_BAR; PG8_MMA(1, 0, At, B0); PG8_MMA(1, 1, At, B1); PG8_BAR; PG8_SCHED;
        }
        if (wr == 0) PG8_BAR;
        { Unit ue = cur; int fre = fr, fqe = fq;
          asm volatile("" : "+s"(ue.pm), "+s"(ue.pn), "+s"(ue.z), "+v"(fre), "+v"(fqe));
          E(acc, ue, wr, wc, fre, fqe); }
        if (!has_next) break;
#pragma unroll
        for (int a = 0; a < 2; ++a)
#pragma unroll
            for (int b = 0; b < 2; ++b)
#pragma unroll
                for (int m = 0; m < 4; ++m)
#pragma unroll
                    for (int n = 0; n < 2; ++n) acc[a][b][m][n] = (f32x4){0.f, 0.f, 0.f, 0.f};
        cur = nxt; cA = nA; cB = nB; ++ui;
        if (wr == 1) PG8_BAR;
    }
    PG8_WAIT_V(0);
    PG8_BAR;
#undef PG8_SA
#undef PG8_SB
#undef PG8_STAGE
#undef PG8_LDA
#undef PG8_LDB
#undef PG8_MMA
#undef PG8_WAIT_V
#undef PG8_WAIT_L
#undef PG8_BAR
#undef PG8_SCHED
}
}
using pg8::Unit;
typedef f32x4 Acc[2][2][4][2];

#define EPI_ROWS(ai, m) (u.pm * 256 + (ai) * 128 + wr * 64 + (m) * 16 + fr)
__device__ __forceinline__ bool mfence() { asm volatile("" ::: "memory"); return true; }
#define FOR_AI_M _Pragma("unroll") for (int ai = 0; ai < 2; ++ai) _Pragma("unroll") for (int m = 0; m < 4; ++m) if (mfence())
#define FOR_BJ _Pragma("unroll") for (int bj = 0; bj < 2; ++bj)
__device__ __forceinline__ u32x4 pack8(const f32x4 v0, const f32x4 v1) { u32x4 w; w.x = cvt_pk_bf16(v0[0], v0[1]); w.y = cvt_pk_bf16(v0[2], v0[3]); w.z = cvt_pk_bf16(v1[0], v1[1]); w.w = cvt_pk_bf16(v1[2], v1[3]); return w; }

struct EpiZ {
    static constexpr bool PERM = true;
    bf16_t* ZP; bf16_t* UH; float* out;
    __device__ __forceinline__ void operator()(Acc& acc, const Unit& u, int wr, int wc, int fr, int fq) const {
        FOR_AI_M { const int row = EPI_ROWS(ai, m);
            FOR_BJ { const int col = u.pn * 256 + bj * 128 + wc * 32 + 8 * fq; const f32x4 v0 = acc[ai][bj][m][0], v1 = acc[ai][bj][m][1]; const u32x4 w = pack8(v0, v1);
                if (col < DPOOL) {
                    *(u32x4*)(ZP + (size_t)row * DPOOL + col) = w;
                    float* dst = nullptr;
                    if (row >= SEQ - 15 && row < SEQ) dst = out + O_POOLP + (size_t)(row - (SEQ - 15)) * DPOOL + col;
                    else if (row >= SEQ && ((row & 15) != 0)) dst = out + O_POOLS + ((size_t)((row - SEQ) >> 4) * 15 + ((row & 15) - 1)) * DPOOL + col;
                    if (dst) { *(f32x4*)dst = v0; *(f32x4*)(dst + 4) = v1; }
                } else {
                    const int cc = col - DPOOL, gg = cc >> 4, hh = cc & 15;
                    *(u32x4*)(UH + ((size_t)gg * NCHP + (row >> 4)) * KY + (row & 15) * 16 + hh) = w;
                } } }
    }
};
struct EpiKV {
    static constexpr bool PERM = false;
    float* out; bf16_t* KB; bf16_t* VT;
    __device__ __forceinline__ void operator()(Acc& acc, const Unit& u, int wr, int wc, int fr, int fq) const {
        FOR_AI_M { const int row = EPI_ROWS(ai, m);
            FOR_BJ {
#pragma unroll
                for (int n = 0; n < 2; ++n) { const int col = u.pn * 256 + bj * 128 + wc * 32 + 16 * n + 4 * fq; const f32x4 v = acc[ai][bj][m][n];
                    if (col < D) { *(f32x4*)(out + O_MK + (size_t)row * D + col) = v; u32x2 w; w.x = cvt_pk_bf16(v[0], v[1]); w.y = cvt_pk_bf16(v[2], v[3]); *(u32x2*)(KB + (size_t)row * D + col) = w; }
                    else { const int c2 = col - D; *(f32x4*)(out + O_MV + (size_t)row * D + c2) = v; } } }
            asm volatile("" ::: "memory"); }
    }
};
struct EpiE {
    static constexpr bool PERM = false;
    float* E;
    __device__ __forceinline__ void operator()(Acc& acc, const Unit& u, int wr, int wc, int fr, int fq) const {
        FOR_AI_M { const int row = EPI_ROWS(ai, m);
#pragma unroll
            for (int n = 0; n < 2; ++n) { const int col = wc * 32 + 16 * n + 4 * fq; *(f32x4*)(E + ((size_t)u.z * NCHP + row) * 128 + col) = acc[ai][0][m][n]; } }
    }
};
__device__ __forceinline__ float gelu_tanh(float x) {
    const float t = 0.7978845608028654f * (x + 0.044715f * x * x * x);
    const float e = __expf(-2.f * t);
    return x / (1.f + e);
}
struct EpiY {
    static constexpr bool PERM = true;
    bf16_t* MIX;
    __device__ __forceinline__ void operator()(Acc& acc, const Unit& u, int wr, int wc, int fr, int fq) const {
        FOR_AI_M { const int ch = EPI_ROWS(ai, m); if (ch < NCH) {
            FOR_BJ { const int col = bj * 128 + wc * 32 + 8 * fq, t = col >> 4, hh = col & 15; f32x4 v0 = acc[ai][bj][m][0], v1 = acc[ai][bj][m][1];
#pragma unroll
                for (int j = 0; j < 4; ++j) { v0[j] = gelu_tanh(v0[j]); v1[j] = gelu_tanh(v1[j]); }
                *(u32x4*)(MIX + (size_t)(ch * 16 + t) * D + DPOOL + u.z * 16 + hh) = pack8(v0, v1); } } }
    }
};
struct EpiPool {
    static constexpr bool PERM = true;
    bf16_t* CAT; const float* scale;
    __device__ __forceinline__ void operator()(Acc& acc, const Unit& u, int wr, int wc, int fr, int fq) const {
        FOR_BJ { const int col = u.pn * 256 + bj * 128 + wc * 32 + 8 * fq; const f32x4 s0 = *(const f32x4*)(scale + col), s1 = *(const f32x4*)(scale + col + 4);
            FOR_AI_M { const int row = EPI_ROWS(ai, m); *(u32x4*)(CAT + (size_t)row * D + col) = pack8(acc[ai][bj][m][0] * s0, acc[ai][bj][m][1] * s1); } }
    }
};
struct EpiGlu {
    static constexpr bool PERM = true;
    bf16_t* CAT; const bf16_t* MIX; const float* bias;
    __device__ __forceinline__ void operator()(Acc& acc, const Unit& u, int wr, int wc, int fr, int fq) const {
        FOR_BJ { const int col = u.pn * 256 + bj * 128 + wc * 32 + 8 * fq; const f32x4 b0 = *(const f32x4*)(bias + col), b1 = *(const f32x4*)(bias + col + 4);
            FOR_AI_M { const int row = EPI_ROWS(ai, m); const u32x4 yv = *(const u32x4*)(MIX + (size_t)row * D + DPOOL + col);
                f32x4 v0 = acc[ai][bj][m][0] + b0, v1 = acc[ai][bj][m][1] + b1; const unsigned yw[4] = {yv.x, yv.y, yv.z, yv.w};
#pragma unroll
                for (int j = 0; j < 4; ++j) { const float ya = bf2f(yw[j >> 1] >> ((j & 1) * 16) & 0xffffu), yb = bf2f(yw[2 + (j >> 1)] >> ((j & 1) * 16) & 0xffffu);
                    v0[j] = ya / (1.f + __expf(-v0[j])); v1[j] = yb / (1.f + __expf(-v1[j])); }
                *(u32x4*)(CAT + (size_t)row * D + DPOOL + col) = pack8(v0, v1); } }
    }
};
struct EpiRes {
    static constexpr bool PERM = false;
    const float* baseP; const float* baseS; float* out; bf16_t* Xb; float* SS;
    __device__ __forceinline__ void operator()(Acc& acc, const Unit& u, int wr, int wc, int fr, int fq) const {
        FOR_AI_M { const int row = EPI_ROWS(ai, m); const float* brow = (row < SEQ) ? baseP + (size_t)row * D : baseS + (size_t)(row - SEQ) * D; float ssq = 0.f;
            FOR_BJ {
#pragma unroll
                for (int n = 0; n < 2; ++n) { const int col = u.pn * 256 + bj * 128 + wc * 32 + 16 * n + 4 * fq; const f32x4 v = acc[ai][bj][m][n] + *(const f32x4*)(brow + col);
                    *(f32x4*)(out + (size_t)row * D + col) = v; ssq += (v[0] * v[0] + v[1] * v[1]) + (v[2] * v[2] + v[3] * v[3]);
                    if (Xb) { u32x2 w; w.x = cvt_pk_bf16(v[0], v[1]); w.y = cvt_pk_bf16(v[2], v[3]); *(u32x2*)(Xb + (size_t)row * D + col) = w; } } }
            ssq += shfl_x(ssq, fr + 16 * fq, 16); ssq += shfl_x(ssq, fr + 16 * fq, 32);
            if (fq == 0) atomicAdd(SS + row, ssq); }
    }
};
struct EpiQ {
    static constexpr bool PERM = true;
    bf16_t* Q; const float* SS;
    __device__ __forceinline__ void operator()(Acc& acc, const Unit& u, int wr, int wc, int fr, int fq) const {
        FOR_AI_M { const int row = EPI_ROWS(ai, m); const float rs = rsqrtf(SS[row] * (1.f / D) + EPS) * QSCALE;
            FOR_BJ { const int col = u.pn * 256 + bj * 128 + wc * 32 + 8 * fq; *(u32x4*)(Q + (size_t)row * D + col) = pack8(acc[ai][bj][m][0] * rs, acc[ai][bj][m][1] * rs); } }
    }
};
struct EpiSoftmax {
    static constexpr bool PERM = true;
    bf16_t* P; LAS float* tmax; LAS float* tsum;
    __device__ __forceinline__ void operator()(Acc& acc, const Unit& u, int wr, int wc, int fr, int fq) const {
        FOR_AI_M { float mx = -3.0e38f;
            FOR_BJ {
#pragma unroll
                for (int n = 0; n < 2; ++n) { const f32x4 v = acc[ai][bj][m][n]; mx = fmaxf(mx, fmaxf(fmaxf(v[0], v[1]), fmaxf(v[2], v[3]))); } }
            mx = fmaxf(mx, shfl_x(mx, fr + 16 * fq, 16)); mx = fmaxf(mx, shfl_x(mx, fr + 16 * fq, 32));
            if (fq == 0) tmax[(ai * 128 + wr * 64 + m * 16 + fr) * 4 + wc] = mx; }
        LDS_WAIT(); __builtin_amdgcn_s_barrier(); asm volatile("" ::: "memory");
        FOR_AI_M { const int r = ai * 128 + wr * 64 + m * 16 + fr; const f32x4 t = *(const LAS f32x4*)(tmax + r * 4); const float mx = fmaxf(fmaxf(t[0], t[1]), fmaxf(t[2], t[3])); float s = 0.f;
            FOR_BJ {
#pragma unroll
                for (int n = 0; n < 2; ++n) { f32x4 v = acc[ai][bj][m][n];
#pragma unroll
                    for (int j = 0; j < 4; ++j) { v[j] = __builtin_amdgcn_exp2f(v[j] - mx); s += v[j]; }
                    acc[ai][bj][m][n] = v; } }
            s += shfl_x(s, fr + 16 * fq, 16); s += shfl_x(s, fr + 16 * fq, 32);
            if (fq == 0) tsum[r * 4 + wc] = s; }
        LDS_WAIT(); __builtin_amdgcn_s_barrier(); asm volatile("" ::: "memory");
        FOR_AI_M { const int r = ai * 128 + wr * 64 + m * 16 + fr, row = u.pm * 256 + r; const f32x4 t = *(const LAS f32x4*)(tsum + r * 4); const float inv = 1.f / ((t[0] + t[1]) + (t[2] + t[3]));
            FOR_BJ { const int col = u.z * 256 + bj * 128 + wc * 32 + 8 * fq; *(u32x4*)(P + (size_t)row * D + col) = pack8(acc[ai][bj][m][0] * inv, acc[ai][bj][m][1] * inv); } }
    }
};
struct EpiO {
    static constexpr bool PERM = true;
    bf16_t* O;
    __device__ __forceinline__ void operator()(Acc& acc, const Unit& u, int wr, int wc, int fr, int fq) const {
        FOR_AI_M { const int row = EPI_ROWS(ai, m);
            FOR_BJ { const int col = u.z * 256 + bj * 128 + wc * 32 + 8 * fq; *(u32x4*)(O + (size_t)row * D + col) = pack8(acc[ai][bj][m][0], acc[ai][bj][m][1]); } }
    }
};
struct EpiUp {
    static constexpr bool PERM = true;
    bf16_t* U; const float* SS;
    __device__ __forceinline__ void operator()(Acc& acc, const Unit& u, int wr, int wc, int fr, int fq) const {
        FOR_AI_M { const int row = EPI_ROWS(ai, m); const float rs = rsqrtf(SS[row] * (1.f / D) + EPS);
            FOR_BJ { const int col = u.pn * 256 + bj * 128 + wc * 32 + 8 * fq; f32x4 v0 = acc[ai][bj][m][0] * rs, v1 = acc[ai][bj][m][1] * rs;
#pragma unroll
                for (int j = 0; j < 4; ++j) { const float a = fmaxf(v0[j], 0.f), b = fmaxf(v1[j], 0.f); v0[j] = a * a; v1[j] = b * b; }
                *(u32x4*)(U + (size_t)row * DFF + col) = pack8(v0, v1); } }
    }
};

struct Ctx {
    const float* in[33]; float* out; unsigned char* ws;
};
__device__ __forceinline__ float wave_sum(float v, int lane) {
#pragma unroll
    for (int o = 1; o < 64; o <<= 1) v += shfl_x(v, lane, o);
    return v;
}
__device__ __forceinline__ float wave_max(float v, int lane) {
#pragma unroll
    for (int o = 1; o < 64; o <<= 1) v = fmaxf(v, shfl_x(v, lane, o));
    return v;
}
__device__ __forceinline__ void transpose_item(const float* W, int ldw, int nblk, bf16_t* WT, int ldt, int row_off, int col_off, const float* ksc, LAS float* scr, int item, int lane) {
    const int kb = item / nblk, nb = item % nblk, k0 = 64 * kb, n0 = 32 * nb;
#pragma unroll 8
    for (int i = 0; i < 32; ++i) { const int kk = 2 * i + (lane >> 5); float v = W[(size_t)(k0 + kk) * ldw + n0 + (lane & 31)]; if (ksc) v *= ksc[k0 + kk]; scr[kk * 33 + (lane & 31)] = v; }
    LDS_WAIT(); asm volatile("" ::: "memory");
    const int c = lane & 7;
#pragma unroll
    for (int j = 0; j < 4; ++j) { const int n = (lane >> 3) + 8 * j; const LAS float* s = scr + (8 * c) * 33 + n;
        u32x4 o; o.x = pk2(s[0 * 33], s[1 * 33]); o.y = pk2(s[2 * 33], s[3 * 33]); o.z = pk2(s[4 * 33], s[5 * 33]); o.w = pk2(s[6 * 33], s[7 * 33]);
        *(u32x4*)(WT + (size_t)(row_off + n0 + n) * ldt + col_off + k0 + 8 * c) = o; }
    LDS_WAIT(); asm volatile("" ::: "memory");
}
__device__ __forceinline__ void rms_row_to_bf16(const float* xrow, const float* g, bf16_t* orow, int lane) {
    const f32x4* xr = (const f32x4*)xrow + lane; const f32x4* gr = (const f32x4*)g + lane;
    f32x4 v[4]; float s = 0.f;
#pragma unroll
    for (int j = 0; j < 4; ++j) { v[j] = xr[64 * j]; s += (v[j].x * v[j].x + v[j].y * v[j].y) + (v[j].z * v[j].z + v[j].w * v[j].w); }
    const float rs = rsqrtf(wave_sum(s, lane) * (1.f / D) + EPS);
    u32x2* o8 = (u32x2*)orow + lane;
#pragma unroll
    for (int j = 0; j < 4; ++j) { const f32x4 gg = gr[64 * j]; u32x2 w; w.x = pk2(v[j].x * rs * gg.x, v[j].y * rs * gg.y); w.y = pk2(v[j].z * rs * gg.z, v[j].w * rs * gg.w); o8[64 * j] = w; }
}

__device__ __forceinline__ void p0_prologue(const Ctx& C, LAS unsigned char* lds, int G, int bid, int wv) {
    const int tid = tidx(wv), lane = tid & 63, wave = tid >> 6;
    LAS float* scr = (LAS float*)(lds + wave * 16384);
    const int gw = bid * 8 + wave, NGW = G * 8;
    unsigned char* ws = C.ws;
    constexpr int I_SQ = 16 * 32, I_UP = 16 * 128, I_DN = 64 * 32, I_GLU = 8 * 16, I_PL = 4 * 2 * 4;
    constexpr int NIT = 6 * I_SQ + I_UP + I_DN + I_GLU + I_PL;
    for (int it = gw; it < NIT; it += NGW) {
        int r = it;
        if (r < I_SQ) { transpose_item(C.in[9], D, 32, (bf16_t*)(ws + WS_WIN), D, 0, 0, nullptr, scr, r, lane); continue; } r -= I_SQ;
        if (r < I_SQ) { transpose_item(C.in[22], D, 32, (bf16_t*)(ws + WS_WOUT), D, 0, 0, nullptr, scr, r, lane); continue; } r -= I_SQ;
        if (r < I_SQ) { transpose_item(C.in[25], D, 32, (bf16_t*)(ws + WS_WQ), D, 0, 0, C.in[23], scr, r, lane); continue; } r -= I_SQ;
        if (r < I_SQ) { transpose_item(C.in[26], D, 32, (bf16_t*)(ws + WS_WKV), D, 0, 0, nullptr, scr, r, lane); continue; } r -= I_SQ;
        if (r < I_SQ) { transpose_item(C.in[27], D, 32, (bf16_t*)(ws + WS_WKV), D, D, 0, nullptr, scr, r, lane); continue; } r -= I_SQ;
        if (r < I_SQ) { transpose_item(C.in[28], D, 32, (bf16_t*)(ws + WS_WO), D, 0, 0, nullptr, scr, r, lane); continue; } r -= I_SQ;
        if (r < I_UP) { transpose_item(C.in[30], DFF, 128, (bf16_t*)(ws + WS_WUP), D, 0, 0, C.in[29], scr, r, lane); continue; } r -= I_UP;
        if (r < I_DN) { transpose_item(C.in[31], D, 32, (bf16_t*)(ws + WS_WDOWN), DFF, 0, 0, nullptr, scr, r, lane); continue; } r -= I_DN;
        if (r < I_GLU) { transpose_item(C.in[20], DSSM, 16, (bf16_t*)(ws + WS_WGLU), DSSM, 0, 0, nullptr, scr, r, lane); continue; } r -= I_GLU;
        { const int gp = r / 8, rr = r % 8; transpose_item(C.in[10] + (size_t)gp * 128 * 128, 128, 4, (bf16_t*)(ws + WS_WPOOL), DPOOL, gp * 128, gp * 128, nullptr, scr, rr, lane); }
    }
    const int gt = bid * 512 + tid, NGT = G * 512;
    { bf16_t* WP = (bf16_t*)(ws + WS_WPOOL);
      for (int i = gt; i < 512 * 512 / 8; i += NGT) { const int n = i / 64, k = (i % 64) * 8; if ((n >> 7) != (k >> 7)) *(u32x4*)(WP + (size_t)n * DPOOL + k) = (u32x4){0u, 0u, 0u, 0u}; }
      float* SS = (float*)(ws + WS_SS); for (int i = gt; i < 3 * M; i += NGT) SS[i] = 0.f; }
    { bf16_t* H1 = (bf16_t*)(ws + WS_T0); bf16_t* MN = (bf16_t*)(ws + WS_MN);
      for (int m = gw; m < M + NMEM; m += NGW) {
          if (m < SEQ) rms_row_to_bf16(C.in[0] + (size_t)m * D, C.in[8], H1 + (size_t)m * D, lane);
          else if (m < M) rms_row_to_bf16(C.in[1] + (size_t)(m - SEQ) * D, C.in[8], H1 + (size_t)m * D, lane);
          else rms_row_to_bf16(C.in[7] + (size_t)(m - M) * D, C.in[24], MN + (size_t)(m - M) * D, lane); } }
    { float* AP = (float*)(ws + WS_AP); float* BB = (float*)(ws + WS_BB);
      for (int i = gt; i < NG * NP; i += NGT) { const int g = i / NP, p = i % NP;
          const float are = C.in[12][i], aim = C.in[13][i], dt = expf(C.in[19][g]);
          const float mag = expf(are * dt); float sn, cs; sincosf(aim * dt, &sn, &cs);
          const float abr = mag * cs, abi = mag * sn;
          float pr = 1.f, pi = 0.f;
          for (int k = 0; k <= 16; ++k) { AP[((size_t)(g * 17 + k) * NP + p) * 2] = pr; AP[((size_t)(g * 17 + k) * NP + p) * 2 + 1] = pi; const float nr = pr * abr - pi * abi, ni = pr * abi + pi * abr; pr = nr; pi = ni; }
          const float nr = abr - 1.f, ni = abi, den = are * are + aim * aim; const float cr = (nr * are + ni * aim) / den, ci = (ni * are - nr * aim) / den;
          for (int h = 0; h < NH; ++h) { const float br = C.in[14][(size_t)i * NH + h], bi = C.in[15][(size_t)i * NH + h];
              BB[((size_t)i * NH + h) * 2] = cr * br - ci * bi; BB[((size_t)i * NH + h) * 2 + 1] = cr * bi + ci * br; } } }
}
__device__ __forceinline__ void p1_pre(const Ctx& C, int G, int bid, int wv) {
    const int gt = bid * 512 + tidx(wv), NGT = G * 512; unsigned char* ws = C.ws;
    const float* AP = (const float*)(ws + WS_AP); const float* BB = (const float*)(ws + WS_BB); float* KL = (float*)(ws + WS_KLAG); bf16_t* WB = (bf16_t*)(ws + WS_WB);
    for (int i = gt; i < NG * 16 * 16 * 16; i += NGT) { const int hp = i & 15, h = (i >> 4) & 15, k = (i >> 8) & 15, g = i >> 12; float s = 0.f;
        for (int p = 0; p < NP; ++p) { const float cr = C.in[16][((size_t)g * NH + h) * NP + p], ci = C.in[17][((size_t)g * NH + h) * NP + p];
            const float ar = AP[((size_t)(g * 17 + k) * NP + p) * 2], ai = AP[((size_t)(g * 17 + k) * NP + p) * 2 + 1];
            const float br = BB[((size_t)(g * NP + p) * NH + hp) * 2], bi = BB[((size_t)(g * NP + p) * NH + hp) * 2 + 1];
            const float tr = ar * br - ai * bi, ti = ar * bi + ai * br; s += cr * tr - ci * ti; }
        if (k == 0 && h == hp) s += C.in[18][g * NH + h];
        KL[i] = s; }
    for (int i = gt; i < NG * 256 * 256; i += NGT) { const int k = i & 255, n = (i >> 8) & 255, g = i >> 16; float v = 0.f;
        if (n < 128) { const int p = n & 63, s = k >> 4, hp = k & 15; const float ar = AP[((size_t)(g * 17 + 15 - s) * NP + p) * 2], ai = AP[((size_t)(g * 17 + 15 - s) * NP + p) * 2 + 1];
            const float br = BB[((size_t)(g * NP + p) * NH + hp) * 2], bi = BB[((size_t)(g * NP + p) * NH + hp) * 2 + 1];
            v = (n < 64) ? (ar * br - ai * bi) : (ar * bi + ai * br); }
        WB[i] = (bf16_t)f2bf(v); }
}
__device__ __forceinline__ void p2a_pre(const Ctx& C, int G, int bid, int wv) {
    const int gt = bid * 512 + tidx(wv), NGT = G * 512; unsigned char* ws = C.ws;
    const float* AP = (const float*)(ws + WS_AP); const float* KL = (const float*)(ws + WS_KLAG); bf16_t* WY = (bf16_t*)(ws + WS_WY);
    for (int i = gt; i < NG * 256 * KY; i += NGT) { const int k = i % KY, n = (i / KY) & 255, g = i / (KY * 256), t = n >> 4, h = n & 15; float v = 0.f;
        if (k < 256) { const int s = k >> 4, hp = k & 15; if (s <= t) v = KL[(((size_t)g * 16 + (t - s)) * 16 + h) * 16 + hp]; }
        else { const int p = (k - 256) & 63; const float cr = C.in[16][((size_t)g * NH + h) * NP + p], ci = C.in[17][((size_t)g * NH + h) * NP + p];
            const float ar = AP[((size_t)(g * 17 + t + 1) * NP + p) * 2], ai = AP[((size_t)(g * 17 + t + 1) * NP + p) * 2 + 1];
            v = (k < 320) ? (cr * ar - ci * ai) : -(cr * ai + ci * ar); }
        WY[i] = (bf16_t)f2bf(v); }
    { const float* MV = C.out + O_MV; bf16_t* VT = (bf16_t*)(ws + WS_VT);
      for (int i = gt; i < D * NMEM; i += NGT) { const int c = i >> 8, n = i & 255; VT[i] = (bf16_t)f2bf(MV[(size_t)n * D + c]); } }
}
__device__ __forceinline__ void p2b_prefix(const Ctx& C, LAS unsigned char* lds, int g, int wv) {
    const int tid = tidx(wv), p = tid & 63, seg = tid >> 6; unsigned char* ws = C.ws;
    const float* AP = (const float*)(ws + WS_AP); const float* E = (const float*)(ws + WS_E) + (size_t)g * NCHP * 128; bf16_t* UH = (bf16_t*)(ws + WS_UH) + (size_t)g * NCHP * KY;
    LAS float* L = (LAS float*)lds;
    const float ar = AP[((size_t)(g * 17 + 16) * NP + p) * 2], ai = AP[((size_t)(g * 17 + 16) * NP + p) * 2 + 1];
    float hr = 0.f, hi = 0.f; const int c0 = seg * 128;
    for (int c = c0; c < c0 + 128; c += 8) { float er[8], ei[8];
#pragma unroll
        for (int j = 0; j < 8; ++j) { er[j] = E[(size_t)(c + j) * 128 + p]; ei[j] = E[(size_t)(c + j) * 128 + 64 + p]; }
#pragma unroll
        for (int j = 0; j < 8; ++j) { const float nr = ar * hr - ai * hi + er[j], ni = ar * hi + ai * hr + ei[j]; hr = nr; hi = ni; } }
    L[(seg * 64 + p) * 2] = hr; L[(seg * 64 + p) * 2 + 1] = hi;
    float sr = ar, si = ai;
#pragma unroll
    for (int j = 0; j < 7; ++j) { const float nr = sr * sr - si * si, ni = 2.f * sr * si; sr = nr; si = ni; }
    __syncthreads();
    hr = 0.f; hi = 0.f;
    for (int j = 0; j < seg; ++j) { const float lr = L[(j * 64 + p) * 2], li = L[(j * 64 + p) * 2 + 1]; const float nr = sr * hr - si * hi + lr, ni = sr * hi + si * hr + li; hr = nr; hi = ni; }
    for (int c = c0; c < c0 + 128; c += 8) { float er[8], ei[8];
#pragma unroll
        for (int j = 0; j < 8; ++j) { er[j] = E[(size_t)(c + j) * 128 + p]; ei[j] = E[(size_t)(c + j) * 128 + 64 + p]; }
#pragma unroll
        for (int j = 0; j < 8; ++j) { UH[(size_t)(c + j) * KY + 256 + p] = (bf16_t)f2bf(hr); UH[(size_t)(c + j) * KY + 320 + p] = (bf16_t)f2bf(hi);
            const float nr = ar * hr - ai * hi + er[j], ni = ar * hi + ai * hr + ei[j]; hr = nr; hi = ni; } }
    if (seg == 7) { C.out[O_SREP + g * NP + p] = hr; C.out[O_SIMP + g * NP + p] = hi; }
    for (int b = seg; b < 16; b += 8) { const float h0r = C.in[5][((size_t)b * NG + g) * NP + p], h0i = C.in[6][((size_t)b * NG + g) * NP + p]; const int c = 1024 + b;
        UH[(size_t)c * KY + 256 + p] = (bf16_t)f2bf(h0r); UH[(size_t)c * KY + 320 + p] = (bf16_t)f2bf(h0i);
        C.out[O_SRES + ((size_t)b * NG + g) * NP + p] = ar * h0r - ai * h0i + E[(size_t)c * 128 + p];
        C.out[O_SIMS + ((size_t)b * NG + g) * NP + p] = ar * h0i + ai * h0r + E[(size_t)c * 128 + 64 + p]; }
    __syncthreads();
}
__device__ __forceinline__ void p2b_pool(const Ctx& C, int worker, int nworkers, int wv) {
    const int tid = tidx(wv), sub = tid >> 6, cl = (tid & 63) * 8; unsigned char* ws = C.ws;
    const bf16_t* ZP = (const bf16_t*)(ws + WS_ZP); bf16_t* MIX = (bf16_t*)(ws + WS_T1);
    const int w = 2 << (cl >> 7);
    for (int blk = worker * 8 + sub; blk < NCH; blk += nworkers * 8) { const int r0 = blk * 16; const bool samp = r0 >= SEQ; const int b = (r0 - SEQ) >> 4;
        for (int t = 0; t < 16; ++t) { const int row = r0 + t; float s[8] = {0.f, 0.f, 0.f, 0.f, 0.f, 0.f, 0.f, 0.f}; float cur[8];
            for (int j = 0; j < w; ++j) { const int rr = row - j; float v[8];
                if (!samp) { if (rr < 0) break; const u32x4 q = *(const u32x4*)(ZP + (size_t)rr * DPOOL + cl); const unsigned qq[4] = {q.x, q.y, q.z, q.w};
#pragma unroll
                    for (int e = 0; e < 8; ++e) v[e] = bf2f((qq[e >> 1] >> ((e & 1) * 16)) & 0xffffu); }
                else if (t - j >= 0) { const u32x4 q = *(const u32x4*)(ZP + (size_t)rr * DPOOL + cl); const unsigned qq[4] = {q.x, q.y, q.z, q.w};
#pragma unroll
                    for (int e = 0; e < 8; ++e) v[e] = bf2f((qq[e >> 1] >> ((e & 1) * 16)) & 0xffffu); }
                else { const float* hp = C.in[4] + ((size_t)b * 15 + (15 + t - j)) * DPOOL + cl; const f32x4 a = *(const f32x4*)hp, bb = *(const f32x4*)(hp + 4);
                    v[0] = a[0]; v[1] = a[1]; v[2] = a[2]; v[3] = a[3]; v[4] = bb[0]; v[5] = bb[1]; v[6] = bb[2]; v[7] = bb[3]; }
#pragma unroll
                for (int e = 0; e < 8; ++e) { s[e] += v[e]; if (j == 0) cur[e] = v[e]; } }
            const int cnt = samp ? w : ((row + 1 < w) ? row + 1 : w); const float inv = 1.f / (float)cnt;
            u32x4 o; o.x = pk2(s[0] * inv - cur[0], s[1] * inv - cur[1]); o.y = pk2(s[2] * inv - cur[2], s[3] * inv - cur[3]); o.z = pk2(s[4] * inv - cur[4], s[5] * inv - cur[5]); o.w = pk2(s[6] * inv - cur[6], s[7] * inv - cur[7]);
            *(u32x4*)(MIX + (size_t)row * D + cl) = o; } }
}
__device__ __forceinline__ void sample_attn_item(const Ctx& C, LAS unsigned char* lds, int item, int wv) {
    const int tid = tidx(wv), lane = tid & 63, wave = tid >> 6, fr = lane & 15, fq = lane >> 4; const int b = item >> 2, h = item & 3; unsigned char* ws = C.ws;
    const bf16_t* Q = (const bf16_t*)(ws + WS_T1); bf16_t* O = (bf16_t*)(ws + WS_T0);
    const float* Kc = C.in[2] + (size_t)b * NMEM * D + h * HD; const float* Vc = C.in[3] + (size_t)b * NMEM * D + h * HD;
    LAS float* Sl = (LAS float*)lds;
    LAS float* PT = (LAS float*)(lds + 16384);
    bf16x8 qf[8];
#pragma unroll
    for (int kk = 0; kk < 8; ++kk) qf[kk] = *(const bf16x8*)(Q + (size_t)(SEQ + b * 16 + fr) * D + h * HD + kk * 32 + fq * 8);
#pragma unroll
    for (int kbi = 0; kbi < 2; ++kbi) { const int kb = wave + 8 * kbi; f32x4 acc = {0.f, 0.f, 0.f, 0.f}; const float* kr = Kc + (size_t)(kb * 16 + fr) * D + fq * 8;
#pragma unroll
        for (int kk = 0; kk < 8; ++kk) { const f32x4 a = *(const f32x4*)(kr + kk * 32), c = *(const f32x4*)(kr + kk * 32 + 4); const u32x4 w = pack8(a, c);
            acc = __builtin_amdgcn_mfma_f32_16x16x32_bf16(qf[kk], __builtin_bit_cast(bf16x8, w), acc, 0, 0, 0); }
#pragma unroll
        for (int r = 0; r < 4; ++r) Sl[(4 * fq + r) * 256 + kb * 16 + fr] = acc[r]; }
    __syncthreads();
#pragma unroll
    for (int rr = 0; rr < 2; ++rr) { const int s = wave * 2 + rr; float v[4]; float mx = -3.0e38f;
#pragma unroll
        for (int j = 0; j < 4; ++j) { v[j] = Sl[s * 256 + lane + 64 * j]; mx = fmaxf(mx, v[j]); }
        mx = wave_max(mx, lane); float sum = 0.f;
#pragma unroll
        for (int j = 0; j < 4; ++j) { v[j] = __builtin_amdgcn_exp2f(v[j] - mx); sum += v[j]; }
        const float inv = 1.f / wave_sum(sum, lane);
#pragma unroll
        for (int j = 0; j < 4; ++j) PT[(lane + 64 * j) * 16 + s] = v[j] * inv; }
    __syncthreads();
    { const int d = tid & 255, sh = tid >> 8; float o[8] = {0.f, 0.f, 0.f, 0.f, 0.f, 0.f, 0.f, 0.f};
#pragma unroll 8
      for (int n = 0; n < NMEM; ++n) { const float v = Vc[(size_t)n * D + d]; const f32x4 p0 = *(const LAS f32x4*)(PT + n * 16 + sh * 8), p1 = *(const LAS f32x4*)(PT + n * 16 + sh * 8 + 4);
          o[0] += p0[0] * v; o[1] += p0[1] * v; o[2] += p0[2] * v; o[3] += p0[3] * v; o[4] += p1[0] * v; o[5] += p1[1] * v; o[6] += p1[2] * v; o[7] += p1[3] * v; }
#pragma unroll
      for (int e = 0; e < 8; ++e) O[(size_t)(SEQ + b * 16 + sh * 8 + e) * D + h * HD + d] = (bf16_t)f2bf(o[e]); }
    __syncthreads();
}

#ifndef PHMASK
#define PHMASK 0xFFFF
#endif
#define PH(k) if constexpr (((PHMASK) >> (k)) & 1)
constexpr int LDS_BYTES = 131072 + 8192 + 1024;
__global__ void __launch_bounds__(512, 2) fwd_megakernel(Ctx C) {
    extern __shared__ __attribute__((aligned(16))) unsigned char lds_raw[];
    LAS unsigned char* lds = (LAS unsigned char*)lds_raw;
    cg::grid_group grid = cg::this_grid();
    const int wv = __builtin_amdgcn_readfirstlane((int)threadIdx.x >> 6);
    const int G = gridDim.x, bid = blockIdx.x; unsigned char* ws = C.ws;
    bf16_t* T0 = (bf16_t*)(ws + WS_T0); bf16_t* T1 = (bf16_t*)(ws + WS_T1); bf16_t* T2 = (bf16_t*)(ws + WS_T2);
    float* SS1 = (float*)(ws + WS_SS); float* SS2 = SS1 + M; float* SS3 = SS2 + M;
    float* Y = C.out + O_Y;
    pg8::Order S;

    p0_prologue(C, lds, G, bid, wv);
    grid.sync();

    p1_pre(C, G, bid, wv);
    PH(0) { pg8::Gemm g{(const char*)T0, (const char*)(ws + WS_WIN), D, D, 0, 0, D}; S.init(M / 256, 4, 1, G, bid);
      EpiZ E{(bf16_t*)(ws + WS_ZP), (bf16_t*)(ws + WS_UH), C.out}; pg8::gemm_phase(lds, g, S, E, wv); }
    PH(1) { pg8::Gemm g{(const char*)(ws + WS_MN), (const char*)(ws + WS_WKV), D, D, 0, 0, D}; S.init(1, 8, 1, G, (bid + G - (260 % G)) % G);
      EpiKV E{C.out, (bf16_t*)(ws + WS_KB), (bf16_t*)(ws + WS_VT)}; pg8::gemm_phase(lds, g, S, E, wv); }
    grid.sync();

    p2a_pre(C, G, bid, wv);
    PH(2) { pg8::Gemm g{(const char*)(ws + WS_UH), (const char*)(ws + WS_WB), KY, 256, (size_t)NCHP * KY * 2, (size_t)256 * 256 * 2, 256}; S.init(NCHP / 256, 1, NG, G, bid);
      EpiE E{(float*)(ws + WS_E)}; pg8::gemm_phase(lds, g, S, E, wv); }
    grid.sync();

    if (bid < NG) p2b_prefix(C, lds, bid, wv);
    if (G > NG) { if (bid >= NG) p2b_pool(C, bid - NG, G - NG, wv); } else p2b_pool(C, bid, G, wv);
    grid.sync();

    PH(3) { pg8::Gemm g{(const char*)(ws + WS_UH), (const char*)(ws + WS_WY), KY, KY, (size_t)NCHP * KY * 2, (size_t)256 * KY * 2, KY}; S.init(NCHP / 256, 1, NG, G, bid);
      EpiY E{T1}; pg8::gemm_phase(lds, g, S, E, wv); }
    PH(4) { pg8::Gemm g{(const char*)T1, (const char*)(ws + WS_WPOOL), D, DPOOL, 0, 0, DPOOL}; S.init(M / 256, 2, 1, G, (bid + G - (160 % G)) % G);
      EpiPool E{T2, C.in[11]}; pg8::gemm_phase(lds, g, S, E, wv); }
    grid.sync();

    PH(5) { pg8::Gemm g{(const char*)(T1 + DPOOL), (const char*)(ws + WS_WGLU), D, DSSM, 0, 0, DSSM}; S.init(M / 256, 2, 1, G, bid);
      EpiGlu E{T2, T1, C.in[21]}; pg8::gemm_phase(lds, g, S, E, wv); }
    grid.sync();

    PH(6) { pg8::Gemm g{(const char*)T2, (const char*)(ws + WS_WOUT), D, D, 0, 0, D}; S.init(M / 256, 4, 1, G, bid);
      EpiRes E{C.in[0], C.in[1], Y, T0, SS1}; pg8::gemm_phase(lds, g, S, E, wv); }
    grid.sync();

    PH(7) { pg8::Gemm g{(const char*)T0, (const char*)(ws + WS_WQ), D, D, 0, 0, D}; S.init(M / 256, 4, 1, G, bid);
      EpiQ E{T1, SS1}; pg8::gemm_phase(lds, g, S, E, wv); }
    grid.sync();

    PH(8) { pg8::Gemm g{(const char*)T1, (const char*)(ws + WS_KB), D, D, (size_t)HD * 2, (size_t)HD * 2, HD}; S.init(SEQ / 256, 1, NHEAD, G, bid);
      EpiSoftmax E{T2, (LAS float*)(lds + 131072), (LAS float*)(lds + 131072 + 4096)}; pg8::gemm_phase(lds, g, S, E, wv); }
    for (int it = bid; it < 64; it += G) sample_attn_item(C, lds, it, wv);
    grid.sync();

    PH(9) { pg8::Gemm g{(const char*)T2, (const char*)(ws + WS_VT), D, NMEM, (size_t)HD * 2, (size_t)HD * NMEM * 2, NMEM}; S.init(SEQ / 256, 1, NHEAD, G, bid);
      EpiO E{T0}; pg8::gemm_phase(lds, g, S, E, wv); }
    grid.sync();

    PH(10) { pg8::Gemm g{(const char*)T0, (const char*)(ws + WS_WO), D, D, 0, 0, D}; S.init(M / 256, 4, 1, G, bid);
      EpiRes E{Y, Y + (size_t)SEQ * D, Y, T2, SS2}; pg8::gemm_phase(lds, g, S, E, wv); }
    grid.sync();

    PH(11) { pg8::Gemm g{(const char*)T2, (const char*)(ws + WS_WUP), D, D, 0, 0, D}; S.init(M / 256, DFF / 256, 1, G, bid);
      EpiUp E{(bf16_t*)(ws + WS_U), SS2}; pg8::gemm_phase(lds, g, S, E, wv); }
    grid.sync();

    PH(12) { pg8::Gemm g{(const char*)(ws + WS_U), (const char*)(ws + WS_WDOWN), DFF, DFF, 0, 0, DFF}; S.init(M / 256, 4, 1, G, bid);
      EpiRes E{Y, Y + (size_t)SEQ * D, Y, nullptr, SS3}; pg8::gemm_phase(lds, g, S, E, wv); }
    grid.sync();

    { const int lane = tidx(wv) & 63, gw = bid * 8 + (tidx(wv) >> 6), NGW = G * 8; const f32x4* gr = (const f32x4*)C.in[32] + lane;
      for (int m = gw; m < M; m += NGW) { const float rs = rsqrtf(SS3[m] * (1.f / D) + EPS); f32x4* xr = (f32x4*)(Y + (size_t)m * D) + lane;
#pragma unroll
          for (int j = 0; j < 4; ++j) { const f32x4 v = xr[64 * j], gg = gr[64 * j]; xr[64 * j] = (f32x4){v.x * rs * gg.x, v.y * rs * gg.y, v.z * rs * gg.z, v.w * rs * gg.w}; } } }
}

extern "C" void kernel_launch(void* const* d_in, const int* in_sizes, int n_in, void* d_out, int out_size, void* d_ws, size_t ws_size, hipStream_t stream) {
    static int grid = 0;
    if (grid == 0) {
        if (n_in != 33 || (size_t)out_size != O_END || ws_size < WS_END) { fprintf(stderr, "kernel_launch: unexpected shapes n_in %d out %d ws %zu\n", n_in, out_size, ws_size); grid = -1; return; }
        int dev = 0, cus = 0, per_cu = 0;
        hipGetDevice(&dev); hipDeviceGetAttribute(&cus, hipDeviceAttributeMultiprocessorCount, dev);
        if (hipFuncSetAttribute((const void*)fwd_megakernel, hipFuncAttributeMaxDynamicSharedMemorySize, LDS_BYTES) != hipSuccess) { fprintf(stderr, "kernel_launch: hipFuncSetAttribute failed\n"); grid = -1; return; }
        if (hipOccupancyMaxActiveBlocksPerMultiprocessor(&per_cu, (const void*)fwd_megakernel, 512, LDS_BYTES) != hipSuccess || per_cu < 1) { fprintf(stderr, "kernel_launch: occupancy query failed (%d)\n", per_cu); (void)hipGetLastError(); per_cu = 1; }
        if (per_cu > 1) per_cu = 1;
        grid = cus * per_cu; if (grid > 256) grid = 256;
    }
    if (grid < 0) return;
    Ctx c{};
    for (int i = 0; i < 33; ++i) c.in[i] = (const float*)d_in[i];
    c.out = (float*)d_out; c.ws = (unsigned char*)d_ws;
    void* args[] = {&c};
    hipError_t e = hipLaunchCooperativeKernel((const void*)fwd_megakernel, dim3(grid), dim3(512), args, LDS_BYTES, stream);
    if (e != hipSuccess) fprintf(stderr, "cooperative launch failed: %s (grid %d)\n", hipGetErrorString(e), grid);
}
```

```cpp
#include <hip/hip_runtime.h>
#include <hip/hip_cooperative_groups.h>
#include <cstdio>
#include <cstdint>
namespace cg = cooperative_groups;

#define LAS __attribute__((address_space(3)))
typedef unsigned short bf16_t;
typedef short bf16x8 __attribute__((ext_vector_type(8)));
typedef float f32x4 __attribute__((ext_vector_type(4)));
typedef float f32x2 __attribute__((ext_vector_type(2)));
typedef unsigned u32x4 __attribute__((ext_vector_type(4)));
typedef unsigned u32x2 __attribute__((ext_vector_type(2)));

constexpr int D = 1024, SEQ = 16384, NSAMP = 256, M = SEQ + NSAMP, DFF = 4096, DPOOL = 512, DSSM = 512;
constexpr int NG = 32, NP = 64, NH = 16, TC = 16, NCH = M / TC  , NCHP = 1280, KY = 384;
constexpr int NMEM = 256, HD = 256, NHEAD = 4;
constexpr float EPS = 1e-6f;
constexpr float QSCALE = 0.0625f * 1.4426950408889634f;

constexpr size_t O_Y = 0, O_MK = (size_t)M * D, O_MV = O_MK + 262144, O_POOLP = O_MV + 262144, O_SREP = O_POOLP + 7680, O_SIMP = O_SREP + 2048,
                 O_POOLS = O_SIMP + 2048, O_SRES = O_POOLS + 122880, O_SIMS = O_SRES + 32768, O_END = O_SIMS + 32768;

constexpr size_t MiB = 1u << 20;
constexpr size_t WS_WIN = 0, WS_WOUT = 2 * MiB, WS_WQ = 4 * MiB, WS_WKV = 6 * MiB, WS_WO = 10 * MiB, WS_WUP = 12 * MiB, WS_WDOWN = 20 * MiB,
                 WS_WGLU = 28 * MiB, WS_WPOOL = 28 * MiB + 512 * 1024, WS_MN = 29 * MiB, WS_KB = 29 * MiB + 512 * 1024, WS_VT = 30 * MiB,
                 WS_AP = 30 * MiB + 512 * 1024,
                 WS_BB = WS_AP + 320 * 1024,
                 WS_KLAG = WS_BB + 256 * 1024,
                 WS_SS = WS_KLAG + 512 * 1024,
                 WS_BAR = 32 * MiB - 128 * 1024,
                 WS_WB = 32 * MiB,
                 WS_WY = 36 * MiB,
                 WS_E = 42 * MiB,
                 WS_UH = 62 * MiB,
                 WS_ZP = 92 * MiB,
                 WS_T0 = 109 * MiB, WS_T1 = 142 * MiB, WS_T2 = 175 * MiB, WS_END = 208 * MiB,
                 WS_U = 42 * MiB;
static_assert(WS_SS + 3 * M * 4 <= WS_BAR, "misc region");
static_assert(WS_U + (size_t)M * DFF * 2 <= WS_T2, "U overlay");

__device__ __forceinline__ unsigned f2bf(float f) { unsigned u = __builtin_bit_cast(unsigned, f); return (u + 0x7fffu + ((u >> 16) & 1u)) >> 16; }
__device__ __forceinline__ unsigned pk2(float lo, float hi) { return f2bf(lo) | (f2bf(hi) << 16); }
__device__ __forceinline__ float bf2f(unsigned b) { return __builtin_bit_cast(float, b << 16); }
__device__ __forceinline__ unsigned cvt_pk_bf16(float lo, float hi) { unsigned r; asm volatile("v_cvt_pk_bf16_f32 %0, %1, %2" : "=v"(r) : "v"(lo), "v"(hi)); return r; }
#define LDS_WAIT() asm volatile("s_waitcnt lgkmcnt(0)" ::: "memory")
__device__ __forceinline__ int lane_id() { int l; asm volatile("v_mbcnt_lo_u32_b32 %0, -1, 0\n\tv_mbcnt_hi_u32_b32 %0, -1, %0" : "=v"(l)); return l; }
__device__ __forceinline__ int tidx(int wv) { return wv * 64 + lane_id(); }
__device__ __forceinline__ float shfl_x(float v, int lane, int mask) { return __builtin_bit_cast(float, __builtin_amdgcn_ds_bpermute((lane ^ mask) << 2, __builtin_bit_cast(int, v))); }

namespace pg8 {
constexpr int BM = 256, BK = 64, HALF = 128, HTB = HALF * BK * 2, STAGE_BYTES = 8 * HTB, NXCD = 8, WGM = 8;
__host__ __device__ __forceinline__ int lds_byte(int r, int c) { const int st = (r >> 4) * 2 + (c >> 5), rr = r & 15, cc = c & 31, ob = rr * 64 + cc * 2; return st * 1024 + (ob ^ (((ob >> 9) & 1) << 5)); }
__host__ __device__ __forceinline__ void stage_rc(int b, int& R, int& C) { const int st = b / 1024, sb = b % 1024, swz = sb ^ (((sb >> 9) & 1) << 5); R = (st >> 1) * 16 + swz / 64; C = (st & 1) * 32 + (swz % 64) / 2; }
__host__ __device__ __forceinline__ int perm32(int rho) { const int n = rho >> 4, i = rho & 15; return 8 * (i >> 2) + 4 * n + (i & 3); }

struct Unit { int pm, pn, z; };
struct Gemm { const char* A; const char* B; int lda, ldb; size_t sAz, sBz; int K; };
struct Order {
    int nM, nN, nZ, G, c;
    __device__ void init(int nM_, int nN_, int nZ_, int G_, int c_) { nM = nM_; nN = nN_; nZ = nZ_; G = G_; c = c_; }
    __device__ bool next(int i, Unit& u) const {
        const int per = nM * nN, nwg = per * nZ; const long L = (long)i * G + c; if (L >= nwg) return false;
        int wgid = (int)L; { const int q = nwg / NXCD, r = nwg % NXCD, xcd = wgid % NXCD, off = wgid / NXCD; wgid = (xcd < r ? xcd * (q + 1) : r * (q + 1) + (xcd - r) * q) + off; }
        u.z = wgid / per; const int l = wgid % per;
        const int nig = WGM * nN, gid = l / nig, fm = gid * WGM, gsz = (nM - fm) < WGM ? (nM - fm) : WGM;
        u.pm = fm + ((l % nig) % gsz); u.pn = (l % nig) / gsz; return true;
    }
};

template <class Epi>
__device__ __forceinline__ void gemm_phase(LAS unsigned char* lds, const Gemm g, const Order& S, Epi& E, int wv) {
    const int tid = tidx(wv), wid = __builtin_amdgcn_readfirstlane(tid >> 6), lane = tid & 63, wr = wid >> 2, wc = wid & 3, fr = lane & 15, fq = lane >> 4;
    const int nt = g.K / BK;
    unsigned voffA[2], voffB[2];
#pragma unroll
    for (int i = 0; i < 2; ++i) { int R, C; stage_rc(tid * 16 + i * 8192, R, C); const int Rb = Epi::PERM ? ((R & ~31) + perm32(R & 31)) : R;
        voffA[i] = (unsigned)(R * g.lda + C) * 2u; voffB[i] = (unsigned)(Rb * g.ldb + C) * 2u; }
    const size_t kstep = (size_t)(BK * 2);
    const size_t hA = (size_t)HALF * g.lda * 2, hB = (size_t)HALF * g.ldb * 2;
    const unsigned ldsw = (unsigned)wid * 1024u;
    const int aoff = lds_byte(wr * 64 + fr, fq * 8), boff = lds_byte(wc * 32 + fr, fq * 8);
#define PG8_SA(b, h) (((b) * 2 + (h)) * HTB)
#define PG8_SB(b, h) ((4 + (b) * 2 + (h)) * HTB)
#define PG8_STAGE(bufoff, gbase, voff) do { _Pragma("unroll") for (int _i = 0; _i < 2; ++_i) \
        __builtin_amdgcn_global_load_lds((const unsigned*)((const char*)(gbase) + (voff)[_i]), (LAS unsigned*)(lds + (bufoff) + ldsw + _i * 8192), 16, 0, 0); } while (0)
#define PG8_LDA(dst, b, h) do { _Pragma("unroll") for (int m = 0; m < 4; ++m) _Pragma("unroll") for (int k = 0; k < 2; ++k) dst[m][k] = *(const LAS bf16x8*)(lds + PG8_SA(b, h) + aoff + m * 2048 + k * 1024); } while (0)
#define PG8_LDB(dst, b, h) do { _Pragma("unroll") for (int n = 0; n < 2; ++n) _Pragma("unroll") for (int k = 0; k < 2; ++k) dst[n][k] = *(const LAS bf16x8*)(lds + PG8_SB(b, h) + boff + n * 2048 + k * 1024); } while (0)
#define PG8_MMA(ai, bj, At, Bt) do { __builtin_amdgcn_s_setprio(1); _Pragma("unroll") for (int m = 0; m < 4; ++m) _Pragma("unroll") for (int n = 0; n < 2; ++n) _Pragma("unroll") for (int k = 0; k < 2; ++k) \
        acc[ai][bj][m][n] = __builtin_amdgcn_mfma_f32_16x16x32_bf16(Bt[n][k], At[m][k], acc[ai][bj][m][n], 0, 0, 0); __builtin_amdgcn_s_setprio(0); } while (0)
#define PG8_WAIT_V(n) asm volatile("s_waitcnt vmcnt(" #n ")" ::: "memory")
#define PG8_WAIT_L(n) asm volatile("s_waitcnt lgkmcnt(" #n ")" ::: "memory")
#define PG8_BAR __builtin_amdgcn_s_barrier()
#define PG8_SCHED __builtin_amdgcn_sched_barrier(0)
    Unit cur, nxt; int ui = 0;
    if (!S.next(0, cur)) return;
    f32x4 acc[2][2][4][2];
#pragma unroll
    for (int a = 0; a < 2; ++a)
#pragma unroll
        for (int b = 0; b < 2; ++b)
#pragma unroll
            for (int m = 0; m < 4; ++m)
#pragma unroll
                for (int n = 0; n < 2; ++n) acc[a][b][m][n] = (f32x4){0.f, 0.f, 0.f, 0.f};
    bf16x8 At[4][2], B0[2][2], B1[2][2];
    const char* cA = g.A + (size_t)cur.z * g.sAz + (size_t)cur.pm * 2 * hA; const char* cB = g.B + (size_t)cur.z * g.sBz + (size_t)cur.pn * 2 * hB;
    PG8_STAGE(PG8_SB(0, 0), cB, voffB); PG8_STAGE(PG8_SB(0, 1), cB + hB, voffB); PG8_STAGE(PG8_SA(0, 0), cA, voffA); PG8_STAGE(PG8_SA(0, 1), cA + hA, voffA);
    if (wr == 1) PG8_BAR;
    PG8_WAIT_V(2); PG8_BAR;
    PG8_STAGE(PG8_SB(1, 0), cB + kstep, voffB); PG8_STAGE(PG8_SA(1, 0), cA + kstep, voffA); PG8_STAGE(PG8_SB(1, 1), cB + hB + kstep, voffB);
    PG8_WAIT_V(6); PG8_BAR;
    for (;;) {
        const bool has_next = S.next(ui + 1, nxt);
        const char* nA = has_next ? g.A + (size_t)nxt.z * g.sAz + (size_t)nxt.pm * 2 * hA : cA; const char* nB = has_next ? g.B + (size_t)nxt.z * g.sBz + (size_t)nxt.pn * 2 * hB : cB;
        for (int t = 0; t < nt; t += 2) {
            const bool last = (t == nt - 2);
            const char* a1 = cA + (size_t)(t + 1) * kstep;
            const char* a2 = last ? nA : cA + (size_t)(t + 2) * kstep; const char* b2 = last ? nB : cB + (size_t)(t + 2) * kstep;
            const char* a3 = a2 + kstep; const char* b3 = b2 + kstep;
            PG8_LDB(B0, 0, 0); PG8_LDB(B1, 0, 1); PG8_SCHED; PG8_LDA(At, 0, 0); PG8_STAGE(PG8_SA(1, 1), a1 + hA, voffA);
            PG8_WAIT_V(8); PG8_WAIT_L(0); PG8_BAR; PG8_MMA(0, 0, At, B0); PG8_MMA(0, 1, At, B1); PG8_BAR; PG8_SCHED;
            PG8_LDA(At, 0, 1); PG8_STAGE(PG8_SB(0, 0), b2, voffB); PG8_STAGE(PG8_SB(0, 1), b2 + hB, voffB); PG8_STAGE(PG8_SA(0, 0), a2, voffA);
            PG8_WAIT_V(8); PG8_WAIT_L(0); PG8_BAR; PG8_MMA(1, 0, At, B0); PG8_MMA(1, 1, At, B1); PG8_BAR; PG8_SCHED;
            PG8_LDB(B0, 1, 0); PG8_LDB(B1, 1, 1); PG8_SCHED; PG8_LDA(At, 1, 0); PG8_STAGE(PG8_SA(0, 1), a2 + hA, voffA);
            PG8_WAIT_V(8); PG8_WAIT_L(0); PG8_BAR; PG8_MMA(0, 0, At, B0); PG8_MMA(0, 1, At, B1); PG8_BAR; PG8_SCHED;
            PG8_LDA(At, 1, 1); PG8_STAGE(PG8_SB(1, 0), b3, voffB); PG8_STAGE(PG8_SB(1, 1), b3 + hB, voffB); PG8_STAGE(PG8_SA(1, 0), a3, voffA);
            PG8_WAIT_V(8); PG8_WAIT_L(0); PG8_BAR; PG8_MMA(1, 0, At, B0); PG8_MMA(1, 1, At, B1); PG8_BAR; PG8_SCHED;
        }
        if (wr == 0) PG8_BAR;
        { Unit ue = cur; int fre = fr, fqe = fq;
          asm volatile("" : "+s"(ue.pm), "+s"(ue.pn), "+s"(ue.z), "+v"(fre), "+v"(fqe));
          E(acc, ue, wr, wc, fre, fqe); }
        if (!has_next) break;
#pragma unroll
        for (int a = 0; a < 2; ++a)
#pragma unroll
            for (int b = 0; b < 2; ++b)
#pragma unroll
                for (int m = 0; m < 4; ++m)
#pragma unroll
                    for (int n = 0; n < 2; ++n) acc[a][b][m][n] = (f32x4){0.f, 0.f, 0.f, 0.f};
        cur = nxt; cA = nA; cB = nB; ++ui;
        if (wr == 1) PG8_BAR;
    }
    PG8_WAIT_V(0);
    PG8_BAR;
#undef PG8_SA
#undef PG8_SB
#undef PG8_STAGE
#undef PG8_LDA
#undef PG8_LDB
#undef PG8_MMA
#undef PG8_WAIT_V
#undef PG8_WAIT_L
#undef PG8_BAR
#undef PG8_SCHED
}
}
using pg8::Unit;
typedef f32x4 Acc[2][2][4][2];

#define EPI_ROWS(ai, m) (u.pm * 256 + (ai) * 128 + wr * 64 + (m) * 16 + fr)
__device__ __forceinline__ bool mfence() { asm volatile("" ::: "memory"); return true; }
#define FOR_AI_M _Pragma("unroll") for (int ai = 0; ai < 2; ++ai) _Pragma("unroll") for (int m = 0; m < 4; ++m) if (mfence())
#define FOR_BJ _Pragma("unroll") for (int bj = 0; bj < 2; ++bj)
__device__ __forceinline__ u32x4 pack8(const f32x4 v0, const f32x4 v1) { u32x4 w; w.x = cvt_pk_bf16(v0[0], v0[1]); w.y = cvt_pk_bf16(v0[2], v0[3]); w.z = cvt_pk_bf16(v1[0], v1[1]); w.w = cvt_pk_bf16(v1[2], v1[3]); return w; }

struct EpiZ {
    static constexpr bool PERM = true;
    bf16_t* ZP; bf16_t* UH; float* out;
    __device__ __forceinline__ void operator()(Acc& acc, const Unit& u, int wr, int wc, int fr, int fq) const {
        FOR_AI_M { const int row = EPI_ROWS(ai, m);
            FOR_BJ { const int col = u.pn * 256 + bj * 128 + wc * 32 + 8 * fq; const f32x4 v0 = acc[ai][bj][m][0], v1 = acc[ai][bj][m][1]; const u32x4 w = pack8(v0, v1);
                if (col < DPOOL) {
                    *(u32x4*)(ZP + (size_t)row * DPOOL + col) = w;
                    float* dst = nullptr;
                    if (row >= SEQ - 15 && row < SEQ) dst = out + O_POOLP + (size_t)(row - (SEQ - 15)) * DPOOL + col;
                    else if (row >= SEQ && ((row & 15) != 0)) dst = out + O_POOLS + ((size_t)((row - SEQ) >> 4) * 15 + ((row & 15) - 1)) * DPOOL + col;
                    if (dst) { *(f32x4*)dst = v0; *(f32x4*)(dst + 4) = v1; }
                } else {
                    const int cc = col - DPOOL, gg = cc >> 4, hh = cc & 15;
                    *(u32x4*)(UH + ((size_t)gg * NCHP + (row >> 4)) * KY + (row & 15) * 16 + hh) = w;
                } } }
    }
};
struct EpiKV {
    static constexpr bool PERM = false;
    float* out; bf16_t* KB; bf16_t* VT;
    __device__ __forceinline__ void operator()(Acc& acc, const Unit& u, int wr, int wc, int fr, int fq) const {
        FOR_AI_M { const int row = EPI_ROWS(ai, m);
            FOR_BJ {
#pragma unroll
                for (int n = 0; n < 2; ++n) { const int col = u.pn * 256 + bj * 128 + wc * 32 + 16 * n + 4 * fq; const f32x4 v = acc[ai][bj][m][n];
                    if (col < D) { *(f32x4*)(out + O_MK + (size_t)row * D + col) = v; u32x2 w; w.x = cvt_pk_bf16(v[0], v[1]); w.y = cvt_pk_bf16(v[2], v[3]); *(u32x2*)(KB + (size_t)row * D + col) = w; }
                    else { const int c2 = col - D; *(f32x4*)(out + O_MV + (size_t)row * D + c2) = v; } } }
            asm volatile("" ::: "memory"); }
    }
};
struct EpiE {
    static constexpr bool PERM = false;
    float* E;
    __device__ __forceinline__ void operator()(Acc& acc, const Unit& u, int wr, int wc, int fr, int fq) const {
        FOR_AI_M { const int row = EPI_ROWS(ai, m);
#pragma unroll
            for (int n = 0; n < 2; ++n) { const int col = wc * 32 + 16 * n + 4 * fq; *(f32x4*)(E + ((size_t)u.z * NCHP + row) * 128 + col) = acc[ai][0][m][n]; } }
    }
};
__device__ __forceinline__ float gelu_tanh(float x) {
    const float t = 0.7978845608028654f * (x + 0.044715f * x * x * x);
    const float e = __expf(-2.f * t);
    return x / (1.f + e);
}
struct EpiY {
    static constexpr bool PERM = true;
    bf16_t* MIX;
    __device__ __forceinline__ void operator()(Acc& acc, const Unit& u, int wr, int wc, int fr, int fq) const {
        FOR_AI_M { const int ch = EPI_ROWS(ai, m); if (ch < NCH) {
            FOR_BJ { const int col = bj * 128 + wc * 32 + 8 * fq, t = col >> 4, hh = col & 15; f32x4 v0 = acc[ai][bj][m][0], v1 = acc[ai][bj][m][1];
#pragma unroll
                for (int j = 0; j < 4; ++j) { v0[j] = gelu_tanh(v0[j]); v1[j] = gelu_tanh(v1[j]); }
                *(u32x4*)(MIX + (size_t)(ch * 16 + t) * D + DPOOL + u.z * 16 + hh) = pack8(v0, v1); } } }
    }
};
struct EpiPool {
    static constexpr bool PERM = true;
    bf16_t* CAT; const float* scale;
    __device__ __forceinline__ void operator()(Acc& acc, const Unit& u, int wr, int wc, int fr, int fq) const {
        FOR_BJ { const int col = u.pn * 256 + bj * 128 + wc * 32 + 8 * fq; const f32x4 s0 = *(const f32x4*)(scale + col), s1 = *(const f32x4*)(scale + col + 4);
            FOR_AI_M { const int row = EPI_ROWS(ai, m); *(u32x4*)(CAT + (size_t)row * D + col) = pack8(acc[ai][bj][m][0] * s0, acc[ai][bj][m][1] * s1); } }
    }
};
struct EpiGlu {
    static constexpr bool PERM = true;
    bf16_t* CAT; const bf16_t* MIX; const float* bias;
    __device__ __forceinline__ void operator()(Acc& acc, const Unit& u, int wr, int wc, int fr, int fq) const {
        FOR_BJ { const int col = u.pn * 256 + bj * 128 + wc * 32 + 8 * fq; const f32x4 b0 = *(const f32x4*)(bias + col), b1 = *(const f32x4*)(bias + col + 4);
            FOR_AI_M { const int row = EPI_ROWS(ai, m); const u32x4 yv = *(const u32x4*)(MIX + (size_t)row * D + DPOOL + col);
                f32x4 v0 = acc[ai][bj][m][0] + b0, v1 = acc[ai][bj][m][1] + b1; const unsigned yw[4] = {yv.x, yv.y, yv.z, yv.w};
#pragma unroll
                for (int j = 0; j < 4; ++j) { const float ya = bf2f(yw[j >> 1] >> ((j & 1) * 16) & 0xffffu), yb = bf2f(yw[2 + (j >> 1)] >> ((j & 1) * 16) & 0xffffu);
                    v0[j] = ya / (1.f + __expf(-v0[j])); v1[j] = yb / (1.f + __expf(-v1[j])); }
                *(u32x4*)(CAT + (size_t)row * D + DPOOL + col) = pack8(v0, v1); } }
    }
};
struct EpiRes {
    static constexpr bool PERM = false;
    const float* baseP; const float* baseS; float* out; bf16_t* Xb; float* SS;
    __device__ __forceinline__ void operator()(Acc& acc, const Unit& u, int wr, int wc, int fr, int fq) const {
        FOR_AI_M { const int row = EPI_ROWS(ai, m); const float* brow = (row < SEQ) ? baseP + (size_t)row * D : baseS + (size_t)(row - SEQ) * D; float ssq = 0.f;
            FOR_BJ {
#pragma unroll
                for (int n = 0; n < 2; ++n) { const int col = u.pn * 256 + bj * 128 + wc * 32 + 16 * n + 4 * fq; const f32x4 v = acc[ai][bj][m][n] + *(const f32x4*)(brow + col);
                    *(f32x4*)(out + (size_t)row * D + col) = v; ssq += (v[0] * v[0] + v[1] * v[1]) + (v[2] * v[2] + v[3] * v[3]);
                    if (Xb) { u32x2 w; w.x = cvt_pk_bf16(v[0], v[1]); w.y = cvt_pk_bf16(v[2], v[3]); *(u32x2*)(Xb + (size_t)row * D + col) = w; } } }
            ssq += shfl_x(ssq, fr + 16 * fq, 16); ssq += shfl_x(ssq, fr + 16 * fq, 32);
            if (fq == 0) atomicAdd(SS + row, ssq); }
    }
};
struct EpiQ {
    static constexpr bool PERM = true;
    bf16_t* Q; const float* SS;
    __device__ __forceinline__ void operator()(Acc& acc, const Unit& u, int wr, int wc, int fr, int fq) const {
        FOR_AI_M { const int row = EPI_ROWS(ai, m); const float rs = rsqrtf(SS[row] * (1.f / D) + EPS) * QSCALE;
            FOR_BJ { const int col = u.pn * 256 + bj * 128 + wc * 32 + 8 * fq; *(u32x4*)(Q + (size_t)row * D + col) = pack8(acc[ai][bj][m][0] * rs, acc[ai][bj][m][1] * rs); } }
    }
};
struct EpiSoftmax {
    static constexpr bool PERM = true;
    bf16_t* P; LAS float* tmax; LAS float* tsum;
    __device__ __forceinline__ void operator()(Acc& acc, const Unit& u, int wr, int wc, int fr, int fq) const {
        FOR_AI_M { float mx = -3.0e38f;
            FOR_BJ {
#pragma unroll
                for (int n = 0; n < 2; ++n) { const f32x4 v = acc[ai][bj][m][n]; mx = fmaxf(mx, fmaxf(fmaxf(v[0], v[1]), fmaxf(v[2], v[3]))); } }
            mx = fmaxf(mx, shfl_x(mx, fr + 16 * fq, 16)); mx = fmaxf(mx, shfl_x(mx, fr + 16 * fq, 32));
            if (fq == 0) tmax[(ai * 128 + wr * 64 + m * 16 + fr) * 4 + wc] = mx; }
        LDS_WAIT(); __builtin_amdgcn_s_barrier(); asm volatile("" ::: "memory");
        FOR_AI_M { const int r = ai * 128 + wr * 64 + m * 16 + fr; const f32x4 t = *(const LAS f32x4*)(tmax + r * 4); const float mx = fmaxf(fmaxf(t[0], t[1]), fmaxf(t[2], t[3])); float s = 0.f;
            FOR_BJ {
#pragma unroll
                for (int n = 0; n < 2; ++n) { f32x4 v = acc[ai][bj][m][n];
#pragma unroll
                    for (int j = 0; j < 4; ++j) { v[j] = __builtin_amdgcn_exp2f(v[j] - mx); s += v[j]; }
                    acc[ai][bj][m][n] = v; } }
            s += shfl_x(s, fr + 16 * fq, 16); s += shfl_x(s, fr + 16 * fq, 32);
            if (fq == 0) tsum[r * 4 + wc] = s; }
        LDS_WAIT(); __builtin_amdgcn_s_barrier(); asm volatile("" ::: "memory");
        FOR_AI_M { const int r = ai * 128 + wr * 64 + m * 16 + fr, row = u.pm * 256 + r; const f32x4 t = *(const LAS f32x4*)(tsum + r * 4); const float inv = 1.f / ((t[0] + t[1]) + (t[2] + t[3]));
            FOR_BJ { const int col = u.z * 256 + bj * 128 + wc * 32 + 8 * fq; *(u32x4*)(P + (size_t)row * D + col) = pack8(acc[ai][bj][m][0] * inv, acc[ai][bj][m][1] * inv); } }
    }
};
struct EpiO {
    static constexpr bool PERM = true;
    bf16_t* O;
    __device__ __forceinline__ void operator()(Acc& acc, const Unit& u, int wr, int wc, int fr, int fq) const {
        FOR_AI_M { const int row = EPI_ROWS(ai, m);
            FOR_BJ { const int col = u.z * 256 + bj * 128 + wc * 32 + 8 * fq; *(u32x4*)(O + (size_t)row * D + col) = pack8(acc[ai][bj][m][0], acc[ai][bj][m][1]); } }
    }
};
struct EpiUp {
    static constexpr bool PERM = true;
    bf16_t* U; const float* SS;
    __device__ __forceinline__ void operator()(Acc& acc, const Unit& u, int wr, int wc, int fr, int fq) const {
        FOR_AI_M { const int row = EPI_ROWS(ai, m); const float rs = rsqrtf(SS[row] * (1.f / D) + EPS);
            FOR_BJ { const int col = u.pn * 256 + bj * 128 + wc * 32 + 8 * fq; f32x4 v0 = acc[ai][bj][m][0] * rs, v1 = acc[ai][bj][m][1] * rs;
#pragma unroll
                for (int j = 0; j < 4; ++j) { const float a = fmaxf(v0[j], 0.f), b = fmaxf(v1[j], 0.f); v0[j] = a * a; v1[j] = b * b; }
                *(u32x4*)(U + (size_t)row * DFF + col) = pack8(v0, v1); } }
    }
};

struct Ctx {
    const float* in[33]; float* out; unsigned char* ws;
};
__device__ __forceinline__ float wave_sum(float v, int lane) {
#pragma unroll
    for (int o = 1; o < 64; o <<= 1) v += shfl_x(v, lane, o);
    return v;
}
__device__ __forceinline__ float wave_max(float v, int lane) {
#pragma unroll
    for (int o = 1; o < 64; o <<= 1) v = fmaxf(v, shfl_x(v, lane, o));
    return v;
}
__device__ __forceinline__ void transpose_item(const float* W, int ldw, int nblk, bf16_t* WT, int ldt, int row_off, int col_off, const float* ksc, LAS float* scr, int item, int lane) {
    const int kb = item / nblk, nb = item % nblk, k0 = 64 * kb, n0 = 32 * nb;
#pragma unroll 8
    for (int i = 0; i < 32; ++i) { const int kk = 2 * i + (lane >> 5); float v = W[(size_t)(k0 + kk) * ldw + n0 + (lane & 31)]; if (ksc) v *= ksc[k0 + kk]; scr[kk * 33 + (lane & 31)] = v; }
    LDS_WAIT(); asm volatile("" ::: "memory");
    const int c = lane & 7;
#pragma unroll
    for (int j = 0; j < 4; ++j) { const int n = (lane >> 3) + 8 * j; const LAS float* s = scr + (8 * c) * 33 + n;
        u32x4 o; o.x = pk2(s[0 * 33], s[1 * 33]); o.y = pk2(s[2 * 33], s[3 * 33]); o.z = pk2(s[4 * 33], s[5 * 33]); o.w = pk2(s[6 * 33], s[7 * 33]);
        *(u32x4*)(WT + (size_t)(row_off + n0 + n) * ldt + col_off + k0 + 8 * c) = o; }
    LDS_WAIT(); asm volatile("" ::: "memory");
}
__device__ __forceinline__ void rms_row_to_bf16(const float* xrow, const float* g, bf16_t* orow, int lane) {
    const f32x4* xr = (const f32x4*)xrow + lane; const f32x4* gr = (const f32x4*)g + lane;
    f32x4 v[4]; float s = 0.f;
#pragma unroll
    for (int j = 0; j < 4; ++j) { v[j] = xr[64 * j]; s += (v[j].x * v[j].x + v[j].y * v[j].y) + (v[j].z * v[j].z + v[j].w * v[j].w); }
    const float rs = rsqrtf(wave_sum(s, lane) * (1.f / D) + EPS);
    u32x2* o8 = (u32x2*)orow + lane;
#pragma unroll
    for (int j = 0; j < 4; ++j) { const f32x4 gg = gr[64 * j]; u32x2 w; w.x = pk2(v[j].x * rs * gg.x, v[j].y * rs * gg.y); w.y = pk2(v[j].z * rs * gg.z, v[j].w * rs * gg.w); o8[64 * j] = w; }
}

__device__ __forceinline__ void p0_prologue(const Ctx& C, LAS unsigned char* lds, int G, int bid, int wv) {
    const int tid = tidx(wv), lane = tid & 63, wave = tid >> 6;
    LAS float* scr = (LAS float*)(lds + wave * 16384);
    const int gw = bid * 8 + wave, NGW = G * 8;
    unsigned char* ws = C.ws;
    constexpr int I_SQ = 16 * 32, I_UP = 16 * 128, I_DN = 64 * 32, I_GLU = 8 * 16, I_PL = 4 * 2 * 4;
    constexpr int NIT = 6 * I_SQ + I_UP + I_DN + I_GLU + I_PL;
    for (int it = gw; it < NIT; it += NGW) {
        int r = it;
        if (r < I_SQ) { transpose_item(C.in[9], D, 32, (bf16_t*)(ws + WS_WIN), D, 0, 0, nullptr, scr, r, lane); continue; } r -= I_SQ;
        if (r < I_SQ) { transpose_item(C.in[22], D, 32, (bf16_t*)(ws + WS_WOUT), D, 0, 0, nullptr, scr, r, lane); continue; } r -= I_SQ;
        if (r < I_SQ) { transpose_item(C.in[25], D, 32, (bf16_t*)(ws + WS_WQ), D, 0, 0, C.in[23], scr, r, lane); continue; } r -= I_SQ;
        if (r < I_SQ) { transpose_item(C.in[26], D, 32, (bf16_t*)(ws + WS_WKV), D, 0, 0, nullptr, scr, r, lane); continue; } r -= I_SQ;
        if (r < I_SQ) { transpose_item(C.in[27], D, 32, (bf16_t*)(ws + WS_WKV), D, D, 0, nullptr, scr, r, lane); continue; } r -= I_SQ;
        if (r < I_SQ) { transpose_item(C.in[28], D, 32, (bf16_t*)(ws + WS_WO), D, 0, 0, nullptr, scr, r, lane); continue; } r -= I_SQ;
        if (r < I_UP) { transpose_item(C.in[30], DFF, 128, (bf16_t*)(ws + WS_WUP), D, 0, 0, C.in[29], scr, r, lane); continue; } r -= I_UP;
        if (r < I_DN) { transpose_item(C.in[31], D, 32, (bf16_t*)(ws + WS_WDOWN), DFF, 0, 0, nullptr, scr, r, lane); continue; } r -= I_DN;
        if (r < I_GLU) { transpose_item(C.in[20], DSSM, 16, (bf16_t*)(ws + WS_WGLU), DSSM, 0, 0, nullptr, scr, r, lane); continue; } r -= I_GLU;
        { const int gp = r / 8, rr = r % 8; transpose_item(C.in[10] + (size_t)gp * 128 * 128, 128, 4, (bf16_t*)(ws + WS_WPOOL), DPOOL, gp * 128, gp * 128, nullptr, scr, rr, lane); }
    }
    const int gt = bid * 512 + tid, NGT = G * 512;
    { bf16_t* WP = (bf16_t*)(ws + WS_WPOOL);
      for (int i = gt; i < 512 * 512 / 8; i += NGT) { const int n = i / 64, k = (i % 64) * 8; if ((n >> 7) != (k >> 7)) *(u32x4*)(WP + (size_t)n * DPOOL + k) = (u32x4){0u, 0u, 0u, 0u}; }
      float* SS = (float*)(ws + WS_SS); for (int i = gt; i < 3 * M; i += NGT) SS[i] = 0.f; }
    { bf16_t* H1 = (bf16_t*)(ws + WS_T0); bf16_t* MN = (bf16_t*)(ws + WS_MN);
      for (int m = gw; m < M + NMEM; m += NGW) {
          if (m < SEQ) rms_row_to_bf16(C.in[0] + (size_t)m * D, C.in[8], H1 + (size_t)m * D, lane);
          else if (m < M) rms_row_to_bf16(C.in[1] + (size_t)(m - SEQ) * D, C.in[8], H1 + (size_t)m * D, lane);
          else rms_row_to_bf16(C.in[7] + (size_t)(m - M) * D, C.in[24], MN + (size_t)(m - M) * D, lane); } }
    { float* AP = (float*)(ws + WS_AP); float* BB = (float*)(ws + WS_BB);
      for (int i = gt; i < NG * NP; i += NGT) { const int g = i / NP, p = i % NP;
          const float are = C.in[12][i], aim = C.in[13][i], dt = expf(C.in[19][g]);
          const float mag = expf(are * dt); float sn, cs; sincosf(aim * dt, &sn, &cs);
          const float abr = mag * cs, abi = mag * sn;
          float pr = 1.f, pi = 0.f;
          for (int k = 0; k <= 16; ++k) { AP[((size_t)(g * 17 + k) * NP + p) * 2] = pr; AP[((size_t)(g * 17 + k) * NP + p) * 2 + 1] = pi; const float nr = pr * abr - pi * abi, ni = pr * abi + pi * abr; pr = nr; pi = ni; }
          const float nr = abr - 1.f, ni = abi, den = are * are + aim * aim; const float cr = (nr * are + ni * aim) / den, ci = (ni * are - nr * aim) / den;
          for (int h = 0; h < NH; ++h) { const float br = C.in[14][(size_t)i * NH + h], bi = C.in[15][(size_t)i * NH + h];
              BB[((size_t)i * NH + h) * 2] = cr * br - ci * bi; BB[((size_t)i * NH + h) * 2 + 1] = cr * bi + ci * br; } } }
}
__device__ __forceinline__ void p1_pre(const Ctx& C, int G, int bid, int wv) {
    const int gt = bid * 512 + tidx(wv), NGT = G * 512; unsigned char* ws = C.ws;
    const float* AP = (const float*)(ws + WS_AP); const float* BB = (const float*)(ws + WS_BB); float* KL = (float*)(ws + WS_KLAG); bf16_t* WB = (bf16_t*)(ws + WS_WB);
    for (int i = gt; i < NG * 16 * 16 * 16; i += NGT) { const int hp = i & 15, h = (i >> 4) & 15, k = (i >> 8) & 15, g = i >> 12; float s = 0.f;
        for (int p = 0; p < NP; ++p) { const float cr = C.in[16][((size_t)g * NH + h) * NP + p], ci = C.in[17][((size_t)g * NH + h) * NP + p];
            const float ar = AP[((size_t)(g * 17 + k) * NP + p) * 2], ai = AP[((size_t)(g * 17 + k) * NP + p) * 2 + 1];
            const float br = BB[((size_t)(g * NP + p) * NH + hp) * 2], bi = BB[((size_t)(g * NP + p) * NH + hp) * 2 + 1];
            const float tr = ar * br - ai * bi, ti = ar * bi + ai * br; s += cr * tr - ci * ti; }
        if (k == 0 && h == hp) s += C.in[18][g * NH + h];
        KL[i] = s; }
    for (int i = gt; i < NG * 256 * 256; i += NGT) { const int k = i & 255, n = (i >> 8) & 255, g = i >> 16; float v = 0.f;
        if (n < 128) { const int p = n & 63, s = k >> 4, hp = k & 15; const float ar = AP[((size_t)(g * 17 + 15 - s) * NP + p) * 2], ai = AP[((size_t)(g * 17 + 15 - s) * NP + p) * 2 + 1];
            const float br = BB[((size_t)(g * NP + p) * NH + hp) * 2], bi = BB[((size_t)(g * NP + p) * NH + hp) * 2 + 1];
            v = (n < 64) ? (ar * br - ai * bi) : (ar * bi + ai * br); }
        WB[i] = (bf16_t)f2bf(v); }
}
__device__ __forceinline__ void p2a_pre(const Ctx& C, int G, int bid, int wv) {
    const int gt = bid * 512 + tidx(wv), NGT = G * 512; unsigned char* ws = C.ws;
    const float* AP = (const float*)(ws + WS_AP); const float* KL = (const float*)(ws + WS_KLAG); bf16_t* WY = (bf16_t*)(ws + WS_WY);
    for (int i = gt; i < NG * 256 * KY; i += NGT) { const int k = i % KY, n = (i / KY) & 255, g = i / (KY * 256), t = n >> 4, h = n & 15; float v = 0.f;
        if (k < 256) { const int s = k >> 4, hp = k & 15; if (s <= t) v = KL[(((size_t)g * 16 + (t - s)) * 16 + h) * 16 + hp]; }
        else { const int p = (k - 256) & 63; const float cr = C.in[16][((size_t)g * NH + h) * NP + p], ci = C.in[17][((size_t)g * NH + h) * NP + p];
            const float ar = AP[((size_t)(g * 17 + t + 1) * NP + p) * 2], ai = AP[((size_t)(g * 17 + t + 1) * NP + p) * 2 + 1];
            v = (k < 320) ? (cr * ar - ci * ai) : -(cr * ai + ci * ar); }
        WY[i] = (bf16_t)f2bf(v); }
    { const float* MV = C.out + O_MV; bf16_t* VT = (bf16_t*)(ws + WS_VT);
      for (int i = gt; i < D * NMEM; i += NGT) { const int c = i >> 8, n = i & 255; VT[i] = (bf16_t)f2bf(MV[(size_t)n * D + c]); } }
}
__device__ __forceinline__ void p2b_prefix(const Ctx& C, LAS unsigned char* lds, int g, int wv) {
    const int tid = tidx(wv), p = tid & 63, seg = tid >> 6; unsigned char* ws = C.ws;
    const float* AP = (const float*)(ws + WS_AP); const float* E = (const float*)(ws + WS_E) + (size_t)g * NCHP * 128; bf16_t* UH = (bf16_t*)(ws + WS_UH) + (size_t)g * NCHP * KY;
    LAS float* L = (LAS float*)lds;
    const float ar = AP[((size_t)(g * 17 + 16) * NP + p) * 2], ai = AP[((size_t)(g * 17 + 16) * NP + p) * 2 + 1];
    float hr = 0.f, hi = 0.f; const int c0 = seg * 128;
    for (int c = c0; c < c0 + 128; c += 8) { float er[8], ei[8];
#pragma unroll
        for (int j = 0; j < 8; ++j) { er[j] = E[(size_t)(c + j) * 128 + p]; ei[j] = E[(size_t)(c + j) * 128 + 64 + p]; }
#pragma unroll
        for (int j = 0; j < 8; ++j) { const float nr = ar * hr - ai * hi + er[j], ni = ar * hi + ai * hr + ei[j]; hr = nr; hi = ni; } }
    L[(seg * 64 + p) * 2] = hr; L[(seg * 64 + p) * 2 + 1] = hi;
    float sr = ar, si = ai;
#pragma unroll
    for (int j = 0; j < 7; ++j) { const float nr = sr * sr - si * si, ni = 2.f * sr * si; sr = nr; si = ni; }
    __syncthreads();
    hr = 0.f; hi = 0.f;
    for (int j = 0; j < seg; ++j) { const float lr = L[(j * 64 + p) * 2], li = L[(j * 64 + p) * 2 + 1]; const float nr = sr * hr - si * hi + lr, ni = sr * hi + si * hr + li; hr = nr; hi = ni; }
    for (int c = c0; c < c0 + 128; c += 8) { float er[8], ei[8];
#pragma unroll
        for (int j = 0; j < 8; ++j) { er[j] = E[(size_t)(c + j) * 128 + p]; ei[j] = E[(size_t)(c + j) * 128 + 64 + p]; }
#pragma unroll
        for (int j = 0; j < 8; ++j) { UH[(size_t)(c + j) * KY + 256 + p] = (bf16_t)f2bf(hr); UH[(size_t)(c + j) * KY + 320 + p] = (bf16_t)f2bf(hi);
            const float nr = ar * hr - ai * hi + er[j], ni = ar * hi + ai * hr + ei[j]; hr = nr; hi = ni; } }
    if (seg == 7) { C.out[O_SREP + g * NP + p] = hr; C.out[O_SIMP + g * NP + p] = hi; }
    for (int b = seg; b < 16; b += 8) { const float h0r = C.in[5][((size_t)b * NG + g) * NP + p], h0i = C.in[6][((size_t)b * NG + g) * NP + p]; const int c = 1024 + b;
        UH[(size_t)c * KY + 256 + p] = (bf16_t)f2bf(h0r); UH[(size_t)c * KY + 320 + p] = (bf16_t)f2bf(h0i);
        C.out[O_SRES + ((size_t)b * NG + g) * NP + p] = ar * h0r - ai * h0i + E[(size_t)c * 128 + p];
        C.out[O_SIMS + ((size_t)b * NG + g) * NP + p] = ar * h0i + ai * h0r + E[(size_t)c * 128 + 64 + p]; }
    __syncthreads();
}
__device__ __forceinline__ void p2b_pool(const Ctx& C, int worker, int nworkers, int wv) {
    const int tid = tidx(wv), sub = tid >> 6, cl = (tid & 63) * 8; unsigned char* ws = C.ws;
    const bf16_t* ZP = (const bf16_t*)(ws + WS_ZP); bf16_t* MIX = (bf16_t*)(ws + WS_T1);
    const int w = 2 << (cl >> 7);
    for (int blk = worker * 8 + sub; blk < NCH; blk += nworkers * 8) { const int r0 = blk * 16; const bool samp = r0 >= SEQ; const int b = (r0 - SEQ) >> 4;
        for (int t = 0; t < 16; ++t) { const int row = r0 + t; float s[8] = {0.f, 0.f, 0.f, 0.f, 0.f, 0.f, 0.f, 0.f}; float cur[8];
            for (int j = 0; j < w; ++j) { const int rr = row - j; float v[8];
                if (!samp) { if (rr < 0) break; const u32x4 q = *(const u32x4*)(ZP + (size_t)rr * DPOOL + cl); const unsigned qq[4] = {q.x, q.y, q.z, q.w};
#pragma unroll
                    for (int e = 0; e < 8; ++e) v[e] = bf2f((qq[e >> 1] >> ((e & 1) * 16)) & 0xffffu); }
                else if (t - j >= 0) { const u32x4 q = *(const u32x4*)(ZP + (size_t)rr * DPOOL + cl); const unsigned qq[4] = {q.x, q.y, q.z, q.w};
#pragma unroll
                    for (int e = 0; e < 8; ++e) v[e] = bf2f((qq[e >> 1] >> ((e & 1) * 16)) & 0xffffu); }
                else { const float* hp = C.in[4] + ((size_t)b * 15 + (15 + t - j)) * DPOOL + cl; const f32x4 a = *(const f32x4*)hp, bb = *(const f32x4*)(hp + 4);
                    v[0] = a[0]; v[1] = a[1]; v[2] = a[2]; v[3] = a[3]; v[4] = bb[0]; v[5] = bb[1]; v[6] = bb[2]; v[7] = bb[3]; }
#pragma unroll
                for (int e = 0; e < 8; ++e) { s[e] += v[e]; if (j == 0) cur[e] = v[e]; } }
            const int cnt = samp ? w : ((row + 1 < w) ? row + 1 : w); const float inv = 1.f / (float)cnt;
            u32x4 o; o.x = pk2(s[0] * inv - cur[0], s[1] * inv - cur[1]); o.y = pk2(s[2] * inv - cur[2], s[3] * inv - cur[3]); o.z = pk2(s[4] * inv - cur[4], s[5] * inv - cur[5]); o.w = pk2(s[6] * inv - cur[6], s[7] * inv - cur[7]);
            *(u32x4*)(MIX + (size_t)row * D + cl) = o; } }
}
__device__ __forceinline__ void sample_attn_item(const Ctx& C, LAS unsigned char* lds, int item, int wv) {
    const int tid = tidx(wv), lane = tid & 63, wave = tid >> 6, fr = lane & 15, fq = lane >> 4; const int b = item >> 2, h = item & 3; unsigned char* ws = C.ws;
    const bf16_t* Q = (const bf16_t*)(ws + WS_T1); bf16_t* O = (bf16_t*)(ws + WS_T0);
    const float* Kc = C.in[2] + (size_t)b * NMEM * D + h * HD; const float* Vc = C.in[3] + (size_t)b * NMEM * D + h * HD;
    LAS float* Sl = (LAS float*)lds;
    LAS float* PT = (LAS float*)(lds + 16384);
    bf16x8 qf[8];
#pragma unroll
    for (int kk = 0; kk < 8; ++kk) qf[kk] = *(const bf16x8*)(Q + (size_t)(SEQ + b * 16 + fr) * D + h * HD + kk * 32 + fq * 8);
#pragma unroll
    for (int kbi = 0; kbi < 2; ++kbi) { const int kb = wave + 8 * kbi; f32x4 acc = {0.f, 0.f, 0.f, 0.f}; const float* kr = Kc + (size_t)(kb * 16 + fr) * D + fq * 8;
#pragma unroll
        for (int kk = 0; kk < 8; ++kk) { const f32x4 a = *(const f32x4*)(kr + kk * 32), c = *(const f32x4*)(kr + kk * 32 + 4); const u32x4 w = pack8(a, c);
            acc = __builtin_amdgcn_mfma_f32_16x16x32_bf16(qf[kk], __builtin_bit_cast(bf16x8, w), acc, 0, 0, 0); }
#pragma unroll
        for (int r = 0; r < 4; ++r) Sl[(4 * fq + r) * 256 + kb * 16 + fr] = acc[r]; }
    __syncthreads();
#pragma unroll
    for (int rr = 0; rr < 2; ++rr) { const int s = wave * 2 + rr; float v[4]; float mx = -3.0e38f;
#pragma unroll
        for (int j = 0; j < 4; ++j) { v[j] = Sl[s * 256 + lane + 64 * j]; mx = fmaxf(mx, v[j]); }
        mx = wave_max(mx, lane); float sum = 0.f;
#pragma unroll
        for (int j = 0; j < 4; ++j) { v[j] = __builtin_amdgcn_exp2f(v[j] - mx); sum += v[j]; }
        const float inv = 1.f / wave_sum(sum, lane);
#pragma unroll
        for (int j = 0; j < 4; ++j) PT[(lane + 64 * j) * 16 + s] = v[j] * inv; }
    __syncthreads();
    { const int d = tid & 255, sh = tid >> 8; float o[8] = {0.f, 0.f, 0.f, 0.f, 0.f, 0.f, 0.f, 0.f};
#pragma unroll 8
      for (int n = 0; n < NMEM; ++n) { const float v = Vc[(size_t)n * D + d]; const f32x4 p0 = *(const LAS f32x4*)(PT + n * 16 + sh * 8), p1 = *(const LAS f32x4*)(PT + n * 16 + sh * 8 + 4);
          o[0] += p0[0] * v; o[1] += p0[1] * v; o[2] += p0[2] * v; o[3] += p0[3] * v; o[4] += p1[0] * v; o[5] += p1[1] * v; o[6] += p1[2] * v; o[7] += p1[3] * v; }
#pragma unroll
      for (int e = 0; e < 8; ++e) O[(size_t)(SEQ + b * 16 + sh * 8 + e) * D + h * HD + d] = (bf16_t)f2bf(o[e]); }
    __syncthreads();
}

#define XB_TMO      128
#define XB_XCNT(j)  (256  + 64 * (j))
#define XB_XSUB(j)  (1280 + 64 * (j))
#define XB_XGEN(j)  (2304 + 64 * (j))
#define XB_TOP      3328
#define XB_TOPGEN   3392
#define XCD_BAR_WORDS 3456
#define XB_SPIN_CAP (1u << 18)

__device__ __forceinline__ unsigned xb_ld(unsigned* p)              { return __hip_atomic_load(p, __ATOMIC_RELAXED, __HIP_MEMORY_SCOPE_AGENT); }
__device__ __forceinline__ unsigned xb_add(unsigned* p, unsigned v) { return __hip_atomic_fetch_add(p, v, __ATOMIC_RELAXED, __HIP_MEMORY_SCOPE_AGENT); }
__device__ __forceinline__ unsigned xb_xcc_id() { return (unsigned)__builtin_amdgcn_s_getreg((3 << 11) | 20) & 0xFu; }
#define XB_SPIN(cond, bar) do { unsigned _sp = 0; while (cond) { __builtin_amdgcn_s_sleep(1); \
    if ((++_sp & 255u) == 0u) { if (xb_ld(&(bar)[XB_TMO])) break; if (_sp > XB_SPIN_CAP) { atomicAdd(&(bar)[XB_TMO], 1u); break; } } } } while (0)

struct XcdBarrier {
    unsigned* bar; unsigned x;
    volatile LAS unsigned* st;
};

__device__ __forceinline__ XcdBarrier xcd_barrier_post(unsigned* bar, volatile LAS unsigned* st, int wv) {
    XcdBarrier b; b.bar = bar; b.x = xb_xcc_id(); b.st = st;
    if (tidx(wv) == 0) (void)xb_add(&bar[XB_XCNT(b.x)], 1u);
    return b;
}
__device__ __forceinline__ void xcd_barrier_complete(unsigned* bar, unsigned x, unsigned& nloc, unsigned& nx) {
    const unsigned G = gridDim.x * gridDim.y * gridDim.z;
    unsigned sum, cnt, mine, sp = 0u;
    for (;;) {
        sum = 0u; cnt = 0u; mine = 0u;
#pragma unroll
        for (unsigned j = 0; j < 16; ++j) { const unsigned c = xb_ld(&bar[XB_XCNT(j)]); sum += c; cnt += (c > 0u) ? 1u : 0u; mine = (j == x) ? c : mine; }
        if (sum == G) break;
        __builtin_amdgcn_s_sleep(1);
        if ((++sp & 255u) == 0u) { if (xb_ld(&bar[XB_TMO])) break; if (sp > XB_SPIN_CAP) { atomicAdd(&bar[XB_TMO], 1u); break; } }
    }
    nloc = mine > 0u ? mine : 1u; nx = cnt > 0u ? cnt : 1u;
}

__device__ __forceinline__ void xcd_barrier(const XcdBarrier& b, int wv) {
    asm volatile("s_waitcnt vmcnt(0)" ::: "memory");
    __syncthreads();
    if (tidx(wv) == 0) {
        unsigned* bar = b.bar;
        __builtin_amdgcn_s_waitcnt(0);
        unsigned nloc = b.st[0], nx = b.st[1];
        if (nloc == 0u) { xcd_barrier_complete(bar, b.x, nloc, nx); b.st[0] = nloc; b.st[1] = nx; }
        const unsigned old = xb_add(&bar[XB_XSUB(b.x)], 1u);
        const unsigned gen = old / nloc;
        if (old + 1u == (gen + 1u) * nloc) {
            __builtin_amdgcn_fence(__ATOMIC_RELEASE, "agent");
            asm volatile("s_waitcnt vmcnt(0)" ::: "memory");
            const unsigned og = xb_add(&bar[XB_TOP], 1u);
            const unsigned tg = og / nx;
            if (og + 1u == (tg + 1u) * nx) xb_add(&bar[XB_TOPGEN], 1u);
            else XB_SPIN(xb_ld(&bar[XB_TOPGEN]) == tg, bar);
            __builtin_amdgcn_fence(__ATOMIC_ACQUIRE, "agent");
            xb_add(&bar[XB_XGEN(b.x)], 1u);
            asm volatile("s_waitcnt vmcnt(0)" ::: "memory");
        } else {
            XB_SPIN(xb_ld(&bar[XB_XGEN(b.x)]) == gen, bar);
            __builtin_amdgcn_fence(__ATOMIC_ACQUIRE, "agent");
            asm volatile("s_waitcnt vmcnt(0)" ::: "memory");
        }
    }
    __syncthreads();
}

#ifndef PHMASK
#define PHMASK 0xFFFF
#endif
#define PH(k) if constexpr (((PHMASK) >> (k)) & 1)
constexpr int LDS_BYTES = 131072 + 8192 + 1024;
__global__ void __launch_bounds__(512, 2) fwd_megakernel(Ctx C) {
    extern __shared__ __attribute__((aligned(16))) unsigned char lds_raw[];
    LAS unsigned char* lds = (LAS unsigned char*)lds_raw;
    cg::grid_group grid = cg::this_grid();
    const int wv = __builtin_amdgcn_readfirstlane((int)threadIdx.x >> 6);
    const int G = gridDim.x, bid = blockIdx.x; unsigned char* ws = C.ws;
    bf16_t* T0 = (bf16_t*)(ws + WS_T0); bf16_t* T1 = (bf16_t*)(ws + WS_T1); bf16_t* T2 = (bf16_t*)(ws + WS_T2);
    float* SS1 = (float*)(ws + WS_SS); float* SS2 = SS1 + M; float* SS3 = SS2 + M;
    float* Y = C.out + O_Y;
    pg8::Order S;

    if (bid == 0) { unsigned* bw = (unsigned*)(ws + WS_BAR); for (int i = tidx(wv); i < XCD_BAR_WORDS; i += 512) bw[i] = 0u; }
    { volatile LAS unsigned* misc = (volatile LAS unsigned*)(lds + 131072 + 8192); if (tidx(wv) < 16) misc[tidx(wv)] = 0u; }
    p0_prologue(C, lds, G, bid, wv);
    grid.sync();
    const XcdBarrier xbar = xcd_barrier_post((unsigned*)(ws + WS_BAR), (volatile LAS unsigned*)(lds + 131072 + 8192), wv);

    p1_pre(C, G, bid, wv);
    PH(0) { pg8::Gemm g{(const char*)T0, (const char*)(ws + WS_WIN), D, D, 0, 0, D}; S.init(M / 256, 4, 1, G, bid);
      EpiZ E{(bf16_t*)(ws + WS_ZP), (bf16_t*)(ws + WS_UH), C.out}; pg8::gemm_phase(lds, g, S, E, wv); }
    PH(1) { pg8::Gemm g{(const char*)(ws + WS_MN), (const char*)(ws + WS_WKV), D, D, 0, 0, D}; S.init(1, 8, 1, G, (bid + G - (260 % G)) % G);
      EpiKV E{C.out, (bf16_t*)(ws + WS_KB), (bf16_t*)(ws + WS_VT)}; pg8::gemm_phase(lds, g, S, E, wv); }
    xcd_barrier(xbar, wv);

    p2a_pre(C, G, bid, wv);
    PH(2) { pg8::Gemm g{(const char*)(ws + WS_UH), (const char*)(ws + WS_WB), KY, 256, (size_t)NCHP * KY * 2, (size_t)256 * 256 * 2, 256}; S.init(NCHP / 256, 1, NG, G, bid);
      EpiE E{(float*)(ws + WS_E)}; pg8::gemm_phase(lds, g, S, E, wv); }
    xcd_barrier(xbar, wv);

    if (bid < NG) p2b_prefix(C, lds, bid, wv);
    if (G > NG) { if (bid >= NG) p2b_pool(C, bid - NG, G - NG, wv); } else p2b_pool(C, bid, G, wv);
    xcd_barrier(xbar, wv);

    PH(3) { pg8::Gemm g{(const char*)(ws + WS_UH), (const char*)(ws + WS_WY), KY, KY, (size_t)NCHP * KY * 2, (size_t)256 * KY * 2, KY}; S.init(NCHP / 256, 1, NG, G, bid);
      EpiY E{T1}; pg8::gemm_phase(lds, g, S, E, wv); }
    PH(4) { pg8::Gemm g{(const char*)T1, (const char*)(ws + WS_WPOOL), D, DPOOL, 0, 0, DPOOL}; S.init(M / 256, 2, 1, G, (bid + G - (160 % G)) % G);
      EpiPool E{T2, C.in[11]}; pg8::gemm_phase(lds, g, S, E, wv); }
    xcd_barrier(xbar, wv);

    PH(5) { pg8::Gemm g{(const char*)(T1 + DPOOL), (const char*)(ws + WS_WGLU), D, DSSM, 0, 0, DSSM}; S.init(M / 256, 2, 1, G, bid);
      EpiGlu E{T2, T1, C.in[21]}; pg8::gemm_phase(lds, g, S, E, wv); }
    xcd_barrier(xbar, wv);

    PH(6) { pg8::Gemm g{(const char*)T2, (const char*)(ws + WS_WOUT), D, D, 0, 0, D}; S.init(M / 256, 4, 1, G, bid);
      EpiRes E{C.in[0], C.in[1], Y, T0, SS1}; pg8::gemm_phase(lds, g, S, E, wv); }
    xcd_barrier(xbar, wv);

    PH(7) { pg8::Gemm g{(const char*)T0, (const char*)(ws + WS_WQ), D, D, 0, 0, D}; S.init(M / 256, 4, 1, G, bid);
      EpiQ E{T1, SS1}; pg8::gemm_phase(lds, g, S, E, wv); }
    xcd_barrier(xbar, wv);

    PH(8) { pg8::Gemm g{(const char*)T1, (const char*)(ws + WS_KB), D, D, (size_t)HD * 2, (size_t)HD * 2, HD}; S.init(SEQ / 256, 1, NHEAD, G, bid);
      EpiSoftmax E{T2, (LAS float*)(lds + 131072), (LAS float*)(lds + 131072 + 4096)}; pg8::gemm_phase(lds, g, S, E, wv); }
    for (int it = bid; it < 64; it += G) sample_attn_item(C, lds, it, wv);
    xcd_barrier(xbar, wv);

    PH(9) { pg8::Gemm g{(const char*)T2, (const char*)(ws + WS_VT), D, NMEM, (size_t)HD * 2, (size_t)HD * NMEM * 2, NMEM}; S.init(SEQ / 256, 1, NHEAD, G, bid);
      EpiO E{T0}; pg8::gemm_phase(lds, g, S, E, wv); }
    xcd_barrier(xbar, wv);

    PH(10) { pg8::Gemm g{(const char*)T0, (const char*)(ws + WS_WO), D, D, 0, 0, D}; S.init(M / 256, 4, 1, G, bid);
      EpiRes E{Y, Y + (size_t)SEQ * D, Y, T2, SS2}; pg8::gemm_phase(lds, g, S, E, wv); }
    xcd_barrier(xbar, wv);

    PH(11) { pg8::Gemm g{(const char*)T2, (const char*)(ws + WS_WUP), D, D, 0, 0, D}; S.init(M / 256, DFF / 256, 1, G, bid);
      EpiUp E{(bf16_t*)(ws + WS_U), SS2}; pg8::gemm_phase(lds, g, S, E, wv); }
    xcd_barrier(xbar, wv);

    PH(12) { pg8::Gemm g{(const char*)(ws + WS_U), (const char*)(ws + WS_WDOWN), DFF, DFF, 0, 0, DFF}; S.init(M / 256, 4, 1, G, bid);
      EpiRes E{Y, Y + (size_t)SEQ * D, Y, nullptr, SS3}; pg8::gemm_phase(lds, g, S, E, wv); }
    xcd_barrier(xbar, wv);

    { const int lane = tidx(wv) & 63, gw = bid * 8 + (tidx(wv) >> 6), NGW = G * 8; const f32x4* gr = (const f32x4*)C.in[32] + lane;
      for (int m = gw; m < M; m += NGW) { const float rs = rsqrtf(SS3[m] * (1.f / D) + EPS); f32x4* xr = (f32x4*)(Y + (size_t)m * D) + lane;
#pragma unroll
          for (int j = 0; j < 4; ++j) { const f32x4 v = xr[64 * j], gg = gr[64 * j]; xr[64 * j] = (f32x4){v.x * rs * gg.x, v.y * rs * gg.y, v.z * rs * gg.z, v.w * rs * gg.w}; } } }
}

extern "C" void kernel_launch(void* const* d_in, const int* in_sizes, int n_in, void* d_out, int out_size, void* d_ws, size_t ws_size, hipStream_t stream) {
    static int grid = 0;
    if (grid == 0) {
        if (n_in != 33 || (size_t)out_size != O_END || ws_size < WS_END) { fprintf(stderr, "kernel_launch: unexpected shapes n_in %d out %d ws %zu\n", n_in, out_size, ws_size); grid = -1; return; }
        int dev = 0, cus = 0, per_cu = 0;
        hipGetDevice(&dev); hipDeviceGetAttribute(&cus, hipDeviceAttributeMultiprocessorCount, dev);
        if (hipFuncSetAttribute((const void*)fwd_megakernel, hipFuncAttributeMaxDynamicSharedMemorySize, LDS_BYTES) != hipSuccess) { fprintf(stderr, "kernel_launch: hipFuncSetAttribute failed\n"); grid = -1; return; }
        if (hipOccupancyMaxActiveBlocksPerMultiprocessor(&per_cu, (const void*)fwd_megakernel, 512, LDS_BYTES) != hipSuccess || per_cu < 1) { fprintf(stderr, "kernel_launch: occupancy query failed (%d)\n", per_cu); (void)hipGetLastError(); per_cu = 1; }
        if (per_cu > 1) per_cu = 1;
        grid = cus * per_cu; if (grid > 256) grid = 256;
    }
    if (grid < 0) return;
    Ctx c{};
    for (int i = 0; i < 33; ++i) c.in[i] = (const float*)d_in[i];
    c.out = (float*)d_out; c.ws = (unsigned char*)d_ws;
    void* args[] = {&c};
    hipError_t e = hipLaunchCooperativeKernel((const void*)fwd_megakernel, dim3(grid), dim3(512), args, LDS_BYTES, stream);
    if (e != hipSuccess) fprintf(stderr, "cooperative launch failed: %s (grid %d)\n", hipGetErrorString(e), grid);
}
```

```cpp
#include <hip/hip_runtime.h>
#include <hip/hip_cooperative_groups.h>
#include <cstdio>
#include <cstdint>
namespace cg = cooperative_groups;

#define LAS __attribute__((address_space(3)))
typedef unsigned short bf16_t;
typedef short bf16x8 __attribute__((ext_vector_type(8)));
typedef float f32x4 __attribute__((ext_vector_type(4)));
typedef float f32x2 __attribute__((ext_vector_type(2)));
typedef unsigned u32x4 __attribute__((ext_vector_type(4)));
typedef unsigned u32x2 __attribute__((ext_vector_type(2)));

constexpr int D = 1024, SEQ = 16384, NSAMP = 256, M = SEQ + NSAMP, DFF = 4096, DPOOL = 512, DSSM = 512;
constexpr int NG = 32, NP = 64, NH = 16, TC = 16, NCH = M / TC  , NCHP = 1280, KY = 384;
constexpr int NMEM = 256, HD = 256, NHEAD = 4;
constexpr float EPS = 1e-6f;
constexpr float QSCALE = 0.0625f * 1.4426950408889634f;

constexpr size_t O_Y = 0, O_MK = (size_t)M * D, O_MV = O_MK + 262144, O_POOLP = O_MV + 262144, O_SREP = O_POOLP + 7680, O_SIMP = O_SREP + 2048,
                 O_POOLS = O_SIMP + 2048, O_SRES = O_POOLS + 122880, O_SIMS = O_SRES + 32768, O_END = O_SIMS + 32768;

constexpr size_t MiB = 1u << 20;
constexpr size_t WS_WIN = 0, WS_WOUT = 2 * MiB, WS_WQ = 4 * MiB, WS_WKV = 6 * MiB, WS_WO = 10 * MiB, WS_WUP = 12 * MiB, WS_WDOWN = 20 * MiB,
                 WS_WGLU = 28 * MiB, WS_WPOOL = 28 * MiB + 512 * 1024, WS_MN = 29 * MiB, WS_KB = 29 * MiB + 512 * 1024, WS_VT = 30 * MiB,
                 WS_AP = 30 * MiB + 512 * 1024,
                 WS_BB = WS_AP + 320 * 1024,
                 WS_KLAG = WS_BB + 256 * 1024,
                 WS_SS = WS_KLAG + 512 * 1024,
                 WS_BAR = 32 * MiB - 128 * 1024,
                 WS_WB = 32 * MiB,
                 WS_WY = 36 * MiB,
                 WS_E = 42 * MiB,
                 WS_UH = 62 * MiB,
                 WS_ZP = 92 * MiB,
                 WS_T0 = 109 * MiB, WS_T1 = 142 * MiB, WS_T2 = 175 * MiB, WS_END = 208 * MiB,
                 WS_U = 42 * MiB;
static_assert(WS_SS + 3 * M * 4 <= WS_BAR, "misc region");
static_assert(WS_U + (size_t)M * DFF * 2 <= WS_T2, "U overlay");

__device__ __forceinline__ unsigned f2bf(float f) { unsigned u = __builtin_bit_cast(unsigned, f); return (u + 0x7fffu + ((u >> 16) & 1u)) >> 16; }
__device__ __forceinline__ unsigned pk2(float lo, float hi) { return f2bf(lo) | (f2bf(hi) << 16); }
__device__ __forceinline__ float bf2f(unsigned b) { return __builtin_bit_cast(float, b << 16); }
__device__ __forceinline__ unsigned cvt_pk_bf16(float lo, float hi) { unsigned r; asm volatile("v_cvt_pk_bf16_f32 %0, %1, %2" : "=v"(r) : "v"(lo), "v"(hi)); return r; }
#define LDS_WAIT() asm volatile("s_waitcnt lgkmcnt(0)" ::: "memory")
__device__ __forceinline__ int lane_id() { int l; asm volatile("v_mbcnt_lo_u32_b32 %0, -1, 0\n\tv_mbcnt_hi_u32_b32 %0, -1, %0" : "=v"(l)); return l; }
__device__ __forceinline__ int tidx(int wv) { return wv * 64 + lane_id(); }
__device__ __forceinline__ float shfl_x(float v, int lane, int mask) { return __builtin_bit_cast(float, __builtin_amdgcn_ds_bpermute((lane ^ mask) << 2, __builtin_bit_cast(int, v))); }

namespace pg8 {
constexpr int BM = 256, BK = 64, HALF = 128, HTB = HALF * BK * 2, STAGE_BYTES = 8 * HTB, NXCD = 8, WGM = 8;
__host__ __device__ __forceinline__ int lds_byte(int r, int c) { const int st = (r >> 4) * 2 + (c >> 5), rr = r & 15, cc = c & 31, ob = rr * 64 + cc * 2; return st * 1024 + (ob ^ (((ob >> 9) & 1) << 5)); }
__host__ __device__ __forceinline__ void stage_rc(int b, int& R, int& C) { const int st = b / 1024, sb = b % 1024, swz = sb ^ (((sb >> 9) & 1) << 5); R = (st >> 1) * 16 + swz / 64; C = (st & 1) * 32 + (swz % 64) / 2; }
__host__ __device__ __forceinline__ int perm32(int rho) { const int n = rho >> 4, i = rho & 15; return 8 * (i >> 2) + 4 * n + (i & 3); }

struct Unit { int pm, pn, z; };
struct Gemm { const char* A; const char* B; int lda, ldb; size_t sAz, sBz; int K; };
struct Order {
    int nM, nN, nZ, G, c;
    __device__ void init(int nM_, int nN_, int nZ_, int G_, int c_) { nM = nM_; nN = nN_; nZ = nZ_; G = G_; c = c_; }
    __device__ bool next(int i, Unit& u) const {
        const int per = nM * nN, nwg = per * nZ; const long L = (long)i * G + c; if (L >= nwg) return false;
        int wgid = (int)L; { const int q = nwg / NXCD, r = nwg % NXCD, xcd = wgid % NXCD, off = wgid / NXCD; wgid = (xcd < r ? xcd * (q + 1) : r * (q + 1) + (xcd - r) * q) + off; }
        u.z = wgid / per; const int l = wgid % per;
        const int nig = WGM * nN, gid = l / nig, fm = gid * WGM, gsz = (nM - fm) < WGM ? (nM - fm) : WGM;
        u.pm = fm + ((l % nig) % gsz); u.pn = (l % nig) / gsz; return true;
    }
};

template <class Epi>
__device__ __forceinline__ void gemm_phase(LAS unsigned char* lds, const Gemm g, const Order& S, Epi& E, int wv) {
    const int tid = tidx(wv), wid = __builtin_amdgcn_readfirstlane(tid >> 6), lane = tid & 63, wr = wid >> 2, wc = wid & 3, fr = lane & 15, fq = lane >> 4;
    const int nt = g.K / BK;
    unsigned voffA[2], voffB[2];
#pragma unroll
    for (int i = 0; i < 2; ++i) { int R, C; stage_rc(tid * 16 + i * 8192, R, C); const int Rb = Epi::PERM ? ((R & ~31) + perm32(R & 31)) : R;
        voffA[i] = (unsigned)(R * g.lda + C) * 2u; voffB[i] = (unsigned)(Rb * g.ldb + C) * 2u; }
    const size_t kstep = (size_t)(BK * 2);
    const size_t hA = (size_t)HALF * g.lda * 2, hB = (size_t)HALF * g.ldb * 2;
    const unsigned ldsw = (unsigned)wid * 1024u;
    const int aoff = lds_byte(wr * 64 + fr, fq * 8), boff = lds_byte(wc * 32 + fr, fq * 8);
#define PG8_SA(b, h) (((b) * 2 + (h)) * HTB)
#define PG8_SB(b, h) ((4 + (b) * 2 + (h)) * HTB)
#define PG8_STAGE(bufoff, gbase, voff) do { _Pragma("unroll") for (int _i = 0; _i < 2; ++_i) \
        __builtin_amdgcn_global_load_lds((const unsigned*)((const char*)(gbase) + (voff)[_i]), (LAS unsigned*)(lds + (bufoff) + ldsw + _i * 8192), 16, 0, 0); } while (0)
#define PG8_LDA(dst, b, h) do { _Pragma("unroll") for (int m = 0; m < 4; ++m) _Pragma("unroll") for (int k = 0; k < 2; ++k) dst[m][k] = *(const LAS bf16x8*)(lds + PG8_SA(b, h) + aoff + m * 2048 + k * 1024); } while (0)
#define PG8_LDB(dst, b, h) do { _Pragma("unroll") for (int n = 0; n < 2; ++n) _Pragma("unroll") for (int k = 0; k < 2; ++k) dst[n][k] = *(const LAS bf16x8*)(lds + PG8_SB(b, h) + boff + n * 2048 + k * 1024); } while (0)
#define PG8_MMA(ai, bj, At, Bt) do { __builtin_amdgcn_s_setprio(1); _Pragma("unroll") for (int m = 0; m < 4; ++m) _Pragma("unroll") for (int n = 0; n < 2; ++n) _Pragma("unroll") for (int k = 0; k < 2; ++k) \
        acc[ai][bj][m][n] = __builtin_amdgcn_mfma_f32_16x16x32_bf16(Bt[n][k], At[m][k], acc[ai][bj][m][n], 0, 0, 0); __builtin_amdgcn_s_setprio(0); } while (0)
#define PG8_WAIT_V(n) asm volatile("s_waitcnt vmcnt(" #n ")" ::: "memory")
#define PG8_WAIT_L(n) asm volatile("s_waitcnt lgkmcnt(" #n ")" ::: "memory")
#define PG8_BAR __builtin_amdgcn_s_barrier()
#define PG8_SCHED __builtin_amdgcn_sched_barrier(0)
    Unit cur, nxt; int ui = 0;
    if (!S.next(0, cur)) return;
    f32x4 acc[2][2][4][2];
#pragma unroll
    for (int a = 0; a < 2; ++a)
#pragma unroll
        for (int b = 0; b < 2; ++b)
#pragma unroll
            for (int m = 0; m < 4; ++m)
#pragma unroll
                for (int n = 0; n < 2; ++n) acc[a][b][m][n] = (f32x4){0.f, 0.f, 0.f, 0.f};
    bf16x8 At[4][2], B0[2][2], B1[2][2];
    const char* cA = g.A + (size_t)cur.z * g.sAz + (size_t)cur.pm * 2 * hA; const char* cB = g.B + (size_t)cur.z * g.sBz + (size_t)cur.pn * 2 * hB;
    PG8_STAGE(PG8_SB(0, 0), cB, voffB); PG8_STAGE(PG8_SB(0, 1), cB + hB, voffB); PG8_STAGE(PG8_SA(0, 0), cA, voffA); PG8_STAGE(PG8_SA(0, 1), cA + hA, voffA);
    if (wr == 1) PG8_BAR;
    PG8_WAIT_V(2); PG8_BAR;
    PG8_STAGE(PG8_SB(1, 0), cB + kstep, voffB); PG8_STAGE(PG8_SA(1, 0), cA + kstep, voffA); PG8_STAGE(PG8_SB(1, 1), cB + hB + kstep, voffB);
    PG8_WAIT_V(6); PG8_BAR;
    for (;;) {
        const bool has_next = S.next(ui + 1, nxt);
        const char* nA = has_next ? g.A + (size_t)nxt.z * g.sAz + (size_t)nxt.pm * 2 * hA : cA; const char* nB = has_next ? g.B + (size_t)nxt.z * g.sBz + (size_t)nxt.pn * 2 * hB : cB;
        for (int t = 0; t < nt; t += 2) {
            const bool last = (t == nt - 2);
            const char* a1 = cA + (size_t)(t + 1) * kstep;
            const char* a2 = last ? nA : cA + (size_t)(t + 2) * kstep; const char* b2 = last ? nB : cB + (size_t)(t + 2) * kstep;
            const char* a3 = a2 + kstep; const char* b3 = b2 + kstep;
            PG8_LDB(B0, 0, 0); PG8_LDB(B1, 0, 1); PG8_SCHED; PG8_LDA(At, 0, 0); PG8_STAGE(PG8_SA(1, 1), a1 + hA, voffA);
            PG8_WAIT_V(8); PG8_WAIT_L(0); PG8_BAR; PG8_MMA(0, 0, At, B0); PG8_MMA(0, 1, At, B1); PG8_BAR; PG8_SCHED;
            PG8_LDA(At, 0, 1); PG8_STAGE(PG8_SB(0, 0), b2, voffB); PG8_STAGE(PG8_SB(0, 1), b2 + hB, voffB); PG8_STAGE(PG8_SA(0, 0), a2, voffA);
            PG8_WAIT_V(8); PG8_WAIT_L(0); PG8_BAR; PG8_MMA(1, 0, At, B0); PG8_MMA(1, 1, At, B1); PG8_BAR; PG8_SCHED;
            PG8_LDB(B0, 1, 0); PG8_LDB(B1, 1, 1); PG8_SCHED; PG8_LDA(At, 1, 0); PG8_STAGE(PG8_SA(0, 1), a2 + hA, voffA);
            PG8_WAIT_V(8); PG8_WAIT_L(0); PG8_BAR; PG8_MMA(0, 0, At, B0); PG8_MMA(0, 1, At, B1); PG8_BAR; PG8_SCHED;
            PG8_LDA(At, 1, 1); PG8_STAGE(PG8_SB(1, 0), b3, voffB); PG8_STAGE(PG8_SB(1, 1), b3 + hB, voffB); PG8_STAGE(PG8_SA(1, 0), a3, voffA);
            PG8_WAIT_V(8); PG8_WAIT_L(0); PG8_BAR; PG8_MMA(1, 0, At, B0); PG8_MMA(1, 1, At, B1); PG8_BAR; PG8_SCHED;
        }
        if (wr == 0) PG8_BAR;
        { Unit ue = cur; int fre = fr, fqe = fq;
          asm volatile("" : "+s"(ue.pm), "+s"(ue.pn), "+s"(ue.z), "+v"(fre), "+v"(fqe));
          E(acc, ue, wr, wc, fre, fqe); }
        if (!has_next) break;
#pragma unroll
        for (int a = 0; a < 2; ++a)
#pragma unroll
            for (int b = 0; b < 2; ++b)
#pragma unroll
                for (int m = 0; m < 4; ++m)
#pragma unroll
                    for (int n = 0; n < 2; ++n) acc[a][b][m][n] = (f32x4){0.f, 0.f, 0.f, 0.f};
        cur = nxt; cA = nA; cB = nB; ++ui;
        if (wr == 1) PG8_BAR;
    }
    PG8_WAIT_V(0);
    PG8_BAR;
#undef PG8_SA
#undef PG8_SB
#undef PG8_STAGE
#undef PG8_LDA
#undef PG8_LDB
#undef PG8_MMA
#undef PG8_WAIT_V
#undef PG8_WAIT_L
#undef PG8_BAR
#undef PG8_SCHED
}
}
using pg8::Unit;
typedef f32x4 Acc[2][2][4][2];

#define EPI_ROWS(ai, m) (u.pm * 256 + (ai) * 128 + wr * 64 + (m) * 16 + fr)
__device__ __forceinline__ bool mfence() { asm volatile("" ::: "memory"); return true; }
#define FOR_AI_M _Pragma("unroll") for (int ai = 0; ai < 2; ++ai) _Pragma("unroll") for (int m = 0; m < 4; ++m) if (mfence())
#define FOR_BJ _Pragma("unroll") for (int bj = 0; bj < 2; ++bj)
__device__ __forceinline__ u32x4 pack8(const f32x4 v0, const f32x4 v1) { u32x4 w; w.x = cvt_pk_bf16(v0[0], v0[1]); w.y = cvt_pk_bf16(v0[2], v0[3]); w.z = cvt_pk_bf16(v1[0], v1[1]); w.w = cvt_pk_bf16(v1[2], v1[3]); return w; }

struct EpiZ {
    static constexpr bool PERM = true;
    bf16_t* ZP; bf16_t* UH; float* out;
    __device__ __forceinline__ void operator()(Acc& acc, const Unit& u, int wr, int wc, int fr, int fq) const {
        FOR_AI_M { const int row = EPI_ROWS(ai, m);
            FOR_BJ { const int col = u.pn * 256 + bj * 128 + wc * 32 + 8 * fq; const f32x4 v0 = acc[ai][bj][m][0], v1 = acc[ai][bj][m][1]; const u32x4 w = pack8(v0, v1);
                if (col < DPOOL) {
                    *(u32x4*)(ZP + (size_t)row * DPOOL + col) = w;
                    float* dst = nullptr;
                    if (row >= SEQ - 15 && row < SEQ) dst = out + O_POOLP + (size_t)(row - (SEQ - 15)) * DPOOL + col;
                    else if (row >= SEQ && ((row & 15) != 0)) dst = out + O_POOLS + ((size_t)((row - SEQ) >> 4) * 15 + ((row & 15) - 1)) * DPOOL + col;
                    if (dst) { *(f32x4*)dst = v0; *(f32x4*)(dst + 4) = v1; }
                } else {
                    const int cc = col - DPOOL, gg = cc >> 4, hh = cc & 15;
                    *(u32x4*)(UH + ((size_t)gg * NCHP + (row >> 4)) * KY + (row & 15) * 16 + hh) = w;
                } } }
    }
};
struct EpiKV {
    static constexpr bool PERM = false;
    float* out; bf16_t* KB; bf16_t* VT;
    __device__ __forceinline__ void operator()(Acc& acc, const Unit& u, int wr, int wc, int fr, int fq) const {
        FOR_AI_M { const int row = EPI_ROWS(ai, m);
            FOR_BJ {
#pragma unroll
                for (int n = 0; n < 2; ++n) { const int col = u.pn * 256 + bj * 128 + wc * 32 + 16 * n + 4 * fq; const f32x4 v = acc[ai][bj][m][n];
                    if (col < D) { *(f32x4*)(out + O_MK + (size_t)row * D + col) = v; u32x2 w; w.x = cvt_pk_bf16(v[0], v[1]); w.y = cvt_pk_bf16(v[2], v[3]); *(u32x2*)(KB + (size_t)row * D + col) = w; }
                    else { const int c2 = col - D; *(f32x4*)(out + O_MV + (size_t)row * D + c2) = v; } } }
            asm volatile("" ::: "memory"); }
    }
};
struct EpiE {
    static constexpr bool PERM = false;
    float* E;
    __device__ __forceinline__ void operator()(Acc& acc, const Unit& u, int wr, int wc, int fr, int fq) const {
        FOR_AI_M { const int row = EPI_ROWS(ai, m);
#pragma unroll
            for (int n = 0; n < 2; ++n) { const int col = wc * 32 + 16 * n + 4 * fq; *(f32x4*)(E + ((size_t)u.z * NCHP + row) * 128 + col) = acc[ai][0][m][n]; } }
    }
};
__device__ __forceinline__ float gelu_tanh(float x) {
    const float t = 0.7978845608028654f * (x + 0.044715f * x * x * x);
    const float e = __expf(-2.f * t);
    return x / (1.f + e);
}
struct EpiY {
    static constexpr bool PERM = true;
    bf16_t* MIX;
    __device__ __forceinline__ void operator()(Acc& acc, const Unit& u, int wr, int wc, int fr, int fq) const {
        FOR_AI_M { const int ch = EPI_ROWS(ai, m); if (ch < NCH) {
            FOR_BJ { const int col = bj * 128 + wc * 32 + 8 * fq, t = col >> 4, hh = col & 15; f32x4 v0 = acc[ai][bj][m][0], v1 = acc[ai][bj][m][1];
#pragma unroll
                for (int j = 0; j < 4; ++j) { v0[j] = gelu_tanh(v0[j]); v1[j] = gelu_tanh(v1[j]); }
                *(u32x4*)(MIX + (size_t)(ch * 16 + t) * D + DPOOL + u.z * 16 + hh) = pack8(v0, v1); } } }
    }
};
struct EpiPool {
    static constexpr bool PERM = true;
    bf16_t* CAT; const float* scale;
    __device__ __forceinline__ void operator()(Acc& acc, const Unit& u, int wr, int wc, int fr, int fq) const {
        FOR_BJ { const int col = u.pn * 256 + bj * 128 + wc * 32 + 8 * fq; const f32x4 s0 = *(const f32x4*)(scale + col), s1 = *(const f32x4*)(scale + col + 4);
            FOR_AI_M { const int row = EPI_ROWS(ai, m); *(u32x4*)(CAT + (size_t)row * D + col) = pack8(acc[ai][bj][m][0] * s0, acc[ai][bj][m][1] * s1); } }
    }
};
struct EpiGlu {
    static constexpr bool PERM = true;
    bf16_t* CAT; const bf16_t* MIX; const float* bias;
    __device__ __forceinline__ void operator()(Acc& acc, const Unit& u, int wr, int wc, int fr, int fq) const {
        FOR_BJ { const int col = u.pn * 256 + bj * 128 + wc * 32 + 8 * fq; const f32x4 b0 = *(const f32x4*)(bias + col), b1 = *(const f32x4*)(bias + col + 4);
            FOR_AI_M { const int row = EPI_ROWS(ai, m); const u32x4 yv = *(const u32x4*)(MIX + (size_t)row * D + DPOOL + col);
                f32x4 v0 = acc[ai][bj][m][0] + b0, v1 = acc[ai][bj][m][1] + b1; const unsigned yw[4] = {yv.x, yv.y, yv.z, yv.w};
#pragma unroll
                for (int j = 0; j < 4; ++j) { const float ya = bf2f(yw[j >> 1] >> ((j & 1) * 16) & 0xffffu), yb = bf2f(yw[2 + (j >> 1)] >> ((j & 1) * 16) & 0xffffu);
                    v0[j] = ya / (1.f + __expf(-v0[j])); v1[j] = yb / (1.f + __expf(-v1[j])); }
                *(u32x4*)(CAT + (size_t)row * D + DPOOL + col) = pack8(v0, v1); } }
    }
};
struct EpiRes {
    static constexpr bool PERM = false;
    const float* baseP; const float* baseS; float* out; bf16_t* Xb; float* SS;
    __device__ __forceinline__ void operator()(Acc& acc, const Unit& u, int wr, int wc, int fr, int fq) const {
        FOR_AI_M { const int row = EPI_ROWS(ai, m); const float* brow = (row < SEQ) ? baseP + (size_t)row * D : baseS + (size_t)(row - SEQ) * D; float ssq = 0.f;
            FOR_BJ {
#pragma unroll
                for (int n = 0; n < 2; ++n) { const int col = u.pn * 256 + bj * 128 + wc * 32 + 16 * n + 4 * fq; const f32x4 v = acc[ai][bj][m][n] + *(const f32x4*)(brow + col);
                    *(f32x4*)(out + (size_t)row * D + col) = v; ssq += (v[0] * v[0] + v[1] * v[1]) + (v[2] * v[2] + v[3] * v[3]);
                    if (Xb) { u32x2 w; w.x = cvt_pk_bf16(v[0], v[1]); w.y = cvt_pk_bf16(v[2], v[3]); *(u32x2*)(Xb + (size_t)row * D + col) = w; } } }
            ssq += shfl_x(ssq, fr + 16 * fq, 16); ssq += shfl_x(ssq, fr + 16 * fq, 32);
            if (SS && fq == 0) atomicAdd(SS + row, ssq); }
    }
};
struct EpiQ {
    static constexpr bool PERM = true;
    bf16_t* Q; const float* SS;
    __device__ __forceinline__ void operator()(Acc& acc, const Unit& u, int wr, int wc, int fr, int fq) const {
        FOR_AI_M { const int row = EPI_ROWS(ai, m); const float rs = rsqrtf(SS[row] * (1.f / D) + EPS) * QSCALE;
            FOR_BJ { const int col = u.pn * 256 + bj * 128 + wc * 32 + 8 * fq; *(u32x4*)(Q + (size_t)row * D + col) = pack8(acc[ai][bj][m][0] * rs, acc[ai][bj][m][1] * rs); } }
    }
};
struct EpiSoftmax {
    static constexpr bool PERM = true;
    bf16_t* P; LAS float* tmax; LAS float* tsum;
    __device__ __forceinline__ void operator()(Acc& acc, const Unit& u, int wr, int wc, int fr, int fq) const {
        FOR_AI_M { float mx = -3.0e38f;
            FOR_BJ {
#pragma unroll
                for (int n = 0; n < 2; ++n) { const f32x4 v = acc[ai][bj][m][n]; mx = fmaxf(mx, fmaxf(fmaxf(v[0], v[1]), fmaxf(v[2], v[3]))); } }
            mx = fmaxf(mx, shfl_x(mx, fr + 16 * fq, 16)); mx = fmaxf(mx, shfl_x(mx, fr + 16 * fq, 32));
            if (fq == 0) tmax[(ai * 128 + wr * 64 + m * 16 + fr) * 4 + wc] = mx; }
        LDS_WAIT(); __builtin_amdgcn_s_barrier(); asm volatile("" ::: "memory");
        FOR_AI_M { const int r = ai * 128 + wr * 64 + m * 16 + fr; const f32x4 t = *(const LAS f32x4*)(tmax + r * 4); const float mx = fmaxf(fmaxf(t[0], t[1]), fmaxf(t[2], t[3])); float s = 0.f;
            FOR_BJ {
#pragma unroll
                for (int n = 0; n < 2; ++n) { f32x4 v = acc[ai][bj][m][n];
#pragma unroll
                    for (int j = 0; j < 4; ++j) { v[j] = __builtin_amdgcn_exp2f(v[j] - mx); s += v[j]; }
                    acc[ai][bj][m][n] = v; } }
            s += shfl_x(s, fr + 16 * fq, 16); s += shfl_x(s, fr + 16 * fq, 32);
            if (fq == 0) tsum[r * 4 + wc] = s; }
        LDS_WAIT(); __builtin_amdgcn_s_barrier(); asm volatile("" ::: "memory");
        FOR_AI_M { const int r = ai * 128 + wr * 64 + m * 16 + fr, row = u.pm * 256 + r; const f32x4 t = *(const LAS f32x4*)(tsum + r * 4); const float inv = 1.f / ((t[0] + t[1]) + (t[2] + t[3]));
            FOR_BJ { const int col = u.z * 256 + bj * 128 + wc * 32 + 8 * fq; *(u32x4*)(P + (size_t)row * D + col) = pack8(acc[ai][bj][m][0] * inv, acc[ai][bj][m][1] * inv); } }
    }
};
struct EpiO {
    static constexpr bool PERM = true;
    bf16_t* O;
    __device__ __forceinline__ void operator()(Acc& acc, const Unit& u, int wr, int wc, int fr, int fq) const {
        FOR_AI_M { const int row = EPI_ROWS(ai, m);
            FOR_BJ { const int col = u.z * 256 + bj * 128 + wc * 32 + 8 * fq; *(u32x4*)(O + (size_t)row * D + col) = pack8(acc[ai][bj][m][0], acc[ai][bj][m][1]); } }
    }
};
struct EpiUp {
    static constexpr bool PERM = true;
    bf16_t* U; const float* SS;
    __device__ __forceinline__ void operator()(Acc& acc, const Unit& u, int wr, int wc, int fr, int fq) const {
        FOR_AI_M { const int row = EPI_ROWS(ai, m); const float rs = rsqrtf(SS[row] * (1.f / D) + EPS);
            FOR_BJ { const int col = u.pn * 256 + bj * 128 + wc * 32 + 8 * fq; f32x4 v0 = acc[ai][bj][m][0] * rs, v1 = acc[ai][bj][m][1] * rs;
#pragma unroll
                for (int j = 0; j < 4; ++j) { const float a = fmaxf(v0[j], 0.f), b = fmaxf(v1[j], 0.f); v0[j] = a * a; v1[j] = b * b; }
                *(u32x4*)(U + (size_t)row * DFF + col) = pack8(v0, v1); } }
    }
};

struct Ctx {
    const float* in[33]; float* out; unsigned char* ws;
};
__device__ __forceinline__ float wave_sum(float v, int lane) {
#pragma unroll
    for (int o = 1; o < 64; o <<= 1) v += shfl_x(v, lane, o);
    return v;
}
__device__ __forceinline__ float wave_max(float v, int lane) {
#pragma unroll
    for (int o = 1; o < 64; o <<= 1) v = fmaxf(v, shfl_x(v, lane, o));
    return v;
}
__device__ __forceinline__ void transpose_item(const float* W, int ldw, int nblk, bf16_t* WT, int ldt, int row_off, int col_off, const float* ksc, LAS float* scr, int item, int lane) {
    const int kb = item / nblk, nb = item % nblk, k0 = 64 * kb, n0 = 32 * nb;
#pragma unroll 8
    for (int i = 0; i < 32; ++i) { const int kk = 2 * i + (lane >> 5); float v = W[(size_t)(k0 + kk) * ldw + n0 + (lane & 31)]; if (ksc) v *= ksc[k0 + kk]; scr[kk * 33 + (lane & 31)] = v; }
    LDS_WAIT(); asm volatile("" ::: "memory");
    const int c = lane & 7;
#pragma unroll
    for (int j = 0; j < 4; ++j) { const int n = (lane >> 3) + 8 * j; const LAS float* s = scr + (8 * c) * 33 + n;
        u32x4 o; o.x = pk2(s[0 * 33], s[1 * 33]); o.y = pk2(s[2 * 33], s[3 * 33]); o.z = pk2(s[4 * 33], s[5 * 33]); o.w = pk2(s[6 * 33], s[7 * 33]);
        *(u32x4*)(WT + (size_t)(row_off + n0 + n) * ldt + col_off + k0 + 8 * c) = o; }
    LDS_WAIT(); asm volatile("" ::: "memory");
}
__device__ __forceinline__ void rms_row_to_bf16(const float* xrow, const float* g, bf16_t* orow, int lane) {
    const f32x4* xr = (const f32x4*)xrow + lane; const f32x4* gr = (const f32x4*)g + lane;
    f32x4 v[4]; float s = 0.f;
#pragma unroll
    for (int j = 0; j < 4; ++j) { v[j] = xr[64 * j]; s += (v[j].x * v[j].x + v[j].y * v[j].y) + (v[j].z * v[j].z + v[j].w * v[j].w); }
    const float rs = rsqrtf(wave_sum(s, lane) * (1.f / D) + EPS);
    u32x2* o8 = (u32x2*)orow + lane;
#pragma unroll
    for (int j = 0; j < 4; ++j) { const f32x4 gg = gr[64 * j]; u32x2 w; w.x = pk2(v[j].x * rs * gg.x, v[j].y * rs * gg.y); w.y = pk2(v[j].z * rs * gg.z, v[j].w * rs * gg.w); o8[64 * j] = w; }
}

__device__ __forceinline__ void p0_prologue(const Ctx& C, LAS unsigned char* lds, int G, int bid, int wv) {
    const int tid = tidx(wv), lane = tid & 63, wave = tid >> 6;
    LAS float* scr = (LAS float*)(lds + wave * 16384);
    const int gw = bid * 8 + wave, NGW = G * 8;
    unsigned char* ws = C.ws;
    constexpr int I_SQ = 16 * 32, I_UP = 16 * 128, I_DN = 64 * 32, I_GLU = 8 * 16, I_PL = 4 * 2 * 4;
    constexpr int NIT = 6 * I_SQ + I_UP + I_DN + I_GLU + I_PL;
    for (int it = gw; it < NIT; it += NGW) {
        int r = it;
        if (r < I_SQ) { transpose_item(C.in[9], D, 32, (bf16_t*)(ws + WS_WIN), D, 0, 0, nullptr, scr, r, lane); continue; } r -= I_SQ;
        if (r < I_SQ) { transpose_item(C.in[22], D, 32, (bf16_t*)(ws + WS_WOUT), D, 0, 0, nullptr, scr, r, lane); continue; } r -= I_SQ;
        if (r < I_SQ) { transpose_item(C.in[25], D, 32, (bf16_t*)(ws + WS_WQ), D, 0, 0, C.in[23], scr, r, lane); continue; } r -= I_SQ;
        if (r < I_SQ) { transpose_item(C.in[26], D, 32, (bf16_t*)(ws + WS_WKV), D, 0, 0, nullptr, scr, r, lane); continue; } r -= I_SQ;
        if (r < I_SQ) { transpose_item(C.in[27], D, 32, (bf16_t*)(ws + WS_WKV), D, D, 0, nullptr, scr, r, lane); continue; } r -= I_SQ;
        if (r < I_SQ) { transpose_item(C.in[28], D, 32, (bf16_t*)(ws + WS_WO), D, 0, 0, nullptr, scr, r, lane); continue; } r -= I_SQ;
        if (r < I_UP) { transpose_item(C.in[30], DFF, 128, (bf16_t*)(ws + WS_WUP), D, 0, 0, C.in[29], scr, r, lane); continue; } r -= I_UP;
        if (r < I_DN) { transpose_item(C.in[31], D, 32, (bf16_t*)(ws + WS_WDOWN), DFF, 0, 0, nullptr, scr, r, lane); continue; } r -= I_DN;
        if (r < I_GLU) { transpose_item(C.in[20], DSSM, 16, (bf16_t*)(ws + WS_WGLU), DSSM, 0, 0, nullptr, scr, r, lane); continue; } r -= I_GLU;
        { const int gp = r / 8, rr = r % 8; transpose_item(C.in[10] + (size_t)gp * 128 * 128, 128, 4, (bf16_t*)(ws + WS_WPOOL), DPOOL, gp * 128, gp * 128, nullptr, scr, rr, lane); }
    }
    const int gt = bid * 512 + tid, NGT = G * 512;
    { bf16_t* WP = (bf16_t*)(ws + WS_WPOOL);
      for (int i = gt; i < 512 * 512 / 8; i += NGT) { const int n = i / 64, k = (i % 64) * 8; if ((n >> 7) != (k >> 7)) *(u32x4*)(WP + (size_t)n * DPOOL + k) = (u32x4){0u, 0u, 0u, 0u}; }
      float* SS = (float*)(ws + WS_SS); for (int i = gt; i < 3 * M; i += NGT) SS[i] = 0.f; }
    { bf16_t* H1 = (bf16_t*)(ws + WS_T0); bf16_t* MN = (bf16_t*)(ws + WS_MN);
      for (int m = gw; m < M + NMEM; m += NGW) {
          if (m < SEQ) rms_row_to_bf16(C.in[0] + (size_t)m * D, C.in[8], H1 + (size_t)m * D, lane);
          else if (m < M) rms_row_to_bf16(C.in[1] + (size_t)(m - SEQ) * D, C.in[8], H1 + (size_t)m * D, lane);
          else rms_row_to_bf16(C.in[7] + (size_t)(m - M) * D, C.in[24], MN + (size_t)(m - M) * D, lane); } }
    { float* AP = (float*)(ws + WS_AP); float* BB = (float*)(ws + WS_BB);
      for (int i = gt; i < NG * NP; i += NGT) { const int g = i / NP, p = i % NP;
          const float are = C.in[12][i], aim = C.in[13][i], dt = expf(C.in[19][g]);
          const float mag = expf(are * dt); float sn, cs; sincosf(aim * dt, &sn, &cs);
          const float abr = mag * cs, abi = mag * sn;
          float pr = 1.f, pi = 0.f;
          for (int k = 0; k <= 16; ++k) { AP[((size_t)(g * 17 + k) * NP + p) * 2] = pr; AP[((size_t)(g * 17 + k) * NP + p) * 2 + 1] = pi; const float nr = pr * abr - pi * abi, ni = pr * abi + pi * abr; pr = nr; pi = ni; }
          const float nr = abr - 1.f, ni = abi, den = are * are + aim * aim; const float cr = (nr * are + ni * aim) / den, ci = (ni * are - nr * aim) / den;
          for (int h = 0; h < NH; ++h) { const float br = C.in[14][(size_t)i * NH + h], bi = C.in[15][(size_t)i * NH + h];
              BB[((size_t)i * NH + h) * 2] = cr * br - ci * bi; BB[((size_t)i * NH + h) * 2 + 1] = cr * bi + ci * br; } } }
}
__device__ __forceinline__ void p1_pre(const Ctx& C, int G, int bid, int wv) {
    const int gt = bid * 512 + tidx(wv), NGT = G * 512; unsigned char* ws = C.ws;
    const float* AP = (const float*)(ws + WS_AP); const float* BB = (const float*)(ws + WS_BB); float* KL = (float*)(ws + WS_KLAG); bf16_t* WB = (bf16_t*)(ws + WS_WB);
    for (int i = gt; i < NG * 16 * 16 * 16; i += NGT) { const int hp = i & 15, h = (i >> 4) & 15, k = (i >> 8) & 15, g = i >> 12; float s = 0.f;
        for (int p = 0; p < NP; ++p) { const float cr = C.in[16][((size_t)g * NH + h) * NP + p], ci = C.in[17][((size_t)g * NH + h) * NP + p];
            const float ar = AP[((size_t)(g * 17 + k) * NP + p) * 2], ai = AP[((size_t)(g * 17 + k) * NP + p) * 2 + 1];
            const float br = BB[((size_t)(g * NP + p) * NH + hp) * 2], bi = BB[((size_t)(g * NP + p) * NH + hp) * 2 + 1];
            const float tr = ar * br - ai * bi, ti = ar * bi + ai * br; s += cr * tr - ci * ti; }
        if (k == 0 && h == hp) s += C.in[18][g * NH + h];
        KL[i] = s; }
    for (int i = gt; i < NG * 256 * 256; i += NGT) { const int k = i & 255, n = (i >> 8) & 255, g = i >> 16; float v = 0.f;
        if (n < 128) { const int p = n & 63, s = k >> 4, hp = k & 15; const float ar = AP[((size_t)(g * 17 + 15 - s) * NP + p) * 2], ai = AP[((size_t)(g * 17 + 15 - s) * NP + p) * 2 + 1];
            const float br = BB[((size_t)(g * NP + p) * NH + hp) * 2], bi = BB[((size_t)(g * NP + p) * NH + hp) * 2 + 1];
            v = (n < 64) ? (ar * br - ai * bi) : (ar * bi + ai * br); }
        WB[i] = (bf16_t)f2bf(v); }
}
__device__ __forceinline__ void p2a_pre(const Ctx& C, int G, int bid, int wv) {
    const int gt = bid * 512 + tidx(wv), NGT = G * 512; unsigned char* ws = C.ws;
    const float* AP = (const float*)(ws + WS_AP); const float* KL = (const float*)(ws + WS_KLAG); bf16_t* WY = (bf16_t*)(ws + WS_WY);
    for (int i = gt; i < NG * 256 * KY; i += NGT) { const int k = i % KY, n = (i / KY) & 255, g = i / (KY * 256), t = n >> 4, h = n & 15; float v = 0.f;
        if (k < 256) { const int s = k >> 4, hp = k & 15; if (s <= t) v = KL[(((size_t)g * 16 + (t - s)) * 16 + h) * 16 + hp]; }
        else { const int p = (k - 256) & 63; const float cr = C.in[16][((size_t)g * NH + h) * NP + p], ci = C.in[17][((size_t)g * NH + h) * NP + p];
            const float ar = AP[((size_t)(g * 17 + t + 1) * NP + p) * 2], ai = AP[((size_t)(g * 17 + t + 1) * NP + p) * 2 + 1];
            v = (k < 320) ? (cr * ar - ci * ai) : -(cr * ai + ci * ar); }
        WY[i] = (bf16_t)f2bf(v); }
}
__device__ __forceinline__ void vt_transpose(const Ctx& C, int G, int bid, int wv) {
    const int gt = bid * 512 + tidx(wv), NGT = G * 512; const float* MV = C.out + O_MV; bf16_t* VT = (bf16_t*)(C.ws + WS_VT);
    for (int i = gt; i < D * NMEM; i += NGT) { const int c = i >> 8, n = i & 255; VT[i] = (bf16_t)f2bf(MV[(size_t)n * D + c]); }
}
__device__ __forceinline__ void p2b_prefix(const Ctx& C, LAS unsigned char* lds, int g, int wv) {
    const int tid = tidx(wv), p = tid & 63, seg = tid >> 6; unsigned char* ws = C.ws;
    const float* AP = (const float*)(ws + WS_AP); const float* E = (const float*)(ws + WS_E) + (size_t)g * NCHP * 128; bf16_t* UH = (bf16_t*)(ws + WS_UH) + (size_t)g * NCHP * KY;
    LAS float* L = (LAS float*)lds;
    const float ar = AP[((size_t)(g * 17 + 16) * NP + p) * 2], ai = AP[((size_t)(g * 17 + 16) * NP + p) * 2 + 1];
    float hr = 0.f, hi = 0.f; const int c0 = seg * 128;
    for (int c = c0; c < c0 + 128; c += 8) { float er[8], ei[8];
#pragma unroll
        for (int j = 0; j < 8; ++j) { er[j] = E[(size_t)(c + j) * 128 + p]; ei[j] = E[(size_t)(c + j) * 128 + 64 + p]; }
#pragma unroll
        for (int j = 0; j < 8; ++j) { const float nr = ar * hr - ai * hi + er[j], ni = ar * hi + ai * hr + ei[j]; hr = nr; hi = ni; } }
    L[(seg * 64 + p) * 2] = hr; L[(seg * 64 + p) * 2 + 1] = hi;
    float sr = ar, si = ai;
#pragma unroll
    for (int j = 0; j < 7; ++j) { const float nr = sr * sr - si * si, ni = 2.f * sr * si; sr = nr; si = ni; }
    __syncthreads();
    hr = 0.f; hi = 0.f;
    for (int j = 0; j < seg; ++j) { const float lr = L[(j * 64 + p) * 2], li = L[(j * 64 + p) * 2 + 1]; const float nr = sr * hr - si * hi + lr, ni = sr * hi + si * hr + li; hr = nr; hi = ni; }
    for (int c = c0; c < c0 + 128; c += 8) { float er[8], ei[8];
#pragma unroll
        for (int j = 0; j < 8; ++j) { er[j] = E[(size_t)(c + j) * 128 + p]; ei[j] = E[(size_t)(c + j) * 128 + 64 + p]; }
#pragma unroll
        for (int j = 0; j < 8; ++j) { UH[(size_t)(c + j) * KY + 256 + p] = (bf16_t)f2bf(hr); UH[(size_t)(c + j) * KY + 320 + p] = (bf16_t)f2bf(hi);
            const float nr = ar * hr - ai * hi + er[j], ni = ar * hi + ai * hr + ei[j]; hr = nr; hi = ni; } }
    if (seg == 7) { C.out[O_SREP + g * NP + p] = hr; C.out[O_SIMP + g * NP + p] = hi; }
    for (int b = seg; b < 16; b += 8) { const float h0r = C.in[5][((size_t)b * NG + g) * NP + p], h0i = C.in[6][((size_t)b * NG + g) * NP + p]; const int c = 1024 + b;
        UH[(size_t)c * KY + 256 + p] = (bf16_t)f2bf(h0r); UH[(size_t)c * KY + 320 + p] = (bf16_t)f2bf(h0i);
        C.out[O_SRES + ((size_t)b * NG + g) * NP + p] = ar * h0r - ai * h0i + E[(size_t)c * 128 + p];
        C.out[O_SIMS + ((size_t)b * NG + g) * NP + p] = ar * h0i + ai * h0r + E[(size_t)c * 128 + 64 + p]; }
    __syncthreads();
}
__device__ __forceinline__ void p2b_pool(const Ctx& C, int worker, int nworkers, int wv) {
    const int tid = tidx(wv), sub = tid >> 6, cl = (tid & 63) * 8; unsigned char* ws = C.ws;
    const bf16_t* ZP = (const bf16_t*)(ws + WS_ZP); bf16_t* MIX = (bf16_t*)(ws + WS_T1);
    const int w = 2 << (cl >> 7);
    for (int blk = worker * 8 + sub; blk < NCH; blk += nworkers * 8) { const int r0 = blk * 16; const bool samp = r0 >= SEQ; const int b = (r0 - SEQ) >> 4;
        for (int t = 0; t < 16; ++t) { const int row = r0 + t; float s[8] = {0.f, 0.f, 0.f, 0.f, 0.f, 0.f, 0.f, 0.f}; float cur[8];
            for (int j = 0; j < w; ++j) { const int rr = row - j; float v[8];
                if (!samp) { if (rr < 0) break; const u32x4 q = *(const u32x4*)(ZP + (size_t)rr * DPOOL + cl); const unsigned qq[4] = {q.x, q.y, q.z, q.w};
#pragma unroll
                    for (int e = 0; e < 8; ++e) v[e] = bf2f((qq[e >> 1] >> ((e & 1) * 16)) & 0xffffu); }
                else if (t - j >= 0) { const u32x4 q = *(const u32x4*)(ZP + (size_t)rr * DPOOL + cl); const unsigned qq[4] = {q.x, q.y, q.z, q.w};
#pragma unroll
                    for (int e = 0; e < 8; ++e) v[e] = bf2f((qq[e >> 1] >> ((e & 1) * 16)) & 0xffffu); }
                else { const float* hp = C.in[4] + ((size_t)b * 15 + (15 + t - j)) * DPOOL + cl; const f32x4 a = *(const f32x4*)hp, bb = *(const f32x4*)(hp + 4);
                    v[0] = a[0]; v[1] = a[1]; v[2] = a[2]; v[3] = a[3]; v[4] = bb[0]; v[5] = bb[1]; v[6] = bb[2]; v[7] = bb[3]; }
#pragma unroll
                for (int e = 0; e < 8; ++e) { s[e] += v[e]; if (j == 0) cur[e] = v[e]; } }
            const int cnt = samp ? w : ((row + 1 < w) ? row + 1 : w); const float inv = 1.f / (float)cnt;
            u32x4 o; o.x = pk2(s[0] * inv - cur[0], s[1] * inv - cur[1]); o.y = pk2(s[2] * inv - cur[2], s[3] * inv - cur[3]); o.z = pk2(s[4] * inv - cur[4], s[5] * inv - cur[5]); o.w = pk2(s[6] * inv - cur[6], s[7] * inv - cur[7]);
            *(u32x4*)(MIX + (size_t)row * D + cl) = o; } }
}
__device__ __forceinline__ void sample_attn_item(const Ctx& C, LAS unsigned char* lds, int item, int wv) {
    const int tid = tidx(wv), lane = tid & 63, wave = tid >> 6, fr = lane & 15, fq = lane >> 4; const int b = item >> 2, h = item & 3; unsigned char* ws = C.ws;
    const bf16_t* Q = (const bf16_t*)(ws + WS_T1); bf16_t* O = (bf16_t*)(ws + WS_T0);
    const float* Kc = C.in[2] + (size_t)b * NMEM * D + h * HD; const float* Vc = C.in[3] + (size_t)b * NMEM * D + h * HD;
    LAS float* Sl = (LAS float*)lds;
    LAS float* PT = (LAS float*)(lds + 16384);
    bf16x8 qf[8];
#pragma unroll
    for (int kk = 0; kk < 8; ++kk) qf[kk] = *(const bf16x8*)(Q + (size_t)(SEQ + b * 16 + fr) * D + h * HD + kk * 32 + fq * 8);
#pragma unroll
    for (int kbi = 0; kbi < 2; ++kbi) { const int kb = wave + 8 * kbi; f32x4 acc = {0.f, 0.f, 0.f, 0.f}; const float* kr = Kc + (size_t)(kb * 16 + fr) * D + fq * 8;
#pragma unroll
        for (int kk = 0; kk < 8; ++kk) { const f32x4 a = *(const f32x4*)(kr + kk * 32), c = *(const f32x4*)(kr + kk * 32 + 4); const u32x4 w = pack8(a, c);
            acc = __builtin_amdgcn_mfma_f32_16x16x32_bf16(qf[kk], __builtin_bit_cast(bf16x8, w), acc, 0, 0, 0); }
#pragma unroll
        for (int r = 0; r < 4; ++r) Sl[(4 * fq + r) * 256 + kb * 16 + fr] = acc[r]; }
    __syncthreads();
#pragma unroll
    for (int rr = 0; rr < 2; ++rr) { const int s = wave * 2 + rr; float v[4]; float mx = -3.0e38f;
#pragma unroll
        for (int j = 0; j < 4; ++j) { v[j] = Sl[s * 256 + lane + 64 * j]; mx = fmaxf(mx, v[j]); }
        mx = wave_max(mx, lane); float sum = 0.f;
#pragma unroll
        for (int j = 0; j < 4; ++j) { v[j] = __builtin_amdgcn_exp2f(v[j] - mx); sum += v[j]; }
        const float inv = 1.f / wave_sum(sum, lane);
#pragma unroll
        for (int j = 0; j < 4; ++j) PT[(lane + 64 * j) * 16 + s] = v[j] * inv; }
    __syncthreads();
    { const int d = tid & 255, sh = tid >> 8; float o[8] = {0.f, 0.f, 0.f, 0.f, 0.f, 0.f, 0.f, 0.f};
#pragma unroll 8
      for (int n = 0; n < NMEM; ++n) { const float v = Vc[(size_t)n * D + d]; const f32x4 p0 = *(const LAS f32x4*)(PT + n * 16 + sh * 8), p1 = *(const LAS f32x4*)(PT + n * 16 + sh * 8 + 4);
          o[0] += p0[0] * v; o[1] += p0[1] * v; o[2] += p0[2] * v; o[3] += p0[3] * v; o[4] += p1[0] * v; o[5] += p1[1] * v; o[6] += p1[2] * v; o[7] += p1[3] * v; }
#pragma unroll
      for (int e = 0; e < 8; ++e) O[(size_t)(SEQ + b * 16 + sh * 8 + e) * D + h * HD + d] = (bf16_t)f2bf(o[e]); }
    __syncthreads();
}


template <class Epi4>
__device__ __forceinline__ void skinny_gemm(LAS unsigned char* lds, const bf16_t* A, int lda, const bf16_t* Bt, int ldb, int N, int K, int ksplit, const Epi4& E, int G, int bid, int wv) {
    const int lane = lane_id(), fr = lane & 15, fq = lane >> 4;
    const int ntn = N / 64, per = 4 * ntn, ntiles = per * ksplit, kw = K / ksplit / 8;
    LAS float* red = (LAS float*)lds;
    for (int t = bid; t < ntiles; t += G) {
        const int ks = t / per, tt = t % per, tm = tt & 3, tn = tt >> 2, kbeg = ks * (K / ksplit) + wv * kw;
        f32x4 acc[4][4];
#pragma unroll
        for (int i = 0; i < 4; ++i)
#pragma unroll
            for (int j = 0; j < 4; ++j) acc[i][j] = (f32x4){0.f, 0.f, 0.f, 0.f};
        const bf16_t* ap = A + (size_t)(tm * 64 + fr) * lda + kbeg + fq * 8;
        const bf16_t* bp = Bt + (size_t)(tn * 64 + fr) * ldb + kbeg + fq * 8;
#pragma unroll 2
        for (int k = 0; k < kw; k += 32) { bf16x8 af[4], bfr[4];
#pragma unroll
            for (int i = 0; i < 4; ++i) { af[i] = *(const bf16x8*)(ap + (size_t)i * 16 * lda + k); bfr[i] = *(const bf16x8*)(bp + (size_t)i * 16 * ldb + k); }
#pragma unroll
            for (int i = 0; i < 4; ++i)
#pragma unroll
                for (int j = 0; j < 4; ++j) acc[i][j] = __builtin_amdgcn_mfma_f32_16x16x32_bf16(bfr[j], af[i], acc[i][j], 0, 0, 0); }
#pragma unroll
        for (int i = 0; i < 4; ++i)
#pragma unroll
            for (int j = 0; j < 4; ++j) *(LAS f32x4*)(red + ((wv * 64 + i * 16 + fr) * 64 + j * 16 + 4 * fq)) = acc[i][j];
        __syncthreads();
        { const int tid = wv * 64 + lane, row = tid >> 3, c8 = (tid & 7) * 8; f32x4 s0 = {0.f, 0.f, 0.f, 0.f}, s1 = {0.f, 0.f, 0.f, 0.f};
#pragma unroll
          for (int w = 0; w < 8; ++w) { s0 += *(const LAS f32x4*)(red + ((w * 64 + row) * 64 + c8)); s1 += *(const LAS f32x4*)(red + ((w * 64 + row) * 64 + c8 + 4)); }
          E(tm * 64 + row, tn * 64 + c8, s0); E(tm * 64 + row, tn * 64 + c8 + 4, s1); }
        __syncthreads();
    }
}
__device__ __forceinline__ u32x2 pack4(const f32x4 v) { u32x2 w; w.x = cvt_pk_bf16(v[0], v[1]); w.y = cvt_pk_bf16(v[2], v[3]); return w; }
struct SkZ { bf16_t* ZP; bf16_t* UH; float* out;
    __device__ __forceinline__ void operator()(int r, int c, f32x4 v) const { const int row = SEQ + r;
        if (c < DPOOL) { *(u32x2*)(ZP + (size_t)row * DPOOL + c) = pack4(v); if ((r & 15) != 0) *(f32x4*)(out + O_POOLS + ((size_t)(r >> 4) * 15 + ((r & 15) - 1)) * DPOOL + c) = v; }
        else { const int cc = c - DPOOL, gg = cc >> 4, hh = cc & 15; *(u32x2*)(UH + ((size_t)gg * NCHP + (row >> 4)) * KY + (row & 15) * 16 + hh) = pack4(v); } } };
struct SkPool { bf16_t* CAT; const float* scale;
    __device__ __forceinline__ void operator()(int r, int c, f32x4 v) const { *(u32x2*)(CAT + (size_t)(SEQ + r) * D + c) = pack4(v * *(const f32x4*)(scale + c)); } };
struct SkGlu { bf16_t* CAT; const bf16_t* MIX; const float* bias;
    __device__ __forceinline__ void operator()(int r, int c, f32x4 v) const { const u32x2 y = *(const u32x2*)(MIX + (size_t)(SEQ + r) * D + DPOOL + c); const f32x4 b = *(const f32x4*)(bias + c);
        const float y0 = bf2f(y.x & 0xffffu), y1 = bf2f(y.x >> 16), y2 = bf2f(y.y & 0xffffu), y3 = bf2f(y.y >> 16);
        f32x4 o = {y0 / (1.f + __expf(-(v[0] + b[0]))), y1 / (1.f + __expf(-(v[1] + b[1]))), y2 / (1.f + __expf(-(v[2] + b[2]))), y3 / (1.f + __expf(-(v[3] + b[3])))};
        *(u32x2*)(CAT + (size_t)(SEQ + r) * D + DPOOL + c) = pack4(o); } };
struct SkRes { const float* base; float* out; bf16_t* Xb; float* SS;
    __device__ __forceinline__ void operator()(int r, int c, f32x4 v) const { const f32x4 x = v + *(const f32x4*)(base + (size_t)r * D + c); *(f32x4*)(out + (size_t)r * D + c) = x;
        *(u32x2*)(Xb + (size_t)r * D + c) = pack4(x); atomicAdd(SS + r, (x[0] * x[0] + x[1] * x[1]) + (x[2] * x[2] + x[3] * x[3])); } };
struct SkQ { bf16_t* Q; const float* SS;
    __device__ __forceinline__ void operator()(int r, int c, f32x4 v) const { const float rs = rsqrtf(SS[r] * (1.f / D) + EPS) * QSCALE; *(u32x2*)(Q + (size_t)r * D + c) = pack4(v * rs); } };
struct SkUp { bf16_t* U; const float* SS;
    __device__ __forceinline__ void operator()(int r, int c, f32x4 v) const { const float rs = rsqrtf(SS[r] * (1.f / D) + EPS); f32x4 o;
#pragma unroll
        for (int j = 0; j < 4; ++j) { const float a = fmaxf(v[j] * rs, 0.f); o[j] = a * a; }
        *(u32x2*)(U + (size_t)r * DFF + c) = pack4(o); } };
struct SkAdd { float* out;
    __device__ __forceinline__ void operator()(int r, int c, f32x4 v) const {
#pragma unroll
        for (int j = 0; j < 4; ++j) atomicAdd(out + (size_t)r * D + c + j, v[j]); } };

#define XB_TMO      128
#define XB_XCNT(j)  (256  + 64 * (j))
#define XB_XSUB(j)  (1280 + 64 * (j))
#define XB_XGEN(j)  (2304 + 64 * (j))
#define XB_TOP      3328
#define XB_TOPGEN   3392
#define XCD_BAR_WORDS 3456
#define XB_SPIN_CAP (1u << 18)

__device__ __forceinline__ unsigned xb_ld(unsigned* p)              { return __hip_atomic_load(p, __ATOMIC_RELAXED, __HIP_MEMORY_SCOPE_AGENT); }
__device__ __forceinline__ unsigned xb_add(unsigned* p, unsigned v) { return __hip_atomic_fetch_add(p, v, __ATOMIC_RELAXED, __HIP_MEMORY_SCOPE_AGENT); }
__device__ __forceinline__ unsigned xb_xcc_id() { return (unsigned)__builtin_amdgcn_s_getreg((3 << 11) | 20) & 0xFu; }
#define XB_SPIN(cond, bar) do { unsigned _sp = 0; while (cond) { __builtin_amdgcn_s_sleep(1); \
    if ((++_sp & 255u) == 0u) { if (xb_ld(&(bar)[XB_TMO])) break; if (_sp > XB_SPIN_CAP) { atomicAdd(&(bar)[XB_TMO], 1u); break; } } } } while (0)

struct XcdBarrier {
    unsigned* bar; unsigned x;
    volatile LAS unsigned* st;
};

__device__ __forceinline__ XcdBarrier xcd_barrier_post(unsigned* bar, volatile LAS unsigned* st, int wv) {
    XcdBarrier b; b.bar = bar; b.x = xb_xcc_id(); b.st = st;
    if (tidx(wv) == 0) (void)xb_add(&bar[XB_XCNT(b.x)], 1u);
    return b;
}
__device__ __forceinline__ void xcd_barrier_complete(unsigned* bar, unsigned x, unsigned& nloc, unsigned& nx) {
    const unsigned G = gridDim.x * gridDim.y * gridDim.z;
    unsigned sum, cnt, mine, sp = 0u;
    for (;;) {
        sum = 0u; cnt = 0u; mine = 0u;
#pragma unroll
        for (unsigned j = 0; j < 16; ++j) { const unsigned c = xb_ld(&bar[XB_XCNT(j)]); sum += c; cnt += (c > 0u) ? 1u : 0u; mine = (j == x) ? c : mine; }
        if (sum == G) break;
        __builtin_amdgcn_s_sleep(1);
        if ((++sp & 255u) == 0u) { if (xb_ld(&bar[XB_TMO])) break; if (sp > XB_SPIN_CAP) { atomicAdd(&bar[XB_TMO], 1u); break; } }
    }
    nloc = mine > 0u ? mine : 1u; nx = cnt > 0u ? cnt : 1u;
}

__device__ __forceinline__ void xcd_barrier(const XcdBarrier& b, int wv) {
    asm volatile("s_waitcnt vmcnt(0)" ::: "memory");
    __syncthreads();
    if (tidx(wv) == 0) {
        unsigned* bar = b.bar;
        __builtin_amdgcn_s_waitcnt(0);
        unsigned nloc = b.st[0], nx = b.st[1];
        if (nloc == 0u) { xcd_barrier_complete(bar, b.x, nloc, nx); b.st[0] = nloc; b.st[1] = nx; }
        const unsigned old = xb_add(&bar[XB_XSUB(b.x)], 1u);
        const unsigned gen = old / nloc;
        if (old + 1u == (gen + 1u) * nloc) {
            __builtin_amdgcn_fence(__ATOMIC_RELEASE, "agent");
            asm volatile("s_waitcnt vmcnt(0)" ::: "memory");
            const unsigned og = xb_add(&bar[XB_TOP], 1u);
            const unsigned tg = og / nx;
            if (og + 1u == (tg + 1u) * nx) xb_add(&bar[XB_TOPGEN], 1u);
            else XB_SPIN(xb_ld(&bar[XB_TOPGEN]) == tg, bar);
            __builtin_amdgcn_fence(__ATOMIC_ACQUIRE, "agent");
            xb_add(&bar[XB_XGEN(b.x)], 1u);
            asm volatile("s_waitcnt vmcnt(0)" ::: "memory");
        } else {
            XB_SPIN(xb_ld(&bar[XB_XGEN(b.x)]) == gen, bar);
            __builtin_amdgcn_fence(__ATOMIC_ACQUIRE, "agent");
            asm volatile("s_waitcnt vmcnt(0)" ::: "memory");
        }
    }
    __syncthreads();
}

#ifndef PHMASK
#define PHMASK 0xFFFF
#endif
#define PH(k) if constexpr (((PHMASK) >> (k)) & 1)
constexpr int LDS_BYTES = 131072 + 8192 + 1024;
__global__ void __launch_bounds__(512, 2) fwd_megakernel(Ctx C) {
    extern __shared__ __attribute__((aligned(16))) unsigned char lds_raw[];
    LAS unsigned char* lds = (LAS unsigned char*)lds_raw;
    cg::grid_group grid = cg::this_grid();
    const int wv = __builtin_amdgcn_readfirstlane((int)threadIdx.x >> 6);
    const int G = gridDim.x, bid = blockIdx.x; unsigned char* ws = C.ws;
    bf16_t* T0 = (bf16_t*)(ws + WS_T0); bf16_t* T1 = (bf16_t*)(ws + WS_T1); bf16_t* T2 = (bf16_t*)(ws + WS_T2);
    float* SS1 = (float*)(ws + WS_SS); float* SS2 = SS1 + M;
    float* Y = C.out + O_Y;
    pg8::Order S;

    if (bid == 0) { unsigned* bw = (unsigned*)(ws + WS_BAR); for (int i = tidx(wv); i < XCD_BAR_WORDS; i += 512) bw[i] = 0u; }
    { volatile LAS unsigned* misc = (volatile LAS unsigned*)(lds + 131072 + 8192); if (tidx(wv) < 16) misc[tidx(wv)] = 0u; }
    p0_prologue(C, lds, G, bid, wv);
    grid.sync();
    const XcdBarrier xbar = xcd_barrier_post((unsigned*)(ws + WS_BAR), (volatile LAS unsigned*)(lds + 131072 + 8192), wv);

    p1_pre(C, G, bid, wv);
    PH(0) { pg8::Gemm g{(const char*)T0, (const char*)(ws + WS_WIN), D, D, 0, 0, D}; S.init(SEQ / 256, 4, 1, G, bid);
      EpiZ E{(bf16_t*)(ws + WS_ZP), (bf16_t*)(ws + WS_UH), C.out}; pg8::gemm_phase(lds, g, S, E, wv); }
    { SkZ E{(bf16_t*)(ws + WS_ZP), (bf16_t*)(ws + WS_UH), C.out}; skinny_gemm(lds, T0 + (size_t)SEQ * D, D, (const bf16_t*)(ws + WS_WIN), D, D, D, 1, E, G, bid, wv); }
    xcd_barrier(xbar, wv);

    p2a_pre(C, G, bid, wv);
    PH(2) { pg8::Gemm g{(const char*)(ws + WS_UH), (const char*)(ws + WS_WB), KY, 256, (size_t)NCHP * KY * 2, (size_t)256 * 256 * 2, 256}; S.init(NCHP / 256, 1, NG, G, bid);
      EpiE E{(float*)(ws + WS_E)}; pg8::gemm_phase(lds, g, S, E, wv); }
    xcd_barrier(xbar, wv);

    if (bid < NG) p2b_prefix(C, lds, bid, wv);
    else if (bid < NG + 8) { PH(1) { pg8::Gemm g{(const char*)(ws + WS_MN), (const char*)(ws + WS_WKV), D, D, 0, 0, D}; S.init(1, 8, 1, 8, bid - NG);
      EpiKV E{C.out, (bf16_t*)(ws + WS_KB), (bf16_t*)(ws + WS_VT)}; pg8::gemm_phase(lds, g, S, E, wv); } }
    else p2b_pool(C, bid - NG - 8, G - NG - 8, wv);
    xcd_barrier(xbar, wv);

    vt_transpose(C, G, bid, wv);
    PH(3) { pg8::Gemm g{(const char*)(ws + WS_UH), (const char*)(ws + WS_WY), KY, KY, (size_t)NCHP * KY * 2, (size_t)256 * KY * 2, KY}; S.init(NCHP / 256, 1, NG, G, bid);
      EpiY E{T1}; pg8::gemm_phase(lds, g, S, E, wv); }
    xcd_barrier(xbar, wv);

    PH(5) { pg8::Gemm g{(const char*)(T1 + DPOOL), (const char*)(ws + WS_WGLU), D, DSSM, 0, 0, DSSM}; S.init(SEQ / 256, 2, 1, G, bid);
      EpiGlu E{T2, T1, C.in[21]}; pg8::gemm_phase(lds, g, S, E, wv); }
    PH(4) { pg8::Gemm g{(const char*)T1, (const char*)(ws + WS_WPOOL), D, DPOOL, 0, 0, DPOOL}; S.init(SEQ / 256, 2, 1, G, (bid + G - (128 % G)) % G);
      EpiPool E{T2, C.in[11]}; pg8::gemm_phase(lds, g, S, E, wv); }
    { SkGlu E{T2, T1, C.in[21]}; skinny_gemm(lds, T1 + (size_t)SEQ * D + DPOOL, D, (const bf16_t*)(ws + WS_WGLU), DSSM, DSSM, DSSM, 1, E, G, bid, wv); }
    { SkPool E{T2, C.in[11]}; skinny_gemm(lds, T1 + (size_t)SEQ * D, D, (const bf16_t*)(ws + WS_WPOOL), DPOOL, DPOOL, DPOOL, 1, E, G, (bid + G - 32) % G, wv); }
    xcd_barrier(xbar, wv);

    PH(6) { pg8::Gemm g{(const char*)T2, (const char*)(ws + WS_WOUT), D, D, 0, 0, D}; S.init(SEQ / 256, 4, 1, G, bid);
      EpiRes E{C.in[0], C.in[1], Y, T0, SS1}; pg8::gemm_phase(lds, g, S, E, wv); }
    { SkRes E{C.in[1], Y + (size_t)SEQ * D, T0 + (size_t)SEQ * D, SS1 + SEQ}; skinny_gemm(lds, T2 + (size_t)SEQ * D, D, (const bf16_t*)(ws + WS_WOUT), D, D, D, 1, E, G, bid, wv); }
    xcd_barrier(xbar, wv);

    PH(7) { pg8::Gemm g{(const char*)T0, (const char*)(ws + WS_WQ), D, D, 0, 0, D}; S.init(SEQ / 256, 4, 1, G, bid);
      EpiQ E{T1, SS1}; pg8::gemm_phase(lds, g, S, E, wv); }
    { SkQ E{T1 + (size_t)SEQ * D, SS1 + SEQ}; skinny_gemm(lds, T0 + (size_t)SEQ * D, D, (const bf16_t*)(ws + WS_WQ), D, D, D, 1, E, G, bid, wv); }
    xcd_barrier(xbar, wv);

    PH(8) { pg8::Gemm g{(const char*)T1, (const char*)(ws + WS_KB), D, D, (size_t)HD * 2, (size_t)HD * 2, HD}; S.init(SEQ / 256, 1, NHEAD, G, bid);
      EpiSoftmax E{T2, (LAS float*)(lds + 131072), (LAS float*)(lds + 131072 + 4096)}; pg8::gemm_phase(lds, g, S, E, wv); }
    for (int it = bid; it < 64; it += G) sample_attn_item(C, lds, it, wv);
    xcd_barrier(xbar, wv);

    PH(9) { pg8::Gemm g{(const char*)T2, (const char*)(ws + WS_VT), D, NMEM, (size_t)HD * 2, (size_t)HD * NMEM * 2, NMEM}; S.init(SEQ / 256, 1, NHEAD, G, bid);
      EpiO E{T0}; pg8::gemm_phase(lds, g, S, E, wv); }
    xcd_barrier(xbar, wv);

    PH(10) { pg8::Gemm g{(const char*)T0, (const char*)(ws + WS_WO), D, D, 0, 0, D}; S.init(SEQ / 256, 4, 1, G, bid);
      EpiRes E{Y, Y + (size_t)SEQ * D, Y, T2, SS2}; pg8::gemm_phase(lds, g, S, E, wv); }
    { SkRes E{Y + (size_t)SEQ * D, Y + (size_t)SEQ * D, T2 + (size_t)SEQ * D, SS2 + SEQ}; skinny_gemm(lds, T0 + (size_t)SEQ * D, D, (const bf16_t*)(ws + WS_WO), D, D, D, 1, E, G, bid, wv); }
    xcd_barrier(xbar, wv);

    PH(11) { pg8::Gemm g{(const char*)T2, (const char*)(ws + WS_WUP), D, D, 0, 0, D}; S.init(SEQ / 256, DFF / 256, 1, G, bid);
      EpiUp E{(bf16_t*)(ws + WS_U), SS2}; pg8::gemm_phase(lds, g, S, E, wv); }
    { SkUp E{(bf16_t*)(ws + WS_U) + (size_t)SEQ * DFF, SS2 + SEQ}; skinny_gemm(lds, T2 + (size_t)SEQ * D, D, (const bf16_t*)(ws + WS_WUP), D, DFF, D, 1, E, G, bid, wv); }
    xcd_barrier(xbar, wv);

    PH(12) { pg8::Gemm g{(const char*)(ws + WS_U), (const char*)(ws + WS_WDOWN), DFF, DFF, 0, 0, DFF}; S.init(SEQ / 256, 4, 1, G, bid);
      EpiRes E{Y, Y + (size_t)SEQ * D, Y, nullptr, nullptr}; pg8::gemm_phase(lds, g, S, E, wv); }
    { SkAdd E{Y + (size_t)SEQ * D}; skinny_gemm(lds, (const bf16_t*)(ws + WS_U) + (size_t)SEQ * DFF, DFF, (const bf16_t*)(ws + WS_WDOWN), DFF, D, DFF, 4, E, G, bid, wv); }
    xcd_barrier(xbar, wv);

    { const int lane = lane_id(), gw = bid * 8 + wv, NGW = G * 8; const f32x4* gr = (const f32x4*)C.in[32] + lane;
      for (int m = gw; m < M; m += NGW) { f32x4* xr = (f32x4*)(Y + (size_t)m * D) + lane; f32x4 v[4]; float ss = 0.f;
#pragma unroll
          for (int j = 0; j < 4; ++j) { v[j] = xr[64 * j]; ss += (v[j].x * v[j].x + v[j].y * v[j].y) + (v[j].z * v[j].z + v[j].w * v[j].w); }
          const float rs = rsqrtf(wave_sum(ss, lane) * (1.f / D) + EPS);
#pragma unroll
          for (int j = 0; j < 4; ++j) { const f32x4 gg = gr[64 * j]; xr[64 * j] = (f32x4){v[j].x * rs * gg.x, v[j].y * rs * gg.y, v[j].z * rs * gg.z, v[j].w * rs * gg.w}; } } }
}

extern "C" void kernel_launch(void* const* d_in, const int* in_sizes, int n_in, void* d_out, int out_size, void* d_ws, size_t ws_size, hipStream_t stream) {
    static int grid = 0;
    if (grid == 0) {
        if (n_in != 33 || (size_t)out_size != O_END || ws_size < WS_END) { fprintf(stderr, "kernel_launch: unexpected shapes n_in %d out %d ws %zu\n", n_in, out_size, ws_size); grid = -1; return; }
        int dev = 0, cus = 0, per_cu = 0;
        hipGetDevice(&dev); hipDeviceGetAttribute(&cus, hipDeviceAttributeMultiprocessorCount, dev);
        if (hipFuncSetAttribute((const void*)fwd_megakernel, hipFuncAttributeMaxDynamicSharedMemorySize, LDS_BYTES) != hipSuccess) { fprintf(stderr, "kernel_launch: hipFuncSetAttribute failed\n"); grid = -1; return; }
        if (hipOccupancyMaxActiveBlocksPerMultiprocessor(&per_cu, (const void*)fwd_megakernel, 512, LDS_BYTES) != hipSuccess || per_cu < 1) { fprintf(stderr, "kernel_launch: occupancy query failed (%d)\n", per_cu); (void)hipGetLastError(); per_cu = 1; }
        if (per_cu > 1) per_cu = 1;
        grid = cus * per_cu; if (grid > 256) grid = 256;
    }
    if (grid < 0) return;
    Ctx c{};
    for (int i = 0; i < 33; ++i) c.in[i] = (const float*)d_in[i];
    c.out = (float*)d_out; c.ws = (unsigned char*)d_ws;
    void* args[] = {&c};
    hipError_t e = hipLaunchCooperativeKernel((const void*)fwd_megakernel, dim3(grid), dim3(512), args, LDS_BYTES, stream);
    if (e != hipSuccess) fprintf(stderr, "cooperative launch failed: %s (grid %d)\n", hipGetErrorString(e), grid);
}
```

```cpp
#include <hip/hip_runtime.h>
#include <hip/hip_cooperative_groups.h>
#include <cstdio>
#include <cstdint>
namespace cg = cooperative_groups;

#define LAS __attribute__((address_space(3)))
typedef unsigned short bf16_t;
typedef short bf16x8 __attribute__((ext_vector_type(8)));
typedef float f32x4 __attribute__((ext_vector_type(4)));
typedef float f32x2 __attribute__((ext_vector_type(2)));
typedef unsigned u32x4 __attribute__((ext_vector_type(4)));
typedef unsigned u32x2 __attribute__((ext_vector_type(2)));

constexpr int D = 1024, SEQ = 16384, NSAMP = 256, M = SEQ + NSAMP, DFF = 4096, DPOOL = 512, DSSM = 512;
constexpr int NG = 32, NP = 64, NH = 16, TC = 16, NCH = M / TC  , NCHP = 1280, KY = 384;
constexpr int NMEM = 256, HD = 256, NHEAD = 4;
constexpr float EPS = 1e-6f;
constexpr float QSCALE = 0.0625f * 1.4426950408889634f;

constexpr size_t O_Y = 0, O_MK = (size_t)M * D, O_MV = O_MK + 262144, O_POOLP = O_MV + 262144, O_SREP = O_POOLP + 7680, O_SIMP = O_SREP + 2048,
                 O_POOLS = O_SIMP + 2048, O_SRES = O_POOLS + 122880, O_SIMS = O_SRES + 32768, O_END = O_SIMS + 32768;

constexpr size_t MiB = 1u << 20;
constexpr size_t WS_WIN = 0, WS_WOUT = 2 * MiB, WS_WQ = 4 * MiB, WS_WKV = 6 * MiB, WS_WO = 10 * MiB, WS_WUP = 12 * MiB, WS_WDOWN = 20 * MiB,
                 WS_WGLU = 28 * MiB, WS_WPOOL = 28 * MiB + 512 * 1024, WS_MN = 29 * MiB, WS_KB = 29 * MiB + 512 * 1024, WS_VT = 30 * MiB,
                 WS_AP = 30 * MiB + 512 * 1024,
                 WS_BB = WS_AP + 320 * 1024,
                 WS_KLAG = WS_BB + 256 * 1024,
                 WS_SS = WS_KLAG + 512 * 1024,
                 WS_BAR = 32 * MiB - 128 * 1024,
                 WS_WB = 32 * MiB,
                 WS_WY = 36 * MiB,
                 WS_E = 42 * MiB,
                 WS_UH = 62 * MiB,
                 WS_ZP = 92 * MiB,
                 WS_T0 = 109 * MiB, WS_T1 = 142 * MiB, WS_T2 = 175 * MiB, WS_END = 208 * MiB,
                 WS_U = 42 * MiB,
                 WS_SLAB = 175 * MiB;
static_assert(WS_SS + 3 * M * 4 <= WS_BAR, "misc region");
static_assert(WS_U + (size_t)M * DFF * 2 <= WS_T2, "U overlay");

__device__ __forceinline__ unsigned f2bf(float f) { unsigned u = __builtin_bit_cast(unsigned, f); return (u + 0x7fffu + ((u >> 16) & 1u)) >> 16; }
__device__ __forceinline__ unsigned pk2(float lo, float hi) { return f2bf(lo) | (f2bf(hi) << 16); }
__device__ __forceinline__ float bf2f(unsigned b) { return __builtin_bit_cast(float, b << 16); }
__device__ __forceinline__ unsigned cvt_pk_bf16(float lo, float hi) { unsigned r; asm volatile("v_cvt_pk_bf16_f32 %0, %1, %2" : "=v"(r) : "v"(lo), "v"(hi)); return r; }
#define LDS_WAIT() asm volatile("s_waitcnt lgkmcnt(0)" ::: "memory")
__device__ __forceinline__ int lane_id() { int l; asm volatile("v_mbcnt_lo_u32_b32 %0, -1, 0\n\tv_mbcnt_hi_u32_b32 %0, -1, %0" : "=v"(l)); return l; }
__device__ __forceinline__ int tidx(int wv) { return wv * 64 + lane_id(); }
__device__ __forceinline__ float shfl_x(float v, int lane, int mask) { return __builtin_bit_cast(float, __builtin_amdgcn_ds_bpermute((lane ^ mask) << 2, __builtin_bit_cast(int, v))); }

namespace pg8 {
constexpr int BM = 256, BK = 64, HALF = 128, HTB = HALF * BK * 2, STAGE_BYTES = 8 * HTB, NXCD = 8, WGM = 8;
__host__ __device__ __forceinline__ int lds_byte(int r, int c) { const int st = (r >> 4) * 2 + (c >> 5), rr = r & 15, cc = c & 31, ob = rr * 64 + cc * 2; return st * 1024 + (ob ^ (((ob >> 9) & 1) << 5)); }
__host__ __device__ __forceinline__ void stage_rc(int b, int& R, int& C) { const int st = b / 1024, sb = b % 1024, swz = sb ^ (((sb >> 9) & 1) << 5); R = (st >> 1) * 16 + swz / 64; C = (st & 1) * 32 + (swz % 64) / 2; }
__host__ __device__ __forceinline__ int perm32(int rho) { const int n = rho >> 4, i = rho & 15; return 8 * (i >> 2) + 4 * n + (i & 3); }

struct Unit { int pm, pn, z; };
struct Gemm { const char* A; const char* B; int lda, ldb; size_t sAz, sBz; int K; };
struct Order {
    int nM, nN, nZ, G, c;
    __device__ void init(int nM_, int nN_, int nZ_, int G_, int c_) { nM = nM_; nN = nN_; nZ = nZ_; G = G_; c = c_; }
    __device__ bool next(int i, Unit& u) const {
        const int per = nM * nN, nwg = per * nZ; const long L = (long)i * G + c; if (L >= nwg) return false;
        int wgid = (int)L; { const int q = nwg / NXCD, r = nwg % NXCD, xcd = wgid % NXCD, off = wgid / NXCD; wgid = (xcd < r ? xcd * (q + 1) : r * (q + 1) + (xcd - r) * q) + off; }
        u.z = wgid / per; const int l = wgid % per;
        const int nig = WGM * nN, gid = l / nig, fm = gid * WGM, gsz = (nM - fm) < WGM ? (nM - fm) : WGM;
        u.pm = fm + ((l % nig) % gsz); u.pn = (l % nig) / gsz; return true;
    }
};

template <class Epi>
__device__ __forceinline__ void gemm_phase(LAS unsigned char* lds, const Gemm g, const Order& S, Epi& E, int wv) {
    const int tid = tidx(wv), wid = __builtin_amdgcn_readfirstlane(tid >> 6), lane = tid & 63, wr = wid >> 2, wc = wid & 3, fr = lane & 15, fq = lane >> 4;
    const int nt = g.K / BK;
    unsigned voffA[2], voffB[2];
#pragma unroll
    for (int i = 0; i < 2; ++i) { int R, C; stage_rc(tid * 16 + i * 8192, R, C); const int Rb = Epi::PERM ? ((R & ~31) + perm32(R & 31)) : R;
        voffA[i] = (unsigned)(R * g.lda + C) * 2u; voffB[i] = (unsigned)(Rb * g.ldb + C) * 2u; }
    const size_t kstep = (size_t)(BK * 2);
    const size_t hA = (size_t)HALF * g.lda * 2, hB = (size_t)HALF * g.ldb * 2;
    const unsigned ldsw = (unsigned)wid * 1024u;
    const int aoff = lds_byte(wr * 64 + fr, fq * 8), boff = lds_byte(wc * 32 + fr, fq * 8);
#define PG8_SA(b, h) (((b) * 2 + (h)) * HTB)
#define PG8_SB(b, h) ((4 + (b) * 2 + (h)) * HTB)
#define PG8_STAGE(bufoff, gbase, voff) do { _Pragma("unroll") for (int _i = 0; _i < 2; ++_i) \
        __builtin_amdgcn_global_load_lds((const unsigned*)((const char*)(gbase) + (voff)[_i]), (LAS unsigned*)(lds + (bufoff) + ldsw + _i * 8192), 16, 0, 0); } while (0)
#define PG8_LDA(dst, b, h) do { _Pragma("unroll") for (int m = 0; m < 4; ++m) _Pragma("unroll") for (int k = 0; k < 2; ++k) dst[m][k] = *(const LAS bf16x8*)(lds + PG8_SA(b, h) + aoff + m * 2048 + k * 1024); } while (0)
#define PG8_LDB(dst, b, h) do { _Pragma("unroll") for (int n = 0; n < 2; ++n) _Pragma("unroll") for (int k = 0; k < 2; ++k) dst[n][k] = *(const LAS bf16x8*)(lds + PG8_SB(b, h) + boff + n * 2048 + k * 1024); } while (0)
#define PG8_MMA(ai, bj, At, Bt) do { __builtin_amdgcn_s_setprio(1); _Pragma("unroll") for (int m = 0; m < 4; ++m) _Pragma("unroll") for (int n = 0; n < 2; ++n) _Pragma("unroll") for (int k = 0; k < 2; ++k) \
        acc[ai][bj][m][n] = __builtin_amdgcn_mfma_f32_16x16x32_bf16(Bt[n][k], At[m][k], acc[ai][bj][m][n], 0, 0, 0); __builtin_amdgcn_s_setprio(0); } while (0)
#define PG8_WAIT_V(n) asm volatile("s_waitcnt vmcnt(" #n ")" ::: "memory")
#define PG8_WAIT_L(n) asm volatile("s_waitcnt lgkmcnt(" #n ")" ::: "memory")
#define PG8_BAR __builtin_amdgcn_s_barrier()
#define PG8_SCHED __builtin_amdgcn_sched_barrier(0)
    Unit cur, nxt; int ui = 0;
    if (!S.next(0, cur)) return;
    f32x4 acc[2][2][4][2];
#pragma unroll
    for (int a = 0; a < 2; ++a)
#pragma unroll
        for (int b = 0; b < 2; ++b)
#pragma unroll
            for (int m = 0; m < 4; ++m)
#pragma unroll
                for (int n = 0; n < 2; ++n) acc[a][b][m][n] = (f32x4){0.f, 0.f, 0.f, 0.f};
    bf16x8 At[4][2], B0[2][2], B1[2][2];
    const char* cA = g.A + (size_t)cur.z * g.sAz + (size_t)cur.pm * 2 * hA; const char* cB = g.B + (size_t)cur.z * g.sBz + (size_t)cur.pn * 2 * hB;
    PG8_STAGE(PG8_SB(0, 0), cB, voffB); PG8_STAGE(PG8_SB(0, 1), cB + hB, voffB); PG8_STAGE(PG8_SA(0, 0), cA, voffA); PG8_STAGE(PG8_SA(0, 1), cA + hA, voffA);
    if (wr == 1) PG8_BAR;
    PG8_WAIT_V(2); PG8_BAR;
    PG8_STAGE(PG8_SB(1, 0), cB + kstep, voffB); PG8_STAGE(PG8_SA(1, 0), cA + kstep, voffA); PG8_STAGE(PG8_SB(1, 1), cB + hB + kstep, voffB);
    PG8_WAIT_V(6); PG8_BAR;
    for (;;) {
        const bool has_next = S.next(ui + 1, nxt);
        const char* nA = has_next ? g.A + (size_t)nxt.z * g.sAz + (size_t)nxt.pm * 2 * hA : cA; const char* nB = has_next ? g.B + (size_t)nxt.z * g.sBz + (size_t)nxt.pn * 2 * hB : cB;
        for (int t = 0; t < nt; t += 2) {
            const bool last = (t == nt - 2);
            const char* a1 = cA + (size_t)(t + 1) * kstep;
            const char* a2 = last ? nA : cA + (size_t)(t + 2) * kstep; const char* b2 = last ? nB : cB + (size_t)(t + 2) * kstep;
            const char* a3 = a2 + kstep; const char* b3 = b2 + kstep;
            PG8_LDB(B0, 0, 0); PG8_LDB(B1, 0, 1); PG8_SCHED; PG8_LDA(At, 0, 0); PG8_STAGE(PG8_SA(1, 1), a1 + hA, voffA);
            PG8_WAIT_V(8); PG8_WAIT_L(0); PG8_BAR; PG8_MMA(0, 0, At, B0); PG8_MMA(0, 1, At, B1); PG8_BAR; PG8_SCHED;
            PG8_LDA(At, 0, 1); PG8_STAGE(PG8_SB(0, 0), b2, voffB); PG8_STAGE(PG8_SB(0, 1), b2 + hB, voffB); PG8_STAGE(PG8_SA(0, 0), a2, voffA);
            PG8_WAIT_V(8); PG8_WAIT_L(0); PG8_BAR; PG8_MMA(1, 0, At, B0); PG8_MMA(1, 1, At, B1); PG8_BAR; PG8_SCHED;
            PG8_LDB(B0, 1, 0); PG8_LDB(B1, 1, 1); PG8_SCHED; PG8_LDA(At, 1, 0); PG8_STAGE(PG8_SA(0, 1), a2 + hA, voffA);
            PG8_WAIT_V(8); PG8_WAIT_L(0); PG8_BAR; PG8_MMA(0, 0, At, B0); PG8_MMA(0, 1, At, B1); PG8_BAR; PG8_SCHED;
            PG8_LDA(At, 1, 1); PG8_STAGE(PG8_SB(1, 0), b3, voffB); PG8_STAGE(PG8_SB(1, 1), b3 + hB, voffB); PG8_STAGE(PG8_SA(1, 0), a3, voffA);
            PG8_WAIT_V(8); PG8_WAIT_L(0); PG8_BAR; PG8_MMA(1, 0, At, B0); PG8_MMA(1, 1, At, B1); PG8_BAR; PG8_SCHED;
        }
        if (wr == 0) PG8_BAR;
        { Unit ue = cur; const int le = lane_id(); int fre = le & 15, fqe = le >> 4;
          asm volatile("" : "+s"(ue.pm), "+s"(ue.pn), "+s"(ue.z));
          E(acc, ue, wr, wc, fre, fqe); }
        if (!has_next) break;
#pragma unroll
        for (int a = 0; a < 2; ++a)
#pragma unroll
            for (int b = 0; b < 2; ++b)
#pragma unroll
                for (int m = 0; m < 4; ++m)
#pragma unroll
                    for (int n = 0; n < 2; ++n) acc[a][b][m][n] = (f32x4){0.f, 0.f, 0.f, 0.f};
        cur = nxt; cA = nA; cB = nB; ++ui;
        if (wr == 1) PG8_BAR;
    }
    PG8_WAIT_V(0);
    PG8_BAR;
#undef PG8_SA
#undef PG8_SB
#undef PG8_STAGE
#undef PG8_LDA
#undef PG8_LDB
#undef PG8_MMA
#undef PG8_WAIT_V
#undef PG8_WAIT_L
#undef PG8_BAR
#undef PG8_SCHED
}
}
using pg8::Unit;
typedef f32x4 Acc[2][2][4][2];

#define EPI_ROWS(ai, m) (u.pm * 256 + (ai) * 128 + wr * 64 + (m) * 16 + fr)
__device__ __forceinline__ bool mfence() { asm volatile("" ::: "memory"); return true; }
#define FOR_AI_M _Pragma("unroll") for (int ai = 0; ai < 2; ++ai) _Pragma("unroll") for (int m = 0; m < 4; ++m) if (mfence())
#define FOR_BJ _Pragma("unroll") for (int bj = 0; bj < 2; ++bj)
__device__ __forceinline__ u32x4 pack8(const f32x4 v0, const f32x4 v1) { u32x4 w; w.x = cvt_pk_bf16(v0[0], v0[1]); w.y = cvt_pk_bf16(v0[2], v0[3]); w.z = cvt_pk_bf16(v1[0], v1[1]); w.w = cvt_pk_bf16(v1[2], v1[3]); return w; }

struct EpiZ {
    static constexpr bool PERM = true;
    bf16_t* ZP; bf16_t* UH; float* out;
    __device__ __forceinline__ void operator()(Acc& acc, const Unit& u, int wr, int wc, int fr, int fq) const {
        FOR_AI_M { const int row = EPI_ROWS(ai, m);
            FOR_BJ { const int col = u.pn * 256 + bj * 128 + wc * 32 + 8 * fq; const f32x4 v0 = acc[ai][bj][m][0], v1 = acc[ai][bj][m][1]; const u32x4 w = pack8(v0, v1);
                if (col < DPOOL) {
                    *(u32x4*)(ZP + (size_t)row * DPOOL + col) = w;
                    float* dst = nullptr;
                    if (row >= SEQ - 15 && row < SEQ) dst = out + O_POOLP + (size_t)(row - (SEQ - 15)) * DPOOL + col;
                    else if (row >= SEQ && ((row & 15) != 0)) dst = out + O_POOLS + ((size_t)((row - SEQ) >> 4) * 15 + ((row & 15) - 1)) * DPOOL + col;
                    if (dst) { *(f32x4*)dst = v0; *(f32x4*)(dst + 4) = v1; }
                } else {
                    const int cc = col - DPOOL, gg = cc >> 4, hh = cc & 15;
                    *(u32x4*)(UH + ((size_t)gg * NCHP + (row >> 4)) * KY + (row & 15) * 16 + hh) = w;
                } } }
    }
};
struct EpiKV {
    static constexpr bool PERM = false;
    float* out; bf16_t* KB; bf16_t* VT;
    __device__ __forceinline__ void operator()(Acc& acc, const Unit& u, int wr, int wc, int fr, int fq) const {
        FOR_AI_M { const int row = EPI_ROWS(ai, m);
            FOR_BJ {
#pragma unroll
                for (int n = 0; n < 2; ++n) { const int col = u.pn * 256 + bj * 128 + wc * 32 + 16 * n + 4 * fq; const f32x4 v = acc[ai][bj][m][n];
                    if (col < D) { *(f32x4*)(out + O_MK + (size_t)row * D + col) = v; u32x2 w; w.x = cvt_pk_bf16(v[0], v[1]); w.y = cvt_pk_bf16(v[2], v[3]); *(u32x2*)(KB + (size_t)row * D + col) = w; }
                    else { const int c2 = col - D; *(f32x4*)(out + O_MV + (size_t)row * D + c2) = v; } } }
            asm volatile("" ::: "memory"); }
    }
};
struct EpiE {
    static constexpr bool PERM = false;
    float* E;
    __device__ __forceinline__ void operator()(Acc& acc, const Unit& u, int wr, int wc, int fr, int fq) const {
        FOR_AI_M { const int row = EPI_ROWS(ai, m);
#pragma unroll
            for (int n = 0; n < 2; ++n) { const int col = wc * 32 + 16 * n + 4 * fq; *(f32x4*)(E + ((size_t)u.z * NCHP + row) * 128 + col) = acc[ai][0][m][n]; } }
    }
};
__device__ __forceinline__ float gelu_tanh(float x) {
    const float t = 0.7978845608028654f * (x + 0.044715f * x * x * x);
    const float e = __expf(-2.f * t);
    return x / (1.f + e);
}
struct EpiY {
    static constexpr bool PERM = true;
    bf16_t* MIX;
    __device__ __forceinline__ void operator()(Acc& acc, const Unit& u, int wr, int wc, int fr, int fq) const {
        FOR_AI_M { const int ch = EPI_ROWS(ai, m); if (ch < NCH) {
            FOR_BJ { const int col = bj * 128 + wc * 32 + 8 * fq, t = col >> 4, hh = col & 15; f32x4 v0 = acc[ai][bj][m][0], v1 = acc[ai][bj][m][1];
#pragma unroll
                for (int j = 0; j < 4; ++j) { v0[j] = gelu_tanh(v0[j]); v1[j] = gelu_tanh(v1[j]); }
                *(u32x4*)(MIX + (size_t)(ch * 16 + t) * D + DPOOL + u.z * 16 + hh) = pack8(v0, v1); } } }
    }
};
struct EpiPool {
    static constexpr bool PERM = true;
    bf16_t* CAT; const float* scale;
    __device__ __forceinline__ void operator()(Acc& acc, const Unit& u, int wr, int wc, int fr, int fq) const {
        FOR_BJ { const int col = u.pn * 256 + bj * 128 + wc * 32 + 8 * fq; const f32x4 s0 = *(const f32x4*)(scale + col), s1 = *(const f32x4*)(scale + col + 4);
            FOR_AI_M { const int row = EPI_ROWS(ai, m); *(u32x4*)(CAT + (size_t)row * D + col) = pack8(acc[ai][bj][m][0] * s0, acc[ai][bj][m][1] * s1); } }
    }
};
struct EpiGlu {
    static constexpr bool PERM = true;
    bf16_t* CAT; const bf16_t* MIX; const float* bias;
    __device__ __forceinline__ void operator()(Acc& acc, const Unit& u, int wr, int wc, int fr, int fq) const {
        FOR_BJ { const int col = u.pn * 256 + bj * 128 + wc * 32 + 8 * fq; const f32x4 b0 = *(const f32x4*)(bias + col), b1 = *(const f32x4*)(bias + col + 4);
            FOR_AI_M { const int row = EPI_ROWS(ai, m); const u32x4 yv = *(const u32x4*)(MIX + (size_t)row * D + DPOOL + col);
                f32x4 v0 = acc[ai][bj][m][0] + b0, v1 = acc[ai][bj][m][1] + b1; const unsigned yw[4] = {yv.x, yv.y, yv.z, yv.w};
#pragma unroll
                for (int j = 0; j < 4; ++j) { const float ya = bf2f(yw[j >> 1] >> ((j & 1) * 16) & 0xffffu), yb = bf2f(yw[2 + (j >> 1)] >> ((j & 1) * 16) & 0xffffu);
                    v0[j] = ya / (1.f + __expf(-v0[j])); v1[j] = yb / (1.f + __expf(-v1[j])); }
                *(u32x4*)(CAT + (size_t)row * D + DPOOL + col) = pack8(v0, v1); } }
    }
};
struct EpiRes {
    static constexpr bool PERM = false;
    const float* baseP; const float* baseS; float* out; bf16_t* Xb; float* SS;
    __device__ __forceinline__ void operator()(Acc& acc, const Unit& u, int wr, int wc, int fr, int fq) const {
        FOR_AI_M { const int row = EPI_ROWS(ai, m); const float* brow = (row < SEQ) ? baseP + (size_t)row * D : baseS + (size_t)(row - SEQ) * D; float ssq = 0.f;
            FOR_BJ {
#pragma unroll
                for (int n = 0; n < 2; ++n) { const int col = u.pn * 256 + bj * 128 + wc * 32 + 16 * n + 4 * fq; const f32x4 v = acc[ai][bj][m][n] + *(const f32x4*)(brow + col);
                    *(f32x4*)(out + (size_t)row * D + col) = v; ssq += (v[0] * v[0] + v[1] * v[1]) + (v[2] * v[2] + v[3] * v[3]);
                    if (Xb) { u32x2 w; w.x = cvt_pk_bf16(v[0], v[1]); w.y = cvt_pk_bf16(v[2], v[3]); *(u32x2*)(Xb + (size_t)row * D + col) = w; } } }
            ssq += shfl_x(ssq, fr + 16 * fq, 16); ssq += shfl_x(ssq, fr + 16 * fq, 32);
            if (SS && fq == 0) atomicAdd(SS + row, ssq); }
    }
};
struct EpiQ {
    static constexpr bool PERM = true;
    bf16_t* Q; const float* SS;
    __device__ __forceinline__ void operator()(Acc& acc, const Unit& u, int wr, int wc, int fr, int fq) const {
        FOR_AI_M { const int row = EPI_ROWS(ai, m); const float rs = rsqrtf(SS[row] * (1.f / D) + EPS) * QSCALE;
            FOR_BJ { const int col = u.pn * 256 + bj * 128 + wc * 32 + 8 * fq; *(u32x4*)(Q + (size_t)row * D + col) = pack8(acc[ai][bj][m][0] * rs, acc[ai][bj][m][1] * rs); } }
    }
};
struct EpiSoftmax {
    static constexpr bool PERM = true;
    bf16_t* P; LAS float* tmax; LAS float* tsum;
    __device__ __forceinline__ void operator()(Acc& acc, const Unit& u, int wr, int wc, int fr, int fq) const {
        FOR_AI_M { float mx = -3.0e38f;
            FOR_BJ {
#pragma unroll
                for (int n = 0; n < 2; ++n) { const f32x4 v = acc[ai][bj][m][n]; mx = fmaxf(mx, fmaxf(fmaxf(v[0], v[1]), fmaxf(v[2], v[3]))); } }
            mx = fmaxf(mx, shfl_x(mx, fr + 16 * fq, 16)); mx = fmaxf(mx, shfl_x(mx, fr + 16 * fq, 32));
            if (fq == 0) tmax[(ai * 128 + wr * 64 + m * 16 + fr) * 4 + wc] = mx; }
        LDS_WAIT(); __builtin_amdgcn_s_barrier(); asm volatile("" ::: "memory");
        FOR_AI_M { const int r = ai * 128 + wr * 64 + m * 16 + fr; const f32x4 t = *(const LAS f32x4*)(tmax + r * 4); const float mx = fmaxf(fmaxf(t[0], t[1]), fmaxf(t[2], t[3])); float s = 0.f;
            FOR_BJ {
#pragma unroll
                for (int n = 0; n < 2; ++n) { f32x4 v = acc[ai][bj][m][n];
#pragma unroll
                    for (int j = 0; j < 4; ++j) { v[j] = __builtin_amdgcn_exp2f(v[j] - mx); s += v[j]; }
                    acc[ai][bj][m][n] = v; } }
            s += shfl_x(s, fr + 16 * fq, 16); s += shfl_x(s, fr + 16 * fq, 32);
            if (fq == 0) tsum[r * 4 + wc] = s; }
        LDS_WAIT(); __builtin_amdgcn_s_barrier(); asm volatile("" ::: "memory");
        FOR_AI_M { const int r = ai * 128 + wr * 64 + m * 16 + fr, row = u.pm * 256 + r; const f32x4 t = *(const LAS f32x4*)(tsum + r * 4); const float inv = 1.f / ((t[0] + t[1]) + (t[2] + t[3]));
            FOR_BJ { const int col = u.z * 256 + bj * 128 + wc * 32 + 8 * fq; *(u32x4*)(P + (size_t)row * D + col) = pack8(acc[ai][bj][m][0] * inv, acc[ai][bj][m][1] * inv); } }
    }
};
struct EpiO {
    static constexpr bool PERM = true;
    bf16_t* O;
    __device__ __forceinline__ void operator()(Acc& acc, const Unit& u, int wr, int wc, int fr, int fq) const {
        FOR_AI_M { const int row = EPI_ROWS(ai, m);
            FOR_BJ { const int col = u.z * 256 + bj * 128 + wc * 32 + 8 * fq; *(u32x4*)(O + (size_t)row * D + col) = pack8(acc[ai][bj][m][0], acc[ai][bj][m][1]); } }
    }
};
struct EpiUp {
    static constexpr bool PERM = true;
    bf16_t* U; const float* SS;
    __device__ __forceinline__ void operator()(Acc& acc, const Unit& u, int wr, int wc, int fr, int fq) const {
        FOR_AI_M { const int row = EPI_ROWS(ai, m); const float rs = rsqrtf(SS[row] * (1.f / D) + EPS);
            FOR_BJ { const int col = u.pn * 256 + bj * 128 + wc * 32 + 8 * fq; f32x4 v0 = acc[ai][bj][m][0] * rs, v1 = acc[ai][bj][m][1] * rs;
#pragma unroll
                for (int j = 0; j < 4; ++j) { const float a = fmaxf(v0[j], 0.f), b = fmaxf(v1[j], 0.f); v0[j] = a * a; v1[j] = b * b; }
                *(u32x4*)(U + (size_t)row * DFF + col) = pack8(v0, v1); } }
    }
};

struct Ctx {
    const float* in[33]; float* out; unsigned char* ws;
};
__device__ __forceinline__ float wave_sum(float v, int lane) {
#pragma unroll
    for (int o = 1; o < 64; o <<= 1) v += shfl_x(v, lane, o);
    return v;
}
__device__ __forceinline__ float wave_max(float v, int lane) {
#pragma unroll
    for (int o = 1; o < 64; o <<= 1) v = fmaxf(v, shfl_x(v, lane, o));
    return v;
}
__device__ __forceinline__ void transpose_item(const float* W, int ldw, int nblk, bf16_t* WT, int ldt, int row_off, int col_off, const float* ksc, LAS float* scr, int item, int lane) {
    const int kb = item / nblk, nb = item % nblk, k0 = 64 * kb, n0 = 32 * nb;
#pragma unroll
    for (int i = 0; i < 32; ++i) { const int kk = 2 * i + (lane >> 5); float v = W[(size_t)(k0 + kk) * ldw + n0 + (lane & 31)]; if (ksc) v *= ksc[k0 + kk]; scr[kk * 33 + (lane & 31)] = v; }
    LDS_WAIT(); asm volatile("" ::: "memory");
    const int c = lane & 7;
#pragma unroll
    for (int j = 0; j < 4; ++j) { const int n = (lane >> 3) + 8 * j; const LAS float* s = scr + (8 * c) * 33 + n;
        u32x4 o; o.x = pk2(s[0 * 33], s[1 * 33]); o.y = pk2(s[2 * 33], s[3 * 33]); o.z = pk2(s[4 * 33], s[5 * 33]); o.w = pk2(s[6 * 33], s[7 * 33]);
        *(u32x4*)(WT + (size_t)(row_off + n0 + n) * ldt + col_off + k0 + 8 * c) = o; }
    LDS_WAIT(); asm volatile("" ::: "memory");
}
__device__ __forceinline__ void rms_row_to_bf16(const float* xrow, const float* g, bf16_t* orow, int lane) {
    const f32x4* xr = (const f32x4*)xrow + lane; const f32x4* gr = (const f32x4*)g + lane;
    f32x4 v[4]; float s = 0.f;
#pragma unroll
    for (int j = 0; j < 4; ++j) { v[j] = xr[64 * j]; s += (v[j].x * v[j].x + v[j].y * v[j].y) + (v[j].z * v[j].z + v[j].w * v[j].w); }
    const float rs = rsqrtf(wave_sum(s, lane) * (1.f / D) + EPS);
    u32x2* o8 = (u32x2*)orow + lane;
#pragma unroll
    for (int j = 0; j < 4; ++j) { const f32x4 gg = gr[64 * j]; u32x2 w; w.x = pk2(v[j].x * rs * gg.x, v[j].y * rs * gg.y); w.y = pk2(v[j].z * rs * gg.z, v[j].w * rs * gg.w); o8[64 * j] = w; }
}

__device__ __forceinline__ void p0_prologue(const Ctx& C, LAS unsigned char* lds, int G, int bid, int wv) {
    const int tid = tidx(wv), lane = tid & 63, wave = tid >> 6;
    LAS float* scr = (LAS float*)(lds + wave * 16384);
    const int gw = bid * 8 + wave, NGW = G * 8;
    unsigned char* ws = C.ws;
    constexpr int I_SQ = 16 * 32, I_UP = 16 * 128, I_DN = 64 * 32, I_GLU = 8 * 16, I_PL = 4 * 2 * 4;
    constexpr int NIT = 6 * I_SQ + I_UP + I_DN + I_GLU + I_PL;
    for (int it = gw; it < NIT; it += NGW) {
        int r = it;
        if (r < I_SQ) { transpose_item(C.in[9], D, 32, (bf16_t*)(ws + WS_WIN), D, 0, 0, nullptr, scr, r, lane); continue; } r -= I_SQ;
        if (r < I_SQ) { transpose_item(C.in[22], D, 32, (bf16_t*)(ws + WS_WOUT), D, 0, 0, nullptr, scr, r, lane); continue; } r -= I_SQ;
        if (r < I_SQ) { transpose_item(C.in[25], D, 32, (bf16_t*)(ws + WS_WQ), D, 0, 0, C.in[23], scr, r, lane); continue; } r -= I_SQ;
        if (r < I_SQ) { transpose_item(C.in[26], D, 32, (bf16_t*)(ws + WS_WKV), D, 0, 0, nullptr, scr, r, lane); continue; } r -= I_SQ;
        if (r < I_SQ) { transpose_item(C.in[27], D, 32, (bf16_t*)(ws + WS_WKV), D, D, 0, nullptr, scr, r, lane); continue; } r -= I_SQ;
        if (r < I_SQ) { transpose_item(C.in[28], D, 32, (bf16_t*)(ws + WS_WO), D, 0, 0, nullptr, scr, r, lane); continue; } r -= I_SQ;
        if (r < I_UP) { transpose_item(C.in[30], DFF, 128, (bf16_t*)(ws + WS_WUP), D, 0, 0, C.in[29], scr, r, lane); continue; } r -= I_UP;
        if (r < I_DN) { transpose_item(C.in[31], D, 32, (bf16_t*)(ws + WS_WDOWN), DFF, 0, 0, nullptr, scr, r, lane); continue; } r -= I_DN;
        if (r < I_GLU) { transpose_item(C.in[20], DSSM, 16, (bf16_t*)(ws + WS_WGLU), DSSM, 0, 0, nullptr, scr, r, lane); continue; } r -= I_GLU;
        { const int gp = r / 8, rr = r % 8; transpose_item(C.in[10] + (size_t)gp * 128 * 128, 128, 4, (bf16_t*)(ws + WS_WPOOL), DPOOL, gp * 128, gp * 128, nullptr, scr, rr, lane); }
    }
    const int gt = bid * 512 + tid, NGT = G * 512;
    { bf16_t* WP = (bf16_t*)(ws + WS_WPOOL);
      for (int i = gt; i < 512 * 512 / 8; i += NGT) { const int n = i / 64, k = (i % 64) * 8; if ((n >> 7) != (k >> 7)) *(u32x4*)(WP + (size_t)n * DPOOL + k) = (u32x4){0u, 0u, 0u, 0u}; }
      float* SS = (float*)(ws + WS_SS); for (int i = gt; i < 3 * M; i += NGT) SS[i] = 0.f; }
    { bf16_t* H1 = (bf16_t*)(ws + WS_T0); bf16_t* MN = (bf16_t*)(ws + WS_MN);
      for (int m = gw; m < M + NMEM; m += NGW) {
          if (m < SEQ) rms_row_to_bf16(C.in[0] + (size_t)m * D, C.in[8], H1 + (size_t)m * D, lane);
          else if (m < M) rms_row_to_bf16(C.in[1] + (size_t)(m - SEQ) * D, C.in[8], H1 + (size_t)m * D, lane);
          else rms_row_to_bf16(C.in[7] + (size_t)(m - M) * D, C.in[24], MN + (size_t)(m - M) * D, lane); } }
    { float* AP = (float*)(ws + WS_AP); float* BB = (float*)(ws + WS_BB);
      for (int i = gt; i < NG * NP; i += NGT) { const int g = i / NP, p = i % NP;
          const float are = C.in[12][i], aim = C.in[13][i], dt = expf(C.in[19][g]);
          const float mag = expf(are * dt); float sn, cs; sincosf(aim * dt, &sn, &cs);
          const float abr = mag * cs, abi = mag * sn;
          float pr = 1.f, pi = 0.f;
          for (int k = 0; k <= 16; ++k) { AP[((size_t)(g * 17 + k) * NP + p) * 2] = pr; AP[((size_t)(g * 17 + k) * NP + p) * 2 + 1] = pi; const float nr = pr * abr - pi * abi, ni = pr * abi + pi * abr; pr = nr; pi = ni; }
          const float nr = abr - 1.f, ni = abi, den = are * are + aim * aim; const float cr = (nr * are + ni * aim) / den, ci = (ni * are - nr * aim) / den;
          for (int h = 0; h < NH; ++h) { const float br = C.in[14][(size_t)i * NH + h], bi = C.in[15][(size_t)i * NH + h];
              BB[((size_t)i * NH + h) * 2] = cr * br - ci * bi; BB[((size_t)i * NH + h) * 2 + 1] = cr * bi + ci * br; } } }
}
__device__ __forceinline__ void p1_pre(const Ctx& C, int G, int bid, int wv) {
    const int gt = bid * 512 + tidx(wv), NGT = G * 512; unsigned char* ws = C.ws;
    const float* AP = (const float*)(ws + WS_AP); const float* BB = (const float*)(ws + WS_BB); float* KL = (float*)(ws + WS_KLAG); bf16_t* WB = (bf16_t*)(ws + WS_WB);
    for (int i = gt; i < NG * 16 * 16 * 16; i += NGT) { const int hp = i & 15, h = (i >> 4) & 15, k = (i >> 8) & 15, g = i >> 12; float s = 0.f;
        const f32x4* crp = (const f32x4*)(C.in[16] + ((size_t)g * NH + h) * NP); const f32x4* cip = (const f32x4*)(C.in[17] + ((size_t)g * NH + h) * NP);
        const f32x4* app = (const f32x4*)(AP + (size_t)(g * 17 + k) * NP * 2); const f32x2* bbp = (const f32x2*)(BB + ((size_t)g * NP * NH + hp) * 2);
#pragma unroll 4
        for (int p4 = 0; p4 < NP / 4; ++p4) { const f32x4 cr = crp[p4], ci = cip[p4], a0 = app[2 * p4], a1 = app[2 * p4 + 1];
            const f32x2 b0 = bbp[(4 * p4 + 0) * NH], b1 = bbp[(4 * p4 + 1) * NH], b2 = bbp[(4 * p4 + 2) * NH], b3 = bbp[(4 * p4 + 3) * NH];
            s += cr[0] * (a0[0] * b0.x - a0[1] * b0.y) - ci[0] * (a0[0] * b0.y + a0[1] * b0.x);
            s += cr[1] * (a0[2] * b1.x - a0[3] * b1.y) - ci[1] * (a0[2] * b1.y + a0[3] * b1.x);
            s += cr[2] * (a1[0] * b2.x - a1[1] * b2.y) - ci[2] * (a1[0] * b2.y + a1[1] * b2.x);
            s += cr[3] * (a1[2] * b3.x - a1[3] * b3.y) - ci[3] * (a1[2] * b3.y + a1[3] * b3.x); }
        if (k == 0 && h == hp) s += C.in[18][g * NH + h];
        KL[i] = s; }
    for (int it = gt; it < NG * 256 * 32; it += NGT) { const int k8 = it & 31, n = (it >> 5) & 255, g = it >> 13; u32x4 o = {0u, 0u, 0u, 0u};
        if (n < 128) { const int p = n & 63, sidx = k8 >> 1, hp0 = (k8 & 1) * 8; const f32x2 a = *(const f32x2*)(AP + ((size_t)(g * 17 + 15 - sidx) * NP + p) * 2);
            const f32x4* bb = (const f32x4*)(BB + ((size_t)(g * NP + p) * NH + hp0) * 2); const f32x4 q0 = bb[0], q1 = bb[1], q2 = bb[2], q3 = bb[3];
            float v[8];
            if (n < 64) { v[0] = a.x * q0[0] - a.y * q0[1]; v[1] = a.x * q0[2] - a.y * q0[3]; v[2] = a.x * q1[0] - a.y * q1[1]; v[3] = a.x * q1[2] - a.y * q1[3];
                          v[4] = a.x * q2[0] - a.y * q2[1]; v[5] = a.x * q2[2] - a.y * q2[3]; v[6] = a.x * q3[0] - a.y * q3[1]; v[7] = a.x * q3[2] - a.y * q3[3]; }
            else {        v[0] = a.x * q0[1] + a.y * q0[0]; v[1] = a.x * q0[3] + a.y * q0[2]; v[2] = a.x * q1[1] + a.y * q1[0]; v[3] = a.x * q1[3] + a.y * q1[2];
                          v[4] = a.x * q2[1] + a.y * q2[0]; v[5] = a.x * q2[3] + a.y * q2[2]; v[6] = a.x * q3[1] + a.y * q3[0]; v[7] = a.x * q3[3] + a.y * q3[2]; }
            o.x = pk2(v[0], v[1]); o.y = pk2(v[2], v[3]); o.z = pk2(v[4], v[5]); o.w = pk2(v[6], v[7]); }
        *(u32x4*)(WB + (size_t)it * 8) = o; }
}
__device__ __forceinline__ void p2a_pre(const Ctx& C, int G, int bid, int wv) {
    const int gt = bid * 512 + tidx(wv), NGT = G * 512; unsigned char* ws = C.ws;
    const float* AP = (const float*)(ws + WS_AP); const float* KL = (const float*)(ws + WS_KLAG); bf16_t* WY = (bf16_t*)(ws + WS_WY);
    for (int it = gt; it < NG * 256 * (KY / 8); it += NGT) { const int k8 = it % (KY / 8), n = (it / (KY / 8)) & 255, g = it / ((KY / 8) * 256), t = n >> 4, h = n & 15, k0 = k8 * 8; float v[8];
        if (k0 < 256) { const int sidx = k0 >> 4, hp0 = k0 & 15; f32x4 q0 = {0.f, 0.f, 0.f, 0.f}, q1 = q0;
            if (sidx <= t) { const f32x4* kp = (const f32x4*)(KL + (((size_t)g * 16 + (t - sidx)) * 16 + h) * 16 + hp0); q0 = kp[0]; q1 = kp[1]; }
            v[0] = q0[0]; v[1] = q0[1]; v[2] = q0[2]; v[3] = q0[3]; v[4] = q1[0]; v[5] = q1[1]; v[6] = q1[2]; v[7] = q1[3]; }
        else { const int p0 = (k0 - 256) & 63; const f32x4* crp = (const f32x4*)(C.in[16] + ((size_t)g * NH + h) * NP + p0); const f32x4* cip = (const f32x4*)(C.in[17] + ((size_t)g * NH + h) * NP + p0);
            const f32x4* app = (const f32x4*)(AP + ((size_t)(g * 17 + t + 1) * NP + p0) * 2);
            const f32x4 cr0 = crp[0], cr1 = crp[1], ci0 = cip[0], ci1 = cip[1], a0 = app[0], a1 = app[1], a2 = app[2], a3 = app[3];
            const float cr[8] = {cr0[0], cr0[1], cr0[2], cr0[3], cr1[0], cr1[1], cr1[2], cr1[3]}, ci[8] = {ci0[0], ci0[1], ci0[2], ci0[3], ci1[0], ci1[1], ci1[2], ci1[3]};
            const float ar[8] = {a0[0], a0[2], a1[0], a1[2], a2[0], a2[2], a3[0], a3[2]}, ai[8] = {a0[1], a0[3], a1[1], a1[3], a2[1], a2[3], a3[1], a3[3]};
#pragma unroll
            for (int e = 0; e < 8; ++e) v[e] = (k0 < 320) ? (cr[e] * ar[e] - ci[e] * ai[e]) : -(cr[e] * ai[e] + ci[e] * ar[e]); }
        u32x4 o; o.x = pk2(v[0], v[1]); o.y = pk2(v[2], v[3]); o.z = pk2(v[4], v[5]); o.w = pk2(v[6], v[7]);
        *(u32x4*)(WY + (size_t)it * 8) = o; }
}
__device__ __forceinline__ void p2b_prefix(const Ctx& C, LAS unsigned char* lds, int g, int wv) {
    const int p = lane_id(); unsigned char* ws = C.ws;
    const float* AP = (const float*)(ws + WS_AP); const float* E = (const float*)(ws + WS_E) + (size_t)g * NCHP * 128; bf16_t* UH = (bf16_t*)(ws + WS_UH) + (size_t)g * NCHP * KY;
    LAS float* L = (LAS float*)lds;
    const float ar = AP[((size_t)(g * 17 + 16) * NP + p) * 2], ai = AP[((size_t)(g * 17 + 16) * NP + p) * 2 + 1];
    float hr[4] = {0.f, 0.f, 0.f, 0.f}, hi[4] = {0.f, 0.f, 0.f, 0.f};
    for (int cc = 0; cc < 32; cc += 8) { float er[4][8], ei[4][8];
#pragma unroll
        for (int ch = 0; ch < 4; ++ch)
#pragma unroll
            for (int j = 0; j < 8; ++j) { const size_t c = (size_t)((wv * 4 + ch) * 32 + cc + j); er[ch][j] = E[c * 128 + p]; ei[ch][j] = E[c * 128 + 64 + p]; }
#pragma unroll
        for (int j = 0; j < 8; ++j)
#pragma unroll
            for (int ch = 0; ch < 4; ++ch) { const float nr = ar * hr[ch] - ai * hi[ch] + er[ch][j], ni = ar * hi[ch] + ai * hr[ch] + ei[ch][j]; hr[ch] = nr; hi[ch] = ni; } }
#pragma unroll
    for (int ch = 0; ch < 4; ++ch) { L[((wv * 4 + ch) * 64 + p) * 2] = hr[ch]; L[((wv * 4 + ch) * 64 + p) * 2 + 1] = hi[ch]; }
    float sr = ar, si = ai;
#pragma unroll
    for (int j = 0; j < 5; ++j) { const float nr = sr * sr - si * si, ni = 2.f * sr * si; sr = nr; si = ni; }
    __syncthreads();
    float Hr = 0.f, Hi = 0.f;
    for (int j = 0; j < wv * 4; ++j) { const float lr = L[(j * 64 + p) * 2], li = L[(j * 64 + p) * 2 + 1]; const float nr = sr * Hr - si * Hi + lr, ni = sr * Hi + si * Hr + li; Hr = nr; Hi = ni; }
#pragma unroll
    for (int ch = 0; ch < 4; ++ch) { hr[ch] = Hr; hi[ch] = Hi; const float lr = L[((wv * 4 + ch) * 64 + p) * 2], li = L[((wv * 4 + ch) * 64 + p) * 2 + 1];
        const float nr = sr * Hr - si * Hi + lr, ni = sr * Hi + si * Hr + li; Hr = nr; Hi = ni; }
    if (wv == 7) { C.out[O_SREP + g * NP + p] = Hr; C.out[O_SIMP + g * NP + p] = Hi; }
    for (int cc = 0; cc < 32; cc += 8) { float er[4][8], ei[4][8];
#pragma unroll
        for (int ch = 0; ch < 4; ++ch)
#pragma unroll
            for (int j = 0; j < 8; ++j) { const size_t c = (size_t)((wv * 4 + ch) * 32 + cc + j); er[ch][j] = E[c * 128 + p]; ei[ch][j] = E[c * 128 + 64 + p]; }
#pragma unroll
        for (int j = 0; j < 8; ++j)
#pragma unroll
            for (int ch = 0; ch < 4; ++ch) { const size_t c = (size_t)((wv * 4 + ch) * 32 + cc + j);
                UH[c * KY + 256 + p] = (bf16_t)f2bf(hr[ch]); UH[c * KY + 320 + p] = (bf16_t)f2bf(hi[ch]);
                const float nr = ar * hr[ch] - ai * hi[ch] + er[ch][j], ni = ar * hi[ch] + ai * hr[ch] + ei[ch][j]; hr[ch] = nr; hi[ch] = ni; } }
    for (int b = wv; b < 16; b += 8) { const float h0r = C.in[5][((size_t)b * NG + g) * NP + p], h0i = C.in[6][((size_t)b * NG + g) * NP + p]; const int c = 1024 + b;
        UH[(size_t)c * KY + 256 + p] = (bf16_t)f2bf(h0r); UH[(size_t)c * KY + 320 + p] = (bf16_t)f2bf(h0i);
        C.out[O_SRES + ((size_t)b * NG + g) * NP + p] = ar * h0r - ai * h0i + E[(size_t)c * 128 + p];
        C.out[O_SIMS + ((size_t)b * NG + g) * NP + p] = ar * h0i + ai * h0r + E[(size_t)c * 128 + 64 + p]; }
    __syncthreads();
}
__device__ __forceinline__ void unpack8(const u32x4 q, float* v) { const unsigned qq[4] = {q.x, q.y, q.z, q.w};
#pragma unroll
    for (int e = 0; e < 8; ++e) v[e] = bf2f((qq[e >> 1] >> ((e & 1) * 16)) & 0xffffu); }
__device__ __forceinline__ void p2b_pool(const Ctx& C, int worker, int nworkers, int wv) {
    const int cl = lane_id() * 8; unsigned char* ws = C.ws;
    const bf16_t* ZP = (const bf16_t*)(ws + WS_ZP); bf16_t* MIX = (bf16_t*)(ws + WS_T1);
    const int w = 2 << (cl >> 7);
    for (int blk = worker * 8 + wv; blk < M / 8; blk += nworkers * 8) { const int r0 = blk * 8;
        if (r0 < SEQ) {
#pragma unroll 2
            for (int t = 0; t < 8; ++t) { const int row = r0 + t; u32x4 q[16];
#pragma unroll
                for (int j = 0; j < 16; ++j) { const int rr = row - j; q[j] = *(const u32x4*)(ZP + (size_t)(rr < 0 ? 0 : rr) * DPOOL + cl); }
                float s[8], cur[8]; unpack8(q[0], cur);
#pragma unroll
                for (int e = 0; e < 8; ++e) s[e] = cur[e];
#pragma unroll
                for (int j = 1; j < 16; ++j) { float v[8]; unpack8(q[j], v); const float mk = (j < w && row - j >= 0) ? 1.f : 0.f;
#pragma unroll
                    for (int e = 0; e < 8; ++e) s[e] += mk * v[e]; }
                const int cnt = (row + 1 < w) ? row + 1 : w; const float inv = 1.f / (float)cnt;
                u32x4 o; o.x = pk2(s[0] * inv - cur[0], s[1] * inv - cur[1]); o.y = pk2(s[2] * inv - cur[2], s[3] * inv - cur[3]); o.z = pk2(s[4] * inv - cur[4], s[5] * inv - cur[5]); o.w = pk2(s[6] * inv - cur[6], s[7] * inv - cur[7]);
                *(u32x4*)(MIX + (size_t)row * D + cl) = o; }
        } else { const int b = (r0 - SEQ) >> 4, t0 = r0 & 15;
            for (int tt = 0; tt < 8; ++tt) { const int t = t0 + tt, row = r0 + tt; float s[8] = {0.f, 0.f, 0.f, 0.f, 0.f, 0.f, 0.f, 0.f}; float cur[8];
                for (int j = 0; j < w; ++j) { float v[8];
                    if (t - j >= 0) unpack8(*(const u32x4*)(ZP + (size_t)(row - j) * DPOOL + cl), v);
                    else { const float* hp = C.in[4] + ((size_t)b * 15 + (15 + t - j)) * DPOOL + cl; const f32x4 a = *(const f32x4*)hp, bb = *(const f32x4*)(hp + 4);
                        v[0] = a[0]; v[1] = a[1]; v[2] = a[2]; v[3] = a[3]; v[4] = bb[0]; v[5] = bb[1]; v[6] = bb[2]; v[7] = bb[3]; }
#pragma unroll
                    for (int e = 0; e < 8; ++e) { s[e] += v[e]; if (j == 0) cur[e] = v[e]; } }
                const float inv = 1.f / (float)w;
                u32x4 o; o.x = pk2(s[0] * inv - cur[0], s[1] * inv - cur[1]); o.y = pk2(s[2] * inv - cur[2], s[3] * inv - cur[3]); o.z = pk2(s[4] * inv - cur[4], s[5] * inv - cur[5]); o.w = pk2(s[6] * inv - cur[6], s[7] * inv - cur[7]);
                *(u32x4*)(MIX + (size_t)row * D + cl) = o; } } }
}
__device__ __forceinline__ void sample_attn_item(const Ctx& C, LAS unsigned char* lds, int item, int wv) {
    const int lane = lane_id(), fr = lane & 15, fq = lane >> 4; const int b = item >> 4, h = (item >> 2) & 3, dq = item & 3; unsigned char* ws = C.ws;
    const bf16_t* Q = (const bf16_t*)(ws + WS_T1); bf16_t* O = (bf16_t*)(ws + WS_T0);
    const float* Kc = C.in[2] + (size_t)b * NMEM * D + h * HD; const float* Vc = C.in[3] + (size_t)b * NMEM * D + h * HD + dq * 64;
    LAS float* Sl = (LAS float*)lds;
    LAS float* PT = (LAS float*)(lds + 16384);
    LAS float* red = (LAS float*)(lds + 32768);
    float vv[32];
#pragma unroll
    for (int j = 0; j < 32; ++j) vv[j] = Vc[(size_t)(wv * 32 + j) * D + lane];
    bf16x8 qf[8];
#pragma unroll
    for (int kk = 0; kk < 8; ++kk) qf[kk] = *(const bf16x8*)(Q + (size_t)(SEQ + b * 16 + fr) * D + h * HD + kk * 32 + fq * 8);
#pragma unroll
    for (int kbi = 0; kbi < 2; ++kbi) { const int kb = wv + 8 * kbi; f32x4 acc = {0.f, 0.f, 0.f, 0.f}; const float* kr = Kc + (size_t)(kb * 16 + fr) * D + fq * 8;
#pragma unroll
        for (int kk = 0; kk < 8; ++kk) { const f32x4 a = *(const f32x4*)(kr + kk * 32), c = *(const f32x4*)(kr + kk * 32 + 4); const u32x4 w = pack8(a, c);
            acc = __builtin_amdgcn_mfma_f32_16x16x32_bf16(qf[kk], __builtin_bit_cast(bf16x8, w), acc, 0, 0, 0); }
#pragma unroll
        for (int r = 0; r < 4; ++r) Sl[(4 * fq + r) * 256 + kb * 16 + fr] = acc[r]; }
    __syncthreads();
#pragma unroll
    for (int rr = 0; rr < 2; ++rr) { const int s = wv * 2 + rr; float v[4]; float mx = -3.0e38f;
#pragma unroll
        for (int j = 0; j < 4; ++j) { v[j] = Sl[s * 256 + lane + 64 * j]; mx = fmaxf(mx, v[j]); }
        mx = wave_max(mx, lane); float sum = 0.f;
#pragma unroll
        for (int j = 0; j < 4; ++j) { v[j] = __builtin_amdgcn_exp2f(v[j] - mx); sum += v[j]; }
        const float inv = 1.f / wave_sum(sum, lane);
#pragma unroll
        for (int j = 0; j < 4; ++j) PT[(lane + 64 * j) * 16 + s] = v[j] * inv; }
    __syncthreads();
    { float o[16];
#pragma unroll
      for (int s = 0; s < 16; ++s) o[s] = 0.f;
#pragma unroll
      for (int j = 0; j < 32; ++j) { const LAS f32x4* pp = (const LAS f32x4*)(PT + (wv * 32 + j) * 16);
#pragma unroll
          for (int q4 = 0; q4 < 4; ++q4) { const f32x4 pv = pp[q4]; o[4 * q4 + 0] += pv[0] * vv[j]; o[4 * q4 + 1] += pv[1] * vv[j]; o[4 * q4 + 2] += pv[2] * vv[j]; o[4 * q4 + 3] += pv[3] * vv[j]; } }
#pragma unroll
      for (int s = 0; s < 16; ++s) red[(wv * 16 + s) * 64 + lane] = o[s]; }
    __syncthreads();
    { const int tid = wv * 64 + lane, s = tid >> 5, dp = (tid & 31) * 2; float o0 = 0.f, o1 = 0.f;
#pragma unroll
      for (int w = 0; w < 8; ++w) { const f32x2 t = *(const LAS f32x2*)(red + (w * 16 + s) * 64 + dp); o0 += t.x; o1 += t.y; }
      *(unsigned*)(O + (size_t)(SEQ + b * 16 + s) * D + h * HD + dq * 64 + dp) = pk2(o0, o1); }
    __syncthreads();
}

template <class Epi8>
__device__ __forceinline__ void skinny_gemm(LAS unsigned char* lds, const bf16_t* A, int lda, const bf16_t* Bt, int ldb, int N, int K, int ksplit, const Epi8& E, int G, int bid, int wv) {
    const int lane = lane_id(), fr = lane & 15, fq = lane >> 4;
    const int ntn = N / 64, per = 4 * ntn, ntiles = per * ksplit, kw = K / ksplit / 8;
    LAS float* red = (LAS float*)lds;
    for (int t = bid; t < ntiles; t += G) {
        const int ks = t / per, tt = t % per, tm = tt & 3, tn = tt >> 2, kbeg = ks * (K / ksplit) + wv * kw;
        f32x4 acc[4][4];
#pragma unroll
        for (int i = 0; i < 4; ++i)
#pragma unroll
            for (int j = 0; j < 4; ++j) acc[i][j] = (f32x4){0.f, 0.f, 0.f, 0.f};
        const bf16_t* ap = A + (size_t)(tm * 64 + fr) * lda + kbeg + fq * 8;
        const bf16_t* bp = Bt + (size_t)(tn * 64 + fr) * ldb + kbeg + fq * 8;
#pragma unroll 2
        for (int k = 0; k < kw; k += 32) { bf16x8 af[4], bfr[4];
#pragma unroll
            for (int i = 0; i < 4; ++i) { af[i] = *(const bf16x8*)(ap + (size_t)i * 16 * lda + k); bfr[i] = *(const bf16x8*)(bp + (size_t)i * 16 * ldb + k); }
#pragma unroll
            for (int i = 0; i < 4; ++i)
#pragma unroll
                for (int j = 0; j < 4; ++j) acc[i][j] = __builtin_amdgcn_mfma_f32_16x16x32_bf16(bfr[j], af[i], acc[i][j], 0, 0, 0); }
#pragma unroll
        for (int i = 0; i < 4; ++i)
#pragma unroll
            for (int j = 0; j < 4; ++j) *(LAS f32x4*)(red + ((wv * 64 + i * 16 + fr) * 64 + (((j * 4 + fq) ^ fr) << 2))) = acc[i][j];
        __syncthreads();
        { const int tid = wv * 64 + lane, row = tid >> 3, s8 = (tid & 7) * 2; f32x4 s0 = {0.f, 0.f, 0.f, 0.f}, s1 = {0.f, 0.f, 0.f, 0.f};
#pragma unroll
          for (int w = 0; w < 8; ++w) { s0 += *(const LAS f32x4*)(red + ((w * 64 + row) * 64 + ((s8 ^ (row & 15)) << 2))); s1 += *(const LAS f32x4*)(red + ((w * 64 + row) * 64 + (((s8 + 1) ^ (row & 15)) << 2))); }
          E(tm * 64 + row, tn * 64 + s8 * 4, s0, s1, lane, ks); }
        __syncthreads();
    }
}
__device__ __forceinline__ u32x2 pack4(const f32x4 v) { u32x2 w; w.x = cvt_pk_bf16(v[0], v[1]); w.y = cvt_pk_bf16(v[2], v[3]); return w; }
struct SkZ { bf16_t* ZP; bf16_t* UH; float* out;
    __device__ __forceinline__ void operator()(int r, int c, f32x4 v0, f32x4 v1, int, int) const { const int row = SEQ + r; const u32x4 w = pack8(v0, v1);
        if (c < DPOOL) { *(u32x4*)(ZP + (size_t)row * DPOOL + c) = w; if ((r & 15) != 0) { float* dst = out + O_POOLS + ((size_t)(r >> 4) * 15 + ((r & 15) - 1)) * DPOOL + c; *(f32x4*)dst = v0; *(f32x4*)(dst + 4) = v1; } }
        else { const int cc = c - DPOOL, gg = cc >> 4, hh = cc & 15; *(u32x4*)(UH + ((size_t)gg * NCHP + (row >> 4)) * KY + (row & 15) * 16 + hh) = w; } } };
struct SkKV { float* out; bf16_t* KB; bf16_t* VT;
    __device__ __forceinline__ void operator()(int r, int c, f32x4 v0, f32x4 v1, int, int) const {
        if (c < D) { float* dst = out + O_MK + (size_t)r * D + c; *(f32x4*)dst = v0; *(f32x4*)(dst + 4) = v1; *(u32x4*)(KB + (size_t)r * D + c) = pack8(v0, v1); }
        else { const int c2 = c - D; float* dst = out + O_MV + (size_t)r * D + c2; *(f32x4*)dst = v0; *(f32x4*)(dst + 4) = v1;
#pragma unroll
            for (int j = 0; j < 4; ++j) { VT[(size_t)(c2 + j) * NMEM + r] = (bf16_t)f2bf(v0[j]); VT[(size_t)(c2 + 4 + j) * NMEM + r] = (bf16_t)f2bf(v1[j]); } } } };
struct SkPool { bf16_t* CAT; const float* scale;
    __device__ __forceinline__ void operator()(int r, int c, f32x4 v0, f32x4 v1, int, int) const { *(u32x4*)(CAT + (size_t)(SEQ + r) * D + c) = pack8(v0 * *(const f32x4*)(scale + c), v1 * *(const f32x4*)(scale + c + 4)); } };
struct SkGlu { bf16_t* CAT; const bf16_t* MIX; const float* bias;
    __device__ __forceinline__ void operator()(int r, int c, f32x4 v0, f32x4 v1, int, int) const { float y[8]; unpack8(*(const u32x4*)(MIX + (size_t)(SEQ + r) * D + DPOOL + c), y);
        const f32x4 b0 = *(const f32x4*)(bias + c), b1 = *(const f32x4*)(bias + c + 4);
#pragma unroll
        for (int j = 0; j < 4; ++j) { v0[j] = y[j] / (1.f + __expf(-(v0[j] + b0[j]))); v1[j] = y[4 + j] / (1.f + __expf(-(v1[j] + b1[j]))); }
        *(u32x4*)(CAT + (size_t)(SEQ + r) * D + DPOOL + c) = pack8(v0, v1); } };
struct SkRes { const float* base; float* out; bf16_t* Xb; float* SS;
    __device__ __forceinline__ void operator()(int r, int c, f32x4 v0, f32x4 v1, int lane, int) const { const float* bp = base + (size_t)r * D + c; const f32x4 x0 = v0 + *(const f32x4*)bp, x1 = v1 + *(const f32x4*)(bp + 4);
        float* op = out + (size_t)r * D + c; *(f32x4*)op = x0; *(f32x4*)(op + 4) = x1; *(u32x4*)(Xb + (size_t)r * D + c) = pack8(x0, x1);
        float q = ((x0[0] * x0[0] + x0[1] * x0[1]) + (x0[2] * x0[2] + x0[3] * x0[3])) + ((x1[0] * x1[0] + x1[1] * x1[1]) + (x1[2] * x1[2] + x1[3] * x1[3]));
        q += shfl_x(q, lane, 1); q += shfl_x(q, lane, 2); q += shfl_x(q, lane, 4);
        if ((lane & 7) == 0) atomicAdd(SS + r, q); } };
struct SkQ { bf16_t* Q; const float* SS;
    __device__ __forceinline__ void operator()(int r, int c, f32x4 v0, f32x4 v1, int, int) const { const float rs = rsqrtf(SS[r] * (1.f / D) + EPS) * QSCALE; *(u32x4*)(Q + (size_t)r * D + c) = pack8(v0 * rs, v1 * rs); } };
struct SkUp { bf16_t* U; const float* SS;
    __device__ __forceinline__ void operator()(int r, int c, f32x4 v0, f32x4 v1, int, int) const { const float rs = rsqrtf(SS[r] * (1.f / D) + EPS);
#pragma unroll
        for (int j = 0; j < 4; ++j) { const float a = fmaxf(v0[j] * rs, 0.f), b = fmaxf(v1[j] * rs, 0.f); v0[j] = a * a; v1[j] = b * b; }
        *(u32x4*)(U + (size_t)r * DFF + c) = pack8(v0, v1); } };
struct SkSlab { float* slab;
    __device__ __forceinline__ void operator()(int r, int c, f32x4 v0, f32x4 v1, int, int ks) const { float* dst = slab + ((size_t)ks * NSAMP + r) * D + c; *(f32x4*)dst = v0; *(f32x4*)(dst + 4) = v1; } };

#define XB_TMO      128
#define XB_XCNT(j)  (256  + 64 * (j))
#define XB_XSUB(j)  (1280 + 64 * (j))
#define XB_XGEN(j)  (2304 + 64 * (j))
#define XB_TOP      3328
#define XB_TOPGEN   3392
#define XCD_BAR_WORDS 3456
#define XB_SPIN_CAP (1u << 18)

__device__ __forceinline__ unsigned xb_ld(unsigned* p)              { return __hip_atomic_load(p, __ATOMIC_RELAXED, __HIP_MEMORY_SCOPE_AGENT); }
__device__ __forceinline__ unsigned xb_add(unsigned* p, unsigned v) { return __hip_atomic_fetch_add(p, v, __ATOMIC_RELAXED, __HIP_MEMORY_SCOPE_AGENT); }
__device__ __forceinline__ unsigned xb_xcc_id() { return (unsigned)__builtin_amdgcn_s_getreg((3 << 11) | 20) & 0xFu; }
#define XB_SPIN(cond, bar) do { unsigned _sp = 0; while (cond) { __builtin_amdgcn_s_sleep(1); \
    if ((++_sp & 255u) == 0u) { if (xb_ld(&(bar)[XB_TMO])) break; if (_sp > XB_SPIN_CAP) { atomicAdd(&(bar)[XB_TMO], 1u); break; } } } } while (0)

struct XcdBarrier {
    unsigned* bar; unsigned x;
    volatile LAS unsigned* st;
};

__device__ __forceinline__ XcdBarrier xcd_barrier_post(unsigned* bar, volatile LAS unsigned* st, int wv) {
    XcdBarrier b; b.bar = bar; b.x = xb_xcc_id(); b.st = st;
    if (tidx(wv) == 0) (void)xb_add(&bar[XB_XCNT(b.x)], 1u);
    return b;
}
__device__ __forceinline__ void xcd_barrier_complete(unsigned* bar, unsigned x, unsigned& nloc, unsigned& nx) {
    const unsigned G = gridDim.x * gridDim.y * gridDim.z;
    unsigned sum, cnt, mine, sp = 0u;
    for (;;) {
        sum = 0u; cnt = 0u; mine = 0u;
#pragma unroll
        for (unsigned j = 0; j < 16; ++j) { const unsigned c = xb_ld(&bar[XB_XCNT(j)]); sum += c; cnt += (c > 0u) ? 1u : 0u; mine = (j == x) ? c : mine; }
        if (sum == G) break;
        __builtin_amdgcn_s_sleep(1);
        if ((++sp & 255u) == 0u) { if (xb_ld(&bar[XB_TMO])) break; if (sp > XB_SPIN_CAP) { atomicAdd(&bar[XB_TMO], 1u); break; } }
    }
    nloc = mine > 0u ? mine : 1u; nx = cnt > 0u ? cnt : 1u;
}

__device__ __forceinline__ void xcd_barrier(const XcdBarrier& b, int wv) {
    asm volatile("s_waitcnt vmcnt(0)" ::: "memory");
    __syncthreads();
    if (tidx(wv) == 0) {
        unsigned* bar = b.bar;
        __builtin_amdgcn_s_waitcnt(0);
        unsigned nloc = b.st[0], nx = b.st[1];
        if (nloc == 0u) { xcd_barrier_complete(bar, b.x, nloc, nx); b.st[0] = nloc; b.st[1] = nx; }
        const unsigned old = xb_add(&bar[XB_XSUB(b.x)], 1u);
        const unsigned gen = old / nloc;
        if (old + 1u == (gen + 1u) * nloc) {
            __builtin_amdgcn_fence(__ATOMIC_RELEASE, "agent");
            asm volatile("s_waitcnt vmcnt(0)" ::: "memory");
            const unsigned og = xb_add(&bar[XB_TOP], 1u);
            const unsigned tg = og / nx;
            if (og + 1u == (tg + 1u) * nx) xb_add(&bar[XB_TOPGEN], 1u);
            else XB_SPIN(xb_ld(&bar[XB_TOPGEN]) == tg, bar);
            __builtin_amdgcn_fence(__ATOMIC_ACQUIRE, "agent");
            xb_add(&bar[XB_XGEN(b.x)], 1u);
            asm volatile("s_waitcnt vmcnt(0)" ::: "memory");
        } else {
            XB_SPIN(xb_ld(&bar[XB_XGEN(b.x)]) == gen, bar);
            __builtin_amdgcn_fence(__ATOMIC_ACQUIRE, "agent");
            asm volatile("s_waitcnt vmcnt(0)" ::: "memory");
        }
    }
    __syncthreads();
}

#ifndef PHMASK
#define PHMASK 0xFFFF
#endif
#define PH(k) if constexpr (((PHMASK) >> (k)) & 1)
constexpr int LDS_BYTES = 131072 + 8192 + 1024;
__global__ void __launch_bounds__(512, 2) fwd_megakernel(Ctx C) {
    extern __shared__ __attribute__((aligned(16))) unsigned char lds_raw[];
    LAS unsigned char* lds = (LAS unsigned char*)lds_raw;
    cg::grid_group grid = cg::this_grid();
    const int wv = __builtin_amdgcn_readfirstlane((int)threadIdx.x >> 6);
    const int G = gridDim.x, bid = blockIdx.x; unsigned char* ws = C.ws;
    bf16_t* T0 = (bf16_t*)(ws + WS_T0); bf16_t* T1 = (bf16_t*)(ws + WS_T1); bf16_t* T2 = (bf16_t*)(ws + WS_T2);
    float* SS1 = (float*)(ws + WS_SS); float* SS2 = SS1 + M;
    float* Y = C.out + O_Y;
    pg8::Order S;

    if (bid == 0) { unsigned* bw = (unsigned*)(ws + WS_BAR); for (int i = tidx(wv); i < XCD_BAR_WORDS; i += 512) bw[i] = 0u; }
    { volatile LAS unsigned* misc = (volatile LAS unsigned*)(lds + 131072 + 8192); if (tidx(wv) < 16) misc[tidx(wv)] = 0u; }
    p0_prologue(C, lds, G, bid, wv);
    grid.sync();
    const XcdBarrier xbar = xcd_barrier_post((unsigned*)(ws + WS_BAR), (volatile LAS unsigned*)(lds + 131072 + 8192), wv);

    p1_pre(C, G, bid, wv);
    PH(0) { pg8::Gemm g{(const char*)T0, (const char*)(ws + WS_WIN), D, D, 0, 0, D}; S.init(SEQ / 256, 4, 1, G, bid);
      EpiZ E{(bf16_t*)(ws + WS_ZP), (bf16_t*)(ws + WS_UH), C.out}; pg8::gemm_phase(lds, g, S, E, wv); }
    { SkZ E{(bf16_t*)(ws + WS_ZP), (bf16_t*)(ws + WS_UH), C.out}; skinny_gemm(lds, T0 + (size_t)SEQ * D, D, (const bf16_t*)(ws + WS_WIN), D, D, D, 1, E, G, bid, wv); }
    { SkKV E{C.out, (bf16_t*)(ws + WS_KB), (bf16_t*)(ws + WS_VT)};
      skinny_gemm(lds, (const bf16_t*)(ws + WS_MN), D, (const bf16_t*)(ws + WS_WKV), D, 2 * D, D, 1, E, G, (bid + G - 64) % G, wv); }
    xcd_barrier(xbar, wv);

    p2a_pre(C, G, bid, wv);
    PH(2) { pg8::Gemm g{(const char*)(ws + WS_UH), (const char*)(ws + WS_WB), KY, 256, (size_t)NCHP * KY * 2, (size_t)256 * 256 * 2, 256}; S.init(NCHP / 256, 1, NG, G, bid);
      EpiE E{(float*)(ws + WS_E)}; pg8::gemm_phase(lds, g, S, E, wv); }
    xcd_barrier(xbar, wv);

    if (bid < NG) p2b_prefix(C, lds, bid, wv);
    else p2b_pool(C, bid - NG, G - NG, wv);
    xcd_barrier(xbar, wv);

    PH(3) { pg8::Gemm g{(const char*)(ws + WS_UH), (const char*)(ws + WS_WY), KY, KY, (size_t)NCHP * KY * 2, (size_t)256 * KY * 2, KY}; S.init(NCHP / 256, 1, NG, G, bid);
      EpiY E{T1}; pg8::gemm_phase(lds, g, S, E, wv); }
    xcd_barrier(xbar, wv);

    PH(5) { pg8::Gemm g{(const char*)(T1 + DPOOL), (const char*)(ws + WS_WGLU), D, DSSM, 0, 0, DSSM}; S.init(SEQ / 256, 2, 1, G, bid);
      EpiGlu E{T2, T1, C.in[21]}; pg8::gemm_phase(lds, g, S, E, wv); }
    PH(4) { pg8::Gemm g{(const char*)T1, (const char*)(ws + WS_WPOOL), D, DPOOL, 0, 0, DPOOL}; S.init(SEQ / 256, 2, 1, G, (bid + G - (128 % G)) % G);
      EpiPool E{T2, C.in[11]}; pg8::gemm_phase(lds, g, S, E, wv); }
    { SkGlu E{T2, T1, C.in[21]}; skinny_gemm(lds, T1 + (size_t)SEQ * D + DPOOL, D, (const bf16_t*)(ws + WS_WGLU), DSSM, DSSM, DSSM, 1, E, G, bid, wv); }
    { SkPool E{T2, C.in[11]}; skinny_gemm(lds, T1 + (size_t)SEQ * D, D, (const bf16_t*)(ws + WS_WPOOL), DPOOL, DPOOL, DPOOL, 1, E, G, (bid + G - 32) % G, wv); }
    xcd_barrier(xbar, wv);

    PH(6) { pg8::Gemm g{(const char*)T2, (const char*)(ws + WS_WOUT), D, D, 0, 0, D}; S.init(SEQ / 256, 4, 1, G, bid);
      EpiRes E{C.in[0], C.in[1], Y, T0, SS1}; pg8::gemm_phase(lds, g, S, E, wv); }
    { SkRes E{C.in[1], Y + (size_t)SEQ * D, T0 + (size_t)SEQ * D, SS1 + SEQ}; skinny_gemm(lds, T2 + (size_t)SEQ * D, D, (const bf16_t*)(ws + WS_WOUT), D, D, D, 1, E, G, bid, wv); }
    xcd_barrier(xbar, wv);

    PH(7) { pg8::Gemm g{(const char*)T0, (const char*)(ws + WS_WQ), D, D, 0, 0, D}; S.init(SEQ / 256, 4, 1, G, bid);
      EpiQ E{T1, SS1}; pg8::gemm_phase(lds, g, S, E, wv); }
    { SkQ E{T1 + (size_t)SEQ * D, SS1 + SEQ}; skinny_gemm(lds, T0 + (size_t)SEQ * D, D, (const bf16_t*)(ws + WS_WQ), D, D, D, 1, E, G, bid, wv); }
    xcd_barrier(xbar, wv);

    PH(8) { pg8::Gemm g{(const char*)T1, (const char*)(ws + WS_KB), D, D, (size_t)HD * 2, (size_t)HD * 2, HD}; S.init(SEQ / 256, 1, NHEAD, G, bid);
      EpiSoftmax E{T2, (LAS float*)(lds + 131072), (LAS float*)(lds + 131072 + 4096)}; pg8::gemm_phase(lds, g, S, E, wv); }
    for (int it = bid; it < 256; it += G) sample_attn_item(C, lds, it, wv);
    xcd_barrier(xbar, wv);

    PH(9) { pg8::Gemm g{(const char*)T2, (const char*)(ws + WS_VT), D, NMEM, (size_t)HD * 2, (size_t)HD * NMEM * 2, NMEM}; S.init(SEQ / 256, 1, NHEAD, G, bid);
      EpiO E{T0}; pg8::gemm_phase(lds, g, S, E, wv); }
    xcd_barrier(xbar, wv);

    PH(10) { pg8::Gemm g{(const char*)T0, (const char*)(ws + WS_WO), D, D, 0, 0, D}; S.init(SEQ / 256, 4, 1, G, bid);
      EpiRes E{Y, Y + (size_t)SEQ * D, Y, T2, SS2}; pg8::gemm_phase(lds, g, S, E, wv); }
    { SkRes E{Y + (size_t)SEQ * D, Y + (size_t)SEQ * D, T2 + (size_t)SEQ * D, SS2 + SEQ}; skinny_gemm(lds, T0 + (size_t)SEQ * D, D, (const bf16_t*)(ws + WS_WO), D, D, D, 1, E, G, bid, wv); }
    xcd_barrier(xbar, wv);

    PH(11) { pg8::Gemm g{(const char*)T2, (const char*)(ws + WS_WUP), D, D, 0, 0, D}; S.init(SEQ / 256, DFF / 256, 1, G, bid);
      EpiUp E{(bf16_t*)(ws + WS_U), SS2}; pg8::gemm_phase(lds, g, S, E, wv); }
    { SkUp E{(bf16_t*)(ws + WS_U) + (size_t)SEQ * DFF, SS2 + SEQ}; skinny_gemm(lds, T2 + (size_t)SEQ * D, D, (const bf16_t*)(ws + WS_WUP), D, DFF, D, 1, E, G, bid, wv); }
    xcd_barrier(xbar, wv);

    PH(12) { pg8::Gemm g{(const char*)(ws + WS_U), (const char*)(ws + WS_WDOWN), DFF, DFF, 0, 0, DFF}; S.init(SEQ / 256, 4, 1, G, bid);
      EpiRes E{Y, Y + (size_t)SEQ * D, Y, nullptr, nullptr}; pg8::gemm_phase(lds, g, S, E, wv); }
    { SkSlab E{(float*)(ws + WS_SLAB)}; skinny_gemm(lds, (const bf16_t*)(ws + WS_U) + (size_t)SEQ * DFF, DFF, (const bf16_t*)(ws + WS_WDOWN), DFF, D, DFF, 4, E, G, bid, wv); }
    xcd_barrier(xbar, wv);

    { const int lane = lane_id(), gw = bid * 8 + wv, NGW = G * 8; const f32x4* gr = (const f32x4*)C.in[32] + lane;
      for (int m = gw; m < M; m += NGW) { f32x4* xr = (f32x4*)(Y + (size_t)m * D) + lane; f32x4 v[4]; float ss = 0.f;
#pragma unroll
          for (int j = 0; j < 4; ++j) v[j] = xr[64 * j];
          if (m >= SEQ) {
#pragma unroll
              for (int ks = 0; ks < 4; ++ks) { const f32x4* sp = (const f32x4*)((const float*)(ws + WS_SLAB) + ((size_t)ks * NSAMP + (m - SEQ)) * D) + lane;
#pragma unroll
                  for (int j = 0; j < 4; ++j) v[j] += sp[64 * j]; } }
#pragma unroll
          for (int j = 0; j < 4; ++j) ss += (v[j].x * v[j].x + v[j].y * v[j].y) + (v[j].z * v[j].z + v[j].w * v[j].w);
          const float rs = rsqrtf(wave_sum(ss, lane) * (1.f / D) + EPS);
#pragma unroll
          for (int j = 0; j < 4; ++j) { const f32x4 gg = gr[64 * j]; xr[64 * j] = (f32x4){v[j].x * rs * gg.x, v[j].y * rs * gg.y, v[j].z * rs * gg.z, v[j].w * rs * gg.w}; } } }
}

extern "C" void kernel_launch(void* const* d_in, const int* in_sizes, int n_in, void* d_out, int out_size, void* d_ws, size_t ws_size, hipStream_t stream) {
    static int grid = 0;
    if (grid == 0) {
        if (n_in != 33 || (size_t)out_size != O_END || ws_size < WS_END) { fprintf(stderr, "kernel_launch: unexpected shapes n_in %d out %d ws %zu\n", n_in, out_size, ws_size); grid = -1; return; }
        int dev = 0, cus = 0, per_cu = 0;
        hipGetDevice(&dev); hipDeviceGetAttribute(&cus, hipDeviceAttributeMultiprocessorCount, dev);
        if (hipFuncSetAttribute((const void*)fwd_megakernel, hipFuncAttributeMaxDynamicSharedMemorySize, LDS_BYTES) != hipSuccess) { fprintf(stderr, "kernel_launch: hipFuncSetAttribute failed\n"); grid = -1; return; }
        if (hipOccupancyMaxActiveBlocksPerMultiprocessor(&per_cu, (const void*)fwd_megakernel, 512, LDS_BYTES) != hipSuccess || per_cu < 1) { fprintf(stderr, "kernel_launch: occupancy query failed (%d)\n", per_cu); (void)hipGetLastError(); per_cu = 1; }
        if (per_cu > 1) per_cu = 1;
        grid = cus * per_cu; if (grid > 256) grid = 256;
    }
    if (grid < 0) return;
    Ctx c{};
    for (int i = 0; i < 33; ++i) c.in[i] = (const float*)d_in[i];
    c.out = (float*)d_out; c.ws = (unsigned char*)d_ws;
    void* args[] = {&c};
    hipError_t e = hipLaunchCooperativeKernel((const void*)fwd_megakernel, dim3(grid), dim3(512), args, LDS_BYTES, stream);
    if (e != hipSuccess) fprintf(stderr, "cooperative launch failed: %s (grid %d)\n", hipGetErrorString(e), grid);
}
```

```cpp
#include <hip/hip_runtime.h>
#include <hip/hip_cooperative_groups.h>
#include <cstdio>
#include <cstdint>
namespace cg = cooperative_groups;

#define LAS __attribute__((address_space(3)))
typedef unsigned short bf16_t;
typedef short bf16x8 __attribute__((ext_vector_type(8)));
typedef float f32x4 __attribute__((ext_vector_type(4)));
typedef float f32x2 __attribute__((ext_vector_type(2)));
typedef unsigned u32x4 __attribute__((ext_vector_type(4)));
typedef unsigned u32x2 __attribute__((ext_vector_type(2)));

constexpr int D = 1024, SEQ = 16384, NSAMP = 256, M = SEQ + NSAMP, DFF = 4096, DPOOL = 512, DSSM = 512;
constexpr int NG = 32, NP = 64, NH = 16, TC = 16, NCH = M / TC  , NCHP = 1280, KY = 384;
constexpr int NMEM = 256, HD = 256, NHEAD = 4;
constexpr float EPS = 1e-6f;
constexpr float QSCALE = 0.0625f * 1.4426950408889634f;

constexpr size_t O_Y = 0, O_MK = (size_t)M * D, O_MV = O_MK + 262144, O_POOLP = O_MV + 262144, O_SREP = O_POOLP + 7680, O_SIMP = O_SREP + 2048,
                 O_POOLS = O_SIMP + 2048, O_SRES = O_POOLS + 122880, O_SIMS = O_SRES + 32768, O_END = O_SIMS + 32768;

constexpr size_t MiB = 1u << 20;
constexpr size_t WS_WIN = 0, WS_WOUT = 2 * MiB, WS_WQ = 4 * MiB, WS_WKV = 6 * MiB, WS_WO = 10 * MiB, WS_WUP = 12 * MiB, WS_WDOWN = 20 * MiB,
                 WS_WGLU = 28 * MiB, WS_WPOOL = 28 * MiB + 512 * 1024, WS_MN = 29 * MiB, WS_KB = 29 * MiB + 512 * 1024, WS_VT = 30 * MiB,
                 WS_AP = 30 * MiB + 512 * 1024,
                 WS_BB = WS_AP + 320 * 1024,
                 WS_KLAG = WS_BB + 256 * 1024,
                 WS_SS = WS_KLAG + 512 * 1024,
                 WS_BAR = 32 * MiB - 128 * 1024,
                 WS_WB = 32 * MiB,
                 WS_WY = 36 * MiB,
                 WS_E = 42 * MiB,
                 WS_UH = 62 * MiB,
                 WS_ZP = 92 * MiB,
                 WS_T0 = 109 * MiB, WS_T1 = 142 * MiB, WS_T2 = 175 * MiB, WS_SSP = 208 * MiB  , WS_END = 211 * MiB,
                 WS_U = 42 * MiB,
                 WS_SLAB = 175 * MiB;
static_assert(WS_SS + 3 * M * 4 <= WS_BAR, "misc region");
static_assert(WS_U + (size_t)M * DFF * 2 <= WS_T2, "U overlay");

__device__ __forceinline__ unsigned f2bf(float f) { unsigned u = __builtin_bit_cast(unsigned, f); return (u + 0x7fffu + ((u >> 16) & 1u)) >> 16; }
__device__ __forceinline__ unsigned pk2(float lo, float hi) { return f2bf(lo) | (f2bf(hi) << 16); }
__device__ __forceinline__ float bf2f(unsigned b) { return __builtin_bit_cast(float, b << 16); }
__device__ __forceinline__ unsigned cvt_pk_bf16(float lo, float hi) { unsigned r; asm volatile("v_cvt_pk_bf16_f32 %0, %1, %2" : "=v"(r) : "v"(lo), "v"(hi)); return r; }
#define LDS_WAIT() asm volatile("s_waitcnt lgkmcnt(0)" ::: "memory")
__device__ __forceinline__ int lane_id() { int l; asm volatile("v_mbcnt_lo_u32_b32 %0, -1, 0\n\tv_mbcnt_hi_u32_b32 %0, -1, %0" : "=v"(l)); return l; }
__device__ __forceinline__ int tidx(int wv) { return wv * 64 + lane_id(); }
__device__ __forceinline__ float shfl_x(float v, int lane, int mask) { return __builtin_bit_cast(float, __builtin_amdgcn_ds_bpermute((lane ^ mask) << 2, __builtin_bit_cast(int, v))); }

namespace pg8 {
constexpr int BM = 256, BK = 64, HALF = 128, HTB = HALF * BK * 2, STAGE_BYTES = 8 * HTB, NXCD = 8, WGM = 8;
__host__ __device__ __forceinline__ int lds_byte(int r, int c) { const int st = (r >> 4) * 2 + (c >> 5), rr = r & 15, cc = c & 31, ob = rr * 64 + cc * 2; return st * 1024 + (ob ^ (((ob >> 9) & 1) << 5)); }
__host__ __device__ __forceinline__ void stage_rc(int b, int& R, int& C) { const int st = b / 1024, sb = b % 1024, swz = sb ^ (((sb >> 9) & 1) << 5); R = (st >> 1) * 16 + swz / 64; C = (st & 1) * 32 + (swz % 64) / 2; }
__host__ __device__ __forceinline__ int perm32(int rho) { const int n = rho >> 4, i = rho & 15; return 8 * (i >> 2) + 4 * n + (i & 3); }

struct Unit { int pm, pn, z; };
struct Gemm { const char* A; const char* B; int lda, ldb; size_t sAz, sBz; int K; };
struct Order {
    int nM, nN, nZ, G, c;
    __device__ void init(int nM_, int nN_, int nZ_, int G_, int c_) { nM = nM_; nN = nN_; nZ = nZ_; G = G_; c = c_; }
    __device__ bool next(int i, Unit& u) const {
        const int per = nM * nN, nwg = per * nZ; const long L = (long)i * G + c; if (L >= nwg) return false;
        int wgid = (int)L; { const int q = nwg / NXCD, r = nwg % NXCD, xcd = wgid % NXCD, off = wgid / NXCD; wgid = (xcd < r ? xcd * (q + 1) : r * (q + 1) + (xcd - r) * q) + off; }
        u.z = wgid / per; const int l = wgid % per;
        const int nig = WGM * nN, gid = l / nig, fm = gid * WGM, gsz = (nM - fm) < WGM ? (nM - fm) : WGM;
        u.pm = fm + ((l % nig) % gsz); u.pn = (l % nig) / gsz; return true;
    }
};

template <class Epi>
__device__ __forceinline__ void gemm_phase(LAS unsigned char* lds, const Gemm g, const Order& S, Epi& E, int wv) {
    const int tid = tidx(wv), wid = __builtin_amdgcn_readfirstlane(tid >> 6), lane = tid & 63, wr = wid >> 2, wc = wid & 3, fr = lane & 15, fq = lane >> 4;
    const int nt = g.K / BK;
    unsigned voffA[2], voffB[2];
#pragma unroll
    for (int i = 0; i < 2; ++i) { int R, C; stage_rc(tid * 16 + i * 8192, R, C); const int Rb = Epi::PERM ? ((R & ~31) + perm32(R & 31)) : R;
        voffA[i] = (unsigned)(R * g.lda + C) * 2u; voffB[i] = (unsigned)(Rb * g.ldb + C) * 2u; }
    const size_t kstep = (size_t)(BK * 2);
    const size_t hA = (size_t)HALF * g.lda * 2, hB = (size_t)HALF * g.ldb * 2;
    const unsigned ldsw = (unsigned)wid * 1024u;
    const int aoff = lds_byte(wr * 64 + fr, fq * 8), boff = lds_byte(wc * 32 + fr, fq * 8);
#define PG8_SA(b, h) (((b) * 2 + (h)) * HTB)
#define PG8_SB(b, h) ((4 + (b) * 2 + (h)) * HTB)
#define PG8_STAGE(bufoff, gbase, voff) do { _Pragma("unroll") for (int _i = 0; _i < 2; ++_i) \
        __builtin_amdgcn_global_load_lds((const unsigned*)((const char*)(gbase) + (voff)[_i]), (LAS unsigned*)(lds + (bufoff) + ldsw + _i * 8192), 16, 0, 0); } while (0)
#define PG8_LDA(dst, b, h) do { _Pragma("unroll") for (int m = 0; m < 4; ++m) _Pragma("unroll") for (int k = 0; k < 2; ++k) dst[m][k] = *(const LAS bf16x8*)(lds + PG8_SA(b, h) + aoff + m * 2048 + k * 1024); } while (0)
#define PG8_LDB(dst, b, h) do { _Pragma("unroll") for (int n = 0; n < 2; ++n) _Pragma("unroll") for (int k = 0; k < 2; ++k) dst[n][k] = *(const LAS bf16x8*)(lds + PG8_SB(b, h) + boff + n * 2048 + k * 1024); } while (0)
#define PG8_MMA(ai, bj, At, Bt) do { __builtin_amdgcn_s_setprio(1); _Pragma("unroll") for (int m = 0; m < 4; ++m) _Pragma("unroll") for (int n = 0; n < 2; ++n) _Pragma("unroll") for (int k = 0; k < 2; ++k) \
        acc[ai][bj][m][n] = __builtin_amdgcn_mfma_f32_16x16x32_bf16(Bt[n][k], At[m][k], acc[ai][bj][m][n], 0, 0, 0); __builtin_amdgcn_s_setprio(0); } while (0)
#define PG8_WAIT_V(n) asm volatile("s_waitcnt vmcnt(" #n ")" ::: "memory")
#define PG8_WAIT_L(n) asm volatile("s_waitcnt lgkmcnt(" #n ")" ::: "memory")
#define PG8_BAR __builtin_amdgcn_s_barrier()
#define PG8_SCHED __builtin_amdgcn_sched_barrier(0)
    Unit cur, nxt; int ui = 0;
    if (!S.next(0, cur)) return;
    f32x4 acc[2][2][4][2];
#pragma unroll
    for (int a = 0; a < 2; ++a)
#pragma unroll
        for (int b = 0; b < 2; ++b)
#pragma unroll
            for (int m = 0; m < 4; ++m)
#pragma unroll
                for (int n = 0; n < 2; ++n) acc[a][b][m][n] = (f32x4){0.f, 0.f, 0.f, 0.f};
    bf16x8 At[4][2], B0[2][2], B1[2][2];
    const char* cA = g.A + (size_t)cur.z * g.sAz + (size_t)cur.pm * 2 * hA; const char* cB = g.B + (size_t)cur.z * g.sBz + (size_t)cur.pn * 2 * hB;
    PG8_STAGE(PG8_SB(0, 0), cB, voffB); PG8_STAGE(PG8_SB(0, 1), cB + hB, voffB); PG8_STAGE(PG8_SA(0, 0), cA, voffA); PG8_STAGE(PG8_SA(0, 1), cA + hA, voffA);
    if (wr == 1) PG8_BAR;
    PG8_WAIT_V(2); PG8_BAR;
    PG8_STAGE(PG8_SB(1, 0), cB + kstep, voffB); PG8_STAGE(PG8_SA(1, 0), cA + kstep, voffA); PG8_STAGE(PG8_SB(1, 1), cB + hB + kstep, voffB);
    PG8_WAIT_V(6); PG8_BAR;
    for (;;) {
        const bool has_next = S.next(ui + 1, nxt);
        const char* nA = has_next ? g.A + (size_t)nxt.z * g.sAz + (size_t)nxt.pm * 2 * hA : cA; const char* nB = has_next ? g.B + (size_t)nxt.z * g.sBz + (size_t)nxt.pn * 2 * hB : cB;
        for (int t = 0; t < nt; t += 2) {
            const bool last = (t == nt - 2);
            const char* a1 = cA + (size_t)(t + 1) * kstep;
            const char* a2 = last ? nA : cA + (size_t)(t + 2) * kstep; const char* b2 = last ? nB : cB + (size_t)(t + 2) * kstep;
            const char* a3 = a2 + kstep; const char* b3 = b2 + kstep;
            PG8_LDB(B0, 0, 0); PG8_LDB(B1, 0, 1); PG8_SCHED; PG8_LDA(At, 0, 0); PG8_STAGE(PG8_SA(1, 1), a1 + hA, voffA);
            PG8_WAIT_V(8); PG8_WAIT_L(0); PG8_BAR; PG8_MMA(0, 0, At, B0); PG8_MMA(0, 1, At, B1); PG8_BAR; PG8_SCHED;
            PG8_LDA(At, 0, 1); PG8_STAGE(PG8_SB(0, 0), b2, voffB); PG8_STAGE(PG8_SB(0, 1), b2 + hB, voffB); PG8_STAGE(PG8_SA(0, 0), a2, voffA);
            PG8_WAIT_V(8); PG8_WAIT_L(0); PG8_BAR; PG8_MMA(1, 0, At, B0); PG8_MMA(1, 1, At, B1); PG8_BAR; PG8_SCHED;
            PG8_LDB(B0, 1, 0); PG8_LDB(B1, 1, 1); PG8_SCHED; PG8_LDA(At, 1, 0); PG8_STAGE(PG8_SA(0, 1), a2 + hA, voffA);
            PG8_WAIT_V(8); PG8_WAIT_L(0); PG8_BAR; PG8_MMA(0, 0, At, B0); PG8_MMA(0, 1, At, B1); PG8_BAR; PG8_SCHED;
            PG8_LDA(At, 1, 1); PG8_STAGE(PG8_SB(1, 0), b3, voffB); PG8_STAGE(PG8_SB(1, 1), b3 + hB, voffB); PG8_STAGE(PG8_SA(1, 0), a3, voffA);
            PG8_WAIT_V(8); PG8_WAIT_L(0); PG8_BAR; PG8_MMA(1, 0, At, B0); PG8_MMA(1, 1, At, B1); PG8_BAR; PG8_SCHED;
        }
        if (wr == 0) PG8_BAR;
        { Unit ue = cur; const int le = lane_id(); int fre = le & 15, fqe = le >> 4;
          asm volatile("" : "+s"(ue.pm), "+s"(ue.pn), "+s"(ue.z));
          E(acc, ue, wr, wc, fre, fqe); }
        if (!has_next) break;
#pragma unroll
        for (int a = 0; a < 2; ++a)
#pragma unroll
            for (int b = 0; b < 2; ++b)
#pragma unroll
                for (int m = 0; m < 4; ++m)
#pragma unroll
                    for (int n = 0; n < 2; ++n) acc[a][b][m][n] = (f32x4){0.f, 0.f, 0.f, 0.f};
        cur = nxt; cA = nA; cB = nB; ++ui;
        if (wr == 1) PG8_BAR;
    }
    PG8_WAIT_V(0);
    PG8_BAR;
#undef PG8_SA
#undef PG8_SB
#undef PG8_STAGE
#undef PG8_LDA
#undef PG8_LDB
#undef PG8_MMA
#undef PG8_WAIT_V
#undef PG8_WAIT_L
#undef PG8_BAR
#undef PG8_SCHED
}
}
using pg8::Unit;
typedef f32x4 Acc[2][2][4][2];

#define EPI_ROWS(ai, m) (u.pm * 256 + (ai) * 128 + wr * 64 + (m) * 16 + fr)
__device__ __forceinline__ bool mfence() { asm volatile("" ::: "memory"); return true; }
#define FOR_AI_M _Pragma("unroll") for (int ai = 0; ai < 2; ++ai) _Pragma("unroll") for (int m = 0; m < 4; ++m) if (mfence())
#define FOR_BJ _Pragma("unroll") for (int bj = 0; bj < 2; ++bj)
__device__ __forceinline__ u32x4 pack8(const f32x4 v0, const f32x4 v1) { u32x4 w; w.x = cvt_pk_bf16(v0[0], v0[1]); w.y = cvt_pk_bf16(v0[2], v0[3]); w.z = cvt_pk_bf16(v1[0], v1[1]); w.w = cvt_pk_bf16(v1[2], v1[3]); return w; }

struct EpiZ {
    static constexpr bool PERM = true;
    bf16_t* ZP; bf16_t* UH; float* out;
    __device__ __forceinline__ void operator()(Acc& acc, const Unit& u, int wr, int wc, int fr, int fq) const {
        FOR_AI_M { const int row = EPI_ROWS(ai, m);
            FOR_BJ { const int col = u.pn * 256 + bj * 128 + wc * 32 + 8 * fq; const f32x4 v0 = acc[ai][bj][m][0], v1 = acc[ai][bj][m][1]; const u32x4 w = pack8(v0, v1);
                if (col < DPOOL) {
                    *(u32x4*)(ZP + (size_t)row * DPOOL + col) = w;
                    float* dst = nullptr;
                    if (row >= SEQ - 15 && row < SEQ) dst = out + O_POOLP + (size_t)(row - (SEQ - 15)) * DPOOL + col;
                    else if (row >= SEQ && ((row & 15) != 0)) dst = out + O_POOLS + ((size_t)((row - SEQ) >> 4) * 15 + ((row & 15) - 1)) * DPOOL + col;
                    if (dst) { *(f32x4*)dst = v0; *(f32x4*)(dst + 4) = v1; }
                } else {
                    const int cc = col - DPOOL, gg = cc >> 4, hh = cc & 15;
                    *(u32x4*)(UH + ((size_t)gg * NCHP + (row >> 4)) * KY + (row & 15) * 16 + hh) = w;
                } } }
    }
};
struct EpiKV {
    static constexpr bool PERM = false;
    float* out; bf16_t* KB; bf16_t* VT;
    __device__ __forceinline__ void operator()(Acc& acc, const Unit& u, int wr, int wc, int fr, int fq) const {
        FOR_AI_M { const int row = EPI_ROWS(ai, m);
            FOR_BJ {
#pragma unroll
                for (int n = 0; n < 2; ++n) { const int col = u.pn * 256 + bj * 128 + wc * 32 + 16 * n + 4 * fq; const f32x4 v = acc[ai][bj][m][n];
                    if (col < D) { *(f32x4*)(out + O_MK + (size_t)row * D + col) = v; u32x2 w; w.x = cvt_pk_bf16(v[0], v[1]); w.y = cvt_pk_bf16(v[2], v[3]); *(u32x2*)(KB + (size_t)row * D + col) = w; }
                    else { const int c2 = col - D; *(f32x4*)(out + O_MV + (size_t)row * D + c2) = v; } } }
            asm volatile("" ::: "memory"); }
    }
};
struct EpiE {
    static constexpr bool PERM = false;
    float* E;
    __device__ __forceinline__ void operator()(Acc& acc, const Unit& u, int wr, int wc, int fr, int fq) const {
        FOR_AI_M { const int row = EPI_ROWS(ai, m);
#pragma unroll
            for (int n = 0; n < 2; ++n) { const int col = wc * 32 + 16 * n + 4 * fq; *(f32x4*)(E + ((size_t)u.z * NCHP + row) * 128 + col) = acc[ai][0][m][n]; } }
    }
};
__device__ __forceinline__ float gelu_tanh(float x) {
    const float t = 0.7978845608028654f * (x + 0.044715f * x * x * x);
    const float e = __expf(-2.f * t);
    return x / (1.f + e);
}
struct EpiY {
    static constexpr bool PERM = true;
    bf16_t* MIX;
    __device__ __forceinline__ void operator()(Acc& acc, const Unit& u, int wr, int wc, int fr, int fq) const {
        FOR_AI_M { const int ch = EPI_ROWS(ai, m); if (ch < NCH) {
            FOR_BJ { const int col = bj * 128 + wc * 32 + 8 * fq, t = col >> 4, hh = col & 15; f32x4 v0 = acc[ai][bj][m][0], v1 = acc[ai][bj][m][1];
#pragma unroll
                for (int j = 0; j < 4; ++j) { v0[j] = gelu_tanh(v0[j]); v1[j] = gelu_tanh(v1[j]); }
                *(u32x4*)(MIX + (size_t)(ch * 16 + t) * D + DPOOL + u.z * 16 + hh) = pack8(v0, v1); } } }
    }
};
struct EpiPool {
    static constexpr bool PERM = true;
    bf16_t* CAT; const float* scale;
    __device__ __forceinline__ void operator()(Acc& acc, const Unit& u, int wr, int wc, int fr, int fq) const {
        FOR_BJ { const int col = u.pn * 256 + bj * 128 + wc * 32 + 8 * fq; const f32x4 s0 = *(const f32x4*)(scale + col), s1 = *(const f32x4*)(scale + col + 4);
            FOR_AI_M { const int row = EPI_ROWS(ai, m); *(u32x4*)(CAT + (size_t)row * D + col) = pack8(acc[ai][bj][m][0] * s0, acc[ai][bj][m][1] * s1); } }
    }
};
struct EpiGlu {
    static constexpr bool PERM = true;
    bf16_t* CAT; const bf16_t* MIX; const float* bias;
    __device__ __forceinline__ void operator()(Acc& acc, const Unit& u, int wr, int wc, int fr, int fq) const {
        FOR_BJ { const int col = u.pn * 256 + bj * 128 + wc * 32 + 8 * fq; const f32x4 b0 = *(const f32x4*)(bias + col), b1 = *(const f32x4*)(bias + col + 4);
            FOR_AI_M { const int row = EPI_ROWS(ai, m); const u32x4 yv = *(const u32x4*)(MIX + (size_t)row * D + DPOOL + col);
                f32x4 v0 = acc[ai][bj][m][0] + b0, v1 = acc[ai][bj][m][1] + b1; const unsigned yw[4] = {yv.x, yv.y, yv.z, yv.w};
#pragma unroll
                for (int j = 0; j < 4; ++j) { const float ya = bf2f(yw[j >> 1] >> ((j & 1) * 16) & 0xffffu), yb = bf2f(yw[2 + (j >> 1)] >> ((j & 1) * 16) & 0xffffu);
                    v0[j] = ya / (1.f + __expf(-v0[j])); v1[j] = yb / (1.f + __expf(-v1[j])); }
                *(u32x4*)(CAT + (size_t)row * D + DPOOL + col) = pack8(v0, v1); } }
    }
};
struct EpiRes {
    static constexpr bool PERM = false;
    const float* baseP; const float* baseS; float* out; bf16_t* Xb; float* SS;
    __device__ __forceinline__ void operator()(Acc& acc, const Unit& u, int wr, int wc, int fr, int fq) const {
        FOR_AI_M { const int row = EPI_ROWS(ai, m); const float* brow = (row < SEQ) ? baseP + (size_t)row * D : baseS + (size_t)(row - SEQ) * D; float ssq = 0.f;
            FOR_BJ {
#pragma unroll
                for (int n = 0; n < 2; ++n) { const int col = u.pn * 256 + bj * 128 + wc * 32 + 16 * n + 4 * fq; const f32x4 v = acc[ai][bj][m][n] + *(const f32x4*)(brow + col);
                    *(f32x4*)(out + (size_t)row * D + col) = v; ssq += (v[0] * v[0] + v[1] * v[1]) + (v[2] * v[2] + v[3] * v[3]);
                    if (Xb) { u32x2 w; w.x = cvt_pk_bf16(v[0], v[1]); w.y = cvt_pk_bf16(v[2], v[3]); *(u32x2*)(Xb + (size_t)row * D + col) = w; } } }
            ssq += shfl_x(ssq, fr + 16 * fq, 16); ssq += shfl_x(ssq, fr + 16 * fq, 32);
            if (SS && fq == 0) SS[(size_t)row * 16 + u.pn * 4 + wc] = ssq; }
    }
};
__device__ __forceinline__ float row_rstd(const float* SS, int row) { const f32x4* p = (const f32x4*)(SS + (size_t)row * 16); const f32x4 a = p[0], b = p[1], c = p[2], d = p[3];
    const float t = ((a[0] + a[1]) + (a[2] + a[3])) + ((b[0] + b[1]) + (b[2] + b[3])) + ((c[0] + c[1]) + (c[2] + c[3])) + ((d[0] + d[1]) + (d[2] + d[3])); return rsqrtf(t * (1.f / D) + EPS); }
struct EpiQ {
    static constexpr bool PERM = true;
    bf16_t* Q; const float* SS;
    __device__ __forceinline__ void operator()(Acc& acc, const Unit& u, int wr, int wc, int fr, int fq) const {
        FOR_AI_M { const int row = EPI_ROWS(ai, m); const float rs = row_rstd(SS, row) * QSCALE;
            FOR_BJ { const int col = u.pn * 256 + bj * 128 + wc * 32 + 8 * fq; *(u32x4*)(Q + (size_t)row * D + col) = pack8(acc[ai][bj][m][0] * rs, acc[ai][bj][m][1] * rs); } }
    }
};
struct EpiSoftmax {
    static constexpr bool PERM = true;
    bf16_t* P; LAS float* tmax; LAS float* tsum;
    __device__ __forceinline__ void operator()(Acc& acc, const Unit& u, int wr, int wc, int fr, int fq) const {
        FOR_AI_M { float mx = -3.0e38f;
            FOR_BJ {
#pragma unroll
                for (int n = 0; n < 2; ++n) { const f32x4 v = acc[ai][bj][m][n]; mx = fmaxf(mx, fmaxf(fmaxf(v[0], v[1]), fmaxf(v[2], v[3]))); } }
            mx = fmaxf(mx, shfl_x(mx, fr + 16 * fq, 16)); mx = fmaxf(mx, shfl_x(mx, fr + 16 * fq, 32));
            if (fq == 0) tmax[(ai * 128 + wr * 64 + m * 16 + fr) * 4 + wc] = mx; }
        LDS_WAIT(); __builtin_amdgcn_s_barrier(); asm volatile("" ::: "memory");
        FOR_AI_M { const int r = ai * 128 + wr * 64 + m * 16 + fr; const f32x4 t = *(const LAS f32x4*)(tmax + r * 4); const float mx = fmaxf(fmaxf(t[0], t[1]), fmaxf(t[2], t[3])); float s = 0.f;
            FOR_BJ {
#pragma unroll
                for (int n = 0; n < 2; ++n) { f32x4 v = acc[ai][bj][m][n];
#pragma unroll
                    for (int j = 0; j < 4; ++j) { v[j] = __builtin_amdgcn_exp2f(v[j] - mx); s += v[j]; }
                    acc[ai][bj][m][n] = v; } }
            s += shfl_x(s, fr + 16 * fq, 16); s += shfl_x(s, fr + 16 * fq, 32);
            if (fq == 0) tsum[r * 4 + wc] = s; }
        LDS_WAIT(); __builtin_amdgcn_s_barrier(); asm volatile("" ::: "memory");
        FOR_AI_M { const int r = ai * 128 + wr * 64 + m * 16 + fr, row = u.pm * 256 + r; const f32x4 t = *(const LAS f32x4*)(tsum + r * 4); const float inv = 1.f / ((t[0] + t[1]) + (t[2] + t[3]));
            FOR_BJ { const int col = u.z * 256 + bj * 128 + wc * 32 + 8 * fq; *(u32x4*)(P + (size_t)row * D + col) = pack8(acc[ai][bj][m][0] * inv, acc[ai][bj][m][1] * inv); } }
    }
};
struct EpiO {
    static constexpr bool PERM = true;
    bf16_t* O;
    __device__ __forceinline__ void operator()(Acc& acc, const Unit& u, int wr, int wc, int fr, int fq) const {
        FOR_AI_M { const int row = EPI_ROWS(ai, m);
            FOR_BJ { const int col = u.z * 256 + bj * 128 + wc * 32 + 8 * fq; *(u32x4*)(O + (size_t)row * D + col) = pack8(acc[ai][bj][m][0], acc[ai][bj][m][1]); } }
    }
};
struct EpiUp {
    static constexpr bool PERM = true;
    bf16_t* U; const float* SS;
    __device__ __forceinline__ void operator()(Acc& acc, const Unit& u, int wr, int wc, int fr, int fq) const {
        FOR_AI_M { const int row = EPI_ROWS(ai, m); const float rs = row_rstd(SS, row);
            FOR_BJ { const int col = u.pn * 256 + bj * 128 + wc * 32 + 8 * fq; f32x4 v0 = acc[ai][bj][m][0] * rs, v1 = acc[ai][bj][m][1] * rs;
#pragma unroll
                for (int j = 0; j < 4; ++j) { const float a = fmaxf(v0[j], 0.f), b = fmaxf(v1[j], 0.f); v0[j] = a * a; v1[j] = b * b; }
                *(u32x4*)(U + (size_t)row * DFF + col) = pack8(v0, v1); } }
    }
};

struct Ctx {
    const float* in[33]; float* out; unsigned char* ws;
};
__device__ __forceinline__ float wave_sum(float v, int lane) {
#pragma unroll
    for (int o = 1; o < 64; o <<= 1) v += shfl_x(v, lane, o);
    return v;
}
__device__ __forceinline__ float wave_max(float v, int lane) {
#pragma unroll
    for (int o = 1; o < 64; o <<= 1) v = fmaxf(v, shfl_x(v, lane, o));
    return v;
}
__device__ __forceinline__ void transpose_item(const float* W, int ldw, int nblk, bf16_t* WT, int ldt, int row_off, int col_off, const float* ksc, LAS float* scr, int item, int lane) {
    const int kb = item / nblk, nb = item % nblk, k0 = 64 * kb, n0 = 32 * nb;
#pragma unroll
    for (int i = 0; i < 32; ++i) { const int kk = 2 * i + (lane >> 5); float v = W[(size_t)(k0 + kk) * ldw + n0 + (lane & 31)]; if (ksc) v *= ksc[k0 + kk]; scr[kk * 33 + (lane & 31)] = v; }
    LDS_WAIT(); asm volatile("" ::: "memory");
    const int c = lane & 7;
#pragma unroll
    for (int j = 0; j < 4; ++j) { const int n = (lane >> 3) + 8 * j; const LAS float* s = scr + (8 * c) * 33 + n;
        u32x4 o; o.x = pk2(s[0 * 33], s[1 * 33]); o.y = pk2(s[2 * 33], s[3 * 33]); o.z = pk2(s[4 * 33], s[5 * 33]); o.w = pk2(s[6 * 33], s[7 * 33]);
        *(u32x4*)(WT + (size_t)(row_off + n0 + n) * ldt + col_off + k0 + 8 * c) = o; }
    LDS_WAIT(); asm volatile("" ::: "memory");
}
__device__ __forceinline__ void rms_row_to_bf16(const float* xrow, const float* g, bf16_t* orow, int lane) {
    const f32x4* xr = (const f32x4*)xrow + lane; const f32x4* gr = (const f32x4*)g + lane;
    f32x4 v[4]; float s = 0.f;
#pragma unroll
    for (int j = 0; j < 4; ++j) { v[j] = xr[64 * j]; s += (v[j].x * v[j].x + v[j].y * v[j].y) + (v[j].z * v[j].z + v[j].w * v[j].w); }
    const float rs = rsqrtf(wave_sum(s, lane) * (1.f / D) + EPS);
    u32x2* o8 = (u32x2*)orow + lane;
#pragma unroll
    for (int j = 0; j < 4; ++j) { const f32x4 gg = gr[64 * j]; u32x2 w; w.x = pk2(v[j].x * rs * gg.x, v[j].y * rs * gg.y); w.y = pk2(v[j].z * rs * gg.z, v[j].w * rs * gg.w); o8[64 * j] = w; }
}

__device__ __forceinline__ void p0_prologue(const Ctx& C, LAS unsigned char* lds, int G, int bid, int wv) {
    const int tid = tidx(wv), lane = tid & 63, wave = tid >> 6;
    LAS float* scr = (LAS float*)(lds + wave * 16384);
    const int gw = bid * 8 + wave, NGW = G * 8;
    unsigned char* ws = C.ws;
    constexpr int I_SQ = 16 * 32, I_UP = 16 * 128, I_DN = 64 * 32, I_GLU = 8 * 16, I_PL = 4 * 2 * 4;
    constexpr int NIT = 6 * I_SQ + I_UP + I_DN + I_GLU + I_PL;
    for (int it = gw; it < NIT; it += NGW) {
        int r = it;
        if (r < I_SQ) { transpose_item(C.in[9], D, 32, (bf16_t*)(ws + WS_WIN), D, 0, 0, nullptr, scr, r, lane); continue; } r -= I_SQ;
        if (r < I_SQ) { transpose_item(C.in[22], D, 32, (bf16_t*)(ws + WS_WOUT), D, 0, 0, nullptr, scr, r, lane); continue; } r -= I_SQ;
        if (r < I_SQ) { transpose_item(C.in[25], D, 32, (bf16_t*)(ws + WS_WQ), D, 0, 0, C.in[23], scr, r, lane); continue; } r -= I_SQ;
        if (r < I_SQ) { transpose_item(C.in[26], D, 32, (bf16_t*)(ws + WS_WKV), D, 0, 0, nullptr, scr, r, lane); continue; } r -= I_SQ;
        if (r < I_SQ) { transpose_item(C.in[27], D, 32, (bf16_t*)(ws + WS_WKV), D, D, 0, nullptr, scr, r, lane); continue; } r -= I_SQ;
        if (r < I_SQ) { transpose_item(C.in[28], D, 32, (bf16_t*)(ws + WS_WO), D, 0, 0, nullptr, scr, r, lane); continue; } r -= I_SQ;
        if (r < I_UP) { transpose_item(C.in[30], DFF, 128, (bf16_t*)(ws + WS_WUP), D, 0, 0, C.in[29], scr, r, lane); continue; } r -= I_UP;
        if (r < I_DN) { transpose_item(C.in[31], D, 32, (bf16_t*)(ws + WS_WDOWN), DFF, 0, 0, nullptr, scr, r, lane); continue; } r -= I_DN;
        if (r < I_GLU) { transpose_item(C.in[20], DSSM, 16, (bf16_t*)(ws + WS_WGLU), DSSM, 0, 0, nullptr, scr, r, lane); continue; } r -= I_GLU;
        { const int gp = r / 8, rr = r % 8; transpose_item(C.in[10] + (size_t)gp * 128 * 128, 128, 4, (bf16_t*)(ws + WS_WPOOL), DPOOL, gp * 128, gp * 128, nullptr, scr, rr, lane); }
    }
    const int gt = bid * 512 + tid, NGT = G * 512;
    { bf16_t* WP = (bf16_t*)(ws + WS_WPOOL);
      for (int i = gt; i < 512 * 512 / 8; i += NGT) { const int n = i / 64, k = (i % 64) * 8; if ((n >> 7) != (k >> 7)) *(u32x4*)(WP + (size_t)n * DPOOL + k) = (u32x4){0u, 0u, 0u, 0u}; }
    }
    { bf16_t* H1 = (bf16_t*)(ws + WS_T0); bf16_t* MN = (bf16_t*)(ws + WS_MN);
      for (int m = gw; m < M + NMEM; m += NGW) {
          if (m < SEQ) rms_row_to_bf16(C.in[0] + (size_t)m * D, C.in[8], H1 + (size_t)m * D, lane);
          else if (m < M) rms_row_to_bf16(C.in[1] + (size_t)(m - SEQ) * D, C.in[8], H1 + (size_t)m * D, lane);
          else rms_row_to_bf16(C.in[7] + (size_t)(m - M) * D, C.in[24], MN + (size_t)(m - M) * D, lane); } }
    { float* AP = (float*)(ws + WS_AP); float* BB = (float*)(ws + WS_BB);
      for (int i = gt; i < NG * NP; i += NGT) { const int g = i / NP, p = i % NP;
          const float are = C.in[12][i], aim = C.in[13][i], dt = expf(C.in[19][g]);
          const float mag = expf(are * dt); float sn, cs; sincosf(aim * dt, &sn, &cs);
          const float abr = mag * cs, abi = mag * sn;
          float pr = 1.f, pi = 0.f;
          for (int k = 0; k <= 16; ++k) { AP[((size_t)(g * 17 + k) * NP + p) * 2] = pr; AP[((size_t)(g * 17 + k) * NP + p) * 2 + 1] = pi; const float nr = pr * abr - pi * abi, ni = pr * abi + pi * abr; pr = nr; pi = ni; }
          const float nr = abr - 1.f, ni = abi, den = are * are + aim * aim; const float cr = (nr * are + ni * aim) / den, ci = (ni * are - nr * aim) / den;
          for (int h = 0; h < NH; ++h) { const float br = C.in[14][(size_t)i * NH + h], bi = C.in[15][(size_t)i * NH + h];
              BB[((size_t)i * NH + h) * 2] = cr * br - ci * bi; BB[((size_t)i * NH + h) * 2 + 1] = cr * bi + ci * br; } } }
}
__device__ __forceinline__ void p1_pre(const Ctx& C, int G, int bid, int wv) {
    const int gt = bid * 512 + tidx(wv), NGT = G * 512; unsigned char* ws = C.ws;
    const float* AP = (const float*)(ws + WS_AP); const float* BB = (const float*)(ws + WS_BB); float* KL = (float*)(ws + WS_KLAG); bf16_t* WB = (bf16_t*)(ws + WS_WB);
    for (int i = gt; i < NG * 16 * 16 * 16; i += NGT) { const int hp = i & 15, h = (i >> 4) & 15, k = (i >> 8) & 15, g = i >> 12; float s = 0.f;
        const f32x4* crp = (const f32x4*)(C.in[16] + ((size_t)g * NH + h) * NP); const f32x4* cip = (const f32x4*)(C.in[17] + ((size_t)g * NH + h) * NP);
        const f32x4* app = (const f32x4*)(AP + (size_t)(g * 17 + k) * NP * 2); const f32x2* bbp = (const f32x2*)(BB + ((size_t)g * NP * NH + hp) * 2);
#pragma unroll 4
        for (int p4 = 0; p4 < NP / 4; ++p4) { const f32x4 cr = crp[p4], ci = cip[p4], a0 = app[2 * p4], a1 = app[2 * p4 + 1];
            const f32x2 b0 = bbp[(4 * p4 + 0) * NH], b1 = bbp[(4 * p4 + 1) * NH], b2 = bbp[(4 * p4 + 2) * NH], b3 = bbp[(4 * p4 + 3) * NH];
            s += cr[0] * (a0[0] * b0.x - a0[1] * b0.y) - ci[0] * (a0[0] * b0.y + a0[1] * b0.x);
            s += cr[1] * (a0[2] * b1.x - a0[3] * b1.y) - ci[1] * (a0[2] * b1.y + a0[3] * b1.x);
            s += cr[2] * (a1[0] * b2.x - a1[1] * b2.y) - ci[2] * (a1[0] * b2.y + a1[1] * b2.x);
            s += cr[3] * (a1[2] * b3.x - a1[3] * b3.y) - ci[3] * (a1[2] * b3.y + a1[3] * b3.x); }
        if (k == 0 && h == hp) s += C.in[18][g * NH + h];
        KL[i] = s; }
    for (int it = gt; it < NG * 256 * 32; it += NGT) { const int k8 = it & 31, n = (it >> 5) & 255, g = it >> 13; u32x4 o = {0u, 0u, 0u, 0u};
        if (n < 128) { const int p = n & 63, sidx = k8 >> 1, hp0 = (k8 & 1) * 8; const f32x2 a = *(const f32x2*)(AP + ((size_t)(g * 17 + 15 - sidx) * NP + p) * 2);
            const f32x4* bb = (const f32x4*)(BB + ((size_t)(g * NP + p) * NH + hp0) * 2); const f32x4 q0 = bb[0], q1 = bb[1], q2 = bb[2], q3 = bb[3];
            float v[8];
            if (n < 64) { v[0] = a.x * q0[0] - a.y * q0[1]; v[1] = a.x * q0[2] - a.y * q0[3]; v[2] = a.x * q1[0] - a.y * q1[1]; v[3] = a.x * q1[2] - a.y * q1[3];
                          v[4] = a.x * q2[0] - a.y * q2[1]; v[5] = a.x * q2[2] - a.y * q2[3]; v[6] = a.x * q3[0] - a.y * q3[1]; v[7] = a.x * q3[2] - a.y * q3[3]; }
            else {        v[0] = a.x * q0[1] + a.y * q0[0]; v[1] = a.x * q0[3] + a.y * q0[2]; v[2] = a.x * q1[1] + a.y * q1[0]; v[3] = a.x * q1[3] + a.y * q1[2];
                          v[4] = a.x * q2[1] + a.y * q2[0]; v[5] = a.x * q2[3] + a.y * q2[2]; v[6] = a.x * q3[1] + a.y * q3[0]; v[7] = a.x * q3[3] + a.y * q3[2]; }
            o.x = pk2(v[0], v[1]); o.y = pk2(v[2], v[3]); o.z = pk2(v[4], v[5]); o.w = pk2(v[6], v[7]); }
        *(u32x4*)(WB + (size_t)it * 8) = o; }
}
__device__ __forceinline__ void p2a_pre(const Ctx& C, int G, int bid, int wv) {
    const int gt = bid * 512 + tidx(wv), NGT = G * 512; unsigned char* ws = C.ws;
    const float* AP = (const float*)(ws + WS_AP); const float* KL = (const float*)(ws + WS_KLAG); bf16_t* WY = (bf16_t*)(ws + WS_WY);
    for (int it = gt; it < NG * 256 * (KY / 8); it += NGT) { const int k8 = it % (KY / 8), n = (it / (KY / 8)) & 255, g = it / ((KY / 8) * 256), t = n >> 4, h = n & 15, k0 = k8 * 8; float v[8];
        if (k0 < 256) { const int sidx = k0 >> 4, hp0 = k0 & 15; f32x4 q0 = {0.f, 0.f, 0.f, 0.f}, q1 = q0;
            if (sidx <= t) { const f32x4* kp = (const f32x4*)(KL + (((size_t)g * 16 + (t - sidx)) * 16 + h) * 16 + hp0); q0 = kp[0]; q1 = kp[1]; }
            v[0] = q0[0]; v[1] = q0[1]; v[2] = q0[2]; v[3] = q0[3]; v[4] = q1[0]; v[5] = q1[1]; v[6] = q1[2]; v[7] = q1[3]; }
        else { const int p0 = (k0 - 256) & 63; const f32x4* crp = (const f32x4*)(C.in[16] + ((size_t)g * NH + h) * NP + p0); const f32x4* cip = (const f32x4*)(C.in[17] + ((size_t)g * NH + h) * NP + p0);
            const f32x4* app = (const f32x4*)(AP + ((size_t)(g * 17 + t + 1) * NP + p0) * 2);
            const f32x4 cr0 = crp[0], cr1 = crp[1], ci0 = cip[0], ci1 = cip[1], a0 = app[0], a1 = app[1], a2 = app[2], a3 = app[3];
            const float cr[8] = {cr0[0], cr0[1], cr0[2], cr0[3], cr1[0], cr1[1], cr1[2], cr1[3]}, ci[8] = {ci0[0], ci0[1], ci0[2], ci0[3], ci1[0], ci1[1], ci1[2], ci1[3]};
            const float ar[8] = {a0[0], a0[2], a1[0], a1[2], a2[0], a2[2], a3[0], a3[2]}, ai[8] = {a0[1], a0[3], a1[1], a1[3], a2[1], a2[3], a3[1], a3[3]};
#pragma unroll
            for (int e = 0; e < 8; ++e) v[e] = (k0 < 320) ? (cr[e] * ar[e] - ci[e] * ai[e]) : -(cr[e] * ai[e] + ci[e] * ar[e]); }
        u32x4 o; o.x = pk2(v[0], v[1]); o.y = pk2(v[2], v[3]); o.z = pk2(v[4], v[5]); o.w = pk2(v[6], v[7]);
        *(u32x4*)(WY + (size_t)it * 8) = o; }
}
__device__ __forceinline__ void p2b_prefix(const Ctx& C, LAS unsigned char* lds, int g, int wv) {
    const int p = lane_id(); unsigned char* ws = C.ws;
    const float* AP = (const float*)(ws + WS_AP); const float* E = (const float*)(ws + WS_E) + (size_t)g * NCHP * 128; bf16_t* UH = (bf16_t*)(ws + WS_UH) + (size_t)g * NCHP * KY;
    LAS float* L = (LAS float*)lds;
    const float ar = AP[((size_t)(g * 17 + 16) * NP + p) * 2], ai = AP[((size_t)(g * 17 + 16) * NP + p) * 2 + 1];
    float hr[4] = {0.f, 0.f, 0.f, 0.f}, hi[4] = {0.f, 0.f, 0.f, 0.f};
    for (int cc = 0; cc < 32; cc += 8) { float er[4][8], ei[4][8];
#pragma unroll
        for (int ch = 0; ch < 4; ++ch)
#pragma unroll
            for (int j = 0; j < 8; ++j) { const size_t c = (size_t)((wv * 4 + ch) * 32 + cc + j); er[ch][j] = E[c * 128 + p]; ei[ch][j] = E[c * 128 + 64 + p]; }
#pragma unroll
        for (int j = 0; j < 8; ++j)
#pragma unroll
            for (int ch = 0; ch < 4; ++ch) { const float nr = ar * hr[ch] - ai * hi[ch] + er[ch][j], ni = ar * hi[ch] + ai * hr[ch] + ei[ch][j]; hr[ch] = nr; hi[ch] = ni; } }
#pragma unroll
    for (int ch = 0; ch < 4; ++ch) { L[((wv * 4 + ch) * 64 + p) * 2] = hr[ch]; L[((wv * 4 + ch) * 64 + p) * 2 + 1] = hi[ch]; }
    float sr = ar, si = ai;
#pragma unroll
    for (int j = 0; j < 5; ++j) { const float nr = sr * sr - si * si, ni = 2.f * sr * si; sr = nr; si = ni; }
    __syncthreads();
    float Hr = 0.f, Hi = 0.f;
    for (int j = 0; j < wv * 4; ++j) { const float lr = L[(j * 64 + p) * 2], li = L[(j * 64 + p) * 2 + 1]; const float nr = sr * Hr - si * Hi + lr, ni = sr * Hi + si * Hr + li; Hr = nr; Hi = ni; }
#pragma unroll
    for (int ch = 0; ch < 4; ++ch) { hr[ch] = Hr; hi[ch] = Hi; const float lr = L[((wv * 4 + ch) * 64 + p) * 2], li = L[((wv * 4 + ch) * 64 + p) * 2 + 1];
        const float nr = sr * Hr - si * Hi + lr, ni = sr * Hi + si * Hr + li; Hr = nr; Hi = ni; }
    if (wv == 7) { C.out[O_SREP + g * NP + p] = Hr; C.out[O_SIMP + g * NP + p] = Hi; }
    for (int cc = 0; cc < 32; cc += 8) { float er[4][8], ei[4][8];
#pragma unroll
        for (int ch = 0; ch < 4; ++ch)
#pragma unroll
            for (int j = 0; j < 8; ++j) { const size_t c = (size_t)((wv * 4 + ch) * 32 + cc + j); er[ch][j] = E[c * 128 + p]; ei[ch][j] = E[c * 128 + 64 + p]; }
#pragma unroll
        for (int j = 0; j < 8; ++j)
#pragma unroll
            for (int ch = 0; ch < 4; ++ch) { const size_t c = (size_t)((wv * 4 + ch) * 32 + cc + j);
                UH[c * KY + 256 + p] = (bf16_t)f2bf(hr[ch]); UH[c * KY + 320 + p] = (bf16_t)f2bf(hi[ch]);
                const float nr = ar * hr[ch] - ai * hi[ch] + er[ch][j], ni = ar * hi[ch] + ai * hr[ch] + ei[ch][j]; hr[ch] = nr; hi[ch] = ni; } }
    for (int b = wv; b < 16; b += 8) { const float h0r = C.in[5][((size_t)b * NG + g) * NP + p], h0i = C.in[6][((size_t)b * NG + g) * NP + p]; const int c = 1024 + b;
        UH[(size_t)c * KY + 256 + p] = (bf16_t)f2bf(h0r); UH[(size_t)c * KY + 320 + p] = (bf16_t)f2bf(h0i);
        C.out[O_SRES + ((size_t)b * NG + g) * NP + p] = ar * h0r - ai * h0i + E[(size_t)c * 128 + p];
        C.out[O_SIMS + ((size_t)b * NG + g) * NP + p] = ar * h0i + ai * h0r + E[(size_t)c * 128 + 64 + p]; }
    __syncthreads();
}
__device__ __forceinline__ void unpack8(const u32x4 q, float* v) { const unsigned qq[4] = {q.x, q.y, q.z, q.w};
#pragma unroll
    for (int e = 0; e < 8; ++e) v[e] = bf2f((qq[e >> 1] >> ((e & 1) * 16)) & 0xffffu); }
__device__ __forceinline__ void p2b_pool(const Ctx& C, int worker, int nworkers, int wv) {
    const int cl = lane_id() * 8; unsigned char* ws = C.ws;
    const bf16_t* ZP = (const bf16_t*)(ws + WS_ZP); bf16_t* MIX = (bf16_t*)(ws + WS_T1);
    const int w = 2 << (cl >> 7);
    for (int blk = worker * 8 + wv; blk < M / 8; blk += nworkers * 8) { const int r0 = blk * 8;
        if (r0 < SEQ) {
#pragma unroll 2
            for (int t = 0; t < 8; ++t) { const int row = r0 + t; u32x4 q[16];
#pragma unroll
                for (int j = 0; j < 16; ++j) { const int rr = row - j; q[j] = *(const u32x4*)(ZP + (size_t)(rr < 0 ? 0 : rr) * DPOOL + cl); }
                float s[8], cur[8]; unpack8(q[0], cur);
#pragma unroll
                for (int e = 0; e < 8; ++e) s[e] = cur[e];
#pragma unroll
                for (int j = 1; j < 16; ++j) { float v[8]; unpack8(q[j], v); const float mk = (j < w && row - j >= 0) ? 1.f : 0.f;
#pragma unroll
                    for (int e = 0; e < 8; ++e) s[e] += mk * v[e]; }
                const int cnt = (row + 1 < w) ? row + 1 : w; const float inv = 1.f / (float)cnt;
                u32x4 o; o.x = pk2(s[0] * inv - cur[0], s[1] * inv - cur[1]); o.y = pk2(s[2] * inv - cur[2], s[3] * inv - cur[3]); o.z = pk2(s[4] * inv - cur[4], s[5] * inv - cur[5]); o.w = pk2(s[6] * inv - cur[6], s[7] * inv - cur[7]);
                *(u32x4*)(MIX + (size_t)row * D + cl) = o; }
        } else { const int b = (r0 - SEQ) >> 4, t0 = r0 & 15;
            for (int tt = 0; tt < 8; ++tt) { const int t = t0 + tt, row = r0 + tt; float s[8] = {0.f, 0.f, 0.f, 0.f, 0.f, 0.f, 0.f, 0.f}; float cur[8];
                for (int j = 0; j < w; ++j) { float v[8];
                    if (t - j >= 0) unpack8(*(const u32x4*)(ZP + (size_t)(row - j) * DPOOL + cl), v);
                    else { const float* hp = C.in[4] + ((size_t)b * 15 + (15 + t - j)) * DPOOL + cl; const f32x4 a = *(const f32x4*)hp, bb = *(const f32x4*)(hp + 4);
                        v[0] = a[0]; v[1] = a[1]; v[2] = a[2]; v[3] = a[3]; v[4] = bb[0]; v[5] = bb[1]; v[6] = bb[2]; v[7] = bb[3]; }
#pragma unroll
                    for (int e = 0; e < 8; ++e) { s[e] += v[e]; if (j == 0) cur[e] = v[e]; } }
                const float inv = 1.f / (float)w;
                u32x4 o; o.x = pk2(s[0] * inv - cur[0], s[1] * inv - cur[1]); o.y = pk2(s[2] * inv - cur[2], s[3] * inv - cur[3]); o.z = pk2(s[4] * inv - cur[4], s[5] * inv - cur[5]); o.w = pk2(s[6] * inv - cur[6], s[7] * inv - cur[7]);
                *(u32x4*)(MIX + (size_t)row * D + cl) = o; } } }
}
__device__ __forceinline__ void sample_attn_item(const Ctx& C, LAS unsigned char* lds, int item, int wv) {
    const int lane = lane_id(), fr = lane & 15, fq = lane >> 4; const int b = item >> 4, h = (item >> 2) & 3, dq = item & 3; unsigned char* ws = C.ws;
    const bf16_t* Q = (const bf16_t*)(ws + WS_T1); bf16_t* O = (bf16_t*)(ws + WS_T0);
    const float* Kc = C.in[2] + (size_t)b * NMEM * D + h * HD; const float* Vc = C.in[3] + (size_t)b * NMEM * D + h * HD + dq * 64;
    LAS float* Sl = (LAS float*)lds;
    LAS float* PT = (LAS float*)(lds + 16384);
    LAS float* red = (LAS float*)(lds + 32768);
    float vv[32];
#pragma unroll
    for (int j = 0; j < 32; ++j) vv[j] = Vc[(size_t)(wv * 32 + j) * D + lane];
    bf16x8 qf[8];
#pragma unroll
    for (int kk = 0; kk < 8; ++kk) qf[kk] = *(const bf16x8*)(Q + (size_t)(SEQ + b * 16 + fr) * D + h * HD + kk * 32 + fq * 8);
#pragma unroll
    for (int kbi = 0; kbi < 2; ++kbi) { const int kb = wv + 8 * kbi; f32x4 acc = {0.f, 0.f, 0.f, 0.f}; const float* kr = Kc + (size_t)(kb * 16 + fr) * D + fq * 8;
#pragma unroll
        for (int kk = 0; kk < 8; ++kk) { const f32x4 a = *(const f32x4*)(kr + kk * 32), c = *(const f32x4*)(kr + kk * 32 + 4); const u32x4 w = pack8(a, c);
            acc = __builtin_amdgcn_mfma_f32_16x16x32_bf16(qf[kk], __builtin_bit_cast(bf16x8, w), acc, 0, 0, 0); }
#pragma unroll
        for (int r = 0; r < 4; ++r) Sl[(4 * fq + r) * 256 + kb * 16 + fr] = acc[r]; }
    __syncthreads();
#pragma unroll
    for (int rr = 0; rr < 2; ++rr) { const int s = wv * 2 + rr; float v[4]; float mx = -3.0e38f;
#pragma unroll
        for (int j = 0; j < 4; ++j) { v[j] = Sl[s * 256 + lane + 64 * j]; mx = fmaxf(mx, v[j]); }
        mx = wave_max(mx, lane); float sum = 0.f;
#pragma unroll
        for (int j = 0; j < 4; ++j) { v[j] = __builtin_amdgcn_exp2f(v[j] - mx); sum += v[j]; }
        const float inv = 1.f / wave_sum(sum, lane);
#pragma unroll
        for (int j = 0; j < 4; ++j) PT[(lane + 64 * j) * 16 + s] = v[j] * inv; }
    __syncthreads();
    { float o[16];
#pragma unroll
      for (int s = 0; s < 16; ++s) o[s] = 0.f;
#pragma unroll
      for (int j = 0; j < 32; ++j) { const LAS f32x4* pp = (const LAS f32x4*)(PT + (wv * 32 + j) * 16);
#pragma unroll
          for (int q4 = 0; q4 < 4; ++q4) { const f32x4 pv = pp[q4]; o[4 * q4 + 0] += pv[0] * vv[j]; o[4 * q4 + 1] += pv[1] * vv[j]; o[4 * q4 + 2] += pv[2] * vv[j]; o[4 * q4 + 3] += pv[3] * vv[j]; } }
#pragma unroll
      for (int s = 0; s < 16; ++s) red[(wv * 16 + s) * 64 + lane] = o[s]; }
    __syncthreads();
    { const int tid = wv * 64 + lane, s = tid >> 5, dp = (tid & 31) * 2; float o0 = 0.f, o1 = 0.f;
#pragma unroll
      for (int w = 0; w < 8; ++w) { const f32x2 t = *(const LAS f32x2*)(red + (w * 16 + s) * 64 + dp); o0 += t.x; o1 += t.y; }
      *(unsigned*)(O + (size_t)(SEQ + b * 16 + s) * D + h * HD + dq * 64 + dp) = pk2(o0, o1); }
    __syncthreads();
}

template <class Epi8>
__device__ __forceinline__ void skinny_gemm(LAS unsigned char* lds, const bf16_t* A, int lda, const bf16_t* Bt, int ldb, int N, int K, int ksplit, const Epi8& E, int G, int bid, int wv) {
    const int lane = lane_id(), fr = lane & 15, fq = lane >> 4;
    const int ntn = N / 64, per = 4 * ntn, ntiles = per * ksplit, kw = K / ksplit / 8;
    LAS float* red = (LAS float*)lds;
    for (int t = bid; t < ntiles; t += G) {
        const int ks = t / per, tt = t % per, tm = tt & 3, tn = tt >> 2, kbeg = ks * (K / ksplit) + wv * kw;
        f32x4 acc[4][4];
#pragma unroll
        for (int i = 0; i < 4; ++i)
#pragma unroll
            for (int j = 0; j < 4; ++j) acc[i][j] = (f32x4){0.f, 0.f, 0.f, 0.f};
        const bf16_t* ap = A + (size_t)(tm * 64 + fr) * lda + kbeg + fq * 8;
        const bf16_t* bp = Bt + (size_t)(tn * 64 + fr) * ldb + kbeg + fq * 8;
#pragma unroll 2
        for (int k = 0; k < kw; k += 32) { bf16x8 af[4], bfr[4];
#pragma unroll
            for (int i = 0; i < 4; ++i) { af[i] = *(const bf16x8*)(ap + (size_t)i * 16 * lda + k); bfr[i] = *(const bf16x8*)(bp + (size_t)i * 16 * ldb + k); }
#pragma unroll
            for (int i = 0; i < 4; ++i)
#pragma unroll
                for (int j = 0; j < 4; ++j) acc[i][j] = __builtin_amdgcn_mfma_f32_16x16x32_bf16(bfr[j], af[i], acc[i][j], 0, 0, 0); }
#pragma unroll
        for (int i = 0; i < 4; ++i)
#pragma unroll
            for (int j = 0; j < 4; ++j) *(LAS f32x4*)(red + ((wv * 64 + i * 16 + fr) * 64 + (((j * 4 + fq) ^ fr) << 2))) = acc[i][j];
        __syncthreads();
        { const int tid = wv * 64 + lane, row = tid >> 3, s8 = (tid & 7) * 2; f32x4 s0 = {0.f, 0.f, 0.f, 0.f}, s1 = {0.f, 0.f, 0.f, 0.f};
#pragma unroll
          for (int w = 0; w < 8; ++w) { s0 += *(const LAS f32x4*)(red + ((w * 64 + row) * 64 + ((s8 ^ (row & 15)) << 2))); s1 += *(const LAS f32x4*)(red + ((w * 64 + row) * 64 + (((s8 + 1) ^ (row & 15)) << 2))); }
          E(tm * 64 + row, tn * 64 + s8 * 4, s0, s1, lane, ks); }
        __syncthreads();
    }
}
__device__ __forceinline__ u32x2 pack4(const f32x4 v) { u32x2 w; w.x = cvt_pk_bf16(v[0], v[1]); w.y = cvt_pk_bf16(v[2], v[3]); return w; }
struct SkZ { bf16_t* ZP; bf16_t* UH; float* out;
    __device__ __forceinline__ void operator()(int r, int c, f32x4 v0, f32x4 v1, int, int) const { const int row = SEQ + r; const u32x4 w = pack8(v0, v1);
        if (c < DPOOL) { *(u32x4*)(ZP + (size_t)row * DPOOL + c) = w; if ((r & 15) != 0) { float* dst = out + O_POOLS + ((size_t)(r >> 4) * 15 + ((r & 15) - 1)) * DPOOL + c; *(f32x4*)dst = v0; *(f32x4*)(dst + 4) = v1; } }
        else { const int cc = c - DPOOL, gg = cc >> 4, hh = cc & 15; *(u32x4*)(UH + ((size_t)gg * NCHP + (row >> 4)) * KY + (row & 15) * 16 + hh) = w; } } };
struct SkKV { float* out; bf16_t* KB; bf16_t* VT;
    __device__ __forceinline__ void operator()(int r, int c, f32x4 v0, f32x4 v1, int, int) const {
        if (c < D) { float* dst = out + O_MK + (size_t)r * D + c; *(f32x4*)dst = v0; *(f32x4*)(dst + 4) = v1; *(u32x4*)(KB + (size_t)r * D + c) = pack8(v0, v1); }
        else { const int c2 = c - D; float* dst = out + O_MV + (size_t)r * D + c2; *(f32x4*)dst = v0; *(f32x4*)(dst + 4) = v1;
#pragma unroll
            for (int j = 0; j < 4; ++j) { VT[(size_t)(c2 + j) * NMEM + r] = (bf16_t)f2bf(v0[j]); VT[(size_t)(c2 + 4 + j) * NMEM + r] = (bf16_t)f2bf(v1[j]); } } } };
struct SkPool { bf16_t* CAT; const float* scale;
    __device__ __forceinline__ void operator()(int r, int c, f32x4 v0, f32x4 v1, int, int) const { *(u32x4*)(CAT + (size_t)(SEQ + r) * D + c) = pack8(v0 * *(const f32x4*)(scale + c), v1 * *(const f32x4*)(scale + c + 4)); } };
struct SkGlu { bf16_t* CAT; const bf16_t* MIX; const float* bias;
    __device__ __forceinline__ void operator()(int r, int c, f32x4 v0, f32x4 v1, int, int) const { float y[8]; unpack8(*(const u32x4*)(MIX + (size_t)(SEQ + r) * D + DPOOL + c), y);
        const f32x4 b0 = *(const f32x4*)(bias + c), b1 = *(const f32x4*)(bias + c + 4);
#pragma unroll
        for (int j = 0; j < 4; ++j) { v0[j] = y[j] / (1.f + __expf(-(v0[j] + b0[j]))); v1[j] = y[4 + j] / (1.f + __expf(-(v1[j] + b1[j]))); }
        *(u32x4*)(CAT + (size_t)(SEQ + r) * D + DPOOL + c) = pack8(v0, v1); } };
struct SkRes { const float* base; float* out; bf16_t* Xb; float* SS;
    __device__ __forceinline__ void operator()(int r, int c, f32x4 v0, f32x4 v1, int lane, int) const { const float* bp = base + (size_t)r * D + c; const f32x4 x0 = v0 + *(const f32x4*)bp, x1 = v1 + *(const f32x4*)(bp + 4);
        float* op = out + (size_t)r * D + c; *(f32x4*)op = x0; *(f32x4*)(op + 4) = x1; *(u32x4*)(Xb + (size_t)r * D + c) = pack8(x0, x1);
        float q = ((x0[0] * x0[0] + x0[1] * x0[1]) + (x0[2] * x0[2] + x0[3] * x0[3])) + ((x1[0] * x1[0] + x1[1] * x1[1]) + (x1[2] * x1[2] + x1[3] * x1[3]));
        q += shfl_x(q, lane, 1); q += shfl_x(q, lane, 2); q += shfl_x(q, lane, 4);
        if ((lane & 7) == 0) SS[(size_t)r * 16 + (c >> 6)] = q; } };
struct SkQ { bf16_t* Q; const float* SS;
    __device__ __forceinline__ void operator()(int r, int c, f32x4 v0, f32x4 v1, int, int) const { const float rs = row_rstd(SS, r) * QSCALE; *(u32x4*)(Q + (size_t)r * D + c) = pack8(v0 * rs, v1 * rs); } };
struct SkUp { bf16_t* U; const float* SS;
    __device__ __forceinline__ void operator()(int r, int c, f32x4 v0, f32x4 v1, int, int) const { const float rs = row_rstd(SS, r);
#pragma unroll
        for (int j = 0; j < 4; ++j) { const float a = fmaxf(v0[j] * rs, 0.f), b = fmaxf(v1[j] * rs, 0.f); v0[j] = a * a; v1[j] = b * b; }
        *(u32x4*)(U + (size_t)r * DFF + c) = pack8(v0, v1); } };
struct SkSlab { float* slab;
    __device__ __forceinline__ void operator()(int r, int c, f32x4 v0, f32x4 v1, int, int ks) const { float* dst = slab + ((size_t)ks * NSAMP + r) * D + c; *(f32x4*)dst = v0; *(f32x4*)(dst + 4) = v1; } };

#define XB_TMO      128
#define XB_XCNT(j)  (256  + 64 * (j))
#define XB_XSUB(j)  (1280 + 64 * (j))
#define XB_XGEN(j)  (2304 + 64 * (j))
#define XB_TOP      3328
#define XB_TOPGEN   3392
#define XCD_BAR_WORDS 3456
#define XB_SPIN_CAP (1u << 18)

__device__ __forceinline__ unsigned xb_ld(unsigned* p)              { return __hip_atomic_load(p, __ATOMIC_RELAXED, __HIP_MEMORY_SCOPE_AGENT); }
__device__ __forceinline__ unsigned xb_add(unsigned* p, unsigned v) { return __hip_atomic_fetch_add(p, v, __ATOMIC_RELAXED, __HIP_MEMORY_SCOPE_AGENT); }
__device__ __forceinline__ unsigned xb_xcc_id() { return (unsigned)__builtin_amdgcn_s_getreg((3 << 11) | 20) & 0xFu; }
#define XB_SPIN(cond, bar) do { unsigned _sp = 0; while (cond) { __builtin_amdgcn_s_sleep(1); \
    if ((++_sp & 255u) == 0u) { if (xb_ld(&(bar)[XB_TMO])) break; if (_sp > XB_SPIN_CAP) { atomicAdd(&(bar)[XB_TMO], 1u); break; } } } } while (0)

struct XcdBarrier {
    unsigned* bar; unsigned x;
    volatile LAS unsigned* st;
};

__device__ __forceinline__ XcdBarrier xcd_barrier_post(unsigned* bar, volatile LAS unsigned* st, int wv) {
    XcdBarrier b; b.bar = bar; b.x = xb_xcc_id(); b.st = st;
    if (tidx(wv) == 0) (void)xb_add(&bar[XB_XCNT(b.x)], 1u);
    return b;
}
__device__ __forceinline__ void xcd_barrier_complete(unsigned* bar, unsigned x, unsigned& nloc, unsigned& nx) {
    const unsigned G = gridDim.x * gridDim.y * gridDim.z;
    unsigned sum, cnt, mine, sp = 0u;
    for (;;) {
        sum = 0u; cnt = 0u; mine = 0u;
#pragma unroll
        for (unsigned j = 0; j < 16; ++j) { const unsigned c = xb_ld(&bar[XB_XCNT(j)]); sum += c; cnt += (c > 0u) ? 1u : 0u; mine = (j == x) ? c : mine; }
        if (sum == G) break;
        __builtin_amdgcn_s_sleep(1);
        if ((++sp & 255u) == 0u) { if (xb_ld(&bar[XB_TMO])) break; if (sp > XB_SPIN_CAP) { atomicAdd(&bar[XB_TMO], 1u); break; } }
    }
    nloc = mine > 0u ? mine : 1u; nx = cnt > 0u ? cnt : 1u;
}

__device__ __forceinline__ void xcd_barrier(const XcdBarrier& b, int wv) {
    asm volatile("s_waitcnt vmcnt(0)" ::: "memory");
    __syncthreads();
    if (tidx(wv) == 0) {
        unsigned* bar = b.bar;
        __builtin_amdgcn_s_waitcnt(0);
        unsigned nloc = b.st[0], nx = b.st[1];
        if (nloc == 0u) { xcd_barrier_complete(bar, b.x, nloc, nx); b.st[0] = nloc; b.st[1] = nx; }
        const unsigned old = xb_add(&bar[XB_XSUB(b.x)], 1u);
        const unsigned gen = old / nloc;
        if (old + 1u == (gen + 1u) * nloc) {
            __builtin_amdgcn_fence(__ATOMIC_RELEASE, "agent");
            asm volatile("s_waitcnt vmcnt(0)" ::: "memory");
            const unsigned og = xb_add(&bar[XB_TOP], 1u);
            const unsigned tg = og / nx;
            if (og + 1u == (tg + 1u) * nx) xb_add(&bar[XB_TOPGEN], 1u);
            else XB_SPIN(xb_ld(&bar[XB_TOPGEN]) == tg, bar);
            __builtin_amdgcn_fence(__ATOMIC_ACQUIRE, "agent");
            xb_add(&bar[XB_XGEN(b.x)], 1u);
            asm volatile("s_waitcnt vmcnt(0)" ::: "memory");
        } else {
            XB_SPIN(xb_ld(&bar[XB_XGEN(b.x)]) == gen, bar);
            __builtin_amdgcn_fence(__ATOMIC_ACQUIRE, "agent");
            asm volatile("s_waitcnt vmcnt(0)" ::: "memory");
        }
    }
    __syncthreads();
}

#ifndef PHMASK
#define PHMASK 0xFFFF
#endif
#define PH(k) if constexpr (((PHMASK) >> (k)) & 1)
constexpr int LDS_BYTES = 131072 + 8192 + 1024;
__global__ void __launch_bounds__(512, 2) fwd_megakernel(Ctx C) {
    extern __shared__ __attribute__((aligned(16))) unsigned char lds_raw[];
    LAS unsigned char* lds = (LAS unsigned char*)lds_raw;
    const int wv = __builtin_amdgcn_readfirstlane((int)threadIdx.x >> 6);
    const int G = gridDim.x, bid = blockIdx.x; unsigned char* ws = C.ws;
    bf16_t* T0 = (bf16_t*)(ws + WS_T0); bf16_t* T1 = (bf16_t*)(ws + WS_T1); bf16_t* T2 = (bf16_t*)(ws + WS_T2);
    float* SS1 = (float*)(ws + WS_SSP); float* SS2 = SS1 + (size_t)M * 16;
    float* Y = C.out + O_Y;
    pg8::Order S;

    { volatile LAS unsigned* misc = (volatile LAS unsigned*)(lds + 131072 + 8192); if (tidx(wv) < 16) misc[tidx(wv)] = 0u; }
    __syncthreads();
    const XcdBarrier xbar = xcd_barrier_post((unsigned*)(ws + WS_BAR), (volatile LAS unsigned*)(lds + 131072 + 8192), wv);
    p0_prologue(C, lds, G, bid, wv);
    xcd_barrier(xbar, wv);

    p1_pre(C, G, bid, wv);
    PH(0) { pg8::Gemm g{(const char*)T0, (const char*)(ws + WS_WIN), D, D, 0, 0, D}; S.init(SEQ / 256, 4, 1, G, bid);
      EpiZ E{(bf16_t*)(ws + WS_ZP), (bf16_t*)(ws + WS_UH), C.out}; pg8::gemm_phase(lds, g, S, E, wv); }
    { SkZ E{(bf16_t*)(ws + WS_ZP), (bf16_t*)(ws + WS_UH), C.out}; skinny_gemm(lds, T0 + (size_t)SEQ * D, D, (const bf16_t*)(ws + WS_WIN), D, D, D, 1, E, G, bid, wv); }
    { SkKV E{C.out, (bf16_t*)(ws + WS_KB), (bf16_t*)(ws + WS_VT)};
      skinny_gemm(lds, (const bf16_t*)(ws + WS_MN), D, (const bf16_t*)(ws + WS_WKV), D, 2 * D, D, 1, E, G, (bid + G - 64) % G, wv); }
    xcd_barrier(xbar, wv);

    p2a_pre(C, G, bid, wv);
    PH(2) { pg8::Gemm g{(const char*)(ws + WS_UH), (const char*)(ws + WS_WB), KY, 256, (size_t)NCHP * KY * 2, (size_t)256 * 256 * 2, 256}; S.init(NCHP / 256, 1, NG, G, bid);
      EpiE E{(float*)(ws + WS_E)}; pg8::gemm_phase(lds, g, S, E, wv); }
    xcd_barrier(xbar, wv);

    if (bid < NG) p2b_prefix(C, lds, bid, wv);
    else p2b_pool(C, bid - NG, G - NG, wv);
    xcd_barrier(xbar, wv);

    PH(3) { pg8::Gemm g{(const char*)(ws + WS_UH), (const char*)(ws + WS_WY), KY, KY, (size_t)NCHP * KY * 2, (size_t)256 * KY * 2, KY}; S.init(NCHP / 256, 1, NG, G, bid);
      EpiY E{T1}; pg8::gemm_phase(lds, g, S, E, wv); }
    xcd_barrier(xbar, wv);

    PH(5) { pg8::Gemm g{(const char*)(T1 + DPOOL), (const char*)(ws + WS_WGLU), D, DSSM, 0, 0, DSSM}; S.init(SEQ / 256, 2, 1, G, bid);
      EpiGlu E{T2, T1, C.in[21]}; pg8::gemm_phase(lds, g, S, E, wv); }
    PH(4) { pg8::Gemm g{(const char*)T1, (const char*)(ws + WS_WPOOL), D, DPOOL, 0, 0, DPOOL}; S.init(SEQ / 256, 2, 1, G, (bid + G - (128 % G)) % G);
      EpiPool E{T2, C.in[11]}; pg8::gemm_phase(lds, g, S, E, wv); }
    { SkGlu E{T2, T1, C.in[21]}; skinny_gemm(lds, T1 + (size_t)SEQ * D + DPOOL, D, (const bf16_t*)(ws + WS_WGLU), DSSM, DSSM, DSSM, 1, E, G, bid, wv); }
    { SkPool E{T2, C.in[11]}; skinny_gemm(lds, T1 + (size_t)SEQ * D, D, (const bf16_t*)(ws + WS_WPOOL), DPOOL, DPOOL, DPOOL, 1, E, G, (bid + G - 32) % G, wv); }
    xcd_barrier(xbar, wv);

    PH(6) { pg8::Gemm g{(const char*)T2, (const char*)(ws + WS_WOUT), D, D, 0, 0, D}; S.init(SEQ / 256, 4, 1, G, bid);
      EpiRes E{C.in[0], C.in[1], Y, T0, SS1}; pg8::gemm_phase(lds, g, S, E, wv); }
    { SkRes E{C.in[1], Y + (size_t)SEQ * D, T0 + (size_t)SEQ * D, SS1 + (size_t)SEQ * 16}; skinny_gemm(lds, T2 + (size_t)SEQ * D, D, (const bf16_t*)(ws + WS_WOUT), D, D, D, 1, E, G, bid, wv); }
    xcd_barrier(xbar, wv);

    PH(7) { pg8::Gemm g{(const char*)T0, (const char*)(ws + WS_WQ), D, D, 0, 0, D}; S.init(SEQ / 256, 4, 1, G, bid);
      EpiQ E{T1, SS1}; pg8::gemm_phase(lds, g, S, E, wv); }
    { SkQ E{T1 + (size_t)SEQ * D, SS1 + (size_t)SEQ * 16}; skinny_gemm(lds, T0 + (size_t)SEQ * D, D, (const bf16_t*)(ws + WS_WQ), D, D, D, 1, E, G, bid, wv); }
    xcd_barrier(xbar, wv);

    PH(8) { pg8::Gemm g{(const char*)T1, (const char*)(ws + WS_KB), D, D, (size_t)HD * 2, (size_t)HD * 2, HD}; S.init(SEQ / 256, 1, NHEAD, G, bid);
      EpiSoftmax E{T2, (LAS float*)(lds + 131072), (LAS float*)(lds + 131072 + 4096)}; pg8::gemm_phase(lds, g, S, E, wv); }
    for (int it = bid; it < 256; it += G) sample_attn_item(C, lds, it, wv);
    xcd_barrier(xbar, wv);

    PH(9) { pg8::Gemm g{(const char*)T2, (const char*)(ws + WS_VT), D, NMEM, (size_t)HD * 2, (size_t)HD * NMEM * 2, NMEM}; S.init(SEQ / 256, 1, NHEAD, G, bid);
      EpiO E{T0}; pg8::gemm_phase(lds, g, S, E, wv); }
    xcd_barrier(xbar, wv);

    PH(10) { pg8::Gemm g{(const char*)T0, (const char*)(ws + WS_WO), D, D, 0, 0, D}; S.init(SEQ / 256, 4, 1, G, bid);
      EpiRes E{Y, Y + (size_t)SEQ * D, Y, T2, SS2}; pg8::gemm_phase(lds, g, S, E, wv); }
    { SkRes E{Y + (size_t)SEQ * D, Y + (size_t)SEQ * D, T2 + (size_t)SEQ * D, SS2 + (size_t)SEQ * 16}; skinny_gemm(lds, T0 + (size_t)SEQ * D, D, (const bf16_t*)(ws + WS_WO), D, D, D, 1, E, G, bid, wv); }
    xcd_barrier(xbar, wv);

    PH(11) { pg8::Gemm g{(const char*)T2, (const char*)(ws + WS_WUP), D, D, 0, 0, D}; S.init(SEQ / 256, DFF / 256, 1, G, bid);
      EpiUp E{(bf16_t*)(ws + WS_U), SS2}; pg8::gemm_phase(lds, g, S, E, wv); }
    { SkUp E{(bf16_t*)(ws + WS_U) + (size_t)SEQ * DFF, SS2 + (size_t)SEQ * 16}; skinny_gemm(lds, T2 + (size_t)SEQ * D, D, (const bf16_t*)(ws + WS_WUP), D, DFF, D, 1, E, G, bid, wv); }
    xcd_barrier(xbar, wv);

    PH(12) { pg8::Gemm g{(const char*)(ws + WS_U), (const char*)(ws + WS_WDOWN), DFF, DFF, 0, 0, DFF}; S.init(SEQ / 256, 4, 1, G, bid);
      EpiRes E{Y, Y + (size_t)SEQ * D, Y, nullptr, nullptr}; pg8::gemm_phase(lds, g, S, E, wv); }
    { SkSlab E{(float*)(ws + WS_SLAB)}; skinny_gemm(lds, (const bf16_t*)(ws + WS_U) + (size_t)SEQ * DFF, DFF, (const bf16_t*)(ws + WS_WDOWN), DFF, D, DFF, 4, E, G, bid, wv); }
    xcd_barrier(xbar, wv);

    { const int lane = lane_id(), gw = bid * 8 + wv, NGW = G * 8; const f32x4* gr = (const f32x4*)C.in[32] + lane;
      for (int m = gw; m < M; m += NGW) { f32x4* xr = (f32x4*)(Y + (size_t)m * D) + lane; f32x4 v[4]; float ss = 0.f;
#pragma unroll
          for (int j = 0; j < 4; ++j) v[j] = xr[64 * j];
          if (m >= SEQ) {
#pragma unroll
              for (int ks = 0; ks < 4; ++ks) { const f32x4* sp = (const f32x4*)((const float*)(ws + WS_SLAB) + ((size_t)ks * NSAMP + (m - SEQ)) * D) + lane;
#pragma unroll
                  for (int j = 0; j < 4; ++j) v[j] += sp[64 * j]; } }
#pragma unroll
          for (int j = 0; j < 4; ++j) ss += (v[j].x * v[j].x + v[j].y * v[j].y) + (v[j].z * v[j].z + v[j].w * v[j].w);
          const float rs = rsqrtf(wave_sum(ss, lane) * (1.f / D) + EPS);
#pragma unroll
          for (int j = 0; j < 4; ++j) { const f32x4 gg = gr[64 * j]; xr[64 * j] = (f32x4){v[j].x * rs * gg.x, v[j].y * rs * gg.y, v[j].z * rs * gg.z, v[j].w * rs * gg.w}; } } }
}

extern "C" void kernel_launch(void* const* d_in, const int* in_sizes, int n_in, void* d_out, int out_size, void* d_ws, size_t ws_size, hipStream_t stream) {
    static int grid = 0;
    if (grid == 0) {
        if (n_in != 33 || (size_t)out_size != O_END || ws_size < WS_END) { fprintf(stderr, "kernel_launch: unexpected shapes n_in %d out %d ws %zu\n", n_in, out_size, ws_size); grid = -1; return; }
        int dev = 0, cus = 0, per_cu = 0;
        hipGetDevice(&dev); hipDeviceGetAttribute(&cus, hipDeviceAttributeMultiprocessorCount, dev);
        if (hipFuncSetAttribute((const void*)fwd_megakernel, hipFuncAttributeMaxDynamicSharedMemorySize, LDS_BYTES) != hipSuccess) { fprintf(stderr, "kernel_launch: hipFuncSetAttribute failed\n"); grid = -1; return; }
        if (hipOccupancyMaxActiveBlocksPerMultiprocessor(&per_cu, (const void*)fwd_megakernel, 512, LDS_BYTES) != hipSuccess || per_cu < 1) { fprintf(stderr, "kernel_launch: occupancy query failed (%d)\n", per_cu); (void)hipGetLastError(); per_cu = 1; }
        if (per_cu > 1) per_cu = 1;
        grid = cus * per_cu; if (grid > 256) grid = 256;
    }
    if (grid < 0) return;
    Ctx c{};
    for (int i = 0; i < 33; ++i) c.in[i] = (const float*)d_in[i];
    c.out = (float*)d_out; c.ws = (unsigned char*)d_ws;
    if (hipMemsetAsync((char*)d_ws + WS_BAR, 0, XCD_BAR_WORDS * 4, stream) != hipSuccess) { fprintf(stderr, "kernel_launch: memset of the barrier words failed\n"); return; }
    void* args[] = {&c};
    hipError_t e = hipLaunchCooperativeKernel((const void*)fwd_megakernel, dim3(grid), dim3(512), args, LDS_BYTES, stream);
    if (e != hipSuccess) fprintf(stderr, "cooperative launch failed: %s (grid %d)\n", hipGetErrorString(e), grid);
}
```

```cpp
#include <hip/hip_runtime.h>
#include <hip/hip_cooperative_groups.h>
#include <cstdio>
#include <cstdint>
namespace cg = cooperative_groups;

#define LAS __attribute__((address_space(3)))
typedef unsigned short bf16_t;
typedef short bf16x8 __attribute__((ext_vector_type(8)));
typedef float f32x4 __attribute__((ext_vector_type(4)));
typedef float f32x2 __attribute__((ext_vector_type(2)));
typedef unsigned u32x4 __attribute__((ext_vector_type(4)));
typedef unsigned u32x2 __attribute__((ext_vector_type(2)));

constexpr int D = 1024, SEQ = 16384, NSAMP = 256, M = SEQ + NSAMP, DFF = 4096, DPOOL = 512, DSSM = 512;
constexpr int NG = 32, NP = 64, NH = 16, TC = 16, NCH = M / TC  , NCHP = 1280, KY = 384;
constexpr int NMEM = 256, HD = 256, NHEAD = 4;
constexpr float EPS = 1e-6f;
constexpr float QSCALE = 0.0625f * 1.4426950408889634f;

constexpr size_t O_Y = 0, O_MK = (size_t)M * D, O_MV = O_MK + 262144, O_POOLP = O_MV + 262144, O_SREP = O_POOLP + 7680, O_SIMP = O_SREP + 2048,
                 O_POOLS = O_SIMP + 2048, O_SRES = O_POOLS + 122880, O_SIMS = O_SRES + 32768, O_END = O_SIMS + 32768;

constexpr size_t MiB = 1u << 20;
constexpr size_t WS_WIN = 0, WS_WOUT = 2 * MiB, WS_WQ = 4 * MiB, WS_WKV = 6 * MiB, WS_WO = 10 * MiB, WS_WUP = 12 * MiB, WS_WDOWN = 20 * MiB,
                 WS_WGLU = 28 * MiB, WS_WPOOL = 28 * MiB + 512 * 1024, WS_MN = 29 * MiB, WS_KB = 29 * MiB + 512 * 1024, WS_VT = 30 * MiB,
                 WS_AP = 30 * MiB + 512 * 1024,
                 WS_BB = WS_AP + 320 * 1024,
                 WS_KLAG = WS_BB + 256 * 1024,
                 WS_SS = WS_KLAG + 512 * 1024,
                 WS_BAR = 32 * MiB - 128 * 1024,
                 WS_WB = 32 * MiB,
                 WS_WY = 36 * MiB,
                 WS_E = 42 * MiB,
                 WS_UH = 62 * MiB,
                 WS_ZP = 92 * MiB,
                 WS_T0 = 109 * MiB, WS_T1 = 142 * MiB, WS_T2 = 175 * MiB, WS_SSP = 208 * MiB  , WS_XCH = 215 * MiB  , WS_WQN = 216 * MiB  , WS_WQK = 218 * MiB  , WS_VWO = 220 * MiB  , WS_WOUT2 = 222 * MiB  , WS_END = 224 * MiB,
                 WS_OB = 62 * MiB,
                 WS_U = 42 * MiB,
                 WS_SLAB = 211 * MiB;
static_assert(WS_SS + 3 * M * 4 <= WS_BAR, "misc region");
static_assert(WS_U + (size_t)M * DFF * 2 <= WS_T2, "U overlay");

__device__ __forceinline__ unsigned f2bf(float f) { unsigned u = __builtin_bit_cast(unsigned, f); return (u + 0x7fffu + ((u >> 16) & 1u)) >> 16; }
__device__ __forceinline__ unsigned pk2(float lo, float hi) { return f2bf(lo) | (f2bf(hi) << 16); }
__device__ __forceinline__ float bf2f(unsigned b) { return __builtin_bit_cast(float, b << 16); }
__device__ __forceinline__ unsigned cvt_pk_bf16(float lo, float hi) { unsigned r; asm volatile("v_cvt_pk_bf16_f32 %0, %1, %2" : "=v"(r) : "v"(lo), "v"(hi)); return r; }
#define LDS_WAIT() asm volatile("s_waitcnt lgkmcnt(0)" ::: "memory")
__device__ __forceinline__ int lane_id() { int l; asm volatile("v_mbcnt_lo_u32_b32 %0, -1, 0\n\tv_mbcnt_hi_u32_b32 %0, -1, %0" : "=v"(l)); return l; }
__device__ __forceinline__ int tidx(int wv) { return wv * 64 + lane_id(); }
#define SPIN_CAP (1u << 18)
__device__ __forceinline__ unsigned at_ld(unsigned* p) { return __hip_atomic_load(p, __ATOMIC_RELAXED, __HIP_MEMORY_SCOPE_AGENT); }
__device__ __forceinline__ unsigned at_add(unsigned* p, unsigned v) { return __hip_atomic_fetch_add(p, v, __ATOMIC_RELAXED, __HIP_MEMORY_SCOPE_AGENT); }
__device__ __forceinline__ float shfl_x(float v, int lane, int mask) { return __builtin_bit_cast(float, __builtin_amdgcn_ds_bpermute((lane ^ mask) << 2, __builtin_bit_cast(int, v))); }

__device__ __forceinline__ void unpack8(const u32x4 q, float* v) { const unsigned qq[4] = {q.x, q.y, q.z, q.w};
#pragma unroll
    for (int e = 0; e < 8; ++e) v[e] = bf2f((qq[e >> 1] >> ((e & 1) * 16)) & 0xffffu); }
namespace pg8 {
constexpr int BM = 256, BK = 64, HALF = 128, HTB = HALF * BK * 2, STAGE_BYTES = 8 * HTB, NXCD = 8, WGM = 8;
__host__ __device__ __forceinline__ int lds_byte(int r, int c) { const int st = (r >> 4) * 2 + (c >> 5), rr = r & 15, cc = c & 31, ob = rr * 64 + cc * 2; return st * 1024 + (ob ^ (((ob >> 9) & 1) << 5)); }
__host__ __device__ __forceinline__ void stage_rc(int b, int& R, int& C) { const int st = b / 1024, sb = b % 1024, swz = sb ^ (((sb >> 9) & 1) << 5); R = (st >> 1) * 16 + swz / 64; C = (st & 1) * 32 + (swz % 64) / 2; }
__host__ __device__ __forceinline__ int perm32(int rho) { const int n = rho >> 4, i = rho & 15; return 8 * (i >> 2) + 4 * n + (i & 3); }

struct Unit { int pm, pn, z; };
struct Gemm { const char* A; const char* B; int lda, ldb; size_t sAz, sBz; int K; };
struct Order {
    int nM, nN, nZ, G, c; bool zpn;
    __device__ __forceinline__ void init(int nM_, int nN_, int nZ_, int G_, int c_, bool zpn_ = false) { nM = nM_; nN = nN_; nZ = nZ_; G = G_; c = c_; zpn = zpn_; }
    __device__ __forceinline__ bool next(int i, Unit& u) const {
        const int per = nM * nN, nwg = per * nZ; const long L = (long)i * G + c; if (L >= nwg) return false;
        int wgid = (int)L; { const int q = nwg / NXCD, r = nwg % NXCD, xcd = wgid % NXCD, off = wgid / NXCD; wgid = (xcd < r ? xcd * (q + 1) : r * (q + 1) + (xcd - r) * q) + off; }
        u.z = wgid / per; const int l = wgid % per;
        const int nig = WGM * nN, gid = l / nig, fm = gid * WGM, gsz = (nM - fm) < WGM ? (nM - fm) : WGM;
        u.pm = fm + ((l % nig) % gsz); u.pn = (l % nig) / gsz; if (zpn) { u.z = u.pn; u.pn = 0; } return true;
    }
};

template <class Epi>
__device__ __forceinline__ void gemm_phase(LAS unsigned char* lds, const Gemm g, const Order& S, Epi& E, int wv) {
    const int tid = tidx(wv), wid = __builtin_amdgcn_readfirstlane(tid >> 6), lane = tid & 63, wr = wid >> 2, wc = wid & 3, fr = lane & 15, fq = lane >> 4;
    const int nt = g.K / BK;
    unsigned voffA[2], voffB[2];
#pragma unroll
    for (int i = 0; i < 2; ++i) { int R, C; stage_rc(tid * 16 + i * 8192, R, C); const int Rb = Epi::PERM ? ((R & ~31) + perm32(R & 31)) : R;
        voffA[i] = (unsigned)(R * g.lda + C) * 2u; voffB[i] = (unsigned)(Rb * g.ldb + C) * 2u; }
    const size_t kstep = (size_t)(BK * 2);
    const size_t hA = (size_t)HALF * g.lda * 2, hB = (size_t)HALF * g.ldb * 2;
    const unsigned ldsw = (unsigned)wid * 1024u;
    const int aoff = lds_byte(wr * 64 + fr, fq * 8), boff = lds_byte(wc * 32 + fr, fq * 8);
#define PG8_SA(b, h) (((b) * 2 + (h)) * HTB)
#define PG8_SB(b, h) ((4 + (b) * 2 + (h)) * HTB)
#define PG8_STAGE(bufoff, gbase, voff) do { _Pragma("unroll") for (int _i = 0; _i < 2; ++_i) \
        __builtin_amdgcn_global_load_lds((const unsigned*)((const char*)(gbase) + (voff)[_i]), (LAS unsigned*)(lds + (bufoff) + ldsw + _i * 8192), 16, 0, 0); } while (0)
#define PG8_LDA(dst, b, h) do { _Pragma("unroll") for (int m = 0; m < 4; ++m) _Pragma("unroll") for (int k = 0; k < 2; ++k) dst[m][k] = *(const LAS bf16x8*)(lds + PG8_SA(b, h) + aoff + m * 2048 + k * 1024); } while (0)
#define PG8_LDB(dst, b, h) do { _Pragma("unroll") for (int n = 0; n < 2; ++n) _Pragma("unroll") for (int k = 0; k < 2; ++k) dst[n][k] = *(const LAS bf16x8*)(lds + PG8_SB(b, h) + boff + n * 2048 + k * 1024); } while (0)
#define PG8_MMA(ai, bj, At, Bt) do { __builtin_amdgcn_s_setprio(1); _Pragma("unroll") for (int m = 0; m < 4; ++m) _Pragma("unroll") for (int n = 0; n < 2; ++n) _Pragma("unroll") for (int k = 0; k < 2; ++k) \
        acc[ai][bj][m][n] = __builtin_amdgcn_mfma_f32_16x16x32_bf16(Bt[n][k], At[m][k], acc[ai][bj][m][n], 0, 0, 0); __builtin_amdgcn_s_setprio(0); } while (0)
#define PG8_WAIT_V(n) asm volatile("s_waitcnt vmcnt(" #n ")" ::: "memory")
#define PG8_WAIT_L(n) asm volatile("s_waitcnt lgkmcnt(" #n ")" ::: "memory")
#define PG8_BAR __builtin_amdgcn_s_barrier()
#define PG8_SCHED __builtin_amdgcn_sched_barrier(0)
    Unit cur, nxt; int ui = 0;
    if (!S.next(0, cur)) return;
    f32x4 acc[2][2][4][2];
    if constexpr (Epi::ACC_INIT) E.init(acc, cur, wr, wc, fr, fq);
    else {
#pragma unroll
    for (int a = 0; a < 2; ++a)
#pragma unroll
        for (int b = 0; b < 2; ++b)
#pragma unroll
            for (int m = 0; m < 4; ++m)
#pragma unroll
                for (int n = 0; n < 2; ++n) acc[a][b][m][n] = (f32x4){0.f, 0.f, 0.f, 0.f};
    }
    bf16x8 At[4][2], B0[2][2], B1[2][2];
    const char* cA = g.A + (size_t)cur.z * g.sAz + (size_t)cur.pm * 2 * hA; const char* cB = g.B + (size_t)cur.z * g.sBz + (size_t)cur.pn * 2 * hB;
    PG8_STAGE(PG8_SB(0, 0), cB, voffB); PG8_STAGE(PG8_SB(0, 1), cB + hB, voffB); PG8_STAGE(PG8_SA(0, 0), cA, voffA); PG8_STAGE(PG8_SA(0, 1), cA + hA, voffA);
    if (wr == 1) PG8_BAR;
    PG8_WAIT_V(2); PG8_BAR;
    PG8_STAGE(PG8_SB(1, 0), cB + kstep, voffB); PG8_STAGE(PG8_SA(1, 0), cA + kstep, voffA); PG8_STAGE(PG8_SB(1, 1), cB + hB + kstep, voffB);
    PG8_WAIT_V(6); PG8_BAR;
    if constexpr (Epi::ACC_INIT) {
#pragma unroll
        for (int a = 0; a < 2; ++a)
#pragma unroll
            for (int b = 0; b < 2; ++b)
#pragma unroll
                for (int m = 0; m < 4; ++m) asm volatile("" : "+v"(acc[a][b][m][0]), "+v"(acc[a][b][m][1]));
    }
    for (;;) {
        const bool has_next = S.next(ui + 1, nxt);
        const char* nA = has_next ? g.A + (size_t)nxt.z * g.sAz + (size_t)nxt.pm * 2 * hA : cA; const char* nB = has_next ? g.B + (size_t)nxt.z * g.sBz + (size_t)nxt.pn * 2 * hB : cB;
        for (int t = 0; t < nt; t += 2) {
            const bool last = (t == nt - 2);
            const char* a1 = cA + (size_t)(t + 1) * kstep;
            const char* a2 = last ? nA : cA + (size_t)(t + 2) * kstep; const char* b2 = last ? nB : cB + (size_t)(t + 2) * kstep;
            const char* a3 = a2 + kstep; const char* b3 = b2 + kstep;
            PG8_LDB(B0, 0, 0); PG8_LDB(B1, 0, 1); PG8_SCHED; PG8_LDA(At, 0, 0); PG8_STAGE(PG8_SA(1, 1), a1 + hA, voffA);
            PG8_WAIT_V(8); PG8_WAIT_L(0); PG8_BAR; PG8_MMA(0, 0, At, B0); PG8_MMA(0, 1, At, B1); PG8_BAR; PG8_SCHED;
            PG8_LDA(At, 0, 1); PG8_STAGE(PG8_SB(0, 0), b2, voffB); PG8_STAGE(PG8_SB(0, 1), b2 + hB, voffB); PG8_STAGE(PG8_SA(0, 0), a2, voffA);
            PG8_WAIT_V(8); PG8_WAIT_L(0); PG8_BAR; PG8_MMA(1, 0, At, B0); PG8_MMA(1, 1, At, B1); PG8_BAR; PG8_SCHED;
            PG8_LDB(B0, 1, 0); PG8_LDB(B1, 1, 1); PG8_SCHED; PG8_LDA(At, 1, 0); PG8_STAGE(PG8_SA(0, 1), a2 + hA, voffA);
            PG8_WAIT_V(8); PG8_WAIT_L(0); PG8_BAR; PG8_MMA(0, 0, At, B0); PG8_MMA(0, 1, At, B1); PG8_BAR; PG8_SCHED;
            PG8_LDA(At, 1, 1); PG8_STAGE(PG8_SB(1, 0), b3, voffB); PG8_STAGE(PG8_SB(1, 1), b3 + hB, voffB); PG8_STAGE(PG8_SA(1, 0), a3, voffA);
            PG8_WAIT_V(8); PG8_WAIT_L(0); PG8_BAR; PG8_MMA(1, 0, At, B0); PG8_MMA(1, 1, At, B1); PG8_BAR; PG8_SCHED;
        }
        if (wr == 0) PG8_BAR;
        { Unit ue; ue.pm = __builtin_amdgcn_readfirstlane(cur.pm); ue.pn = __builtin_amdgcn_readfirstlane(cur.pn); ue.z = __builtin_amdgcn_readfirstlane(cur.z); const int le = lane_id(); int fre = le & 15, fqe = le >> 4;
          asm volatile("" : "+s"(ue.pm), "+s"(ue.pn), "+s"(ue.z));
          E(acc, ue, wr, wc, fre, fqe); }
        if (!has_next) break;
        if constexpr (Epi::ACC_INIT) { E.init(acc, nxt, wr, wc, fr, fq);
#pragma unroll
            for (int a = 0; a < 2; ++a)
#pragma unroll
                for (int b = 0; b < 2; ++b)
#pragma unroll
                    for (int m = 0; m < 4; ++m) asm volatile("" : "+v"(acc[a][b][m][0]), "+v"(acc[a][b][m][1]));
        } else {
#pragma unroll
        for (int a = 0; a < 2; ++a)
#pragma unroll
            for (int b = 0; b < 2; ++b)
#pragma unroll
                for (int m = 0; m < 4; ++m)
#pragma unroll
                    for (int n = 0; n < 2; ++n) acc[a][b][m][n] = (f32x4){0.f, 0.f, 0.f, 0.f};
        }
        cur = nxt; cA = nA; cB = nB; ++ui;
        if (wr == 1) PG8_BAR;
    }
    PG8_WAIT_V(0);
    PG8_BAR;
#undef PG8_SA
#undef PG8_SB
#undef PG8_STAGE
#undef PG8_LDA
#undef PG8_LDB
#undef PG8_MMA
#undef PG8_WAIT_V
#undef PG8_WAIT_L
#undef PG8_BAR
#undef PG8_SCHED
}
}
using pg8::Unit;
typedef f32x4 Acc[2][2][4][2];

#define EPI_ROWS(ai, m) (u.pm * 256 + (ai) * 128 + wr * 64 + (m) * 16 + fr)
__device__ __forceinline__ bool mfence() { asm volatile("" ::: "memory"); return true; }
#define FOR_AI_M _Pragma("unroll") for (int ai = 0; ai < 2; ++ai) _Pragma("unroll") for (int m = 0; m < 4; ++m) if (mfence())
#define FOR_BJ _Pragma("unroll") for (int bj = 0; bj < 2; ++bj)
__device__ __forceinline__ u32x4 pack8(const f32x4 v0, const f32x4 v1) { u32x4 w; w.x = cvt_pk_bf16(v0[0], v0[1]); w.y = cvt_pk_bf16(v0[2], v0[3]); w.z = cvt_pk_bf16(v1[0], v1[1]); w.w = cvt_pk_bf16(v1[2], v1[3]); return w; }

struct EpiZ {
    static constexpr bool PERM = true, ACC_INIT = false;
    bf16_t* ZP; bf16_t* UH; float* out;
    __device__ __forceinline__ void operator()(Acc& acc, const Unit& u, int wr, int wc, int fr, int fq) const {
        FOR_AI_M { const int row = EPI_ROWS(ai, m);
            FOR_BJ { const int col = u.pn * 256 + bj * 128 + wc * 32 + 8 * fq; const f32x4 v0 = acc[ai][bj][m][0], v1 = acc[ai][bj][m][1]; const u32x4 w = pack8(v0, v1);
                if (col < DPOOL) {
                    *(u32x4*)(ZP + (size_t)row * DPOOL + col) = w;
                    float* dst = nullptr;
                    if (row >= SEQ - 15 && row < SEQ) dst = out + O_POOLP + (size_t)(row - (SEQ - 15)) * DPOOL + col;
                    else if (row >= SEQ && ((row & 15) != 0)) dst = out + O_POOLS + ((size_t)((row - SEQ) >> 4) * 15 + ((row & 15) - 1)) * DPOOL + col;
                    if (dst) { *(f32x4*)dst = v0; *(f32x4*)(dst + 4) = v1; }
                } else {
                    const int cc = col - DPOOL, gg = cc >> 4, hh = cc & 15;
                    *(u32x4*)(UH + ((size_t)gg * NCHP + (row >> 4)) * KY + (row & 15) * 16 + hh) = w;
                } } }
    }
};
struct EpiKV {
    static constexpr bool PERM = false, ACC_INIT = false;
    float* out; bf16_t* KB; bf16_t* VT;
    __device__ __forceinline__ void operator()(Acc& acc, const Unit& u, int wr, int wc, int fr, int fq) const {
        FOR_AI_M { const int row = EPI_ROWS(ai, m);
            FOR_BJ {
#pragma unroll
                for (int n = 0; n < 2; ++n) { const int col = u.pn * 256 + bj * 128 + wc * 32 + 16 * n + 4 * fq; const f32x4 v = acc[ai][bj][m][n];
                    if (col < D) { *(f32x4*)(out + O_MK + (size_t)row * D + col) = v; u32x2 w; w.x = cvt_pk_bf16(v[0], v[1]); w.y = cvt_pk_bf16(v[2], v[3]); *(u32x2*)(KB + (size_t)row * D + col) = w; }
                    else { const int c2 = col - D; *(f32x4*)(out + O_MV + (size_t)row * D + c2) = v; } } }
            asm volatile("" ::: "memory"); }
    }
};
struct EpiE {
    static constexpr bool PERM = false, ACC_INIT = false;
    float* E;
    __device__ __forceinline__ void operator()(Acc& acc, const Unit& u, int wr, int wc, int fr, int fq) const {
        FOR_AI_M { const int row = EPI_ROWS(ai, m);
#pragma unroll
            for (int n = 0; n < 2; ++n) { const int col = wc * 32 + 16 * n + 4 * fq; *(f32x4*)(E + ((size_t)u.z * NCHP + row) * 128 + col) = acc[ai][0][m][n]; } }
    }
};
__device__ __forceinline__ float gelu_tanh(float x) {
    const float t = 0.7978845608028654f * (x + 0.044715f * x * x * x);
    const float e = __expf(-2.f * t);
    return x / (1.f + e);
}
struct EpiY {
    static constexpr bool PERM = true, ACC_INIT = false;
    bf16_t* MIX;
    __device__ __forceinline__ void operator()(Acc& acc, const Unit& u, int wr, int wc, int fr, int fq) const {
        FOR_AI_M { const int ch = EPI_ROWS(ai, m); if (ch < NCH) {
            FOR_BJ { const int col = bj * 128 + wc * 32 + 8 * fq, t = col >> 4, hh = col & 15; f32x4 v0 = acc[ai][bj][m][0], v1 = acc[ai][bj][m][1];
#pragma unroll
                for (int j = 0; j < 4; ++j) { v0[j] = gelu_tanh(v0[j]); v1[j] = gelu_tanh(v1[j]); }
                *(u32x4*)(MIX + (size_t)(ch * 16 + t) * D + DPOOL + u.z * 16 + hh) = pack8(v0, v1); } } }
    }
};
struct EpiPool {
    static constexpr bool PERM = true, ACC_INIT = false;
    bf16_t* CAT; const float* scale;
    __device__ __forceinline__ void operator()(Acc& acc, const Unit& u, int wr, int wc, int fr, int fq) const {
        FOR_BJ { const int col = u.pn * 256 + bj * 128 + wc * 32 + 8 * fq; const f32x4 s0 = *(const f32x4*)(scale + col), s1 = *(const f32x4*)(scale + col + 4);
            FOR_AI_M { const int row = EPI_ROWS(ai, m); *(u32x4*)(CAT + (size_t)row * D + col) = pack8(acc[ai][bj][m][0] * s0, acc[ai][bj][m][1] * s1); } }
    }
};
struct EpiGlu {
    static constexpr bool PERM = true, ACC_INIT = false;
    bf16_t* CAT; const bf16_t* MIX; const float* bias;
    __device__ __forceinline__ void operator()(Acc& acc, const Unit& u, int wr, int wc, int fr, int fq) const {
        FOR_BJ { const int col = u.pn * 256 + bj * 128 + wc * 32 + 8 * fq; const f32x4 b0 = *(const f32x4*)(bias + col), b1 = *(const f32x4*)(bias + col + 4);
            u32x4 yv[2][4];
#pragma unroll
            for (int ai = 0; ai < 2; ++ai)
#pragma unroll
                for (int m = 0; m < 4; ++m) yv[ai][m] = *(const u32x4*)(MIX + (size_t)EPI_ROWS(ai, m) * D + DPOOL + col);
            FOR_AI_M { const int row = EPI_ROWS(ai, m); float y[8]; unpack8(yv[ai][m], y);
                f32x4 v0 = acc[ai][bj][m][0] + b0, v1 = acc[ai][bj][m][1] + b1;
#pragma unroll
                for (int j = 0; j < 4; ++j) { v0[j] = y[j] / (1.f + __expf(-v0[j])); v1[j] = y[4 + j] / (1.f + __expf(-v1[j])); }
                *(u32x4*)(CAT + (size_t)row * D + DPOOL + col) = pack8(v0, v1); } }
    }
};
template <bool BASE_BF16> struct EpiRes {
    static constexpr bool PERM = false, ACC_INIT = true;
    const void* base; bf16_t* Xb; float* SS;
    __device__ __forceinline__ void init(Acc& acc, const Unit& u, int wr, int wc, int fr, int fq) const {
#pragma unroll
        for (int ai = 0; ai < 2; ++ai)
#pragma unroll
            for (int m = 0; m < 4; ++m) { const size_t off = (size_t)EPI_ROWS(ai, m) * D + u.pn * 256 + wc * 32 + 4 * fq;
#pragma unroll
                for (int bj = 0; bj < 2; ++bj)
#pragma unroll
                    for (int n = 0; n < 2; ++n) {
                        if constexpr (BASE_BF16) { const u32x2 w = *(const u32x2*)((const bf16_t*)base + off + bj * 128 + 16 * n); acc[ai][bj][m][n] = (f32x4){bf2f(w.x & 0xffffu), bf2f(w.x >> 16), bf2f(w.y & 0xffffu), bf2f(w.y >> 16)}; }
                        else acc[ai][bj][m][n] = __builtin_nontemporal_load((const f32x4*)((const float*)base + off + bj * 128 + 16 * n)); } }
    }
    __device__ __forceinline__ void operator()(Acc& acc, const Unit& u, int wr, int wc, int fr, int fq) const {
        FOR_AI_M { const int row = EPI_ROWS(ai, m); float ssq = 0.f;
            FOR_BJ {
#pragma unroll
                for (int n = 0; n < 2; ++n) { const int col = u.pn * 256 + bj * 128 + wc * 32 + 16 * n + 4 * fq; const f32x4 v = acc[ai][bj][m][n];
                    ssq += (v[0] * v[0] + v[1] * v[1]) + (v[2] * v[2] + v[3] * v[3]);
                    u32x2 w; w.x = cvt_pk_bf16(v[0], v[1]); w.y = cvt_pk_bf16(v[2], v[3]); *(u32x2*)(Xb + (size_t)row * D + col) = w; } }
            if (SS) { ssq += shfl_x(ssq, fr + 16 * fq, 16); ssq += shfl_x(ssq, fr + 16 * fq, 32);
                if (fq == 0) SS[(size_t)row * 16 + u.pn * 4 + wc] = ssq; } }
    }
};
__device__ __forceinline__ float row_rstd(const float* SS, int row) { const f32x4* p = (const f32x4*)(SS + (size_t)row * 16); const f32x4 a = p[0], b = p[1], c = p[2], d = p[3];
    const float t = ((a[0] + a[1]) + (a[2] + a[3])) + ((b[0] + b[1]) + (b[2] + b[3])) + ((c[0] + c[1]) + (c[2] + c[3])) + ((d[0] + d[1]) + (d[2] + d[3])); return rsqrtf(t * (1.f / D) + EPS); }
__device__ __forceinline__ int prep_rstd(LAS float* tab, const float* SS, const pg8::Order& S, int wv) {
    Unit u0; int pm = -1;
    if (S.next(0, u0)) { pm = u0.pm; const int tid = tidx(wv); if (tid < 256) tab[tid] = row_rstd(SS, pm * 256 + tid); }
    __syncthreads();
    return pm;
}
struct EpiQ {
    static constexpr bool PERM = true, ACC_INIT = false;
    bf16_t* Q; const float* SS; const LAS float* tab; int tab_pm;
    __device__ __forceinline__ void operator()(Acc& acc, const Unit& u, int wr, int wc, int fr, int fq) const {
        FOR_AI_M { const int row = EPI_ROWS(ai, m); const float rs = ((u.pm == tab_pm) ? tab[ai * 128 + wr * 64 + m * 16 + fr] : row_rstd(SS, row)) * QSCALE;
            FOR_BJ { const int col = u.pn * 256 + bj * 128 + wc * 32 + 8 * fq; *(u32x4*)(Q + (size_t)row * D + col) = pack8(acc[ai][bj][m][0] * rs, acc[ai][bj][m][1] * rs); } }
    }
};
struct EpiWqk {
    static constexpr bool PERM = true, ACC_INIT = false;
    bf16_t* W;
    __device__ __forceinline__ void operator()(Acc& acc, const Unit& u, int wr, int wc, int fr, int fq) const {
        FOR_AI_M { const int row = u.z * 256 + ai * 128 + wr * 64 + m * 16 + fr;
            FOR_BJ { const int col = u.pn * 256 + bj * 128 + wc * 32 + 8 * fq; *(u32x4*)(W + (size_t)row * D + col) = pack8(acc[ai][bj][m][0], acc[ai][bj][m][1]); } }
    }
};
struct EpiVWo {
    static constexpr bool PERM = true, ACC_INIT = false;
    bf16_t* W;
    __device__ __forceinline__ void operator()(Acc& acc, const Unit& u, int wr, int wc, int fr, int fq) const {
        FOR_AI_M { const int row = EPI_ROWS(ai, m);
            FOR_BJ { const int col = (u.z + u.pn) * 256 + bj * 128 + wc * 32 + 8 * fq; *(u32x4*)(W + (size_t)row * D + col) = pack8(acc[ai][bj][m][0], acc[ai][bj][m][1]); } }
    }
};
struct EpiSoftmax {
    static constexpr bool PERM = true, ACC_INIT = false;
    bf16_t* P; LAS float* tmax; LAS float* tsum; const LAS float* rs;
    __device__ __forceinline__ void operator()(Acc& acc, const Unit& u, int wr, int wc, int fr, int fq) const {
        if (rs) { FOR_AI_M { const float sc = rs[ai * 128 + wr * 64 + m * 16 + fr] * QSCALE;
            FOR_BJ {
#pragma unroll
                for (int n = 0; n < 2; ++n) acc[ai][bj][m][n] = acc[ai][bj][m][n] * sc; } } }
        FOR_AI_M { float mx = -3.0e38f;
            FOR_BJ {
#pragma unroll
                for (int n = 0; n < 2; ++n) { const f32x4 v = acc[ai][bj][m][n]; mx = fmaxf(mx, fmaxf(fmaxf(v[0], v[1]), fmaxf(v[2], v[3]))); } }
            mx = fmaxf(mx, shfl_x(mx, fr + 16 * fq, 16)); mx = fmaxf(mx, shfl_x(mx, fr + 16 * fq, 32));
            if (fq == 0) tmax[(ai * 128 + wr * 64 + m * 16 + fr) * 4 + wc] = mx; }
        LDS_WAIT(); __builtin_amdgcn_s_barrier(); asm volatile("" ::: "memory");
        FOR_AI_M { const int r = ai * 128 + wr * 64 + m * 16 + fr; const f32x4 t = *(const LAS f32x4*)(tmax + r * 4); const float mx = fmaxf(fmaxf(t[0], t[1]), fmaxf(t[2], t[3])); float s = 0.f;
            FOR_BJ {
#pragma unroll
                for (int n = 0; n < 2; ++n) { f32x4 v = acc[ai][bj][m][n];
#pragma unroll
                    for (int j = 0; j < 4; ++j) { v[j] = __builtin_amdgcn_exp2f(v[j] - mx); s += v[j]; }
                    acc[ai][bj][m][n] = v; } }
            s += shfl_x(s, fr + 16 * fq, 16); s += shfl_x(s, fr + 16 * fq, 32);
            if (fq == 0) tsum[r * 4 + wc] = s; }
        LDS_WAIT(); __builtin_amdgcn_s_barrier(); asm volatile("" ::: "memory");
        FOR_AI_M { const int r = ai * 128 + wr * 64 + m * 16 + fr, row = u.pm * 256 + r; const f32x4 t = *(const LAS f32x4*)(tsum + r * 4); const float inv = 1.f / ((t[0] + t[1]) + (t[2] + t[3]));
            FOR_BJ { const int col = (u.z + u.pn) * 256 + bj * 128 + wc * 32 + 8 * fq; *(u32x4*)(P + (size_t)row * D + col) = pack8(acc[ai][bj][m][0] * inv, acc[ai][bj][m][1] * inv); } }
    }
};
struct EpiO {
    static constexpr bool PERM = true, ACC_INIT = false;
    bf16_t* O;
    __device__ __forceinline__ void operator()(Acc& acc, const Unit& u, int wr, int wc, int fr, int fq) const {
        FOR_AI_M { const int row = EPI_ROWS(ai, m);
            FOR_BJ { const int col = u.z * 256 + bj * 128 + wc * 32 + 8 * fq; *(u32x4*)(O + (size_t)row * D + col) = pack8(acc[ai][bj][m][0], acc[ai][bj][m][1]); } }
    }
};
struct EpiUp {
    static constexpr bool PERM = true, ACC_INIT = false;
    bf16_t* U; const float* SS; const LAS float* tab; int tab_pm;
    __device__ __forceinline__ void operator()(Acc& acc, const Unit& u, int wr, int wc, int fr, int fq) const {
        FOR_AI_M { const int row = EPI_ROWS(ai, m); const float rs = (u.pm == tab_pm) ? tab[ai * 128 + wr * 64 + m * 16 + fr] : row_rstd(SS, row);
            FOR_BJ { const int col = u.pn * 256 + bj * 128 + wc * 32 + 8 * fq; f32x4 v0 = acc[ai][bj][m][0] * rs, v1 = acc[ai][bj][m][1] * rs;
#pragma unroll
                for (int j = 0; j < 4; ++j) { const float a = fmaxf(v0[j], 0.f), b = fmaxf(v1[j], 0.f); v0[j] = a * a; v1[j] = b * b; }
                *(u32x4*)(U + (size_t)row * DFF + col) = pack8(v0, v1); } }
    }
};

struct EpiFinal {
    static constexpr bool PERM = false, ACC_INIT = true;
    const bf16_t* base; float* out; const float* gain; float* xch; unsigned* cnt; LAS float* P; LAS float* Sr; int wv;
    __device__ __forceinline__ void init(Acc& acc, const Unit& u, int wr, int wc, int fr, int fq) const {
#pragma unroll
        for (int ai = 0; ai < 2; ++ai)
#pragma unroll
            for (int m = 0; m < 4; ++m) { const size_t off = (size_t)EPI_ROWS(ai, m) * D + u.pn * 256 + wc * 32 + 4 * fq;
#pragma unroll
                for (int bj = 0; bj < 2; ++bj)
#pragma unroll
                    for (int n = 0; n < 2; ++n) { const u32x2 w = *(const u32x2*)(base + off + bj * 128 + 16 * n); acc[ai][bj][m][n] = (f32x4){bf2f(w.x & 0xffffu), bf2f(w.x >> 16), bf2f(w.y & 0xffffu), bf2f(w.y >> 16)}; } }
    }
    __device__ __forceinline__ void operator()(Acc& acc, const Unit& u, int wr, int wc, int fr, int fq) const {
        FOR_AI_M { float ssq = 0.f;
            FOR_BJ {
#pragma unroll
                for (int n = 0; n < 2; ++n) { const f32x4 v = acc[ai][bj][m][n]; ssq += (v[0] * v[0] + v[1] * v[1]) + (v[2] * v[2] + v[3] * v[3]); } }
            ssq += shfl_x(ssq, fr + 16 * fq, 16); ssq += shfl_x(ssq, fr + 16 * fq, 32);
            if (fq == 0) P[(ai * 128 + wr * 64 + m * 16 + fr) * 4 + wc] = ssq; }
        LDS_WAIT(); __builtin_amdgcn_s_barrier(); asm volatile("" ::: "memory");
        const int tid = tidx(wv);
        if (tid < 256) { const f32x4 t = *(const LAS f32x4*)(P + tid * 4);
            __hip_atomic_store(xch + ((size_t)(u.pm * 256 + tid) * 4 + u.pn), (t[0] + t[1]) + (t[2] + t[3]), __ATOMIC_RELAXED, __HIP_MEMORY_SCOPE_AGENT); }
        asm volatile("s_waitcnt vmcnt(0)" ::: "memory"); __builtin_amdgcn_s_barrier(); asm volatile("" ::: "memory");
        if (tid == 0) { unsigned* c = cnt + 16 * u.pm; (void)at_add(c, 1u); unsigned sp = 0; while (at_ld(c) < 4u) { __builtin_amdgcn_s_sleep(1); if (++sp > SPIN_CAP) break; }
            __builtin_amdgcn_fence(__ATOMIC_ACQUIRE, "agent"); asm volatile("s_waitcnt vmcnt(0)" ::: "memory"); }
        __builtin_amdgcn_s_barrier(); asm volatile("" ::: "memory");
        if (tid < 256) { float* x = xch + (size_t)(u.pm * 256 + tid) * 4; float t = 0.f;
#pragma unroll
            for (int j = 0; j < 4; ++j) t += __hip_atomic_load(x + j, __ATOMIC_RELAXED, __HIP_MEMORY_SCOPE_AGENT);
            Sr[tid] = rsqrtf(t * (1.f / D) + EPS); }
        LDS_WAIT(); __builtin_amdgcn_s_barrier(); asm volatile("" ::: "memory");
        f32x4 gv[2][2];
#pragma unroll
        for (int bj = 0; bj < 2; ++bj)
#pragma unroll
            for (int n = 0; n < 2; ++n) gv[bj][n] = *(const f32x4*)(gain + u.pn * 256 + bj * 128 + wc * 32 + 16 * n + 4 * fq);
        FOR_AI_M { const int r = ai * 128 + wr * 64 + m * 16 + fr; const float rs = Sr[r]; float* orow = out + (size_t)(u.pm * 256 + r) * D + u.pn * 256 + wc * 32 + 4 * fq;
            FOR_BJ {
#pragma unroll
                for (int n = 0; n < 2; ++n) *(f32x4*)(orow + bj * 128 + 16 * n) = acc[ai][bj][m][n] * rs * gv[bj][n]; } }
    }
};

struct Ctx {
    const float* in[33]; float* out; unsigned char* ws;
};
__device__ __forceinline__ float wave_sum(float v, int lane) {
#pragma unroll
    for (int o = 1; o < 64; o <<= 1) v += shfl_x(v, lane, o);
    return v;
}
__device__ __forceinline__ float wave_max(float v, int lane) {
#pragma unroll
    for (int o = 1; o < 64; o <<= 1) v = fmaxf(v, shfl_x(v, lane, o));
    return v;
}
__device__ __forceinline__ void transpose_item(const float* W, int ldw, int nblk, bf16_t* WT, int ldt, int row_off, int col_off, const float* ksc, LAS float* scr, int item, int lane) {
    const int kb = item / nblk, nb = item % nblk, k0 = 64 * kb, n0 = 32 * nb;
#pragma unroll
    for (int i = 0; i < 8; ++i) { const int kk = 8 * i + (lane >> 3), nn = 4 * (lane & 7);
        f32x4 v = __builtin_nontemporal_load((const f32x4*)&W[(size_t)(k0 + kk) * ldw + n0 + nn]); if (ksc) v = v * ksc[k0 + kk];
        scr[kk * 33 + nn] = v[0]; scr[kk * 33 + nn + 1] = v[1]; scr[kk * 33 + nn + 2] = v[2]; scr[kk * 33 + nn + 3] = v[3]; }
    LDS_WAIT(); asm volatile("" ::: "memory");
    const int c = lane & 7;
#pragma unroll
    for (int j = 0; j < 4; ++j) { const int n = (lane >> 3) + 8 * j; const LAS float* s = scr + (8 * c) * 33 + n;
        u32x4 o; o.x = pk2(s[0 * 33], s[1 * 33]); o.y = pk2(s[2 * 33], s[3 * 33]); o.z = pk2(s[4 * 33], s[5 * 33]); o.w = pk2(s[6 * 33], s[7 * 33]);
        *(u32x4*)(WT + (size_t)(row_off + n0 + n) * ldt + col_off + k0 + 8 * c) = o; }
    LDS_WAIT(); asm volatile("" ::: "memory");
}
__device__ __forceinline__ void rms_row_to_bf16(const float* xrow, const float* g, bf16_t* orow, int lane) {
    const f32x4* xr = (const f32x4*)xrow + lane; const f32x4* gr = (const f32x4*)g + lane;
    f32x4 v[4]; float s = 0.f;
#pragma unroll
    for (int j = 0; j < 4; ++j) { v[j] = __builtin_nontemporal_load(&xr[64 * j]); s += (v[j].x * v[j].x + v[j].y * v[j].y) + (v[j].z * v[j].z + v[j].w * v[j].w); }
    const float rs = rsqrtf(wave_sum(s, lane) * (1.f / D) + EPS);
    u32x2* o8 = (u32x2*)orow + lane;
#pragma unroll
    for (int j = 0; j < 4; ++j) { const f32x4 gg = gr[64 * j]; u32x2 w; w.x = pk2(v[j].x * rs * gg.x, v[j].y * rs * gg.y); w.y = pk2(v[j].z * rs * gg.z, v[j].w * rs * gg.w); o8[64 * j] = w; }
}

__device__ __forceinline__ void p0_prologue(const Ctx& C, LAS unsigned char* lds, int G, int bid, int wv) {
    const int tid = tidx(wv), lane = tid & 63, wave = tid >> 6;
    LAS float* scr = (LAS float*)(lds + wave * 16384);
    const int gw = bid * 8 + wave, NGW = G * 8;
    unsigned char* ws = C.ws;
    constexpr int I_SQ = 16 * 32, I_UP = 16 * 128, I_DN = 64 * 32, I_GLU = 8 * 16, I_PL = 8 * 32;
    constexpr int NIT = 6 * I_SQ + I_UP + I_DN + I_GLU + I_PL;
    for (int it = gw; it < NIT; it += NGW) {
        int r = it;
        if (r < I_SQ) { transpose_item(C.in[9], D, 32, (bf16_t*)(ws + WS_WIN), D, 0, 0, nullptr, scr, r, lane); continue; } r -= I_SQ;
        if (r < I_SQ) { transpose_item(C.in[22], D, 32, (bf16_t*)(ws + WS_WOUT), D, 0, 0, nullptr, scr, r, lane); continue; } r -= I_SQ;
        if (r < I_SQ) { transpose_item(C.in[25], D, 32, (bf16_t*)(ws + WS_WQ), D, 0, 0, C.in[23], scr, r, lane); continue; } r -= I_SQ;
        if (r < I_SQ) { transpose_item(C.in[26], D, 32, (bf16_t*)(ws + WS_WKV), D, 0, 0, nullptr, scr, r, lane); continue; } r -= I_SQ;
        if (r < I_SQ) { transpose_item(C.in[27], D, 32, (bf16_t*)(ws + WS_WKV), D, D, 0, nullptr, scr, r, lane); continue; } r -= I_SQ;
        if (r < I_SQ) { transpose_item(C.in[28], D, 32, (bf16_t*)(ws + WS_WO), D, 0, 0, nullptr, scr, r, lane); continue; } r -= I_SQ;
        if (r < I_UP) { transpose_item(C.in[30], DFF, 128, (bf16_t*)(ws + WS_WUP), D, 0, 0, C.in[29], scr, r, lane); continue; } r -= I_UP;
        if (r < I_DN) { transpose_item(C.in[31], D, 32, (bf16_t*)(ws + WS_WDOWN), DFF, 0, 0, nullptr, scr, r, lane); continue; } r -= I_DN;
        if (r < I_GLU) { transpose_item(C.in[20], DSSM, 16, (bf16_t*)(ws + WS_WGLU), DSSM, 0, 0, nullptr, scr, r, lane); continue; } r -= I_GLU;
        transpose_item(C.in[22] + (size_t)DPOOL * D, D, 32, (bf16_t*)(ws + WS_WOUT2), D, 0, DPOOL, nullptr, scr, r, lane);
    }
    const int gt = bid * 512 + tid, NGT = G * 512;
    { bf16_t* WP = (bf16_t*)(ws + WS_WPOOL); const float* wp = C.in[10]; const float* sc = C.in[11];
      for (int i = gt; i < 512 * 512 / 8; i += NGT) { const int c = i / 64, d0 = (i % 64) * 8; u32x4 o = {0u, 0u, 0u, 0u};
          if ((c >> 7) == (d0 >> 7)) { const float* src = wp + ((size_t)(c >> 7) * 128 + (c & 127)) * 128 + (d0 & 127); const f32x4 a = *(const f32x4*)src, b = *(const f32x4*)(src + 4), s0 = *(const f32x4*)(sc + d0), s1 = *(const f32x4*)(sc + d0 + 4);
              o.x = pk2(a[0] * s0[0], a[1] * s0[1]); o.y = pk2(a[2] * s0[2], a[3] * s0[3]); o.z = pk2(b[0] * s1[0], b[1] * s1[1]); o.w = pk2(b[2] * s1[2], b[3] * s1[3]); }
          *(u32x4*)(WP + (size_t)c * DPOOL + d0) = o; }
    }
    { const float* Wq = C.in[25]; const float* gx = C.in[23]; bf16_t* WQN = (bf16_t*)(ws + WS_WQN);
      for (int i = gt; i < D * D / 8; i += NGT) { const int k = i >> 7; const float gk = gx[k]; const f32x4 a = *(const f32x4*)(Wq + (size_t)i * 8), b = *(const f32x4*)(Wq + (size_t)i * 8 + 4);
          u32x4 o; o.x = pk2(a[0] * gk, a[1] * gk); o.y = pk2(a[2] * gk, a[3] * gk); o.z = pk2(b[0] * gk, b[1] * gk); o.w = pk2(b[2] * gk, b[3] * gk); *(u32x4*)(WQN + (size_t)i * 8) = o; } }
    { bf16_t* H1 = (bf16_t*)(ws + WS_T0); bf16_t* MN = (bf16_t*)(ws + WS_MN);
      auto src = [&](int m) -> const f32x4* { return (const f32x4*)(m < SEQ ? C.in[0] + (size_t)m * D : (m < M ? C.in[1] + (size_t)(m - SEQ) * D : C.in[7] + (size_t)(m - M) * D)) + lane; };
      int m = NGW - 1 - gw; f32x4 nx[4], ny[4];
      if (m < M + NMEM) { const f32x4* xr = src(m);
#pragma unroll
          for (int j = 0; j < 4; ++j) nx[j] = __builtin_nontemporal_load(&xr[64 * j]); }
      if (m + NGW < M + NMEM) { const f32x4* xr = src(m + NGW);
#pragma unroll
          for (int j = 0; j < 4; ++j) ny[j] = __builtin_nontemporal_load(&xr[64 * j]); }
      for (; m < M + NMEM; m += NGW) { f32x4 v[4];
#pragma unroll
          for (int j = 0; j < 4; ++j) { v[j] = nx[j]; nx[j] = ny[j]; }
          if (m + 2 * NGW < M + NMEM) { const f32x4* xr = src(m + 2 * NGW);
#pragma unroll
              for (int j = 0; j < 4; ++j) ny[j] = __builtin_nontemporal_load(&xr[64 * j]); }
          float ss = 0.f;
#pragma unroll
          for (int j = 0; j < 4; ++j) ss += (v[j].x * v[j].x + v[j].y * v[j].y) + (v[j].z * v[j].z + v[j].w * v[j].w);
          const float rs = rsqrtf(wave_sum(ss, lane) * (1.f / D) + EPS);
          const f32x4* gr = (const f32x4*)(m < M ? C.in[8] : C.in[24]) + lane; u32x2* o8 = (u32x2*)(m < M ? H1 + (size_t)m * D : MN + (size_t)(m - M) * D) + lane;
#pragma unroll
          for (int j = 0; j < 4; ++j) { const f32x4 gg = gr[64 * j]; u32x2 w; w.x = pk2(v[j].x * rs * gg.x, v[j].y * rs * gg.y); w.y = pk2(v[j].z * rs * gg.z, v[j].w * rs * gg.w); o8[64 * j] = w; } } }
    { float* AP = (float*)(ws + WS_AP); float* BB = (float*)(ws + WS_BB);
      for (int i = gt; i < NG * NP; i += NGT) { const int g = i / NP, p = i % NP;
          const float are = C.in[12][i], aim = C.in[13][i], dt = expf(C.in[19][g]);
          const float mag = expf(are * dt); float sn, cs; sincosf(aim * dt, &sn, &cs);
          const float abr = mag * cs, abi = mag * sn;
          float pr = 1.f, pi = 0.f;
          for (int k = 0; k <= 16; ++k) { AP[((size_t)(g * 17 + k) * NP + p) * 2] = pr; AP[((size_t)(g * 17 + k) * NP + p) * 2 + 1] = pi; const float nr = pr * abr - pi * abi, ni = pr * abi + pi * abr; pr = nr; pi = ni; }
          const float nr = abr - 1.f, ni = abi, den = are * are + aim * aim; const float cr = (nr * are + ni * aim) / den, ci = (ni * are - nr * aim) / den;
          for (int h = 0; h < NH; ++h) { const float br = C.in[14][(size_t)i * NH + h], bi = C.in[15][(size_t)i * NH + h];
              BB[((size_t)i * NH + h) * 2] = cr * br - ci * bi; BB[((size_t)i * NH + h) * 2 + 1] = cr * bi + ci * br; } } }
}
__device__ __forceinline__ void p1_pre(const Ctx& C, int G, int bid, int wv) {
    const int gt = bid * 512 + tidx(wv), NGT = G * 512; unsigned char* ws = C.ws;
    const float* AP = (const float*)(ws + WS_AP); const float* BB = (const float*)(ws + WS_BB); float* KL = (float*)(ws + WS_KLAG); bf16_t* WB = (bf16_t*)(ws + WS_WB);
    for (int i = gt; i < NG * 16 * 16 * 16; i += NGT) { const int hp = i & 15, h = (i >> 4) & 15, k = (i >> 8) & 15, g = i >> 12; float s = 0.f;
        const f32x4* crp = (const f32x4*)(C.in[16] + ((size_t)g * NH + h) * NP); const f32x4* cip = (const f32x4*)(C.in[17] + ((size_t)g * NH + h) * NP);
        const f32x4* app = (const f32x4*)(AP + (size_t)(g * 17 + k) * NP * 2); const f32x2* bbp = (const f32x2*)(BB + ((size_t)g * NP * NH + hp) * 2);
#pragma unroll 4
        for (int p4 = 0; p4 < NP / 4; ++p4) { const f32x4 cr = crp[p4], ci = cip[p4], a0 = app[2 * p4], a1 = app[2 * p4 + 1];
            const f32x2 b0 = bbp[(4 * p4 + 0) * NH], b1 = bbp[(4 * p4 + 1) * NH], b2 = bbp[(4 * p4 + 2) * NH], b3 = bbp[(4 * p4 + 3) * NH];
            s += cr[0] * (a0[0] * b0.x - a0[1] * b0.y) - ci[0] * (a0[0] * b0.y + a0[1] * b0.x);
            s += cr[1] * (a0[2] * b1.x - a0[3] * b1.y) - ci[1] * (a0[2] * b1.y + a0[3] * b1.x);
            s += cr[2] * (a1[0] * b2.x - a1[1] * b2.y) - ci[2] * (a1[0] * b2.y + a1[1] * b2.x);
            s += cr[3] * (a1[2] * b3.x - a1[3] * b3.y) - ci[3] * (a1[2] * b3.y + a1[3] * b3.x); }
        if (k == 0 && h == hp) s += C.in[18][g * NH + h];
        KL[i] = s; }
    for (int it = gt; it < NG * 256 * 32; it += NGT) { const int k8 = it & 31, n = (it >> 5) & 255, g = it >> 13; u32x4 o = {0u, 0u, 0u, 0u};
        if (n < 128) { const int p = n & 63, sidx = k8 >> 1, hp0 = (k8 & 1) * 8; const f32x2 a = *(const f32x2*)(AP + ((size_t)(g * 17 + 15 - sidx) * NP + p) * 2);
            const f32x4* bb = (const f32x4*)(BB + ((size_t)(g * NP + p) * NH + hp0) * 2); const f32x4 q0 = bb[0], q1 = bb[1], q2 = bb[2], q3 = bb[3];
            float v[8];
            if (n < 64) { v[0] = a.x * q0[0] - a.y * q0[1]; v[1] = a.x * q0[2] - a.y * q0[3]; v[2] = a.x * q1[0] - a.y * q1[1]; v[3] = a.x * q1[2] - a.y * q1[3];
                          v[4] = a.x * q2[0] - a.y * q2[1]; v[5] = a.x * q2[2] - a.y * q2[3]; v[6] = a.x * q3[0] - a.y * q3[1]; v[7] = a.x * q3[2] - a.y * q3[3]; }
            else {        v[0] = a.x * q0[1] + a.y * q0[0]; v[1] = a.x * q0[3] + a.y * q0[2]; v[2] = a.x * q1[1] + a.y * q1[0]; v[3] = a.x * q1[3] + a.y * q1[2];
                          v[4] = a.x * q2[1] + a.y * q2[0]; v[5] = a.x * q2[3] + a.y * q2[2]; v[6] = a.x * q3[1] + a.y * q3[0]; v[7] = a.x * q3[3] + a.y * q3[2]; }
            o.x = pk2(v[0], v[1]); o.y = pk2(v[2], v[3]); o.z = pk2(v[4], v[5]); o.w = pk2(v[6], v[7]); }
        *(u32x4*)(WB + (size_t)it * 8) = o; }
}
__device__ __forceinline__ void wy_gen(const Ctx& C, int it0, int it1, int start, int stride) {
    unsigned char* ws = C.ws;
    const float* AP = (const float*)(ws + WS_AP); const float* KL = (const float*)(ws + WS_KLAG); bf16_t* WY = (bf16_t*)(ws + WS_WY);
    for (int it = it0 + start; it < it1; it += stride) { const int k8 = it % (KY / 8), n = (it / (KY / 8)) & 255, g = it / ((KY / 8) * 256), t = n >> 4, h = n & 15, k0 = k8 * 8; float v[8];
        if (k0 < 256) { const int sidx = k0 >> 4, hp0 = k0 & 15; f32x4 q0 = {0.f, 0.f, 0.f, 0.f}, q1 = q0;
            if (sidx <= t) { const f32x4* kp = (const f32x4*)(KL + (((size_t)g * 16 + (t - sidx)) * 16 + h) * 16 + hp0); q0 = kp[0]; q1 = kp[1]; }
            v[0] = q0[0]; v[1] = q0[1]; v[2] = q0[2]; v[3] = q0[3]; v[4] = q1[0]; v[5] = q1[1]; v[6] = q1[2]; v[7] = q1[3]; }
        else { const int p0 = (k0 - 256) & 63; const f32x4* crp = (const f32x4*)(C.in[16] + ((size_t)g * NH + h) * NP + p0); const f32x4* cip = (const f32x4*)(C.in[17] + ((size_t)g * NH + h) * NP + p0);
            const f32x4* app = (const f32x4*)(AP + ((size_t)(g * 17 + t + 1) * NP + p0) * 2);
            const f32x4 cr0 = crp[0], cr1 = crp[1], ci0 = cip[0], ci1 = cip[1], a0 = app[0], a1 = app[1], a2 = app[2], a3 = app[3];
            const float cr[8] = {cr0[0], cr0[1], cr0[2], cr0[3], cr1[0], cr1[1], cr1[2], cr1[3]}, ci[8] = {ci0[0], ci0[1], ci0[2], ci0[3], ci1[0], ci1[1], ci1[2], ci1[3]};
            const float ar[8] = {a0[0], a0[2], a1[0], a1[2], a2[0], a2[2], a3[0], a3[2]}, ai[8] = {a0[1], a0[3], a1[1], a1[3], a2[1], a2[3], a3[1], a3[3]};
#pragma unroll
            for (int e = 0; e < 8; ++e) v[e] = (k0 < 320) ? (cr[e] * ar[e] - ci[e] * ai[e]) : -(cr[e] * ai[e] + ci[e] * ar[e]); }
        u32x4 o; o.x = pk2(v[0], v[1]); o.y = pk2(v[2], v[3]); o.z = pk2(v[4], v[5]); o.w = pk2(v[6], v[7]);
        *(u32x4*)(WY + (size_t)it * 8) = o; }
}
__device__ __forceinline__ void p2b_prefix(const Ctx& C, LAS unsigned char* lds, int g, int tile, int wv) {
    const int p = lane_id(); unsigned char* ws = C.ws;
    const float* AP = (const float*)(ws + WS_AP); const float* E = (const float*)(ws + WS_E) + (size_t)g * NCHP * 128; bf16_t* UH = (bf16_t*)(ws + WS_UH) + (size_t)g * NCHP * KY;
    LAS float* L = (LAS float*)lds;
    const float ar = AP[((size_t)(g * 17 + 16) * NP + p) * 2], ai = AP[((size_t)(g * 17 + 16) * NP + p) * 2 + 1];
    if (tile < 4) {
    float hr[4] = {0.f, 0.f, 0.f, 0.f}, hi[4] = {0.f, 0.f, 0.f, 0.f};
    for (int cc = 0; cc < 32; cc += 8) { float er[4][8], ei[4][8];
#pragma unroll
        for (int ch = 0; ch < 4; ++ch)
#pragma unroll
            for (int j = 0; j < 8; ++j) { const size_t c = (size_t)((wv * 4 + ch) * 32 + cc + j); er[ch][j] = E[c * 128 + p]; ei[ch][j] = E[c * 128 + 64 + p]; }
#pragma unroll
        for (int j = 0; j < 8; ++j)
#pragma unroll
            for (int ch = 0; ch < 4; ++ch) { const float nr = ar * hr[ch] - ai * hi[ch] + er[ch][j], ni = ar * hi[ch] + ai * hr[ch] + ei[ch][j]; hr[ch] = nr; hi[ch] = ni; } }
#pragma unroll
    for (int ch = 0; ch < 4; ++ch) { L[((wv * 4 + ch) * 64 + p) * 2] = hr[ch]; L[((wv * 4 + ch) * 64 + p) * 2 + 1] = hi[ch]; }
    float sr = ar, si = ai;
#pragma unroll
    for (int j = 0; j < 5; ++j) { const float nr = sr * sr - si * si, ni = 2.f * sr * si; sr = nr; si = ni; }
    __syncthreads();
    float Hr = 0.f, Hi = 0.f;
    for (int j = 0; j < wv * 4; ++j) { const float lr = L[(j * 64 + p) * 2], li = L[(j * 64 + p) * 2 + 1]; const float nr = sr * Hr - si * Hi + lr, ni = sr * Hi + si * Hr + li; Hr = nr; Hi = ni; }
#pragma unroll
    for (int ch = 0; ch < 4; ++ch) { hr[ch] = Hr; hi[ch] = Hi; const float lr = L[((wv * 4 + ch) * 64 + p) * 2], li = L[((wv * 4 + ch) * 64 + p) * 2 + 1];
        const float nr = sr * Hr - si * Hi + lr, ni = sr * Hi + si * Hr + li; Hr = nr; Hi = ni; }
    if (wv == 7 && tile == 3) { C.out[O_SREP + g * NP + p] = Hr; C.out[O_SIMP + g * NP + p] = Hi; }
    if ((wv >> 1) == tile)
    for (int cc = 0; cc < 32; cc += 8) { float er[4][8], ei[4][8];
#pragma unroll
        for (int ch = 0; ch < 4; ++ch)
#pragma unroll
            for (int j = 0; j < 8; ++j) { const size_t c = (size_t)((wv * 4 + ch) * 32 + cc + j); er[ch][j] = E[c * 128 + p]; ei[ch][j] = E[c * 128 + 64 + p]; }
#pragma unroll
        for (int j = 0; j < 8; ++j)
#pragma unroll
            for (int ch = 0; ch < 4; ++ch) { const size_t c = (size_t)((wv * 4 + ch) * 32 + cc + j);
                UH[c * KY + 256 + p] = (bf16_t)f2bf(hr[ch]); UH[c * KY + 320 + p] = (bf16_t)f2bf(hi[ch]);
                const float nr = ar * hr[ch] - ai * hi[ch] + er[ch][j], ni = ar * hi[ch] + ai * hr[ch] + ei[ch][j]; hr[ch] = nr; hi[ch] = ni; } }
    } else
    for (int b = wv; b < 16; b += 8) { const float h0r = C.in[5][((size_t)b * NG + g) * NP + p], h0i = C.in[6][((size_t)b * NG + g) * NP + p]; const int c = 1024 + b;
        UH[(size_t)c * KY + 256 + p] = (bf16_t)f2bf(h0r); UH[(size_t)c * KY + 320 + p] = (bf16_t)f2bf(h0i);
        C.out[O_SRES + ((size_t)b * NG + g) * NP + p] = ar * h0r - ai * h0i + E[(size_t)c * 128 + p];
        C.out[O_SIMS + ((size_t)b * NG + g) * NP + p] = ar * h0i + ai * h0r + E[(size_t)c * 128 + 64 + p]; }
    __syncthreads();
}
__device__ __forceinline__ void p2b_pool(const Ctx& C, int worker, int nworkers, int wv) {
    const int cl = lane_id() * 8; unsigned char* ws = C.ws;
    const bf16_t* ZP = (const bf16_t*)(ws + WS_ZP); bf16_t* MIX = (bf16_t*)(ws + WS_T2);
    const int w = 2 << (cl >> 7);
    for (int blk = worker * 8 + wv; blk < M / 8; blk += nworkers * 8) { const int r0 = blk * 8;
        if (r0 < SEQ) {
#pragma unroll 2
            for (int t = 0; t < 8; ++t) { const int row = r0 + t; u32x4 q[16];
#pragma unroll
                for (int j = 0; j < 16; ++j) { const int rr = row - j; q[j] = *(const u32x4*)(ZP + (size_t)(rr < 0 ? 0 : rr) * DPOOL + cl); }
                float s[8], cur[8]; unpack8(q[0], cur);
#pragma unroll
                for (int e = 0; e < 8; ++e) s[e] = cur[e];
#pragma unroll
                for (int j = 1; j < 16; ++j) { float v[8]; unpack8(q[j], v); const float mk = (j < w && row - j >= 0) ? 1.f : 0.f;
#pragma unroll
                    for (int e = 0; e < 8; ++e) s[e] += mk * v[e]; }
                const int cnt = (row + 1 < w) ? row + 1 : w; const float inv = 1.f / (float)cnt;
                u32x4 o; o.x = pk2(s[0] * inv - cur[0], s[1] * inv - cur[1]); o.y = pk2(s[2] * inv - cur[2], s[3] * inv - cur[3]); o.z = pk2(s[4] * inv - cur[4], s[5] * inv - cur[5]); o.w = pk2(s[6] * inv - cur[6], s[7] * inv - cur[7]);
                *(u32x4*)(MIX + (size_t)row * D + cl) = o; }
        } else { const int b = (r0 - SEQ) >> 4, t0 = r0 & 15;
            for (int tt = 0; tt < 8; ++tt) { const int t = t0 + tt, row = r0 + tt; float s[8] = {0.f, 0.f, 0.f, 0.f, 0.f, 0.f, 0.f, 0.f}; float cur[8];
                for (int j = 0; j < w; ++j) { float v[8];
                    if (t - j >= 0) unpack8(*(const u32x4*)(ZP + (size_t)(row - j) * DPOOL + cl), v);
                    else { const float* hp = C.in[4] + ((size_t)b * 15 + (15 + t - j)) * DPOOL + cl; const f32x4 a = *(const f32x4*)hp, bb = *(const f32x4*)(hp + 4);
                        v[0] = a[0]; v[1] = a[1]; v[2] = a[2]; v[3] = a[3]; v[4] = bb[0]; v[5] = bb[1]; v[6] = bb[2]; v[7] = bb[3]; }
#pragma unroll
                    for (int e = 0; e < 8; ++e) { s[e] += v[e]; if (j == 0) cur[e] = v[e]; } }
                const float inv = 1.f / (float)w;
                u32x4 o; o.x = pk2(s[0] * inv - cur[0], s[1] * inv - cur[1]); o.y = pk2(s[2] * inv - cur[2], s[3] * inv - cur[3]); o.z = pk2(s[4] * inv - cur[4], s[5] * inv - cur[5]); o.w = pk2(s[6] * inv - cur[6], s[7] * inv - cur[7]);
                *(u32x4*)(MIX + (size_t)row * D + cl) = o; } } }
}
__device__ __forceinline__ void sample_attn_item(const Ctx& C, LAS unsigned char* lds, int item, int wv) {
    const int lane = lane_id(), fr = lane & 15, fq = lane >> 4; const int b = item >> 4, h = (item >> 2) & 3, dq = item & 3; unsigned char* ws = C.ws;
    const bf16_t* Q = (const bf16_t*)(ws + WS_T1); bf16_t* O = (bf16_t*)(ws + WS_OB);
    const float* Kc = C.in[2] + (size_t)b * NMEM * D + h * HD; const float* Vc = C.in[3] + (size_t)b * NMEM * D + h * HD + dq * 64;
    LAS float* Sl = (LAS float*)lds;
    LAS float* PT = (LAS float*)(lds + 16384);
    LAS float* red = (LAS float*)(lds + 32768);
    float vv[32];
#pragma unroll
    for (int j = 0; j < 32; ++j) vv[j] = __builtin_nontemporal_load(&Vc[(size_t)(wv * 32 + j) * D + lane]);
    bf16x8 qf[8];
#pragma unroll
    for (int kk = 0; kk < 8; ++kk) qf[kk] = *(const bf16x8*)(Q + (size_t)(SEQ + b * 16 + fr) * D + h * HD + kk * 32 + fq * 8);
#pragma unroll
    for (int kbi = 0; kbi < 2; ++kbi) { const int kb = wv + 8 * kbi; f32x4 acc = {0.f, 0.f, 0.f, 0.f}; const float* kr = Kc + (size_t)(kb * 16 + fr) * D + fq * 8;
#pragma unroll
        for (int kk = 0; kk < 8; ++kk) { const f32x4 a = __builtin_nontemporal_load((const f32x4*)(kr + kk * 32)), c = __builtin_nontemporal_load((const f32x4*)(kr + kk * 32 + 4)); const u32x4 w = pack8(a, c);
            acc = __builtin_amdgcn_mfma_f32_16x16x32_bf16(qf[kk], __builtin_bit_cast(bf16x8, w), acc, 0, 0, 0); }
#pragma unroll
        for (int r = 0; r < 4; ++r) Sl[(4 * fq + r) * 256 + kb * 16 + fr] = acc[r]; }
    __syncthreads();
#pragma unroll
    for (int rr = 0; rr < 2; ++rr) { const int s = wv * 2 + rr; float v[4]; float mx = -3.0e38f;
#pragma unroll
        for (int j = 0; j < 4; ++j) { v[j] = Sl[s * 256 + lane + 64 * j]; mx = fmaxf(mx, v[j]); }
        mx = wave_max(mx, lane); float sum = 0.f;
#pragma unroll
        for (int j = 0; j < 4; ++j) { v[j] = __builtin_amdgcn_exp2f(v[j] - mx); sum += v[j]; }
        const float inv = 1.f / wave_sum(sum, lane);
#pragma unroll
        for (int j = 0; j < 4; ++j) PT[(lane + 64 * j) * 16 + s] = v[j] * inv; }
    __syncthreads();
    { float o[16];
#pragma unroll
      for (int s = 0; s < 16; ++s) o[s] = 0.f;
#pragma unroll
      for (int j = 0; j < 32; ++j) { const LAS f32x4* pp = (const LAS f32x4*)(PT + (wv * 32 + j) * 16);
#pragma unroll
          for (int q4 = 0; q4 < 4; ++q4) { const f32x4 pv = pp[q4]; o[4 * q4 + 0] += pv[0] * vv[j]; o[4 * q4 + 1] += pv[1] * vv[j]; o[4 * q4 + 2] += pv[2] * vv[j]; o[4 * q4 + 3] += pv[3] * vv[j]; } }
#pragma unroll
      for (int s = 0; s < 16; ++s) red[(wv * 16 + s) * 64 + lane] = o[s]; }
    __syncthreads();
    { const int tid = wv * 64 + lane, s = tid >> 5, dp = (tid & 31) * 2; float o0 = 0.f, o1 = 0.f;
#pragma unroll
      for (int w = 0; w < 8; ++w) { const f32x2 t = *(const LAS f32x2*)(red + (w * 16 + s) * 64 + dp); o0 += t.x; o1 += t.y; }
      *(unsigned*)(O + (size_t)(SEQ + b * 16 + s) * D + h * HD + dq * 64 + dp) = pk2(o0, o1); }
    __syncthreads();
}

template <class Epi8>
__device__ __forceinline__ void skinny_gemm(LAS unsigned char* lds, const bf16_t* A, int lda, const bf16_t* Bt, int ldb, int N, int K, int ksplit, const Epi8& E, int G, int bid, int wv) {
    const int lane = lane_id(), fr = lane & 15, fq = lane >> 4;
    const int ntn = N / 64, per = 4 * ntn, ntiles = per * ksplit, kw = K / ksplit / 8;
    LAS float* red = (LAS float*)lds;
    for (int t = bid; t < ntiles; t += G) {
        const int ks = t / per, tt = t % per, tm = tt & 3, tn = tt >> 2, kbeg = ks * (K / ksplit) + wv * kw;
        f32x4 acc[4][4];
#pragma unroll
        for (int i = 0; i < 4; ++i)
#pragma unroll
            for (int j = 0; j < 4; ++j) acc[i][j] = (f32x4){0.f, 0.f, 0.f, 0.f};
        const bf16_t* ap = A + (size_t)(tm * 64 + fr) * lda + kbeg + fq * 8;
        const bf16_t* bp = Bt + (size_t)(tn * 64 + fr) * ldb + kbeg + fq * 8;
#pragma unroll 4
        for (int k = 0; k < kw; k += 32) { bf16x8 af[4], bfr[4];
#pragma unroll
            for (int i = 0; i < 4; ++i) { af[i] = *(const bf16x8*)(ap + (size_t)i * 16 * lda + k); bfr[i] = *(const bf16x8*)(bp + (size_t)i * 16 * ldb + k); }
#pragma unroll
            for (int i = 0; i < 4; ++i)
#pragma unroll
                for (int j = 0; j < 4; ++j) acc[i][j] = __builtin_amdgcn_mfma_f32_16x16x32_bf16(bfr[j], af[i], acc[i][j], 0, 0, 0); }
#pragma unroll
        for (int i = 0; i < 4; ++i)
#pragma unroll
            for (int j = 0; j < 4; ++j) *(LAS f32x4*)(red + ((wv * 64 + i * 16 + fr) * 64 + (((j * 4 + fq) ^ fr) << 2))) = acc[i][j];
        __syncthreads();
        { const int tid = wv * 64 + lane, row = tid >> 3, s8 = (tid & 7) * 2; f32x4 s0 = {0.f, 0.f, 0.f, 0.f}, s1 = {0.f, 0.f, 0.f, 0.f};
#pragma unroll
          for (int w = 0; w < 8; ++w) { s0 += *(const LAS f32x4*)(red + ((w * 64 + row) * 64 + ((s8 ^ (row & 15)) << 2))); s1 += *(const LAS f32x4*)(red + ((w * 64 + row) * 64 + (((s8 + 1) ^ (row & 15)) << 2))); }
          E(tm * 64 + row, tn * 64 + s8 * 4, s0, s1, lane, ks); }
        __syncthreads();
    }
}
__device__ __forceinline__ u32x2 pack4(const f32x4 v) { u32x2 w; w.x = cvt_pk_bf16(v[0], v[1]); w.y = cvt_pk_bf16(v[2], v[3]); return w; }
struct SkZ { bf16_t* ZP; bf16_t* UH; float* out;
    __device__ __forceinline__ void operator()(int r, int c, f32x4 v0, f32x4 v1, int, int) const { const int row = SEQ + r; const u32x4 w = pack8(v0, v1);
        if (c < DPOOL) { *(u32x4*)(ZP + (size_t)row * DPOOL + c) = w; if ((r & 15) != 0) { float* dst = out + O_POOLS + ((size_t)(r >> 4) * 15 + ((r & 15) - 1)) * DPOOL + c; *(f32x4*)dst = v0; *(f32x4*)(dst + 4) = v1; } }
        else { const int cc = c - DPOOL, gg = cc >> 4, hh = cc & 15; *(u32x4*)(UH + ((size_t)gg * NCHP + (row >> 4)) * KY + (row & 15) * 16 + hh) = w; } } };
struct SkKV { float* out; bf16_t* KB; bf16_t* VT;
    __device__ __forceinline__ void operator()(int r, int c, f32x4 v0, f32x4 v1, int, int) const {
        if (c < D) { float* dst = out + O_MK + (size_t)r * D + c; *(f32x4*)dst = v0; *(f32x4*)(dst + 4) = v1; *(u32x4*)(KB + (size_t)r * D + c) = pack8(v0, v1); }
        else { const int c2 = c - D; float* dst = out + O_MV + (size_t)r * D + c2; *(f32x4*)dst = v0; *(f32x4*)(dst + 4) = v1;
            *(u32x4*)(VT + (size_t)r * D + c2) = pack8(v0, v1); } } };
struct SkPool { bf16_t* CAT; const float* scale;
    __device__ __forceinline__ void operator()(int r, int c, f32x4 v0, f32x4 v1, int, int) const { *(u32x4*)(CAT + (size_t)(SEQ + r) * D + c) = pack8(v0 * *(const f32x4*)(scale + c), v1 * *(const f32x4*)(scale + c + 4)); } };
struct SkGlu { bf16_t* CAT; const bf16_t* MIX; const float* bias;
    __device__ __forceinline__ void operator()(int r, int c, f32x4 v0, f32x4 v1, int, int) const { float y[8]; unpack8(*(const u32x4*)(MIX + (size_t)(SEQ + r) * D + DPOOL + c), y);
        const f32x4 b0 = *(const f32x4*)(bias + c), b1 = *(const f32x4*)(bias + c + 4);
#pragma unroll
        for (int j = 0; j < 4; ++j) { v0[j] = y[j] / (1.f + __expf(-(v0[j] + b0[j]))); v1[j] = y[4 + j] / (1.f + __expf(-(v1[j] + b1[j]))); }
        *(u32x4*)(CAT + (size_t)(SEQ + r) * D + DPOOL + c) = pack8(v0, v1); } };
template <bool BASE_BF16> struct SkRes { const void* base; bf16_t* Xb; float* SS;
    __device__ __forceinline__ void operator()(int r, int c, f32x4 v0, f32x4 v1, int lane, int) const { f32x4 x0, x1;
        if constexpr (BASE_BF16) { float y[8]; unpack8(*(const u32x4*)((const bf16_t*)base + (size_t)r * D + c), y); x0 = v0 + (f32x4){y[0], y[1], y[2], y[3]}; x1 = v1 + (f32x4){y[4], y[5], y[6], y[7]}; }
        else { const float* bp = (const float*)base + (size_t)r * D + c; x0 = v0 + *(const f32x4*)bp; x1 = v1 + *(const f32x4*)(bp + 4); }
        *(u32x4*)(Xb + (size_t)r * D + c) = pack8(x0, x1);
        float q = ((x0[0] * x0[0] + x0[1] * x0[1]) + (x0[2] * x0[2] + x0[3] * x0[3])) + ((x1[0] * x1[0] + x1[1] * x1[1]) + (x1[2] * x1[2] + x1[3] * x1[3]));
        q += shfl_x(q, lane, 1); q += shfl_x(q, lane, 2); q += shfl_x(q, lane, 4);
        if ((lane & 7) == 0) SS[(size_t)r * 16 + (c >> 6)] = q; } };
struct SkQ { bf16_t* Q; const float* SS;
    __device__ __forceinline__ void operator()(int r, int c, f32x4 v0, f32x4 v1, int, int) const { const float rs = row_rstd(SS, r) * QSCALE; *(u32x4*)(Q + (size_t)r * D + c) = pack8(v0 * rs, v1 * rs); } };
struct SkUp { bf16_t* U; const float* SS;
    __device__ __forceinline__ void operator()(int r, int c, f32x4 v0, f32x4 v1, int, int) const { const float rs = row_rstd(SS, r);
#pragma unroll
        for (int j = 0; j < 4; ++j) { const float a = fmaxf(v0[j] * rs, 0.f), b = fmaxf(v1[j] * rs, 0.f); v0[j] = a * a; v1[j] = b * b; }
        *(u32x4*)(U + (size_t)r * DFF + c) = pack8(v0, v1); } };
struct SkSlab { float* slab;
    __device__ __forceinline__ void operator()(int r, int c, f32x4 v0, f32x4 v1, int, int ks) const { float* dst = slab + ((size_t)ks * NSAMP + r) * D + c;
        asm volatile("global_store_dwordx4 %0, %1, off sc0 sc1\n\ts_nop 1" :: "v"(dst), "v"(v0) : "memory");
        asm volatile("global_store_dwordx4 %0, %1, off offset:16 sc0 sc1\n\ts_nop 1" :: "v"(dst), "v"(v1) : "memory"); } };
#define XB_TMO      128
#define XB_XCNT(j)  (256  + 64 * (j))
#define XB_XSUB(j)  (1280 + 64 * (j))
#define XB_XGEN(j)  (2304 + 64 * (j))
#define XB_TOP      3328
#define XB_TOPGEN   3392
#define XCD_BAR_WORDS 3456
#define XB_SPIN_CAP (1u << 18)

__device__ __forceinline__ unsigned xb_ld(unsigned* p)              { return __hip_atomic_load(p, __ATOMIC_RELAXED, __HIP_MEMORY_SCOPE_AGENT); }
__device__ __forceinline__ unsigned xb_add(unsigned* p, unsigned v) { return __hip_atomic_fetch_add(p, v, __ATOMIC_RELAXED, __HIP_MEMORY_SCOPE_AGENT); }
__device__ __forceinline__ unsigned xb_xcc_id() { return (unsigned)__builtin_amdgcn_s_getreg((3 << 11) | 20) & 0xFu; }
#define XB_SPIN(cond, bar) do { unsigned _sp = 0; while (cond) { __builtin_amdgcn_s_sleep(1); \
    if ((++_sp & 255u) == 0u) { if (xb_ld(&(bar)[XB_TMO])) break; if (_sp > XB_SPIN_CAP) { atomicAdd(&(bar)[XB_TMO], 1u); break; } } } } while (0)

struct XcdBarrier {
    unsigned* bar; unsigned x;
    volatile LAS unsigned* st;
};

__device__ __forceinline__ XcdBarrier xcd_barrier_post(unsigned* bar, volatile LAS unsigned* st, int wv) {
    XcdBarrier b; b.bar = bar; b.x = xb_xcc_id(); b.st = st;
    if (tidx(wv) == 0) (void)xb_add(&bar[XB_XCNT(b.x)], 1u);
    return b;
}
__device__ __forceinline__ void xcd_barrier_complete(unsigned* bar, unsigned x, unsigned& nloc, unsigned& nx) {
    const unsigned G = gridDim.x * gridDim.y * gridDim.z;
    unsigned sum, cnt, mine, sp = 0u;
    for (;;) {
        sum = 0u; cnt = 0u; mine = 0u;
#pragma unroll
        for (unsigned j = 0; j < 16; ++j) { const unsigned c = xb_ld(&bar[XB_XCNT(j)]); sum += c; cnt += (c > 0u) ? 1u : 0u; mine = (j == x) ? c : mine; }
        if (sum == G) break;
        __builtin_amdgcn_s_sleep(1);
        if ((++sp & 255u) == 0u) { if (xb_ld(&bar[XB_TMO])) break; if (sp > XB_SPIN_CAP) { atomicAdd(&bar[XB_TMO], 1u); break; } }
    }
    nloc = mine > 0u ? mine : 1u; nx = cnt > 0u ? cnt : 1u;
}

__device__ __forceinline__ void xcd_barrier(const XcdBarrier& b, int wv) {
    asm volatile("s_waitcnt vmcnt(0)" ::: "memory");
    __syncthreads();
    if (tidx(wv) == 0) {
        unsigned* bar = b.bar;
        __builtin_amdgcn_s_waitcnt(0);
        unsigned nloc = b.st[0], nx = b.st[1];
        if (nloc == 0u) { xcd_barrier_complete(bar, b.x, nloc, nx); b.st[0] = nloc; b.st[1] = nx; }
        const unsigned old = xb_add(&bar[XB_XSUB(b.x)], 1u);
        const unsigned gen = old / nloc;
        if (old + 1u == (gen + 1u) * nloc) {
            __builtin_amdgcn_fence(__ATOMIC_RELEASE, "agent");
            asm volatile("s_waitcnt vmcnt(0)" ::: "memory");
            const unsigned og = xb_add(&bar[XB_TOP], 1u);
            const unsigned tg = og / nx;
            if (og + 1u == (tg + 1u) * nx) xb_add(&bar[XB_TOPGEN], 1u);
            else XB_SPIN(xb_ld(&bar[XB_TOPGEN]) == tg, bar);
            __builtin_amdgcn_fence(__ATOMIC_ACQUIRE, "agent");
            xb_add(&bar[XB_XGEN(b.x)], 1u);
            asm volatile("s_waitcnt vmcnt(0)" ::: "memory");
        } else {
            XB_SPIN(xb_ld(&bar[XB_XGEN(b.x)]) == gen, bar);
            __builtin_amdgcn_fence(__ATOMIC_ACQUIRE, "agent");
            asm volatile("s_waitcnt vmcnt(0)" ::: "memory");
        }
    }
    __syncthreads();
}

#ifndef PHMASK
#define PHMASK 0xFFFF
#endif
#define PH(k) if constexpr (((PHMASK) >> (k)) & 1)
#ifndef TPROBE
#define TPROBE 0
#endif
#ifndef TP_BASE
#define TP_BASE 0
#endif
#define TSTAMP(k) do { if (TPROBE && bid == 0 && tidx(wv) == 0) ((unsigned long long*)(ws + WS_BAR + 65536))[k] = __builtin_amdgcn_s_memrealtime(); } while (0)
constexpr int LDS_BYTES = 131072 + 8192 + 2048;
__global__ void __launch_bounds__(512, 2) fwd_megakernel(Ctx C) {
    extern __shared__ __attribute__((aligned(16))) unsigned char lds_raw[];
    LAS unsigned char* lds = (LAS unsigned char*)lds_raw;
    const int wv = __builtin_amdgcn_readfirstlane((int)threadIdx.x >> 6);
    const int G = gridDim.x, bid = blockIdx.x; unsigned char* ws = C.ws;
    bf16_t* T0 = (bf16_t*)(ws + WS_T0); bf16_t* T1 = (bf16_t*)(ws + WS_T1); bf16_t* T2 = (bf16_t*)(ws + WS_T2); bf16_t* OB = (bf16_t*)(ws + WS_OB);
    float* SS1 = (float*)(ws + WS_SSP); float* SS2 = SS1 + (size_t)M * 16;
    float* Y = C.out + O_Y;
    pg8::Order S;

    { volatile LAS unsigned* misc = (volatile LAS unsigned*)(lds + 131072 + 8192); if (tidx(wv) < 16) misc[tidx(wv)] = 0u; }
    __syncthreads();
    const XcdBarrier xbar = xcd_barrier_post((unsigned*)(ws + WS_BAR), (volatile LAS unsigned*)(lds + 131072 + 8192), wv);
    TSTAMP(0);
    p0_prologue(C, lds, G, bid, wv);
    xcd_barrier(xbar, wv);
    TSTAMP(1);

    p1_pre(C, G, bid, wv);
    PH(0) { pg8::Gemm g{(const char*)T0, (const char*)(ws + WS_WIN), D, D, 0, 0, D}; S.init(SEQ / 256, 4, 1, G, bid);
      EpiZ E{(bf16_t*)(ws + WS_ZP), (bf16_t*)(ws + WS_UH), C.out}; pg8::gemm_phase(lds, g, S, E, wv); }
    { SkZ E{(bf16_t*)(ws + WS_ZP), (bf16_t*)(ws + WS_UH), C.out}; skinny_gemm(lds, T0 + (size_t)SEQ * D, D, (const bf16_t*)(ws + WS_WIN), D, D, D, 1, E, G, bid, wv); }
    { SkKV E{C.out, (bf16_t*)(ws + WS_KB), (bf16_t*)(ws + WS_VT)};
      skinny_gemm(lds, (const bf16_t*)(ws + WS_MN), D, (const bf16_t*)(ws + WS_WKV), D, 2 * D, D, 1, E, G, (bid + G - 64) % G, wv); }
    xcd_barrier(xbar, wv);
    TSTAMP(2);

    { S.init(NCHP / 256, 1, NG, G, bid); Unit u0;
      if (S.next(0, u0)) { const int grp = u0.z, tile = u0.pm;
        wy_gen(C, grp * 256 * (KY / 8), (grp + 1) * 256 * (KY / 8), tile * 512 + tidx(wv), 5 * 512);
        PH(2) { pg8::Gemm g{(const char*)(ws + WS_UH), (const char*)(ws + WS_WB), KY, 256, (size_t)NCHP * KY * 2, (size_t)256 * 256 * 2, 256};
          EpiE E{(float*)(ws + WS_E)}; pg8::gemm_phase(lds, g, S, E, wv); }
        asm volatile("s_waitcnt vmcnt(0)" ::: "memory"); __syncthreads();
        if (tidx(wv) == 0) { unsigned* cnt = (unsigned*)(ws + WS_BAR + 16384) + 64 * grp;
            __builtin_amdgcn_fence(__ATOMIC_RELEASE, "agent"); asm volatile("s_waitcnt vmcnt(0)" ::: "memory");
            (void)xb_add(cnt, 1u);
            unsigned sp = 0; while (xb_ld(cnt) < 5u) { __builtin_amdgcn_s_sleep(1); if (++sp > XB_SPIN_CAP) break; }
            __builtin_amdgcn_fence(__ATOMIC_ACQUIRE, "agent"); asm volatile("s_waitcnt vmcnt(0)" ::: "memory"); }
        __syncthreads();
        p2b_prefix(C, lds, grp, tile, wv);
        asm volatile("s_waitcnt vmcnt(0)" ::: "memory"); __syncthreads();
        PH(3) { pg8::Gemm g{(const char*)(ws + WS_UH), (const char*)(ws + WS_WY), KY, KY, (size_t)NCHP * KY * 2, (size_t)256 * KY * 2, KY};
          EpiY E{T1}; pg8::gemm_phase(lds, g, S, E, wv); }
      } else {
        if (bid < 176) { PH(1) { pg8::Gemm g{(const char*)(ws + WS_KB), (const char*)(ws + WS_WQN), D, D, (size_t)HD * 2, (size_t)HD * 2, HD}; S.init(1, 4, NHEAD, 16, bid - 160);
            EpiWqk E{(bf16_t*)(ws + WS_WQK)}; pg8::gemm_phase(lds, g, S, E, wv); } }
        else if (bid < 192) { PH(1) { pg8::Gemm g{(const char*)(ws + WS_WO), (const char*)(ws + WS_VT), D, D, (size_t)HD * 2, (size_t)HD * 2, HD}; S.init(4, 1, NHEAD, 16, bid - 176);
            EpiVWo E{(bf16_t*)(ws + WS_VWO)}; pg8::gemm_phase(lds, g, S, E, wv); } }
        else if (bid < 200) { PH(1) { pg8::Gemm g{(const char*)(ws + WS_WOUT), (const char*)(ws + WS_WPOOL), D, DPOOL, 0, 0, DPOOL}; S.init(4, 2, 1, 8, bid - 192);
            EpiVWo E{(bf16_t*)(ws + WS_WOUT2)}; pg8::gemm_phase(lds, g, S, E, wv); } }
        p2b_pool(C, bid - 160, G - 160, wv); }
    }
    xcd_barrier(xbar, wv);
    TSTAMP(3);

    PH(5) { pg8::Gemm g{(const char*)(T1 + DPOOL), (const char*)(ws + WS_WGLU), D, DSSM, 0, 0, DSSM}; S.init(SEQ / 256, 2, 1, G, bid);
      EpiGlu E{T2, T1, C.in[21]}; pg8::gemm_phase(lds, g, S, E, wv); }
    { SkGlu E{T2, T1, C.in[21]}; skinny_gemm(lds, T1 + (size_t)SEQ * D + DPOOL, D, (const bf16_t*)(ws + WS_WGLU), DSSM, DSSM, DSSM, 1, E, G, (bid + G - 128) % G, wv); }
    xcd_barrier(xbar, wv);
    TSTAMP(6);

    PH(6) { pg8::Gemm g{(const char*)T2, (const char*)(ws + WS_WOUT2), D, D, 0, 0, D}; S.init(SEQ / 256, 4, 1, G, bid);
      EpiRes<false> E{C.in[0], T0, SS1}; pg8::gemm_phase(lds, g, S, E, wv); }
    { SkRes<false> E{C.in[1], T0 + (size_t)SEQ * D, SS1 + (size_t)SEQ * 16}; skinny_gemm(lds, T2 + (size_t)SEQ * D, D, (const bf16_t*)(ws + WS_WOUT2), D, D, D, 1, E, G, bid, wv); }
    xcd_barrier(xbar, wv);
    TSTAMP(7);

    { SkQ E{T1 + (size_t)SEQ * D, SS1 + (size_t)SEQ * 16}; skinny_gemm(lds, T0 + (size_t)SEQ * D, D, (const bf16_t*)(ws + WS_WQ), D, D, D, 1, E, G, bid, wv); }
    asm volatile("s_waitcnt vmcnt(0)" ::: "memory"); __syncthreads();
    if (bid < 64 && tidx(wv) == 0) { __builtin_amdgcn_fence(__ATOMIC_RELEASE, "agent"); asm volatile("s_waitcnt vmcnt(0)" ::: "memory"); (void)xb_add((unsigned*)(ws + WS_BAR + 32768), 1u); }
    TSTAMP(8);
    PH(8) { pg8::Gemm g{(const char*)T0, (const char*)(ws + WS_WQK), D, D, 0, 0, D}; S.init(SEQ / 256, 4, 1, G, bid);
      LAS float* tab = (LAS float*)(lds + 131072 + 8192 + 1024); (void)prep_rstd(tab, SS1, S, wv);
      EpiSoftmax E{T1, (LAS float*)(lds + 131072), (LAS float*)(lds + 131072 + 4096), tab}; pg8::gemm_phase(lds, g, S, E, wv); }
    TSTAMP(9);
    if (tidx(wv) == 0) { unsigned* cnt = (unsigned*)(ws + WS_BAR + 32768); unsigned sp = 0; while (xb_ld(cnt) < 64u) { __builtin_amdgcn_s_sleep(1); if (++sp > XB_SPIN_CAP) break; }
        __builtin_amdgcn_fence(__ATOMIC_ACQUIRE, "agent"); asm volatile("s_waitcnt vmcnt(0)" ::: "memory"); }
    __syncthreads();
    for (int it = bid; it < 256; it += G) sample_attn_item(C, lds, it, wv);
    xcd_barrier(xbar, wv);
    TSTAMP(10);

    PH(10) { pg8::Gemm g{(const char*)T1, (const char*)(ws + WS_VWO), D, D, 0, 0, D}; S.init(SEQ / 256, 4, 1, G, bid);
      EpiRes<true> E{T0, T2, SS2}; pg8::gemm_phase(lds, g, S, E, wv); }
    { SkRes<true> E{T0 + (size_t)SEQ * D, T2 + (size_t)SEQ * D, SS2 + (size_t)SEQ * 16}; skinny_gemm(lds, OB + (size_t)SEQ * D, D, (const bf16_t*)(ws + WS_WO), D, D, D, 1, E, G, bid, wv); }
    xcd_barrier(xbar, wv);
    TSTAMP(11);

    PH(11) { pg8::Gemm g{(const char*)T2, (const char*)(ws + WS_WUP), D, D, 0, 0, D}; S.init(SEQ / 256, DFF / 256, 1, G, bid);
      LAS float* tab = (LAS float*)(lds + 131072); const int tpm = prep_rstd(tab, SS2, S, wv);
      EpiUp E{(bf16_t*)(ws + WS_U), SS2, tab, tpm}; pg8::gemm_phase(lds, g, S, E, wv); }
    { SkUp E{(bf16_t*)(ws + WS_U) + (size_t)SEQ * DFF, SS2 + (size_t)SEQ * 16}; skinny_gemm(lds, T2 + (size_t)SEQ * D, D, (const bf16_t*)(ws + WS_WUP), D, DFF, D, 1, E, G, bid, wv); }
    xcd_barrier(xbar, wv);
    TSTAMP(12);

    PH(12) { pg8::Gemm g{(const char*)(ws + WS_U), (const char*)(ws + WS_WDOWN), DFF, DFF, 0, 0, DFF}; S.init(SEQ / 256, 4, 1, G, bid);
      EpiFinal E{T2, Y, C.in[32], (float*)(ws + WS_XCH), (unsigned*)(ws + WS_BAR + 40960), (LAS float*)(lds + 131072), (LAS float*)(lds + 131072 + 4096), wv}; pg8::gemm_phase(lds, g, S, E, wv); }
    { SkSlab E{(float*)(ws + WS_SLAB)}; skinny_gemm(lds, (const bf16_t*)(ws + WS_U) + (size_t)SEQ * DFF, DFF, (const bf16_t*)(ws + WS_WDOWN), DFF, D, DFF, 4, E, G, bid, wv); }
    asm volatile("s_waitcnt vmcnt(0)" ::: "memory"); __syncthreads();
    { unsigned* cs = (unsigned*)(ws + WS_BAR + 40960) + 16 * 64;
      if (tidx(wv) == 0) { (void)xb_add(cs, 1u); unsigned sp = 0; while (xb_ld(cs) < 256u) { __builtin_amdgcn_s_sleep(1); if (++sp > XB_SPIN_CAP) break; }
          __builtin_amdgcn_fence(__ATOMIC_ACQUIRE, "agent"); asm volatile("s_waitcnt vmcnt(0)" ::: "memory"); }
      __syncthreads();
      if (wv == 0 && bid < NSAMP) { const int lane = lane_id(), m = SEQ + bid; const u32x2* xr = (const u32x2*)(T2 + (size_t)m * D) + lane; f32x4 v[4]; float ss = 0.f;
#pragma unroll
          for (int j = 0; j < 4; ++j) { const u32x2 w = xr[64 * j]; v[j] = (f32x4){bf2f(w.x & 0xffffu), bf2f(w.x >> 16), bf2f(w.y & 0xffffu), bf2f(w.y >> 16)}; }
#pragma unroll
          for (int ks = 0; ks < 4; ++ks) { const f32x4* sp = (const f32x4*)((const float*)(ws + WS_SLAB) + ((size_t)ks * NSAMP + bid) * D) + lane;
#pragma unroll
              for (int j = 0; j < 4; ++j) v[j] += sp[64 * j]; }
#pragma unroll
          for (int j = 0; j < 4; ++j) ss += (v[j].x * v[j].x + v[j].y * v[j].y) + (v[j].z * v[j].z + v[j].w * v[j].w);
          const float rs = rsqrtf(wave_sum(ss, lane) * (1.f / D) + EPS); const f32x4* gr = (const f32x4*)C.in[32] + lane; f32x4* yr = (f32x4*)(Y + (size_t)m * D) + lane;
#pragma unroll
          for (int j = 0; j < 4; ++j) { const f32x4 gg = gr[64 * j]; yr[64 * j] = (f32x4){v[j].x * rs * gg.x, v[j].y * rs * gg.y, v[j].z * rs * gg.z, v[j].w * rs * gg.w}; } } }
#if TPROBE
    __syncthreads();
    if (bid == 0 && tidx(wv) == 0) { asm volatile("s_waitcnt vmcnt(0)" ::: "memory"); const unsigned long long tend = __builtin_amdgcn_s_memrealtime(); volatile unsigned long long* ts = (volatile unsigned long long*)(ws + WS_BAR + 65536);
        const size_t offs[10] = {O_Y, O_Y + (size_t)SEQ * D, O_MK, O_MV, O_POOLP, O_SREP, O_SIMP, O_POOLS, O_SRES, O_SIMS};
        for (int k = 0; k < 10; ++k) { const int ph = TP_BASE + k; const unsigned long long a = ts[ph], b = (ph + 1 <= 13) ? ts[ph + 1] : tend; C.out[offs[k]] += (float)(b - a) * 0.01f; } }
#endif
}

extern "C" void kernel_launch(void* const* d_in, const int* in_sizes, int n_in, void* d_out, int out_size, void* d_ws, size_t ws_size, hipStream_t stream) {
    static int grid = 0;
    if (grid == 0) {
        if (n_in != 33 || (size_t)out_size != O_END || ws_size < WS_END) { fprintf(stderr, "kernel_launch: unexpected shapes n_in %d out %d ws %zu\n", n_in, out_size, ws_size); grid = -1; return; }
        int dev = 0, cus = 0, per_cu = 0;
        hipGetDevice(&dev); hipDeviceGetAttribute(&cus, hipDeviceAttributeMultiprocessorCount, dev);
        if (hipFuncSetAttribute((const void*)fwd_megakernel, hipFuncAttributeMaxDynamicSharedMemorySize, LDS_BYTES) != hipSuccess) { fprintf(stderr, "kernel_launch: hipFuncSetAttribute failed\n"); grid = -1; return; }
        if (hipOccupancyMaxActiveBlocksPerMultiprocessor(&per_cu, (const void*)fwd_megakernel, 512, LDS_BYTES) != hipSuccess || per_cu < 1) { fprintf(stderr, "kernel_launch: occupancy query failed (%d)\n", per_cu); (void)hipGetLastError(); per_cu = 1; }
        if (per_cu > 1) per_cu = 1;
        grid = cus * per_cu; if (grid > 256) grid = 256;
        if (grid != 256) { fprintf(stderr, "kernel_launch: this kernel is laid out for exactly 256 resident workgroups (one per CU of a 256-CU device), got %d\n", grid); grid = -1; return; }
    }
    if (grid < 0) return;
    Ctx c{};
    for (int i = 0; i < 33; ++i) c.in[i] = (const float*)d_in[i];
    c.out = (float*)d_out; c.ws = (unsigned char*)d_ws;
    if (hipMemsetAsync((char*)d_ws + WS_BAR, 0, 65536, stream) != hipSuccess) { fprintf(stderr, "kernel_launch: memset of the barrier words failed\n"); return; }
    void* args[] = {&c};
    hipError_t e = hipLaunchCooperativeKernel((const void*)fwd_megakernel, dim3(grid), dim3(512), args, LDS_BYTES, stream);
    if (e != hipSuccess) fprintf(stderr, "cooperative launch failed: %s (grid %d)\n", hipGetErrorString(e), grid);
}
```

```cpp
#include <hip/hip_runtime.h>
#include <hip/hip_cooperative_groups.h>
#include <cstdio>
#include <cstdint>
namespace cg = cooperative_groups;

#define LAS __attribute__((address_space(3)))
typedef unsigned short bf16_t;
typedef short bf16x8 __attribute__((ext_vector_type(8)));
typedef float f32x4 __attribute__((ext_vector_type(4)));
typedef float f32x2 __attribute__((ext_vector_type(2)));
typedef unsigned u32x4 __attribute__((ext_vector_type(4)));
typedef unsigned u32x2 __attribute__((ext_vector_type(2)));

constexpr int D = 1024, SEQ = 16384, NSAMP = 256, M = SEQ + NSAMP, DFF = 4096, DPOOL = 512, DSSM = 512;
constexpr int NG = 32, NP = 64, NH = 16, TC = 16, NCH = M / TC  , NCHP = 1280, KY = 384;
constexpr int NMEM = 256, HD = 256, NHEAD = 4;
constexpr float EPS = 1e-6f;
constexpr float QSCALE = 0.0625f * 1.4426950408889634f;

constexpr size_t O_Y = 0, O_MK = (size_t)M * D, O_MV = O_MK + 262144, O_POOLP = O_MV + 262144, O_SREP = O_POOLP + 7680, O_SIMP = O_SREP + 2048,
                 O_POOLS = O_SIMP + 2048, O_SRES = O_POOLS + 122880, O_SIMS = O_SRES + 32768, O_END = O_SIMS + 32768;

constexpr size_t MiB = 1u << 20;
constexpr size_t WS_WIN = 0, WS_WOUT = 2 * MiB, WS_WQ = 4 * MiB, WS_WKV = 6 * MiB, WS_WO = 10 * MiB, WS_WUP = 12 * MiB, WS_WDOWN = 20 * MiB,
                 WS_WGLU = 28 * MiB, WS_WPOOL = 28 * MiB + 512 * 1024, WS_MN = 29 * MiB, WS_KB = 29 * MiB + 512 * 1024, WS_VT = 30 * MiB,
                 WS_AP = 30 * MiB + 512 * 1024,
                 WS_BB = WS_AP + 320 * 1024,
                 WS_KLAG = WS_BB + 256 * 1024,
                 WS_SS = WS_KLAG + 512 * 1024,
                 WS_BAR = 32 * MiB - 128 * 1024,
                 WS_WB = 32 * MiB,
                 WS_WY = 36 * MiB,
                 WS_E = 42 * MiB,
                 WS_UH = 62 * MiB,
                 WS_ZP = 92 * MiB,
                 WS_T0 = 109 * MiB, WS_T1 = 142 * MiB, WS_T2 = 175 * MiB, WS_SSP = 208 * MiB  , WS_XCH = 215 * MiB  , WS_WQN = 216 * MiB  , WS_WQK = 218 * MiB  , WS_VWO = 220 * MiB  , WS_WOUT2 = 222 * MiB  , WS_END = 224 * MiB,
                 WS_OB = 62 * MiB,
                 WS_U = 42 * MiB,
                 WS_SLAB = 211 * MiB;
static_assert(WS_SS + 3 * M * 4 <= WS_BAR, "misc region");
static_assert(WS_U + (size_t)M * DFF * 2 <= WS_T2, "U overlay");

__device__ __forceinline__ unsigned f2bf(float f) { unsigned u = __builtin_bit_cast(unsigned, f); return (u + 0x7fffu + ((u >> 16) & 1u)) >> 16; }
__device__ __forceinline__ unsigned pk2(float lo, float hi) { return f2bf(lo) | (f2bf(hi) << 16); }
__device__ __forceinline__ float bf2f(unsigned b) { return __builtin_bit_cast(float, b << 16); }
__device__ __forceinline__ unsigned cvt_pk_bf16(float lo, float hi) { unsigned r; asm volatile("v_cvt_pk_bf16_f32 %0, %1, %2" : "=v"(r) : "v"(lo), "v"(hi)); return r; }
#define LDS_WAIT() asm volatile("s_waitcnt lgkmcnt(0)" ::: "memory")
__device__ __forceinline__ int lane_id() { int l; asm volatile("v_mbcnt_lo_u32_b32 %0, -1, 0\n\tv_mbcnt_hi_u32_b32 %0, -1, %0" : "=v"(l)); return l; }
__device__ __forceinline__ int tidx(int wv) { return wv * 64 + lane_id(); }
#define SPIN_CAP (1u << 18)
__device__ __forceinline__ unsigned at_ld(unsigned* p) { return __hip_atomic_load(p, __ATOMIC_RELAXED, __HIP_MEMORY_SCOPE_AGENT); }
__device__ __forceinline__ unsigned at_add(unsigned* p, unsigned v) { return __hip_atomic_fetch_add(p, v, __ATOMIC_RELAXED, __HIP_MEMORY_SCOPE_AGENT); }
__device__ __forceinline__ float shfl_x(float v, int lane, int mask) { return __builtin_bit_cast(float, __builtin_amdgcn_ds_bpermute((lane ^ mask) << 2, __builtin_bit_cast(int, v))); }

__device__ __forceinline__ void unpack8(const u32x4 q, float* v) { const unsigned qq[4] = {q.x, q.y, q.z, q.w};
#pragma unroll
    for (int e = 0; e < 8; ++e) v[e] = bf2f((qq[e >> 1] >> ((e & 1) * 16)) & 0xffffu); }
namespace pg8 {
constexpr int BM = 256, BK = 64, HALF = 128, HTB = HALF * BK * 2, STAGE_BYTES = 8 * HTB, NXCD = 8, WGM = 8;
__host__ __device__ __forceinline__ int lds_byte(int r, int c) { const int st = (r >> 4) * 2 + (c >> 5), rr = r & 15, cc = c & 31, ob = rr * 64 + cc * 2; return st * 1024 + (ob ^ (((ob >> 9) & 1) << 5)); }
__host__ __device__ __forceinline__ void stage_rc(int b, int& R, int& C) { const int st = b / 1024, sb = b % 1024, swz = sb ^ (((sb >> 9) & 1) << 5); R = (st >> 1) * 16 + swz / 64; C = (st & 1) * 32 + (swz % 64) / 2; }
__host__ __device__ __forceinline__ int perm32(int rho) { const int n = rho >> 4, i = rho & 15; return 8 * (i >> 2) + 4 * n + (i & 3); }

struct Unit { int pm, pn, z; };
struct Gemm { const char* A; const char* B; int lda, ldb; size_t sAz, sBz; int K; };
struct Order {
    int nM, nN, nZ, G, c; bool zpn;
    __device__ __forceinline__ void init(int nM_, int nN_, int nZ_, int G_, int c_, bool zpn_ = false) { nM = nM_; nN = nN_; nZ = nZ_; G = G_; c = c_; zpn = zpn_; }
    __device__ __forceinline__ bool next(int i, Unit& u) const {
        const int per = nM * nN, nwg = per * nZ; const long L = (long)i * G + c; if (L >= nwg) return false;
        int wgid = (int)L; { const int q = nwg / NXCD, r = nwg % NXCD, xcd = wgid % NXCD, off = wgid / NXCD; wgid = (xcd < r ? xcd * (q + 1) : r * (q + 1) + (xcd - r) * q) + off; }
        u.z = wgid / per; const int l = wgid % per;
        const int nig = WGM * nN, gid = l / nig, fm = gid * WGM, gsz = (nM - fm) < WGM ? (nM - fm) : WGM;
        u.pm = fm + ((l % nig) % gsz); u.pn = (l % nig) / gsz; if (zpn) { u.z = u.pn; u.pn = 0; } return true;
    }
};

template <class Epi>
__device__ __forceinline__ void gemm_phase(LAS unsigned char* lds, const Gemm g, const Order& S, Epi& E, int wv) {
    const int tid = tidx(wv), wid = __builtin_amdgcn_readfirstlane(tid >> 6), lane = tid & 63, wr = wid >> 2, wc = wid & 3, fr = lane & 15, fq = lane >> 4;
    const int nt = g.K / BK;
    unsigned voffA[2], voffB[2];
#pragma unroll
    for (int i = 0; i < 2; ++i) { int R, C; stage_rc(tid * 16 + i * 8192, R, C); const int Rb = Epi::PERM ? ((R & ~31) + perm32(R & 31)) : R;
        voffA[i] = (unsigned)(R * g.lda + C) * 2u; voffB[i] = (unsigned)(Rb * g.ldb + C) * 2u; }
    const size_t kstep = (size_t)(BK * 2);
    const size_t hA = (size_t)HALF * g.lda * 2, hB = (size_t)HALF * g.ldb * 2;
    const unsigned ldsw = (unsigned)wid * 1024u;
    const int aoff = lds_byte(wr * 64 + fr, fq * 8), boff = lds_byte(wc * 32 + fr, fq * 8);
#define PG8_SA(b, h) (((b) * 2 + (h)) * HTB)
#define PG8_SB(b, h) ((4 + (b) * 2 + (h)) * HTB)
#define PG8_STAGE(bufoff, gbase, voff) do { _Pragma("unroll") for (int _i = 0; _i < 2; ++_i) \
        __builtin_amdgcn_global_load_lds((const unsigned*)((const char*)(gbase) + (voff)[_i]), (LAS unsigned*)(lds + (bufoff) + ldsw + _i * 8192), 16, 0, 0); } while (0)
#define PG8_LDA(dst, b, h) do { _Pragma("unroll") for (int m = 0; m < 4; ++m) _Pragma("unroll") for (int k = 0; k < 2; ++k) dst[m][k] = *(const LAS bf16x8*)(lds + PG8_SA(b, h) + aoff + m * 2048 + k * 1024); } while (0)
#define PG8_LDB(dst, b, h) do { _Pragma("unroll") for (int n = 0; n < 2; ++n) _Pragma("unroll") for (int k = 0; k < 2; ++k) dst[n][k] = *(const LAS bf16x8*)(lds + PG8_SB(b, h) + boff + n * 2048 + k * 1024); } while (0)
#define PG8_MMA(ai, bj, At, Bt) do { __builtin_amdgcn_s_setprio(1); _Pragma("unroll") for (int m = 0; m < 4; ++m) _Pragma("unroll") for (int n = 0; n < 2; ++n) _Pragma("unroll") for (int k = 0; k < 2; ++k) \
        acc[ai][bj][m][n] = __builtin_amdgcn_mfma_f32_16x16x32_bf16(Bt[n][k], At[m][k], acc[ai][bj][m][n], 0, 0, 0); __builtin_amdgcn_s_setprio(0); } while (0)
#define PG8_WAIT_V(n) asm volatile("s_waitcnt vmcnt(" #n ")" ::: "memory")
#define PG8_WAIT_L(n) asm volatile("s_waitcnt lgkmcnt(" #n ")" ::: "memory")
#define PG8_BAR __builtin_amdgcn_s_barrier()
#define PG8_SCHED __builtin_amdgcn_sched_barrier(0)
    Unit cur, nxt; int ui = 0;
    if (!S.next(0, cur)) return;
    f32x4 acc[2][2][4][2];
    if constexpr (Epi::ACC_INIT) E.init(acc, cur, wr, wc, fr, fq);
    else {
#pragma unroll
    for (int a = 0; a < 2; ++a)
#pragma unroll
        for (int b = 0; b < 2; ++b)
#pragma unroll
            for (int m = 0; m < 4; ++m)
#pragma unroll
                for (int n = 0; n < 2; ++n) acc[a][b][m][n] = (f32x4){0.f, 0.f, 0.f, 0.f};
    }
    bf16x8 At[4][2], B0[2][2], B1[2][2];
    const char* cA = g.A + (size_t)cur.z * g.sAz + (size_t)cur.pm * 2 * hA; const char* cB = g.B + (size_t)cur.z * g.sBz + (size_t)cur.pn * 2 * hB;
    PG8_STAGE(PG8_SB(0, 0), cB, voffB); PG8_STAGE(PG8_SB(0, 1), cB + hB, voffB); PG8_STAGE(PG8_SA(0, 0), cA, voffA); PG8_STAGE(PG8_SA(0, 1), cA + hA, voffA);
    if (wr == 1) PG8_BAR;
    PG8_WAIT_V(2); PG8_BAR;
    PG8_STAGE(PG8_SB(1, 0), cB + kstep, voffB); PG8_STAGE(PG8_SA(1, 0), cA + kstep, voffA); PG8_STAGE(PG8_SB(1, 1), cB + hB + kstep, voffB);
    PG8_WAIT_V(6); PG8_BAR;
    if constexpr (Epi::ACC_INIT) {
#pragma unroll
        for (int a = 0; a < 2; ++a)
#pragma unroll
            for (int b = 0; b < 2; ++b)
#pragma unroll
                for (int m = 0; m < 4; ++m) asm volatile("" : "+v"(acc[a][b][m][0]), "+v"(acc[a][b][m][1]));
    }
    for (;;) {
        const bool has_next = S.next(ui + 1, nxt);
        const char* nA = has_next ? g.A + (size_t)nxt.z * g.sAz + (size_t)nxt.pm * 2 * hA : cA; const char* nB = has_next ? g.B + (size_t)nxt.z * g.sBz + (size_t)nxt.pn * 2 * hB : cB;
        for (int t = 0; t < nt; t += 2) {
            const bool last = (t == nt - 2);
            const char* a1 = cA + (size_t)(t + 1) * kstep;
            const char* a2 = last ? nA : cA + (size_t)(t + 2) * kstep; const char* b2 = last ? nB : cB + (size_t)(t + 2) * kstep;
            const char* a3 = a2 + kstep; const char* b3 = b2 + kstep;
            PG8_LDB(B0, 0, 0); PG8_LDB(B1, 0, 1); PG8_SCHED; PG8_LDA(At, 0, 0); PG8_STAGE(PG8_SA(1, 1), a1 + hA, voffA);
            PG8_WAIT_V(8); PG8_WAIT_L(0); PG8_BAR; PG8_MMA(0, 0, At, B0); PG8_MMA(0, 1, At, B1); PG8_BAR; PG8_SCHED;
            PG8_LDA(At, 0, 1); PG8_STAGE(PG8_SB(0, 0), b2, voffB); PG8_STAGE(PG8_SB(0, 1), b2 + hB, voffB); PG8_STAGE(PG8_SA(0, 0), a2, voffA);
            PG8_WAIT_V(8); PG8_WAIT_L(0); PG8_BAR; PG8_MMA(1, 0, At, B0); PG8_MMA(1, 1, At, B1); PG8_BAR; PG8_SCHED;
            PG8_LDB(B0, 1, 0); PG8_LDB(B1, 1, 1); PG8_SCHED; PG8_LDA(At, 1, 0); PG8_STAGE(PG8_SA(0, 1), a2 + hA, voffA);
            PG8_WAIT_V(8); PG8_WAIT_L(0); PG8_BAR; PG8_MMA(0, 0, At, B0); PG8_MMA(0, 1, At, B1); PG8_BAR; PG8_SCHED;
            PG8_LDA(At, 1, 1); PG8_STAGE(PG8_SB(1, 0), b3, voffB); PG8_STAGE(PG8_SB(1, 1), b3 + hB, voffB); PG8_STAGE(PG8_SA(1, 0), a3, voffA);
            PG8_WAIT_V(8); PG8_WAIT_L(0); PG8_BAR; PG8_MMA(1, 0, At, B0); PG8_MMA(1, 1, At, B1); PG8_BAR; PG8_SCHED;
        }
        if (wr == 0) PG8_BAR;
        { Unit ue; ue.pm = __builtin_amdgcn_readfirstlane(cur.pm); ue.pn = __builtin_amdgcn_readfirstlane(cur.pn); ue.z = __builtin_amdgcn_readfirstlane(cur.z); const int le = lane_id(); int fre = le & 15, fqe = le >> 4;
          asm volatile("" : "+s"(ue.pm), "+s"(ue.pn), "+s"(ue.z));
          E(acc, ue, wr, wc, fre, fqe); }
        if (!has_next) break;
        if constexpr (Epi::ACC_INIT) { E.init(acc, nxt, wr, wc, fr, fq);
#pragma unroll
            for (int a = 0; a < 2; ++a)
#pragma unroll
                for (int b = 0; b < 2; ++b)
#pragma unroll
                    for (int m = 0; m < 4; ++m) asm volatile("" : "+v"(acc[a][b][m][0]), "+v"(acc[a][b][m][1]));
        } else {
#pragma unroll
        for (int a = 0; a < 2; ++a)
#pragma unroll
            for (int b = 0; b < 2; ++b)
#pragma unroll
                for (int m = 0; m < 4; ++m)
#pragma unroll
                    for (int n = 0; n < 2; ++n) acc[a][b][m][n] = (f32x4){0.f, 0.f, 0.f, 0.f};
        }
        cur = nxt; cA = nA; cB = nB; ++ui;
        if (wr == 1) PG8_BAR;
    }
    PG8_WAIT_V(0);
    PG8_BAR;
#undef PG8_SA
#undef PG8_SB
#undef PG8_STAGE
#undef PG8_LDA
#undef PG8_LDB
#undef PG8_MMA
#undef PG8_WAIT_V
#undef PG8_WAIT_L
#undef PG8_BAR
#undef PG8_SCHED
}
}
using pg8::Unit;
typedef f32x4 Acc[2][2][4][2];

#define EPI_ROWS(ai, m) (u.pm * 256 + (ai) * 128 + wr * 64 + (m) * 16 + fr)
__device__ __forceinline__ bool mfence() { asm volatile("" ::: "memory"); return true; }
#define FOR_AI_M _Pragma("unroll") for (int ai = 0; ai < 2; ++ai) _Pragma("unroll") for (int m = 0; m < 4; ++m) if (mfence())
#define FOR_BJ _Pragma("unroll") for (int bj = 0; bj < 2; ++bj)
__device__ __forceinline__ u32x4 pack8(const f32x4 v0, const f32x4 v1) { u32x4 w; w.x = cvt_pk_bf16(v0[0], v0[1]); w.y = cvt_pk_bf16(v0[2], v0[3]); w.z = cvt_pk_bf16(v1[0], v1[1]); w.w = cvt_pk_bf16(v1[2], v1[3]); return w; }

struct EpiZ {
    static constexpr bool PERM = true, ACC_INIT = false;
    bf16_t* ZP; bf16_t* UH; float* out;
    __device__ __forceinline__ void operator()(Acc& acc, const Unit& u, int wr, int wc, int fr, int fq) const {
        FOR_AI_M { const int row = EPI_ROWS(ai, m);
            FOR_BJ { const int col = u.pn * 256 + bj * 128 + wc * 32 + 8 * fq; const f32x4 v0 = acc[ai][bj][m][0], v1 = acc[ai][bj][m][1]; const u32x4 w = pack8(v0, v1);
                if (col < DPOOL) {
                    *(u32x4*)(ZP + (size_t)row * DPOOL + col) = w;
                    float* dst = nullptr;
                    if (row >= SEQ - 15 && row < SEQ) dst = out + O_POOLP + (size_t)(row - (SEQ - 15)) * DPOOL + col;
                    else if (row >= SEQ && ((row & 15) != 0)) dst = out + O_POOLS + ((size_t)((row - SEQ) >> 4) * 15 + ((row & 15) - 1)) * DPOOL + col;
                    if (dst) { *(f32x4*)dst = v0; *(f32x4*)(dst + 4) = v1; }
                } else {
                    const int cc = col - DPOOL, gg = cc >> 4, hh = cc & 15;
                    *(u32x4*)(UH + ((size_t)gg * NCHP + (row >> 4)) * KY + (row & 15) * 16 + hh) = w;
                } } }
    }
};
struct EpiKV {
    static constexpr bool PERM = false, ACC_INIT = false;
    float* out; bf16_t* KB; bf16_t* VT;
    __device__ __forceinline__ void operator()(Acc& acc, const Unit& u, int wr, int wc, int fr, int fq) const {
        FOR_AI_M { const int row = EPI_ROWS(ai, m);
            FOR_BJ {
#pragma unroll
                for (int n = 0; n < 2; ++n) { const int col = u.pn * 256 + bj * 128 + wc * 32 + 16 * n + 4 * fq; const f32x4 v = acc[ai][bj][m][n];
                    if (col < D) { *(f32x4*)(out + O_MK + (size_t)row * D + col) = v; u32x2 w; w.x = cvt_pk_bf16(v[0], v[1]); w.y = cvt_pk_bf16(v[2], v[3]); *(u32x2*)(KB + (size_t)row * D + col) = w; }
                    else { const int c2 = col - D; *(f32x4*)(out + O_MV + (size_t)row * D + c2) = v; } } }
            asm volatile("" ::: "memory"); }
    }
};
struct EpiE {
    static constexpr bool PERM = false, ACC_INIT = false;
    float* E;
    __device__ __forceinline__ void operator()(Acc& acc, const Unit& u, int wr, int wc, int fr, int fq) const {
        FOR_AI_M { const int row = EPI_ROWS(ai, m);
#pragma unroll
            for (int n = 0; n < 2; ++n) { const int col = wc * 32 + 16 * n + 4 * fq; *(f32x4*)(E + ((size_t)u.z * NCHP + row) * 128 + col) = acc[ai][0][m][n]; } }
    }
};
__device__ __forceinline__ float gelu_tanh(float x) {
    const float t = 0.7978845608028654f * (x + 0.044715f * x * x * x);
    const float e = __expf(-2.f * t);
    return x / (1.f + e);
}
struct EpiY {
    static constexpr bool PERM = true, ACC_INIT = false;
    bf16_t* MIX;
    __device__ __forceinline__ void operator()(Acc& acc, const Unit& u, int wr, int wc, int fr, int fq) const {
        FOR_AI_M { const int ch = EPI_ROWS(ai, m); if (ch < NCH) {
            FOR_BJ { const int col = bj * 128 + wc * 32 + 8 * fq, t = col >> 4, hh = col & 15; f32x4 v0 = acc[ai][bj][m][0], v1 = acc[ai][bj][m][1];
#pragma unroll
                for (int j = 0; j < 4; ++j) { v0[j] = gelu_tanh(v0[j]); v1[j] = gelu_tanh(v1[j]); }
                *(u32x4*)(MIX + (size_t)(ch * 16 + t) * D + DPOOL + u.z * 16 + hh) = pack8(v0, v1); } } }
    }
};
struct EpiPool {
    static constexpr bool PERM = true, ACC_INIT = false;
    bf16_t* CAT; const float* scale;
    __device__ __forceinline__ void operator()(Acc& acc, const Unit& u, int wr, int wc, int fr, int fq) const {
        FOR_BJ { const int col = u.pn * 256 + bj * 128 + wc * 32 + 8 * fq; const f32x4 s0 = *(const f32x4*)(scale + col), s1 = *(const f32x4*)(scale + col + 4);
            FOR_AI_M { const int row = EPI_ROWS(ai, m); *(u32x4*)(CAT + (size_t)row * D + col) = pack8(acc[ai][bj][m][0] * s0, acc[ai][bj][m][1] * s1); } }
    }
};
struct EpiGlu {
    static constexpr bool PERM = true, ACC_INIT = false;
    bf16_t* CAT; const bf16_t* MIX; const float* bias;
    __device__ __forceinline__ void operator()(Acc& acc, const Unit& u, int wr, int wc, int fr, int fq) const {
        FOR_BJ { const int col = u.pn * 256 + bj * 128 + wc * 32 + 8 * fq; const f32x4 b0 = *(const f32x4*)(bias + col), b1 = *(const f32x4*)(bias + col + 4);
            u32x4 yv[2][4];
#pragma unroll
            for (int ai = 0; ai < 2; ++ai)
#pragma unroll
                for (int m = 0; m < 4; ++m) yv[ai][m] = *(const u32x4*)(MIX + (size_t)EPI_ROWS(ai, m) * D + DPOOL + col);
            FOR_AI_M { const int row = EPI_ROWS(ai, m); float y[8]; unpack8(yv[ai][m], y);
                f32x4 v0 = acc[ai][bj][m][0] + b0, v1 = acc[ai][bj][m][1] + b1;
#pragma unroll
                for (int j = 0; j < 4; ++j) { v0[j] = y[j] / (1.f + __expf(-v0[j])); v1[j] = y[4 + j] / (1.f + __expf(-v1[j])); }
                *(u32x4*)(CAT + (size_t)row * D + DPOOL + col) = pack8(v0, v1); } }
    }
};
template <bool BASE_BF16> struct EpiRes {
    static constexpr bool PERM = false, ACC_INIT = true;
    const void* base; bf16_t* Xb; float* SS;
    __device__ __forceinline__ void init(Acc& acc, const Unit& u, int wr, int wc, int fr, int fq) const {
#pragma unroll
        for (int ai = 0; ai < 2; ++ai)
#pragma unroll
            for (int m = 0; m < 4; ++m) { const size_t off = (size_t)EPI_ROWS(ai, m) * D + u.pn * 256 + wc * 32 + 4 * fq;
#pragma unroll
                for (int bj = 0; bj < 2; ++bj)
#pragma unroll
                    for (int n = 0; n < 2; ++n) {
                        if constexpr (BASE_BF16) { const u32x2 w = *(const u32x2*)((const bf16_t*)base + off + bj * 128 + 16 * n); acc[ai][bj][m][n] = (f32x4){bf2f(w.x & 0xffffu), bf2f(w.x >> 16), bf2f(w.y & 0xffffu), bf2f(w.y >> 16)}; }
                        else acc[ai][bj][m][n] = __builtin_nontemporal_load((const f32x4*)((const float*)base + off + bj * 128 + 16 * n)); } }
    }
    __device__ __forceinline__ void operator()(Acc& acc, const Unit& u, int wr, int wc, int fr, int fq) const {
        FOR_AI_M { const int row = EPI_ROWS(ai, m); float ssq = 0.f;
            FOR_BJ {
#pragma unroll
                for (int n = 0; n < 2; ++n) { const int col = u.pn * 256 + bj * 128 + wc * 32 + 16 * n + 4 * fq; const f32x4 v = acc[ai][bj][m][n];
                    ssq += (v[0] * v[0] + v[1] * v[1]) + (v[2] * v[2] + v[3] * v[3]);
                    u32x2 w; w.x = cvt_pk_bf16(v[0], v[1]); w.y = cvt_pk_bf16(v[2], v[3]); *(u32x2*)(Xb + (size_t)row * D + col) = w; } }
            if (SS) { ssq += shfl_x(ssq, fr + 16 * fq, 16); ssq += shfl_x(ssq, fr + 16 * fq, 32);
                if (fq == 0) SS[(size_t)row * 16 + u.pn * 4 + wc] = ssq; } }
    }
};
__device__ __forceinline__ float row_rstd(const float* SS, int row) { const f32x4* p = (const f32x4*)(SS + (size_t)row * 16); const f32x4 a = p[0], b = p[1], c = p[2], d = p[3];
    const float t = ((a[0] + a[1]) + (a[2] + a[3])) + ((b[0] + b[1]) + (b[2] + b[3])) + ((c[0] + c[1]) + (c[2] + c[3])) + ((d[0] + d[1]) + (d[2] + d[3])); return rsqrtf(t * (1.f / D) + EPS); }
__device__ __forceinline__ int prep_rstd(LAS float* tab, const float* SS, const pg8::Order& S, int wv) {
    Unit u0; int pm = -1;
    if (S.next(0, u0)) { pm = u0.pm; const int tid = tidx(wv); if (tid < 256) tab[tid] = row_rstd(SS, pm * 256 + tid); }
    __syncthreads();
    return pm;
}
struct EpiQ {
    static constexpr bool PERM = true, ACC_INIT = false;
    bf16_t* Q; const float* SS; const LAS float* tab; int tab_pm;
    __device__ __forceinline__ void operator()(Acc& acc, const Unit& u, int wr, int wc, int fr, int fq) const {
        FOR_AI_M { const int row = EPI_ROWS(ai, m); const float rs = ((u.pm == tab_pm) ? tab[ai * 128 + wr * 64 + m * 16 + fr] : row_rstd(SS, row)) * QSCALE;
            FOR_BJ { const int col = u.pn * 256 + bj * 128 + wc * 32 + 8 * fq; *(u32x4*)(Q + (size_t)row * D + col) = pack8(acc[ai][bj][m][0] * rs, acc[ai][bj][m][1] * rs); } }
    }
};
struct EpiWqk {
    static constexpr bool PERM = true, ACC_INIT = false;
    bf16_t* W;
    __device__ __forceinline__ void operator()(Acc& acc, const Unit& u, int wr, int wc, int fr, int fq) const {
        FOR_AI_M { const int row = u.z * 256 + ai * 128 + wr * 64 + m * 16 + fr;
            FOR_BJ { const int col = u.pn * 256 + bj * 128 + wc * 32 + 8 * fq; *(u32x4*)(W + (size_t)row * D + col) = pack8(acc[ai][bj][m][0], acc[ai][bj][m][1]); } }
    }
};
struct EpiVWo {
    static constexpr bool PERM = true, ACC_INIT = false;
    bf16_t* W;
    __device__ __forceinline__ void operator()(Acc& acc, const Unit& u, int wr, int wc, int fr, int fq) const {
        FOR_AI_M { const int row = EPI_ROWS(ai, m);
            FOR_BJ { const int col = (u.z + u.pn) * 256 + bj * 128 + wc * 32 + 8 * fq; *(u32x4*)(W + (size_t)row * D + col) = pack8(acc[ai][bj][m][0], acc[ai][bj][m][1]); } }
    }
};
struct EpiSoftmax {
    static constexpr bool PERM = true, ACC_INIT = false;
    bf16_t* P; LAS float* tmax; LAS float* tsum; const LAS float* rs;
    __device__ __forceinline__ void operator()(Acc& acc, const Unit& u, int wr, int wc, int fr, int fq) const {
        if (rs) { FOR_AI_M { const float sc = rs[ai * 128 + wr * 64 + m * 16 + fr] * QSCALE;
            FOR_BJ {
#pragma unroll
                for (int n = 0; n < 2; ++n) acc[ai][bj][m][n] = acc[ai][bj][m][n] * sc; } } }
        FOR_AI_M { float mx = -3.0e38f;
            FOR_BJ {
#pragma unroll
                for (int n = 0; n < 2; ++n) { const f32x4 v = acc[ai][bj][m][n]; mx = fmaxf(mx, fmaxf(fmaxf(v[0], v[1]), fmaxf(v[2], v[3]))); } }
            mx = fmaxf(mx, shfl_x(mx, fr + 16 * fq, 16)); mx = fmaxf(mx, shfl_x(mx, fr + 16 * fq, 32));
            if (fq == 0) tmax[(ai * 128 + wr * 64 + m * 16 + fr) * 4 + wc] = mx; }
        LDS_WAIT(); __builtin_amdgcn_s_barrier(); asm volatile("" ::: "memory");
        FOR_AI_M { const int r = ai * 128 + wr * 64 + m * 16 + fr; const f32x4 t = *(const LAS f32x4*)(tmax + r * 4); const float mx = fmaxf(fmaxf(t[0], t[1]), fmaxf(t[2], t[3])); float s = 0.f;
            FOR_BJ {
#pragma unroll
                for (int n = 0; n < 2; ++n) { f32x4 v = acc[ai][bj][m][n];
#pragma unroll
                    for (int j = 0; j < 4; ++j) { v[j] = __builtin_amdgcn_exp2f(v[j] - mx); s += v[j]; }
                    acc[ai][bj][m][n] = v; } }
            s += shfl_x(s, fr + 16 * fq, 16); s += shfl_x(s, fr + 16 * fq, 32);
            if (fq == 0) tsum[r * 4 + wc] = s; }
        LDS_WAIT(); __builtin_amdgcn_s_barrier(); asm volatile("" ::: "memory");
        FOR_AI_M { const int r = ai * 128 + wr * 64 + m * 16 + fr, row = u.pm * 256 + r; const f32x4 t = *(const LAS f32x4*)(tsum + r * 4); const float inv = 1.f / ((t[0] + t[1]) + (t[2] + t[3]));
            FOR_BJ { const int col = (u.z + u.pn) * 256 + bj * 128 + wc * 32 + 8 * fq; *(u32x4*)(P + (size_t)row * D + col) = pack8(acc[ai][bj][m][0] * inv, acc[ai][bj][m][1] * inv); } }
    }
};
struct EpiO {
    static constexpr bool PERM = true, ACC_INIT = false;
    bf16_t* O;
    __device__ __forceinline__ void operator()(Acc& acc, const Unit& u, int wr, int wc, int fr, int fq) const {
        FOR_AI_M { const int row = EPI_ROWS(ai, m);
            FOR_BJ { const int col = u.z * 256 + bj * 128 + wc * 32 + 8 * fq; *(u32x4*)(O + (size_t)row * D + col) = pack8(acc[ai][bj][m][0], acc[ai][bj][m][1]); } }
    }
};
struct EpiUp {
    static constexpr bool PERM = true, ACC_INIT = false;
    bf16_t* U; const float* SS; const LAS float* tab; int tab_pm;
    __device__ __forceinline__ void operator()(Acc& acc, const Unit& u, int wr, int wc, int fr, int fq) const {
        FOR_AI_M { const int row = EPI_ROWS(ai, m); const float rs = (u.pm == tab_pm) ? tab[ai * 128 + wr * 64 + m * 16 + fr] : row_rstd(SS, row);
            FOR_BJ { const int col = u.pn * 256 + bj * 128 + wc * 32 + 8 * fq; f32x4 v0 = acc[ai][bj][m][0] * rs, v1 = acc[ai][bj][m][1] * rs;
#pragma unroll
                for (int j = 0; j < 4; ++j) { const float a = fmaxf(v0[j], 0.f), b = fmaxf(v1[j], 0.f); v0[j] = a * a; v1[j] = b * b; }
                *(u32x4*)(U + (size_t)row * DFF + col) = pack8(v0, v1); } }
    }
};

struct EpiFinal {
    static constexpr bool PERM = false, ACC_INIT = true;
    const bf16_t* base; float* out; const float* gain; float* xch; unsigned* cnt; LAS float* P; LAS float* Sr; int wv;
    __device__ __forceinline__ void init(Acc& acc, const Unit& u, int wr, int wc, int fr, int fq) const {
#pragma unroll
        for (int ai = 0; ai < 2; ++ai)
#pragma unroll
            for (int m = 0; m < 4; ++m) { const size_t off = (size_t)EPI_ROWS(ai, m) * D + u.pn * 256 + wc * 32 + 4 * fq;
#pragma unroll
                for (int bj = 0; bj < 2; ++bj)
#pragma unroll
                    for (int n = 0; n < 2; ++n) { const u32x2 w = *(const u32x2*)(base + off + bj * 128 + 16 * n); acc[ai][bj][m][n] = (f32x4){bf2f(w.x & 0xffffu), bf2f(w.x >> 16), bf2f(w.y & 0xffffu), bf2f(w.y >> 16)}; } }
    }
    __device__ __forceinline__ void operator()(Acc& acc, const Unit& u, int wr, int wc, int fr, int fq) const {
        FOR_AI_M { float ssq = 0.f;
            FOR_BJ {
#pragma unroll
                for (int n = 0; n < 2; ++n) { const f32x4 v = acc[ai][bj][m][n]; ssq += (v[0] * v[0] + v[1] * v[1]) + (v[2] * v[2] + v[3] * v[3]); } }
            ssq += shfl_x(ssq, fr + 16 * fq, 16); ssq += shfl_x(ssq, fr + 16 * fq, 32);
            if (fq == 0) P[(ai * 128 + wr * 64 + m * 16 + fr) * 4 + wc] = ssq; }
        LDS_WAIT(); __builtin_amdgcn_s_barrier(); asm volatile("" ::: "memory");
        const int tid = tidx(wv);
        if (tid < 256) { const f32x4 t = *(const LAS f32x4*)(P + tid * 4);
            __hip_atomic_store(xch + ((size_t)(u.pm * 256 + tid) * 4 + u.pn), (t[0] + t[1]) + (t[2] + t[3]), __ATOMIC_RELAXED, __HIP_MEMORY_SCOPE_AGENT); }
        asm volatile("s_waitcnt vmcnt(0)" ::: "memory"); __builtin_amdgcn_s_barrier(); asm volatile("" ::: "memory");
        if (tid == 0) { unsigned* c = cnt + 16 * u.pm; (void)at_add(c, 1u); unsigned sp = 0; while (at_ld(c) < 4u) { __builtin_amdgcn_s_sleep(1); if (++sp > SPIN_CAP) break; }
            __builtin_amdgcn_fence(__ATOMIC_ACQUIRE, "agent"); asm volatile("s_waitcnt vmcnt(0)" ::: "memory"); }
        __builtin_amdgcn_s_barrier(); asm volatile("" ::: "memory");
        if (tid < 256) { float* x = xch + (size_t)(u.pm * 256 + tid) * 4; float t = 0.f;
#pragma unroll
            for (int j = 0; j < 4; ++j) t += __hip_atomic_load(x + j, __ATOMIC_RELAXED, __HIP_MEMORY_SCOPE_AGENT);
            Sr[tid] = rsqrtf(t * (1.f / D) + EPS); }
        LDS_WAIT(); __builtin_amdgcn_s_barrier(); asm volatile("" ::: "memory");
        f32x4 gv[2][2];
#pragma unroll
        for (int bj = 0; bj < 2; ++bj)
#pragma unroll
            for (int n = 0; n < 2; ++n) gv[bj][n] = *(const f32x4*)(gain + u.pn * 256 + bj * 128 + wc * 32 + 16 * n + 4 * fq);
        FOR_AI_M { const int r = ai * 128 + wr * 64 + m * 16 + fr; const float rs = Sr[r]; float* orow = out + (size_t)(u.pm * 256 + r) * D + u.pn * 256 + wc * 32 + 4 * fq;
            FOR_BJ {
#pragma unroll
                for (int n = 0; n < 2; ++n) *(f32x4*)(orow + bj * 128 + 16 * n) = acc[ai][bj][m][n] * rs * gv[bj][n]; } }
    }
};

struct Ctx {
    const float* in[33]; float* out; unsigned char* ws;
};
__device__ __forceinline__ float wave_sum(float v, int lane) {
#pragma unroll
    for (int o = 1; o < 64; o <<= 1) v += shfl_x(v, lane, o);
    return v;
}
__device__ __forceinline__ float wave_max(float v, int lane) {
#pragma unroll
    for (int o = 1; o < 64; o <<= 1) v = fmaxf(v, shfl_x(v, lane, o));
    return v;
}
__device__ __forceinline__ void transpose_item(const float* W, int ldw, int nblk, bf16_t* WT, int ldt, int row_off, int col_off, const float* ksc, LAS float* scr, int item, int lane) {
    const int kb = item / nblk, nb = item % nblk, k0 = 64 * kb, n0 = 32 * nb;
#pragma unroll
    for (int i = 0; i < 8; ++i) { const int kk = 8 * i + (lane >> 3), nn = 4 * (lane & 7);
        f32x4 v = __builtin_nontemporal_load((const f32x4*)&W[(size_t)(k0 + kk) * ldw + n0 + nn]); if (ksc) v = v * ksc[k0 + kk];
        scr[kk * 33 + nn] = v[0]; scr[kk * 33 + nn + 1] = v[1]; scr[kk * 33 + nn + 2] = v[2]; scr[kk * 33 + nn + 3] = v[3]; }
    LDS_WAIT(); asm volatile("" ::: "memory");
    const int c = lane & 7;
#pragma unroll
    for (int j = 0; j < 4; ++j) { const int n = (lane >> 3) + 8 * j; const LAS float* s = scr + (8 * c) * 33 + n;
        u32x4 o; o.x = pk2(s[0 * 33], s[1 * 33]); o.y = pk2(s[2 * 33], s[3 * 33]); o.z = pk2(s[4 * 33], s[5 * 33]); o.w = pk2(s[6 * 33], s[7 * 33]);
        *(u32x4*)(WT + (size_t)(row_off + n0 + n) * ldt + col_off + k0 + 8 * c) = o; }
    LDS_WAIT(); asm volatile("" ::: "memory");
}
__device__ __forceinline__ void rms_row_to_bf16(const float* xrow, const float* g, bf16_t* orow, int lane) {
    const f32x4* xr = (const f32x4*)xrow + lane; const f32x4* gr = (const f32x4*)g + lane;
    f32x4 v[4]; float s = 0.f;
#pragma unroll
    for (int j = 0; j < 4; ++j) { v[j] = __builtin_nontemporal_load(&xr[64 * j]); s += (v[j].x * v[j].x + v[j].y * v[j].y) + (v[j].z * v[j].z + v[j].w * v[j].w); }
    const float rs = rsqrtf(wave_sum(s, lane) * (1.f / D) + EPS);
    u32x2* o8 = (u32x2*)orow + lane;
#pragma unroll
    for (int j = 0; j < 4; ++j) { const f32x4 gg = gr[64 * j]; u32x2 w; w.x = pk2(v[j].x * rs * gg.x, v[j].y * rs * gg.y); w.y = pk2(v[j].z * rs * gg.z, v[j].w * rs * gg.w); o8[64 * j] = w; }
}

__device__ __forceinline__ void p0_prologue(const Ctx& C, LAS unsigned char* lds, int G, int bid, int wv) {
    const int tid = tidx(wv), lane = tid & 63, wave = tid >> 6;
    LAS float* scr = (LAS float*)(lds + wave * 16384);
    const int gw = bid * 8 + wave, NGW = G * 8;
    unsigned char* ws = C.ws;
    constexpr int I_SQ = 16 * 32, I_UP = 16 * 128, I_DN = 64 * 32, I_GLU = 8 * 16, I_PL = 8 * 32;
    constexpr int NIT = 6 * I_SQ + I_UP + I_DN + I_GLU + I_PL;
    for (int it = gw; it < NIT; it += NGW) {
        int r = it;
        if (r < I_SQ) { transpose_item(C.in[9], D, 32, (bf16_t*)(ws + WS_WIN), D, 0, 0, nullptr, scr, r, lane); continue; } r -= I_SQ;
        if (r < I_SQ) { transpose_item(C.in[22], D, 32, (bf16_t*)(ws + WS_WOUT), D, 0, 0, nullptr, scr, r, lane); continue; } r -= I_SQ;
        if (r < I_SQ) { transpose_item(C.in[25], D, 32, (bf16_t*)(ws + WS_WQ), D, 0, 0, C.in[23], scr, r, lane); continue; } r -= I_SQ;
        if (r < I_SQ) { transpose_item(C.in[26], D, 32, (bf16_t*)(ws + WS_WKV), D, 0, 0, nullptr, scr, r, lane); continue; } r -= I_SQ;
        if (r < I_SQ) { transpose_item(C.in[27], D, 32, (bf16_t*)(ws + WS_WKV), D, D, 0, nullptr, scr, r, lane); continue; } r -= I_SQ;
        if (r < I_SQ) { transpose_item(C.in[28], D, 32, (bf16_t*)(ws + WS_WO), D, 0, 0, nullptr, scr, r, lane); continue; } r -= I_SQ;
        if (r < I_UP) { transpose_item(C.in[30], DFF, 128, (bf16_t*)(ws + WS_WUP), D, 0, 0, C.in[29], scr, r, lane); continue; } r -= I_UP;
        if (r < I_DN) { transpose_item(C.in[31], D, 32, (bf16_t*)(ws + WS_WDOWN), DFF, 0, 0, nullptr, scr, r, lane); continue; } r -= I_DN;
        if (r < I_GLU) { transpose_item(C.in[20], DSSM, 16, (bf16_t*)(ws + WS_WGLU), DSSM, 0, 0, nullptr, scr, r, lane); continue; } r -= I_GLU;
        transpose_item(C.in[22] + (size_t)DPOOL * D, D, 32, (bf16_t*)(ws + WS_WOUT2), D, 0, DPOOL, nullptr, scr, r, lane);
    }
    const int gt = bid * 512 + tid, NGT = G * 512;
    { bf16_t* WP = (bf16_t*)(ws + WS_WPOOL); const float* wp = C.in[10]; const float* sc = C.in[11];
      for (int i = gt; i < 512 * 512 / 8; i += NGT) { const int c = i / 64, d0 = (i % 64) * 8; u32x4 o = {0u, 0u, 0u, 0u};
          if ((c >> 7) == (d0 >> 7)) { const float* src = wp + ((size_t)(c >> 7) * 128 + (c & 127)) * 128 + (d0 & 127); const f32x4 a = *(const f32x4*)src, b = *(const f32x4*)(src + 4), s0 = *(const f32x4*)(sc + d0), s1 = *(const f32x4*)(sc + d0 + 4);
              o.x = pk2(a[0] * s0[0], a[1] * s0[1]); o.y = pk2(a[2] * s0[2], a[3] * s0[3]); o.z = pk2(b[0] * s1[0], b[1] * s1[1]); o.w = pk2(b[2] * s1[2], b[3] * s1[3]); }
          *(u32x4*)(WP + (size_t)c * DPOOL + d0) = o; }
    }
    { const float* Wq = C.in[25]; const float* gx = C.in[23]; bf16_t* WQN = (bf16_t*)(ws + WS_WQN);
      for (int i = gt; i < D * D / 8; i += NGT) { const int k = i >> 7; const float gk = gx[k]; const f32x4 a = *(const f32x4*)(Wq + (size_t)i * 8), b = *(const f32x4*)(Wq + (size_t)i * 8 + 4);
          u32x4 o; o.x = pk2(a[0] * gk, a[1] * gk); o.y = pk2(a[2] * gk, a[3] * gk); o.z = pk2(b[0] * gk, b[1] * gk); o.w = pk2(b[2] * gk, b[3] * gk); *(u32x4*)(WQN + (size_t)i * 8) = o; } }
    { bf16_t* H1 = (bf16_t*)(ws + WS_T0); bf16_t* MN = (bf16_t*)(ws + WS_MN);
      auto src = [&](int m) -> const f32x4* { return (const f32x4*)(m < SEQ ? C.in[0] + (size_t)m * D : (m < M ? C.in[1] + (size_t)(m - SEQ) * D : C.in[7] + (size_t)(m - M) * D)) + lane; };
      int m = NGW - 1 - gw; f32x4 nx[4];
      if (m < M + NMEM) { const f32x4* xr = src(m);
#pragma unroll
          for (int j = 0; j < 4; ++j) nx[j] = __builtin_nontemporal_load(&xr[64 * j]); }
      for (; m < M + NMEM; m += NGW) { f32x4 v[4];
#pragma unroll
          for (int j = 0; j < 4; ++j) v[j] = nx[j];
          if (m + NGW < M + NMEM) { const f32x4* xr = src(m + NGW);
#pragma unroll
              for (int j = 0; j < 4; ++j) nx[j] = __builtin_nontemporal_load(&xr[64 * j]); }
          float ss = 0.f;
#pragma unroll
          for (int j = 0; j < 4; ++j) ss += (v[j].x * v[j].x + v[j].y * v[j].y) + (v[j].z * v[j].z + v[j].w * v[j].w);
          const float rs = rsqrtf(wave_sum(ss, lane) * (1.f / D) + EPS);
          const f32x4* gr = (const f32x4*)(m < M ? C.in[8] : C.in[24]) + lane; u32x2* o8 = (u32x2*)(m < M ? H1 + (size_t)m * D : MN + (size_t)(m - M) * D) + lane;
#pragma unroll
          for (int j = 0; j < 4; ++j) { const f32x4 gg = gr[64 * j]; u32x2 w; w.x = pk2(v[j].x * rs * gg.x, v[j].y * rs * gg.y); w.y = pk2(v[j].z * rs * gg.z, v[j].w * rs * gg.w); o8[64 * j] = w; } } }
    { float* AP = (float*)(ws + WS_AP); float* BB = (float*)(ws + WS_BB);
      for (int i = gt; i < NG * NP; i += NGT) { const int g = i / NP, p = i % NP;
          const float are = C.in[12][i], aim = C.in[13][i], dt = expf(C.in[19][g]);
          const float mag = expf(are * dt); float sn, cs; sincosf(aim * dt, &sn, &cs);
          const float abr = mag * cs, abi = mag * sn;
          float pr = 1.f, pi = 0.f;
          for (int k = 0; k <= 16; ++k) { AP[((size_t)(g * 17 + k) * NP + p) * 2] = pr; AP[((size_t)(g * 17 + k) * NP + p) * 2 + 1] = pi; const float nr = pr * abr - pi * abi, ni = pr * abi + pi * abr; pr = nr; pi = ni; }
          const float nr = abr - 1.f, ni = abi, den = are * are + aim * aim; const float cr = (nr * are + ni * aim) / den, ci = (ni * are - nr * aim) / den;
          for (int h = 0; h < NH; ++h) { const float br = C.in[14][(size_t)i * NH + h], bi = C.in[15][(size_t)i * NH + h];
              BB[((size_t)i * NH + h) * 2] = cr * br - ci * bi; BB[((size_t)i * NH + h) * 2 + 1] = cr * bi + ci * br; } } }
}
__device__ __forceinline__ void p1_pre(const Ctx& C, int G, int bid, int wv) {
    const int gt = bid * 512 + tidx(wv), NGT = G * 512; unsigned char* ws = C.ws;
    const float* AP = (const float*)(ws + WS_AP); const float* BB = (const float*)(ws + WS_BB); float* KL = (float*)(ws + WS_KLAG); bf16_t* WB = (bf16_t*)(ws + WS_WB);
    for (int i = gt; i < NG * 16 * 16 * 16; i += NGT) { const int hp = i & 15, h = (i >> 4) & 15, k = (i >> 8) & 15, g = i >> 12; float s = 0.f;
        const f32x4* crp = (const f32x4*)(C.in[16] + ((size_t)g * NH + h) * NP); const f32x4* cip = (const f32x4*)(C.in[17] + ((size_t)g * NH + h) * NP);
        const f32x4* app = (const f32x4*)(AP + (size_t)(g * 17 + k) * NP * 2); const f32x2* bbp = (const f32x2*)(BB + ((size_t)g * NP * NH + hp) * 2);
#pragma unroll 4
        for (int p4 = 0; p4 < NP / 4; ++p4) { const f32x4 cr = crp[p4], ci = cip[p4], a0 = app[2 * p4], a1 = app[2 * p4 + 1];
            const f32x2 b0 = bbp[(4 * p4 + 0) * NH], b1 = bbp[(4 * p4 + 1) * NH], b2 = bbp[(4 * p4 + 2) * NH], b3 = bbp[(4 * p4 + 3) * NH];
            s += cr[0] * (a0[0] * b0.x - a0[1] * b0.y) - ci[0] * (a0[0] * b0.y + a0[1] * b0.x);
            s += cr[1] * (a0[2] * b1.x - a0[3] * b1.y) - ci[1] * (a0[2] * b1.y + a0[3] * b1.x);
            s += cr[2] * (a1[0] * b2.x - a1[1] * b2.y) - ci[2] * (a1[0] * b2.y + a1[1] * b2.x);
            s += cr[3] * (a1[2] * b3.x - a1[3] * b3.y) - ci[3] * (a1[2] * b3.y + a1[3] * b3.x); }
        if (k == 0 && h == hp) s += C.in[18][g * NH + h];
        KL[i] = s; }
    for (int it = gt; it < NG * 256 * 32; it += NGT) { const int k8 = it & 31, n = (it >> 5) & 255, g = it >> 13; u32x4 o = {0u, 0u, 0u, 0u};
        if (n < 128) { const int p = n & 63, sidx = k8 >> 1, hp0 = (k8 & 1) * 8; const f32x2 a = *(const f32x2*)(AP + ((size_t)(g * 17 + 15 - sidx) * NP + p) * 2);
            const f32x4* bb = (const f32x4*)(BB + ((size_t)(g * NP + p) * NH + hp0) * 2); const f32x4 q0 = bb[0], q1 = bb[1], q2 = bb[2], q3 = bb[3];
            float v[8];
            if (n < 64) { v[0] = a.x * q0[0] - a.y * q0[1]; v[1] = a.x * q0[2] - a.y * q0[3]; v[2] = a.x * q1[0] - a.y * q1[1]; v[3] = a.x * q1[2] - a.y * q1[3];
                          v[4] = a.x * q2[0] - a.y * q2[1]; v[5] = a.x * q2[2] - a.y * q2[3]; v[6] = a.x * q3[0] - a.y * q3[1]; v[7] = a.x * q3[2] - a.y * q3[3]; }
            else {        v[0] = a.x * q0[1] + a.y * q0[0]; v[1] = a.x * q0[3] + a.y * q0[2]; v[2] = a.x * q1[1] + a.y * q1[0]; v[3] = a.x * q1[3] + a.y * q1[2];
                          v[4] = a.x * q2[1] + a.y * q2[0]; v[5] = a.x * q2[3] + a.y * q2[2]; v[6] = a.x * q3[1] + a.y * q3[0]; v[7] = a.x * q3[3] + a.y * q3[2]; }
            o.x = pk2(v[0], v[1]); o.y = pk2(v[2], v[3]); o.z = pk2(v[4], v[5]); o.w = pk2(v[6], v[7]); }
        *(u32x4*)(WB + (size_t)it * 8) = o; }
}
__device__ __forceinline__ void wy_gen(const Ctx& C, int it0, int it1, int start, int stride) {
    unsigned char* ws = C.ws;
    const float* AP = (const float*)(ws + WS_AP); const float* KL = (const float*)(ws + WS_KLAG); bf16_t* WY = (bf16_t*)(ws + WS_WY);
    for (int it = it0 + start; it < it1; it += stride) { const int k8 = it % (KY / 8), n = (it / (KY / 8)) & 255, g = it / ((KY / 8) * 256), t = n >> 4, h = n & 15, k0 = k8 * 8; float v[8];
        if (k0 < 256) { const int sidx = k0 >> 4, hp0 = k0 & 15; f32x4 q0 = {0.f, 0.f, 0.f, 0.f}, q1 = q0;
            if (sidx <= t) { const f32x4* kp = (const f32x4*)(KL + (((size_t)g * 16 + (t - sidx)) * 16 + h) * 16 + hp0); q0 = kp[0]; q1 = kp[1]; }
            v[0] = q0[0]; v[1] = q0[1]; v[2] = q0[2]; v[3] = q0[3]; v[4] = q1[0]; v[5] = q1[1]; v[6] = q1[2]; v[7] = q1[3]; }
        else { const int p0 = (k0 - 256) & 63; const f32x4* crp = (const f32x4*)(C.in[16] + ((size_t)g * NH + h) * NP + p0); const f32x4* cip = (const f32x4*)(C.in[17] + ((size_t)g * NH + h) * NP + p0);
            const f32x4* app = (const f32x4*)(AP + ((size_t)(g * 17 + t + 1) * NP + p0) * 2);
            const f32x4 cr0 = crp[0], cr1 = crp[1], ci0 = cip[0], ci1 = cip[1], a0 = app[0], a1 = app[1], a2 = app[2], a3 = app[3];
            const float cr[8] = {cr0[0], cr0[1], cr0[2], cr0[3], cr1[0], cr1[1], cr1[2], cr1[3]}, ci[8] = {ci0[0], ci0[1], ci0[2], ci0[3], ci1[0], ci1[1], ci1[2], ci1[3]};
            const float ar[8] = {a0[0], a0[2], a1[0], a1[2], a2[0], a2[2], a3[0], a3[2]}, ai[8] = {a0[1], a0[3], a1[1], a1[3], a2[1], a2[3], a3[1], a3[3]};
#pragma unroll
            for (int e = 0; e < 8; ++e) v[e] = (k0 < 320) ? (cr[e] * ar[e] - ci[e] * ai[e]) : -(cr[e] * ai[e] + ci[e] * ar[e]); }
        u32x4 o; o.x = pk2(v[0], v[1]); o.y = pk2(v[2], v[3]); o.z = pk2(v[4], v[5]); o.w = pk2(v[6], v[7]);
        *(u32x4*)(WY + (size_t)it * 8) = o; }
}
__device__ __forceinline__ void p2b_prefix(const Ctx& C, LAS unsigned char* lds, int g, int tile, int wv) {
    const int p = lane_id(); unsigned char* ws = C.ws;
    const float* AP = (const float*)(ws + WS_AP); const float* E = (const float*)(ws + WS_E) + (size_t)g * NCHP * 128; bf16_t* UH = (bf16_t*)(ws + WS_UH) + (size_t)g * NCHP * KY;
    LAS float* L = (LAS float*)lds;
    const float ar = AP[((size_t)(g * 17 + 16) * NP + p) * 2], ai = AP[((size_t)(g * 17 + 16) * NP + p) * 2 + 1];
    if (tile < 4) {
    float hr[4] = {0.f, 0.f, 0.f, 0.f}, hi[4] = {0.f, 0.f, 0.f, 0.f};
    for (int cc = 0; cc < 32; cc += 8) { float er[4][8], ei[4][8];
#pragma unroll
        for (int ch = 0; ch < 4; ++ch)
#pragma unroll
            for (int j = 0; j < 8; ++j) { const size_t c = (size_t)((wv * 4 + ch) * 32 + cc + j); er[ch][j] = E[c * 128 + p]; ei[ch][j] = E[c * 128 + 64 + p]; }
#pragma unroll
        for (int j = 0; j < 8; ++j)
#pragma unroll
            for (int ch = 0; ch < 4; ++ch) { const float nr = ar * hr[ch] - ai * hi[ch] + er[ch][j], ni = ar * hi[ch] + ai * hr[ch] + ei[ch][j]; hr[ch] = nr; hi[ch] = ni; } }
#pragma unroll
    for (int ch = 0; ch < 4; ++ch) { L[((wv * 4 + ch) * 64 + p) * 2] = hr[ch]; L[((wv * 4 + ch) * 64 + p) * 2 + 1] = hi[ch]; }
    float sr = ar, si = ai;
#pragma unroll
    for (int j = 0; j < 5; ++j) { const float nr = sr * sr - si * si, ni = 2.f * sr * si; sr = nr; si = ni; }
    __syncthreads();
    float Hr = 0.f, Hi = 0.f;
    for (int j = 0; j < wv * 4; ++j) { const float lr = L[(j * 64 + p) * 2], li = L[(j * 64 + p) * 2 + 1]; const float nr = sr * Hr - si * Hi + lr, ni = sr * Hi + si * Hr + li; Hr = nr; Hi = ni; }
#pragma unroll
    for (int ch = 0; ch < 4; ++ch) { hr[ch] = Hr; hi[ch] = Hi; const float lr = L[((wv * 4 + ch) * 64 + p) * 2], li = L[((wv * 4 + ch) * 64 + p) * 2 + 1];
        const float nr = sr * Hr - si * Hi + lr, ni = sr * Hi + si * Hr + li; Hr = nr; Hi = ni; }
    if (wv == 7 && tile == 3) { C.out[O_SREP + g * NP + p] = Hr; C.out[O_SIMP + g * NP + p] = Hi; }
    if ((wv >> 1) == tile)
    for (int cc = 0; cc < 32; cc += 8) { float er[4][8], ei[4][8];
#pragma unroll
        for (int ch = 0; ch < 4; ++ch)
#pragma unroll
            for (int j = 0; j < 8; ++j) { const size_t c = (size_t)((wv * 4 + ch) * 32 + cc + j); er[ch][j] = E[c * 128 + p]; ei[ch][j] = E[c * 128 + 64 + p]; }
#pragma unroll
        for (int j = 0; j < 8; ++j)
#pragma unroll
            for (int ch = 0; ch < 4; ++ch) { const size_t c = (size_t)((wv * 4 + ch) * 32 + cc + j);
                UH[c * KY + 256 + p] = (bf16_t)f2bf(hr[ch]); UH[c * KY + 320 + p] = (bf16_t)f2bf(hi[ch]);
                const float nr = ar * hr[ch] - ai * hi[ch] + er[ch][j], ni = ar * hi[ch] + ai * hr[ch] + ei[ch][j]; hr[ch] = nr; hi[ch] = ni; } }
    } else
    for (int b = wv; b < 16; b += 8) { const float h0r = C.in[5][((size_t)b * NG + g) * NP + p], h0i = C.in[6][((size_t)b * NG + g) * NP + p]; const int c = 1024 + b;
        UH[(size_t)c * KY + 256 + p] = (bf16_t)f2bf(h0r); UH[(size_t)c * KY + 320 + p] = (bf16_t)f2bf(h0i);
        C.out[O_SRES + ((size_t)b * NG + g) * NP + p] = ar * h0r - ai * h0i + E[(size_t)c * 128 + p];
        C.out[O_SIMS + ((size_t)b * NG + g) * NP + p] = ar * h0i + ai * h0r + E[(size_t)c * 128 + 64 + p]; }
    __syncthreads();
}
__device__ __forceinline__ void p2b_pool(const Ctx& C, int worker, int nworkers, int wv) {
    const int cl = lane_id() * 8; unsigned char* ws = C.ws;
    const bf16_t* ZP = (const bf16_t*)(ws + WS_ZP); bf16_t* MIX = (bf16_t*)(ws + WS_T2);
    const int w = 2 << (cl >> 7);
    for (int blk = worker * 8 + wv; blk < M / 8; blk += nworkers * 8) { const int r0 = blk * 8;
        if (r0 < SEQ) {
#pragma unroll 2
            for (int t = 0; t < 8; ++t) { const int row = r0 + t; u32x4 q[16];
#pragma unroll
                for (int j = 0; j < 16; ++j) { const int rr = row - j; q[j] = *(const u32x4*)(ZP + (size_t)(rr < 0 ? 0 : rr) * DPOOL + cl); }
                float s[8], cur[8]; unpack8(q[0], cur);
#pragma unroll
                for (int e = 0; e < 8; ++e) s[e] = cur[e];
#pragma unroll
                for (int j = 1; j < 16; ++j) { float v[8]; unpack8(q[j], v); const float mk = (j < w && row - j >= 0) ? 1.f : 0.f;
#pragma unroll
                    for (int e = 0; e < 8; ++e) s[e] += mk * v[e]; }
                const int cnt = (row + 1 < w) ? row + 1 : w; const float inv = 1.f / (float)cnt;
                u32x4 o; o.x = pk2(s[0] * inv - cur[0], s[1] * inv - cur[1]); o.y = pk2(s[2] * inv - cur[2], s[3] * inv - cur[3]); o.z = pk2(s[4] * inv - cur[4], s[5] * inv - cur[5]); o.w = pk2(s[6] * inv - cur[6], s[7] * inv - cur[7]);
                *(u32x4*)(MIX + (size_t)row * D + cl) = o; }
        } else { const int b = (r0 - SEQ) >> 4, t0 = r0 & 15;
            for (int tt = 0; tt < 8; ++tt) { const int t = t0 + tt, row = r0 + tt; float s[8] = {0.f, 0.f, 0.f, 0.f, 0.f, 0.f, 0.f, 0.f}; float cur[8];
                for (int j = 0; j < w; ++j) { float v[8];
                    if (t - j >= 0) unpack8(*(const u32x4*)(ZP + (size_t)(row - j) * DPOOL + cl), v);
                    else { const float* hp = C.in[4] + ((size_t)b * 15 + (15 + t - j)) * DPOOL + cl; const f32x4 a = *(const f32x4*)hp, bb = *(const f32x4*)(hp + 4);
                        v[0] = a[0]; v[1] = a[1]; v[2] = a[2]; v[3] = a[3]; v[4] = bb[0]; v[5] = bb[1]; v[6] = bb[2]; v[7] = bb[3]; }
#pragma unroll
                    for (int e = 0; e < 8; ++e) { s[e] += v[e]; if (j == 0) cur[e] = v[e]; } }
                const float inv = 1.f / (float)w;
                u32x4 o; o.x = pk2(s[0] * inv - cur[0], s[1] * inv - cur[1]); o.y = pk2(s[2] * inv - cur[2], s[3] * inv - cur[3]); o.z = pk2(s[4] * inv - cur[4], s[5] * inv - cur[5]); o.w = pk2(s[6] * inv - cur[6], s[7] * inv - cur[7]);
                *(u32x4*)(MIX + (size_t)row * D + cl) = o; } } }
}
__device__ __forceinline__ void sample_attn_item(const Ctx& C, LAS unsigned char* lds, int item, int wv) {
    const int lane = lane_id(), fr = lane & 15, fq = lane >> 4; const int b = item >> 4, h = (item >> 2) & 3, dq = item & 3; unsigned char* ws = C.ws;
    const bf16_t* Q = (const bf16_t*)(ws + WS_T1); bf16_t* O = (bf16_t*)(ws + WS_OB);
    const float* Kc = C.in[2] + (size_t)b * NMEM * D + h * HD; const float* Vc = C.in[3] + (size_t)b * NMEM * D + h * HD + dq * 64;
    LAS float* Sl = (LAS float*)lds;
    LAS float* PT = (LAS float*)(lds + 16384);
    LAS float* red = (LAS float*)(lds + 32768);
    float vv[32];
#pragma unroll
    for (int j = 0; j < 32; ++j) vv[j] = __builtin_nontemporal_load(&Vc[(size_t)(wv * 32 + j) * D + lane]);
    bf16x8 qf[8];
#pragma unroll
    for (int kk = 0; kk < 8; ++kk) qf[kk] = *(const bf16x8*)(Q + (size_t)(SEQ + b * 16 + fr) * D + h * HD + kk * 32 + fq * 8);
#pragma unroll
    for (int kbi = 0; kbi < 2; ++kbi) { const int kb = wv + 8 * kbi; f32x4 acc = {0.f, 0.f, 0.f, 0.f}; const float* kr = Kc + (size_t)(kb * 16 + fr) * D + fq * 8;
#pragma unroll
        for (int kk = 0; kk < 8; ++kk) { const f32x4 a = *(const f32x4*)(kr + kk * 32), c = *(const f32x4*)(kr + kk * 32 + 4); const u32x4 w = pack8(a, c);
            acc = __builtin_amdgcn_mfma_f32_16x16x32_bf16(qf[kk], __builtin_bit_cast(bf16x8, w), acc, 0, 0, 0); }
#pragma unroll
        for (int r = 0; r < 4; ++r) Sl[(4 * fq + r) * 256 + kb * 16 + fr] = acc[r]; }
    __syncthreads();
#pragma unroll
    for (int rr = 0; rr < 2; ++rr) { const int s = wv * 2 + rr; float v[4]; float mx = -3.0e38f;
#pragma unroll
        for (int j = 0; j < 4; ++j) { v[j] = Sl[s * 256 + lane + 64 * j]; mx = fmaxf(mx, v[j]); }
        mx = wave_max(mx, lane); float sum = 0.f;
#pragma unroll
        for (int j = 0; j < 4; ++j) { v[j] = __builtin_amdgcn_exp2f(v[j] - mx); sum += v[j]; }
        const float inv = 1.f / wave_sum(sum, lane);
#pragma unroll
        for (int j = 0; j < 4; ++j) PT[(lane + 64 * j) * 16 + s] = v[j] * inv; }
    __syncthreads();
    { float o[16];
#pragma unroll
      for (int s = 0; s < 16; ++s) o[s] = 0.f;
#pragma unroll
      for (int j = 0; j < 32; ++j) { const LAS f32x4* pp = (const LAS f32x4*)(PT + (wv * 32 + j) * 16);
#pragma unroll
          for (int q4 = 0; q4 < 4; ++q4) { const f32x4 pv = pp[q4]; o[4 * q4 + 0] += pv[0] * vv[j]; o[4 * q4 + 1] += pv[1] * vv[j]; o[4 * q4 + 2] += pv[2] * vv[j]; o[4 * q4 + 3] += pv[3] * vv[j]; } }
#pragma unroll
      for (int s = 0; s < 16; ++s) red[(wv * 16 + s) * 64 + lane] = o[s]; }
    __syncthreads();
    { const int tid = wv * 64 + lane, s = tid >> 5, dp = (tid & 31) * 2; float o0 = 0.f, o1 = 0.f;
#pragma unroll
      for (int w = 0; w < 8; ++w) { const f32x2 t = *(const LAS f32x2*)(red + (w * 16 + s) * 64 + dp); o0 += t.x; o1 += t.y; }
      *(unsigned*)(O + (size_t)(SEQ + b * 16 + s) * D + h * HD + dq * 64 + dp) = pk2(o0, o1); }
    __syncthreads();
}

template <class Epi8>
__device__ __forceinline__ void skinny_gemm(LAS unsigned char* lds, const bf16_t* A, int lda, const bf16_t* Bt, int ldb, int N, int K, int ksplit, const Epi8& E, int G, int bid, int wv) {
    const int lane = lane_id(), fr = lane & 15, fq = lane >> 4;
    const int ntn = N / 64, per = 4 * ntn, ntiles = per * ksplit, kw = K / ksplit / 8;
    LAS float* red = (LAS float*)lds;
    for (int t = bid; t < ntiles; t += G) {
        const int ks = t / per, tt = t % per, tm = tt & 3, tn = tt >> 2, kbeg = ks * (K / ksplit) + wv * kw;
        f32x4 acc[4][4];
#pragma unroll
        for (int i = 0; i < 4; ++i)
#pragma unroll
            for (int j = 0; j < 4; ++j) acc[i][j] = (f32x4){0.f, 0.f, 0.f, 0.f};
        const bf16_t* ap = A + (size_t)(tm * 64 + fr) * lda + kbeg + fq * 8;
        const bf16_t* bp = Bt + (size_t)(tn * 64 + fr) * ldb + kbeg + fq * 8;
#pragma unroll 4
        for (int k = 0; k < kw; k += 32) { bf16x8 af[4], bfr[4];
#pragma unroll
            for (int i = 0; i < 4; ++i) { af[i] = *(const bf16x8*)(ap + (size_t)i * 16 * lda + k); bfr[i] = *(const bf16x8*)(bp + (size_t)i * 16 * ldb + k); }
#pragma unroll
            for (int i = 0; i < 4; ++i)
#pragma unroll
                for (int j = 0; j < 4; ++j) acc[i][j] = __builtin_amdgcn_mfma_f32_16x16x32_bf16(bfr[j], af[i], acc[i][j], 0, 0, 0); }
#pragma unroll
        for (int i = 0; i < 4; ++i)
#pragma unroll
            for (int j = 0; j < 4; ++j) *(LAS f32x4*)(red + ((wv * 64 + i * 16 + fr) * 64 + (((j * 4 + fq) ^ fr) << 2))) = acc[i][j];
        __syncthreads();
        { const int tid = wv * 64 + lane, row = tid >> 3, s8 = (tid & 7) * 2; f32x4 s0 = {0.f, 0.f, 0.f, 0.f}, s1 = {0.f, 0.f, 0.f, 0.f};
#pragma unroll
          for (int w = 0; w < 8; ++w) { s0 += *(const LAS f32x4*)(red + ((w * 64 + row) * 64 + ((s8 ^ (row & 15)) << 2))); s1 += *(const LAS f32x4*)(red + ((w * 64 + row) * 64 + (((s8 + 1) ^ (row & 15)) << 2))); }
          E(tm * 64 + row, tn * 64 + s8 * 4, s0, s1, lane, ks); }
        __syncthreads();
    }
}
__device__ __forceinline__ u32x2 pack4(const f32x4 v) { u32x2 w; w.x = cvt_pk_bf16(v[0], v[1]); w.y = cvt_pk_bf16(v[2], v[3]); return w; }
struct SkZ { bf16_t* ZP; bf16_t* UH; float* out;
    __device__ __forceinline__ void operator()(int r, int c, f32x4 v0, f32x4 v1, int, int) const { const int row = SEQ + r; const u32x4 w = pack8(v0, v1);
        if (c < DPOOL) { *(u32x4*)(ZP + (size_t)row * DPOOL + c) = w; if ((r & 15) != 0) { float* dst = out + O_POOLS + ((size_t)(r >> 4) * 15 + ((r & 15) - 1)) * DPOOL + c; *(f32x4*)dst = v0; *(f32x4*)(dst + 4) = v1; } }
        else { const int cc = c - DPOOL, gg = cc >> 4, hh = cc & 15; *(u32x4*)(UH + ((size_t)gg * NCHP + (row >> 4)) * KY + (row & 15) * 16 + hh) = w; } } };
struct SkKV { float* out; bf16_t* KB; bf16_t* VT;
    __device__ __forceinline__ void operator()(int r, int c, f32x4 v0, f32x4 v1, int, int) const {
        if (c < D) { float* dst = out + O_MK + (size_t)r * D + c; *(f32x4*)dst = v0; *(f32x4*)(dst + 4) = v1; *(u32x4*)(KB + (size_t)r * D + c) = pack8(v0, v1); }
        else { const int c2 = c - D; float* dst = out + O_MV + (size_t)r * D + c2; *(f32x4*)dst = v0; *(f32x4*)(dst + 4) = v1;
            *(u32x4*)(VT + (size_t)r * D + c2) = pack8(v0, v1); } } };
struct SkPool { bf16_t* CAT; const float* scale;
    __device__ __forceinline__ void operator()(int r, int c, f32x4 v0, f32x4 v1, int, int) const { *(u32x4*)(CAT + (size_t)(SEQ + r) * D + c) = pack8(v0 * *(const f32x4*)(scale + c), v1 * *(const f32x4*)(scale + c + 4)); } };
struct SkGlu { bf16_t* CAT; const bf16_t* MIX; const float* bias;
    __device__ __forceinline__ void operator()(int r, int c, f32x4 v0, f32x4 v1, int, int) const { float y[8]; unpack8(*(const u32x4*)(MIX + (size_t)(SEQ + r) * D + DPOOL + c), y);
        const f32x4 b0 = *(const f32x4*)(bias + c), b1 = *(const f32x4*)(bias + c + 4);
#pragma unroll
        for (int j = 0; j < 4; ++j) { v0[j] = y[j] / (1.f + __expf(-(v0[j] + b0[j]))); v1[j] = y[4 + j] / (1.f + __expf(-(v1[j] + b1[j]))); }
        *(u32x4*)(CAT + (size_t)(SEQ + r) * D + DPOOL + c) = pack8(v0, v1); } };
template <bool BASE_BF16> struct SkRes { const void* base; bf16_t* Xb; float* SS;
    __device__ __forceinline__ void operator()(int r, int c, f32x4 v0, f32x4 v1, int lane, int) const { f32x4 x0, x1;
        if constexpr (BASE_BF16) { float y[8]; unpack8(*(const u32x4*)((const bf16_t*)base + (size_t)r * D + c), y); x0 = v0 + (f32x4){y[0], y[1], y[2], y[3]}; x1 = v1 + (f32x4){y[4], y[5], y[6], y[7]}; }
        else { const float* bp = (const float*)base + (size_t)r * D + c; x0 = v0 + *(const f32x4*)bp; x1 = v1 + *(const f32x4*)(bp + 4); }
        *(u32x4*)(Xb + (size_t)r * D + c) = pack8(x0, x1);
        float q = ((x0[0] * x0[0] + x0[1] * x0[1]) + (x0[2] * x0[2] + x0[3] * x0[3])) + ((x1[0] * x1[0] + x1[1] * x1[1]) + (x1[2] * x1[2] + x1[3] * x1[3]));
        q += shfl_x(q, lane, 1); q += shfl_x(q, lane, 2); q += shfl_x(q, lane, 4);
        if ((lane & 7) == 0) SS[(size_t)r * 16 + (c >> 6)] = q; } };
struct SkQ { bf16_t* Q; const float* SS;
    __device__ __forceinline__ void operator()(int r, int c, f32x4 v0, f32x4 v1, int, int) const { const float rs = row_rstd(SS, r) * QSCALE; *(u32x4*)(Q + (size_t)r * D + c) = pack8(v0 * rs, v1 * rs); } };
struct SkUp { bf16_t* U; const float* SS;
    __device__ __forceinline__ void operator()(int r, int c, f32x4 v0, f32x4 v1, int, int) const { const float rs = row_rstd(SS, r);
#pragma unroll
        for (int j = 0; j < 4; ++j) { const float a = fmaxf(v0[j] * rs, 0.f), b = fmaxf(v1[j] * rs, 0.f); v0[j] = a * a; v1[j] = b * b; }
        *(u32x4*)(U + (size_t)r * DFF + c) = pack8(v0, v1); } };
struct SkSlab { float* slab;
    __device__ __forceinline__ void operator()(int r, int c, f32x4 v0, f32x4 v1, int, int ks) const { float* dst = slab + ((size_t)ks * NSAMP + r) * D + c;
        asm volatile("global_store_dwordx4 %0, %1, off sc0 sc1\n\ts_nop 1" :: "v"(dst), "v"(v0) : "memory");
        asm volatile("global_store_dwordx4 %0, %1, off offset:16 sc0 sc1\n\ts_nop 1" :: "v"(dst), "v"(v1) : "memory"); } };
#define XB_TMO      128
#define XB_XCNT(j)  (256  + 64 * (j))
#define XB_XSUB(j)  (1280 + 64 * (j))
#define XB_XGEN(j)  (2304 + 64 * (j))
#define XB_TOP      3328
#define XB_TOPGEN   3392
#define XCD_BAR_WORDS 3456
#define XB_SPIN_CAP (1u << 18)

__device__ __forceinline__ unsigned xb_ld(unsigned* p)              { return __hip_atomic_load(p, __ATOMIC_RELAXED, __HIP_MEMORY_SCOPE_AGENT); }
__device__ __forceinline__ unsigned xb_add(unsigned* p, unsigned v) { return __hip_atomic_fetch_add(p, v, __ATOMIC_RELAXED, __HIP_MEMORY_SCOPE_AGENT); }
__device__ __forceinline__ unsigned xb_xcc_id() { return (unsigned)__builtin_amdgcn_s_getreg((3 << 11) | 20) & 0xFu; }
#define XB_SPIN(cond, bar) do { unsigned _sp = 0; while (cond) { __builtin_amdgcn_s_sleep(1); \
    if ((++_sp & 255u) == 0u) { if (xb_ld(&(bar)[XB_TMO])) break; if (_sp > XB_SPIN_CAP) { atomicAdd(&(bar)[XB_TMO], 1u); break; } } } } while (0)

struct XcdBarrier {
    unsigned* bar; unsigned x;
    volatile LAS unsigned* st;
};

__device__ __forceinline__ XcdBarrier xcd_barrier_post(unsigned* bar, volatile LAS unsigned* st, int wv) {
    XcdBarrier b; b.bar = bar; b.x = xb_xcc_id(); b.st = st;
    if (tidx(wv) == 0) (void)xb_add(&bar[XB_XCNT(b.x)], 1u);
    return b;
}
__device__ __forceinline__ void xcd_barrier_complete(unsigned* bar, unsigned x, unsigned& nloc, unsigned& nx) {
    const unsigned G = gridDim.x * gridDim.y * gridDim.z;
    unsigned sum, cnt, mine, sp = 0u;
    for (;;) {
        sum = 0u; cnt = 0u; mine = 0u;
#pragma unroll
        for (unsigned j = 0; j < 16; ++j) { const unsigned c = xb_ld(&bar[XB_XCNT(j)]); sum += c; cnt += (c > 0u) ? 1u : 0u; mine = (j == x) ? c : mine; }
        if (sum == G) break;
        __builtin_amdgcn_s_sleep(1);
        if ((++sp & 255u) == 0u) { if (xb_ld(&bar[XB_TMO])) break; if (sp > XB_SPIN_CAP) { atomicAdd(&bar[XB_TMO], 1u); break; } }
    }
    nloc = mine > 0u ? mine : 1u; nx = cnt > 0u ? cnt : 1u;
}

__device__ __forceinline__ void xcd_barrier(const XcdBarrier& b, int wv) {
    asm volatile("s_waitcnt vmcnt(0)" ::: "memory");
    __syncthreads();
    if (tidx(wv) == 0) {
        unsigned* bar = b.bar;
        __builtin_amdgcn_s_waitcnt(0);
        unsigned nloc = b.st[0], nx = b.st[1];
        if (nloc == 0u) { xcd_barrier_complete(bar, b.x, nloc, nx); b.st[0] = nloc; b.st[1] = nx; }
        const unsigned old = xb_add(&bar[XB_XSUB(b.x)], 1u);
        const unsigned gen = old / nloc;
        if (old + 1u == (gen + 1u) * nloc) {
            __builtin_amdgcn_fence(__ATOMIC_RELEASE, "agent");
            asm volatile("s_waitcnt vmcnt(0)" ::: "memory");
            const unsigned og = xb_add(&bar[XB_TOP], 1u);
            const unsigned tg = og / nx;
            if (og + 1u == (tg + 1u) * nx) xb_add(&bar[XB_TOPGEN], 1u);
            else XB_SPIN(xb_ld(&bar[XB_TOPGEN]) == tg, bar);
            __builtin_amdgcn_fence(__ATOMIC_ACQUIRE, "agent");
            xb_add(&bar[XB_XGEN(b.x)], 1u);
            asm volatile("s_waitcnt vmcnt(0)" ::: "memory");
        } else {
            XB_SPIN(xb_ld(&bar[XB_XGEN(b.x)]) == gen, bar);
            __builtin_amdgcn_fence(__ATOMIC_ACQUIRE, "agent");
            asm volatile("s_waitcnt vmcnt(0)" ::: "memory");
        }
    }
    __syncthreads();
}

#ifndef PHMASK
#define PHMASK 0xFFFF
#endif
#define PH(k) if constexpr (((PHMASK) >> (k)) & 1)
#ifndef TPROBE
#define TPROBE 0
#endif
#ifndef TP_BASE
#define TP_BASE 0
#endif
#define TSTAMP(k) do { if (TPROBE && bid == 0 && tidx(wv) == 0) ((unsigned long long*)(ws + WS_BAR + 65536))[k] = __builtin_amdgcn_s_memrealtime(); } while (0)
constexpr int LDS_BYTES = 131072 + 8192 + 2048;
__global__ void __launch_bounds__(512, 2) fwd_megakernel(Ctx C) {
    extern __shared__ __attribute__((aligned(16))) unsigned char lds_raw[];
    LAS unsigned char* lds = (LAS unsigned char*)lds_raw;
    const int wv = __builtin_amdgcn_readfirstlane((int)threadIdx.x >> 6);
    const int G = gridDim.x, bid = blockIdx.x; unsigned char* ws = C.ws;
    bf16_t* T0 = (bf16_t*)(ws + WS_T0); bf16_t* T1 = (bf16_t*)(ws + WS_T1); bf16_t* T2 = (bf16_t*)(ws + WS_T2); bf16_t* OB = (bf16_t*)(ws + WS_OB);
    float* SS1 = (float*)(ws + WS_SSP); float* SS2 = SS1 + (size_t)M * 16;
    float* Y = C.out + O_Y;
    pg8::Order S;

    { volatile LAS unsigned* misc = (volatile LAS unsigned*)(lds + 131072 + 8192); if (tidx(wv) < 16) misc[tidx(wv)] = 0u; }
    __syncthreads();
    const XcdBarrier xbar = xcd_barrier_post((unsigned*)(ws + WS_BAR), (volatile LAS unsigned*)(lds + 131072 + 8192), wv);
    TSTAMP(0);
    p0_prologue(C, lds, G, bid, wv);
    xcd_barrier(xbar, wv);
    TSTAMP(1);

    p1_pre(C, G, bid, wv);
    PH(0) { pg8::Gemm g{(const char*)T0, (const char*)(ws + WS_WIN), D, D, 0, 0, D}; S.init(SEQ / 256, 4, 1, G, bid);
      EpiZ E{(bf16_t*)(ws + WS_ZP), (bf16_t*)(ws + WS_UH), C.out}; pg8::gemm_phase(lds, g, S, E, wv); }
    { SkZ E{(bf16_t*)(ws + WS_ZP), (bf16_t*)(ws + WS_UH), C.out}; skinny_gemm(lds, T0 + (size_t)SEQ * D, D, (const bf16_t*)(ws + WS_WIN), D, D, D, 1, E, G, bid, wv); }
    { SkKV E{C.out, (bf16_t*)(ws + WS_KB), (bf16_t*)(ws + WS_VT)};
      skinny_gemm(lds, (const bf16_t*)(ws + WS_MN), D, (const bf16_t*)(ws + WS_WKV), D, 2 * D, D, 1, E, G, (bid + G - 64) % G, wv); }
    xcd_barrier(xbar, wv);
    TSTAMP(2);

    { S.init(NCHP / 256, 1, NG, G, bid); Unit u0;
      if (S.next(0, u0)) { const int grp = u0.z, tile = u0.pm;
        wy_gen(C, grp * 256 * (KY / 8), (grp + 1) * 256 * (KY / 8), tile * 512 + tidx(wv), 5 * 512);
        PH(2) { pg8::Gemm g{(const char*)(ws + WS_UH), (const char*)(ws + WS_WB), KY, 256, (size_t)NCHP * KY * 2, (size_t)256 * 256 * 2, 256};
          EpiE E{(float*)(ws + WS_E)}; pg8::gemm_phase(lds, g, S, E, wv); }
        asm volatile("s_waitcnt vmcnt(0)" ::: "memory"); __syncthreads();
        if (tidx(wv) == 0) { unsigned* cnt = (unsigned*)(ws + WS_BAR + 16384) + 64 * grp;
            __builtin_amdgcn_fence(__ATOMIC_RELEASE, "agent"); asm volatile("s_waitcnt vmcnt(0)" ::: "memory");
            (void)xb_add(cnt, 1u);
            unsigned sp = 0; while (xb_ld(cnt) < 5u) { __builtin_amdgcn_s_sleep(1); if (++sp > XB_SPIN_CAP) break; }
            __builtin_amdgcn_fence(__ATOMIC_ACQUIRE, "agent"); asm volatile("s_waitcnt vmcnt(0)" ::: "memory"); }
        __syncthreads();
        p2b_prefix(C, lds, grp, tile, wv);
        asm volatile("s_waitcnt vmcnt(0)" ::: "memory"); __syncthreads();
        PH(3) { pg8::Gemm g{(const char*)(ws + WS_UH), (const char*)(ws + WS_WY), KY, KY, (size_t)NCHP * KY * 2, (size_t)256 * KY * 2, KY};
          EpiY E{T1}; pg8::gemm_phase(lds, g, S, E, wv); }
      } else {
        if (bid < 176) { PH(1) { pg8::Gemm g{(const char*)(ws + WS_KB), (const char*)(ws + WS_WQN), D, D, (size_t)HD * 2, (size_t)HD * 2, HD}; S.init(1, 4, NHEAD, 16, bid - 160);
            EpiWqk E{(bf16_t*)(ws + WS_WQK)}; pg8::gemm_phase(lds, g, S, E, wv); } }
        else if (bid < 192) { PH(1) { pg8::Gemm g{(const char*)(ws + WS_WO), (const char*)(ws + WS_VT), D, D, (size_t)HD * 2, (size_t)HD * 2, HD}; S.init(4, 1, NHEAD, 16, bid - 176);
            EpiVWo E{(bf16_t*)(ws + WS_VWO)}; pg8::gemm_phase(lds, g, S, E, wv); } }
        else if (bid < 200) { PH(1) { pg8::Gemm g{(const char*)(ws + WS_WOUT), (const char*)(ws + WS_WPOOL), D, DPOOL, 0, 0, DPOOL}; S.init(4, 2, 1, 8, bid - 192);
            EpiVWo E{(bf16_t*)(ws + WS_WOUT2)}; pg8::gemm_phase(lds, g, S, E, wv); } }
        p2b_pool(C, bid - 160, G - 160, wv); }
    }
    xcd_barrier(xbar, wv);
    TSTAMP(3);

    PH(5) { pg8::Gemm g{(const char*)(T1 + DPOOL), (const char*)(ws + WS_WGLU), D, DSSM, 0, 0, DSSM}; S.init(SEQ / 256, 2, 1, G, bid);
      EpiGlu E{T2, T1, C.in[21]}; pg8::gemm_phase(lds, g, S, E, wv); }
    { SkGlu E{T2, T1, C.in[21]}; skinny_gemm(lds, T1 + (size_t)SEQ * D + DPOOL, D, (const bf16_t*)(ws + WS_WGLU), DSSM, DSSM, DSSM, 1, E, G, (bid + G - 128) % G, wv); }
    xcd_barrier(xbar, wv);
    TSTAMP(6);

    PH(6) { pg8::Gemm g{(const char*)T2, (const char*)(ws + WS_WOUT2), D, D, 0, 0, D}; S.init(SEQ / 256, 4, 1, G, bid);
      EpiRes<false> E{C.in[0], T0, SS1}; pg8::gemm_phase(lds, g, S, E, wv); }
    { SkRes<false> E{C.in[1], T0 + (size_t)SEQ * D, SS1 + (size_t)SEQ * 16}; skinny_gemm(lds, T2 + (size_t)SEQ * D, D, (const bf16_t*)(ws + WS_WOUT2), D, D, D, 1, E, G, bid, wv); }
    xcd_barrier(xbar, wv);
    TSTAMP(7);

    { SkQ E{T1 + (size_t)SEQ * D, SS1 + (size_t)SEQ * 16}; skinny_gemm(lds, T0 + (size_t)SEQ * D, D, (const bf16_t*)(ws + WS_WQ), D, D, D, 1, E, G, bid, wv); }
    asm volatile("s_waitcnt vmcnt(0)" ::: "memory"); __syncthreads();
    if (bid < 64 && tidx(wv) == 0) { __builtin_amdgcn_fence(__ATOMIC_RELEASE, "agent"); asm volatile("s_waitcnt vmcnt(0)" ::: "memory"); (void)xb_add((unsigned*)(ws + WS_BAR + 32768), 1u); }
    TSTAMP(8);
    PH(8) { pg8::Gemm g{(const char*)T0, (const char*)(ws + WS_WQK), D, D, 0, 0, D}; S.init(SEQ / 256, 4, 1, G, bid);
      LAS float* tab = (LAS float*)(lds + 131072 + 8192 + 1024); (void)prep_rstd(tab, SS1, S, wv);
      EpiSoftmax E{T1, (LAS float*)(lds + 131072), (LAS float*)(lds + 131072 + 4096), tab}; pg8::gemm_phase(lds, g, S, E, wv); }
    TSTAMP(9);
    if (tidx(wv) == 0) { unsigned* cnt = (unsigned*)(ws + WS_BAR + 32768); unsigned sp = 0; while (xb_ld(cnt) < 64u) { __builtin_amdgcn_s_sleep(1); if (++sp > XB_SPIN_CAP) break; }
        __builtin_amdgcn_fence(__ATOMIC_ACQUIRE, "agent"); asm volatile("s_waitcnt vmcnt(0)" ::: "memory"); }
    __syncthreads();
    for (int it = bid; it < 256; it += G) {
        const int bh = (it & 7) + 8 * (it >> 5), dq = (it >> 3) & 3; sample_attn_item(C, lds, bh * 4 + dq, wv); }
    xcd_barrier(xbar, wv);
    TSTAMP(10);

    PH(10) { pg8::Gemm g{(const char*)T1, (const char*)(ws + WS_VWO), D, D, 0, 0, D}; S.init(SEQ / 256, 4, 1, G, bid);
      EpiRes<true> E{T0, T2, SS2}; pg8::gemm_phase(lds, g, S, E, wv); }
    { SkRes<true> E{T0 + (size_t)SEQ * D, T2 + (size_t)SEQ * D, SS2 + (size_t)SEQ * 16}; skinny_gemm(lds, OB + (size_t)SEQ * D, D, (const bf16_t*)(ws + WS_WO), D, D, D, 1, E, G, bid, wv); }
    xcd_barrier(xbar, wv);
    TSTAMP(11);

    PH(11) { pg8::Gemm g{(const char*)T2, (const char*)(ws + WS_WUP), D, D, 0, 0, D}; S.init(SEQ / 256, DFF / 256, 1, G, bid);
      LAS float* tab = (LAS float*)(lds + 131072); const int tpm = prep_rstd(tab, SS2, S, wv);
      EpiUp E{(bf16_t*)(ws + WS_U), SS2, tab, tpm}; pg8::gemm_phase(lds, g, S, E, wv); }
    { SkUp E{(bf16_t*)(ws + WS_U) + (size_t)SEQ * DFF, SS2 + (size_t)SEQ * 16}; skinny_gemm(lds, T2 + (size_t)SEQ * D, D, (const bf16_t*)(ws + WS_WUP), D, DFF, D, 1, E, G, bid, wv); }
    xcd_barrier(xbar, wv);
    TSTAMP(12);

    PH(12) { pg8::Gemm g{(const char*)(ws + WS_U), (const char*)(ws + WS_WDOWN), DFF, DFF, 0, 0, DFF}; S.init(SEQ / 256, 4, 1, G, bid);
      EpiFinal E{T2, Y, C.in[32], (float*)(ws + WS_XCH), (unsigned*)(ws + WS_BAR + 40960), (LAS float*)(lds + 131072), (LAS float*)(lds + 131072 + 4096), wv}; pg8::gemm_phase(lds, g, S, E, wv); }
    { SkSlab E{(float*)(ws + WS_SLAB)}; skinny_gemm(lds, (const bf16_t*)(ws + WS_U) + (size_t)SEQ * DFF, DFF, (const bf16_t*)(ws + WS_WDOWN), DFF, D, DFF, 4, E, G, bid, wv); }
    asm volatile("s_waitcnt vmcnt(0)" ::: "memory"); __syncthreads();
    { unsigned* cs = (unsigned*)(ws + WS_BAR + 40960) + 16 * 64;
      if (tidx(wv) == 0) { (void)xb_add(cs, 1u); unsigned sp = 0; while (xb_ld(cs) < 256u) { __builtin_amdgcn_s_sleep(1); if (++sp > XB_SPIN_CAP) break; }
          __builtin_amdgcn_fence(__ATOMIC_ACQUIRE, "agent"); asm volatile("s_waitcnt vmcnt(0)" ::: "memory"); }
      __syncthreads();
      if (wv == 0 && bid < NSAMP) { const int lane = lane_id(), m = SEQ + bid; const u32x2* xr = (const u32x2*)(T2 + (size_t)m * D) + lane; f32x4 v[4]; float ss = 0.f;
#pragma unroll
          for (int j = 0; j < 4; ++j) { const u32x2 w = xr[64 * j]; v[j] = (f32x4){bf2f(w.x & 0xffffu), bf2f(w.x >> 16), bf2f(w.y & 0xffffu), bf2f(w.y >> 16)}; }
#pragma unroll
          for (int ks = 0; ks < 4; ++ks) { const f32x4* sp = (const f32x4*)((const float*)(ws + WS_SLAB) + ((size_t)ks * NSAMP + bid) * D) + lane;
#pragma unroll
              for (int j = 0; j < 4; ++j) v[j] += sp[64 * j]; }
#pragma unroll
          for (int j = 0; j < 4; ++j) ss += (v[j].x * v[j].x + v[j].y * v[j].y) + (v[j].z * v[j].z + v[j].w * v[j].w);
          const float rs = rsqrtf(wave_sum(ss, lane) * (1.f / D) + EPS); const f32x4* gr = (const f32x4*)C.in[32] + lane; f32x4* yr = (f32x4*)(Y + (size_t)m * D) + lane;
#pragma unroll
          for (int j = 0; j < 4; ++j) { const f32x4 gg = gr[64 * j]; yr[64 * j] = (f32x4){v[j].x * rs * gg.x, v[j].y * rs * gg.y, v[j].z * rs * gg.z, v[j].w * rs * gg.w}; } } }
#if TPROBE
    __syncthreads();
    if (bid == 0 && tidx(wv) == 0) { asm volatile("s_waitcnt vmcnt(0)" ::: "memory"); const unsigned long long tend = __builtin_amdgcn_s_memrealtime(); volatile unsigned long long* ts = (volatile unsigned long long*)(ws + WS_BAR + 65536);
        const size_t offs[10] = {O_Y, O_Y + (size_t)SEQ * D, O_MK, O_MV, O_POOLP, O_SREP, O_SIMP, O_POOLS, O_SRES, O_SIMS};
        for (int k = 0; k < 10; ++k) { const int ph = TP_BASE + k; const unsigned long long a = ts[ph], b = (ph + 1 <= 13) ? ts[ph + 1] : tend; C.out[offs[k]] += (float)(b - a) * 0.01f; } }
#endif
}

extern "C" void kernel_launch(void* const* d_in, const int* in_sizes, int n_in, void* d_out, int out_size, void* d_ws, size_t ws_size, hipStream_t stream) {
    static int grid = 0;
    if (grid == 0) {
        if (n_in != 33 || (size_t)out_size != O_END || ws_size < WS_END) { fprintf(stderr, "kernel_launch: unexpected shapes n_in %d out %d ws %zu\n", n_in, out_size, ws_size); grid = -1; return; }
        int dev = 0, cus = 0, per_cu = 0;
        hipGetDevice(&dev); hipDeviceGetAttribute(&cus, hipDeviceAttributeMultiprocessorCount, dev);
        if (hipFuncSetAttribute((const void*)fwd_megakernel, hipFuncAttributeMaxDynamicSharedMemorySize, LDS_BYTES) != hipSuccess) { fprintf(stderr, "kernel_launch: hipFuncSetAttribute failed\n"); grid = -1; return; }
        if (hipOccupancyMaxActiveBlocksPerMultiprocessor(&per_cu, (const void*)fwd_megakernel, 512, LDS_BYTES) != hipSuccess || per_cu < 1) { fprintf(stderr, "kernel_launch: occupancy query failed (%d)\n", per_cu); (void)hipGetLastError(); per_cu = 1; }
        if (per_cu > 1) per_cu = 1;
        grid = cus * per_cu; if (grid > 256) grid = 256;
        if (grid != 256) { fprintf(stderr, "kernel_launch: this kernel is laid out for exactly 256 resident workgroups (one per CU of a 256-CU device), got %d\n", grid); grid = -1; return; }
    }
    if (grid < 0) return;
    Ctx c{};
    for (int i = 0; i < 33; ++i) c.in[i] = (const float*)d_in[i];
    c.out = (float*)d_out; c.ws = (unsigned char*)d_ws;
    if (hipMemsetAsync((char*)d_ws + WS_BAR, 0, 65536, stream) != hipSuccess) { fprintf(stderr, "kernel_launch: memset of the barrier words failed\n"); return; }
    void* args[] = {&c};
    hipError_t e = hipLaunchCooperativeKernel((const void*)fwd_megakernel, dim3(grid), dim3(512), args, LDS_BYTES, stream);
    if (e != hipSuccess) fprintf(stderr, "cooperative launch failed: %s (grid %d)\n", hipGetErrorString(e), grid);
}
```

```cpp
#include <hip/hip_runtime.h>
#include <hip/hip_cooperative_groups.h>
#include <cstdio>
#include <cstdint>
namespace cg = cooperative_groups;

#define LAS __attribute__((address_space(3)))
typedef unsigned short bf16_t;
typedef short bf16x8 __attribute__((ext_vector_type(8)));
typedef float f32x4 __attribute__((ext_vector_type(4)));
typedef float f32x2 __attribute__((ext_vector_type(2)));
typedef unsigned u32x4 __attribute__((ext_vector_type(4)));
typedef unsigned u32x2 __attribute__((ext_vector_type(2)));

constexpr int D = 1024, SEQ = 16384, NSAMP = 256, M = SEQ + NSAMP, DFF = 4096, DPOOL = 512, DSSM = 512;
constexpr int NG = 32, NP = 64, NH = 16, TC = 16, NCH = M / TC  , NCHP = 1280, KY = 384;
constexpr int NMEM = 256, HD = 256, NHEAD = 4;
constexpr float EPS = 1e-6f;
constexpr float QSCALE = 0.0625f * 1.4426950408889634f;

constexpr size_t O_Y = 0, O_MK = (size_t)M * D, O_MV = O_MK + 262144, O_POOLP = O_MV + 262144, O_SREP = O_POOLP + 7680, O_SIMP = O_SREP + 2048,
                 O_POOLS = O_SIMP + 2048, O_SRES = O_POOLS + 122880, O_SIMS = O_SRES + 32768, O_END = O_SIMS + 32768;

constexpr size_t MiB = 1u << 20;
constexpr size_t WS_WIN = 0, WS_WOUT = 2 * MiB, WS_WQ = 4 * MiB, WS_WKV = 6 * MiB, WS_WO = 10 * MiB, WS_WUP = 12 * MiB, WS_WDOWN = 20 * MiB,
                 WS_WGLU = 28 * MiB, WS_WPOOL = 28 * MiB + 512 * 1024, WS_MN = 29 * MiB, WS_KB = 29 * MiB + 512 * 1024, WS_VT = 30 * MiB,
                 WS_AP = 30 * MiB + 512 * 1024,
                 WS_BB = WS_AP + 320 * 1024,
                 WS_KLAG = WS_BB + 256 * 1024,
                 WS_SS = WS_KLAG + 512 * 1024,
                 WS_BAR = 32 * MiB - 128 * 1024,
                 WS_WB = 32 * MiB,
                 WS_WY = 36 * MiB,
                 WS_E = 42 * MiB,
                 WS_UH = 62 * MiB,
                 WS_ZP = 92 * MiB,
                 WS_T0 = 109 * MiB, WS_T1 = 142 * MiB, WS_T2 = 175 * MiB, WS_SSP = 208 * MiB  , WS_XCH = 215 * MiB  , WS_WQN = 216 * MiB  , WS_WQK = 218 * MiB  , WS_VWO = 220 * MiB  , WS_WOUT2 = 222 * MiB  , WS_END = 224 * MiB,
                 WS_OB = 62 * MiB,
                 WS_U = 42 * MiB,
                 WS_SLAB = 211 * MiB;
static_assert(WS_SS + 3 * M * 4 <= WS_BAR, "misc region");
static_assert(WS_U + (size_t)M * DFF * 2 <= WS_T2, "U overlay");

__device__ __forceinline__ unsigned f2bf(float f) { unsigned u = __builtin_bit_cast(unsigned, f); return (u + 0x7fffu + ((u >> 16) & 1u)) >> 16; }
__device__ __forceinline__ unsigned pk2(float lo, float hi) { return f2bf(lo) | (f2bf(hi) << 16); }
__device__ __forceinline__ float bf2f(unsigned b) { return __builtin_bit_cast(float, b << 16); }
__device__ __forceinline__ unsigned cvt_pk_bf16(float lo, float hi) { unsigned r; asm volatile("v_cvt_pk_bf16_f32 %0, %1, %2" : "=v"(r) : "v"(lo), "v"(hi)); return r; }
#define LDS_WAIT() asm volatile("s_waitcnt lgkmcnt(0)" ::: "memory")
__device__ __forceinline__ int lane_id() { int l; asm volatile("v_mbcnt_lo_u32_b32 %0, -1, 0\n\tv_mbcnt_hi_u32_b32 %0, -1, %0" : "=v"(l)); return l; }
__device__ __forceinline__ int tidx(int wv) { return wv * 64 + lane_id(); }
#define SPIN_CAP (1u << 18)
__device__ __forceinline__ unsigned at_ld(unsigned* p) { return __hip_atomic_load(p, __ATOMIC_RELAXED, __HIP_MEMORY_SCOPE_AGENT); }
__device__ __forceinline__ unsigned at_add(unsigned* p, unsigned v) { return __hip_atomic_fetch_add(p, v, __ATOMIC_RELAXED, __HIP_MEMORY_SCOPE_AGENT); }
__device__ __forceinline__ float shfl_x(float v, int lane, int mask) { return __builtin_bit_cast(float, __builtin_amdgcn_ds_bpermute((lane ^ mask) << 2, __builtin_bit_cast(int, v))); }

__device__ __forceinline__ void unpack8(const u32x4 q, float* v) { const unsigned qq[4] = {q.x, q.y, q.z, q.w};
#pragma unroll
    for (int e = 0; e < 8; ++e) v[e] = bf2f((qq[e >> 1] >> ((e & 1) * 16)) & 0xffffu); }
namespace pg8 {
constexpr int BM = 256, BK = 64, HALF = 128, HTB = HALF * BK * 2, STAGE_BYTES = 8 * HTB, NXCD = 8, WGM = 8;
__host__ __device__ __forceinline__ int lds_byte(int r, int c) { const int st = (r >> 4) * 2 + (c >> 5), rr = r & 15, cc = c & 31, ob = rr * 64 + cc * 2; return st * 1024 + (ob ^ (((ob >> 9) & 1) << 5)); }
__host__ __device__ __forceinline__ void stage_rc(int b, int& R, int& C) { const int st = b / 1024, sb = b % 1024, swz = sb ^ (((sb >> 9) & 1) << 5); R = (st >> 1) * 16 + swz / 64; C = (st & 1) * 32 + (swz % 64) / 2; }
__host__ __device__ __forceinline__ int perm32(int rho) { const int n = rho >> 4, i = rho & 15; return 8 * (i >> 2) + 4 * n + (i & 3); }

struct Unit { int pm, pn, z; };
struct Gemm { const char* A; const char* B; int lda, ldb; size_t sAz, sBz; int K; };
struct Order {
    int nM, nN, nZ, G, c; bool zpn;
    __device__ __forceinline__ void init(int nM_, int nN_, int nZ_, int G_, int c_, bool zpn_ = false) { nM = nM_; nN = nN_; nZ = nZ_; G = G_; c = c_; zpn = zpn_; }
    __device__ __forceinline__ bool next(int i, Unit& u) const {
        const int per = nM * nN, nwg = per * nZ; const long L = (long)i * G + c; if (L >= nwg) return false;
        int wgid = (int)L; { const int q = nwg / NXCD, r = nwg % NXCD, xcd = wgid % NXCD, off = wgid / NXCD; wgid = (xcd < r ? xcd * (q + 1) : r * (q + 1) + (xcd - r) * q) + off; }
        u.z = wgid / per; const int l = wgid % per;
        const int nig = WGM * nN, gid = l / nig, fm = gid * WGM, gsz = (nM - fm) < WGM ? (nM - fm) : WGM;
        u.pm = fm + ((l % nig) % gsz); u.pn = (l % nig) / gsz; if (zpn) { u.z = u.pn; u.pn = 0; } return true;
    }
};

template <class Epi>
__device__ __forceinline__ void gemm_phase(LAS unsigned char* lds, const Gemm g, const Order& S, Epi& E, int wv) {
    const int tid = tidx(wv), wid = __builtin_amdgcn_readfirstlane(tid >> 6), lane = tid & 63, wr = wid >> 2, wc = wid & 3, fr = lane & 15, fq = lane >> 4;
    const int nt = g.K / BK;
    unsigned voffA[2], voffB[2];
#pragma unroll
    for (int i = 0; i < 2; ++i) { int R, C; stage_rc(tid * 16 + i * 8192, R, C); const int Rb = Epi::PERM ? ((R & ~31) + perm32(R & 31)) : R;
        voffA[i] = (unsigned)(R * g.lda + C) * 2u; voffB[i] = (unsigned)(Rb * g.ldb + C) * 2u; }
    const size_t kstep = (size_t)(BK * 2);
    const size_t hA = (size_t)HALF * g.lda * 2, hB = (size_t)HALF * g.ldb * 2;
    const unsigned ldsw = (unsigned)wid * 1024u;
    const int aoff = lds_byte(wr * 64 + fr, fq * 8), boff = lds_byte(wc * 32 + fr, fq * 8);
#define PG8_SA(b, h) (((b) * 2 + (h)) * HTB)
#define PG8_SB(b, h) ((4 + (b) * 2 + (h)) * HTB)
#define PG8_STAGE(bufoff, gbase, voff) do { _Pragma("unroll") for (int _i = 0; _i < 2; ++_i) \
        __builtin_amdgcn_global_load_lds((const unsigned*)((const char*)(gbase) + (voff)[_i]), (LAS unsigned*)(lds + (bufoff) + ldsw + _i * 8192), 16, 0, 0); } while (0)
#define PG8_LDA(dst, b, h) do { _Pragma("unroll") for (int m = 0; m < 4; ++m) _Pragma("unroll") for (int k = 0; k < 2; ++k) dst[m][k] = *(const LAS bf16x8*)(lds + PG8_SA(b, h) + aoff + m * 2048 + k * 1024); } while (0)
#define PG8_LDB(dst, b, h) do { _Pragma("unroll") for (int n = 0; n < 2; ++n) _Pragma("unroll") for (int k = 0; k < 2; ++k) dst[n][k] = *(const LAS bf16x8*)(lds + PG8_SB(b, h) + boff + n * 2048 + k * 1024); } while (0)
#define PG8_MMA(ai, bj, At, Bt) do { __builtin_amdgcn_s_setprio(1); _Pragma("unroll") for (int m = 0; m < 4; ++m) _Pragma("unroll") for (int n = 0; n < 2; ++n) _Pragma("unroll") for (int k = 0; k < 2; ++k) \
        acc[ai][bj][m][n] = __builtin_amdgcn_mfma_f32_16x16x32_bf16(Bt[n][k], At[m][k], acc[ai][bj][m][n], 0, 0, 0); __builtin_amdgcn_s_setprio(0); } while (0)
#define PG8_WAIT_V(n) asm volatile("s_waitcnt vmcnt(" #n ")" ::: "memory")
#define PG8_WAIT_L(n) asm volatile("s_waitcnt lgkmcnt(" #n ")" ::: "memory")
#define PG8_BAR __builtin_amdgcn_s_barrier()
#define PG8_SCHED __builtin_amdgcn_sched_barrier(0)
    Unit cur, nxt; int ui = 0;
    if (!S.next(0, cur)) return;
    f32x4 acc[2][2][4][2];
    if constexpr (Epi::ACC_INIT) E.init(acc, cur, wr, wc, fr, fq);
    else {
#pragma unroll
    for (int a = 0; a < 2; ++a)
#pragma unroll
        for (int b = 0; b < 2; ++b)
#pragma unroll
            for (int m = 0; m < 4; ++m)
#pragma unroll
                for (int n = 0; n < 2; ++n) acc[a][b][m][n] = (f32x4){0.f, 0.f, 0.f, 0.f};
    }
    bf16x8 At[4][2], B0[2][2], B1[2][2];
    const char* cA = g.A + (size_t)cur.z * g.sAz + (size_t)cur.pm * 2 * hA; const char* cB = g.B + (size_t)cur.z * g.sBz + (size_t)cur.pn * 2 * hB;
    PG8_STAGE(PG8_SB(0, 0), cB, voffB); PG8_STAGE(PG8_SB(0, 1), cB + hB, voffB); PG8_STAGE(PG8_SA(0, 0), cA, voffA); PG8_STAGE(PG8_SA(0, 1), cA + hA, voffA);
    if (wr == 1) PG8_BAR;
    PG8_WAIT_V(2); PG8_BAR;
    PG8_STAGE(PG8_SB(1, 0), cB + kstep, voffB); PG8_STAGE(PG8_SA(1, 0), cA + kstep, voffA); PG8_STAGE(PG8_SB(1, 1), cB + hB + kstep, voffB);
    PG8_WAIT_V(6); PG8_BAR;
    if constexpr (Epi::ACC_INIT) {
#pragma unroll
        for (int a = 0; a < 2; ++a)
#pragma unroll
            for (int b = 0; b < 2; ++b)
#pragma unroll
                for (int m = 0; m < 4; ++m) asm volatile("" : "+v"(acc[a][b][m][0]), "+v"(acc[a][b][m][1]));
    }
    for (;;) {
        const bool has_next = S.next(ui + 1, nxt);
        const char* nA = has_next ? g.A + (size_t)nxt.z * g.sAz + (size_t)nxt.pm * 2 * hA : cA; const char* nB = has_next ? g.B + (size_t)nxt.z * g.sBz + (size_t)nxt.pn * 2 * hB : cB;
        for (int t = 0; t < nt; t += 2) {
            const bool last = (t == nt - 2);
            const char* a1 = cA + (size_t)(t + 1) * kstep;
            const char* a2 = last ? nA : cA + (size_t)(t + 2) * kstep; const char* b2 = last ? nB : cB + (size_t)(t + 2) * kstep;
            const char* a3 = a2 + kstep; const char* b3 = b2 + kstep;
            PG8_LDB(B0, 0, 0); PG8_LDB(B1, 0, 1); PG8_SCHED; PG8_LDA(At, 0, 0); PG8_STAGE(PG8_SA(1, 1), a1 + hA, voffA);
            PG8_WAIT_V(8); PG8_WAIT_L(0); PG8_BAR; PG8_MMA(0, 0, At, B0); PG8_MMA(0, 1, At, B1); PG8_BAR; PG8_SCHED;
            PG8_LDA(At, 0, 1); PG8_STAGE(PG8_SB(0, 0), b2, voffB); PG8_STAGE(PG8_SB(0, 1), b2 + hB, voffB); PG8_STAGE(PG8_SA(0, 0), a2, voffA);
            PG8_WAIT_V(8); PG8_WAIT_L(0); PG8_BAR; PG8_MMA(1, 0, At, B0); PG8_MMA(1, 1, At, B1); PG8_BAR; PG8_SCHED;
            PG8_LDB(B0, 1, 0); PG8_LDB(B1, 1, 1); PG8_SCHED; PG8_LDA(At, 1, 0); PG8_STAGE(PG8_SA(0, 1), a2 + hA, voffA);
            PG8_WAIT_V(8); PG8_WAIT_L(0); PG8_BAR; PG8_MMA(0, 0, At, B0); PG8_MMA(0, 1, At, B1); PG8_BAR; PG8_SCHED;
            PG8_LDA(At, 1, 1); PG8_STAGE(PG8_SB(1, 0), b3, voffB); PG8_STAGE(PG8_SB(1, 1), b3 + hB, voffB); PG8_STAGE(PG8_SA(1, 0), a3, voffA);
            PG8_WAIT_V(8); PG8_WAIT_L(0); PG8_BAR; PG8_MMA(1, 0, At, B0); PG8_MMA(1, 1, At, B1); PG8_BAR; PG8_SCHED;
        }
        if (wr == 0) PG8_BAR;
        { Unit ue; ue.pm = __builtin_amdgcn_readfirstlane(cur.pm); ue.pn = __builtin_amdgcn_readfirstlane(cur.pn); ue.z = __builtin_amdgcn_readfirstlane(cur.z); const int le = lane_id(); int fre = le & 15, fqe = le >> 4;
          asm volatile("" : "+s"(ue.pm), "+s"(ue.pn), "+s"(ue.z));
          E(acc, ue, wr, wc, fre, fqe); }
        if (!has_next) break;
        if constexpr (Epi::ACC_INIT) { E.init(acc, nxt, wr, wc, fr, fq);
#pragma unroll
            for (int a = 0; a < 2; ++a)
#pragma unroll
                for (int b = 0; b < 2; ++b)
#pragma unroll
                    for (int m = 0; m < 4; ++m) asm volatile("" : "+v"(acc[a][b][m][0]), "+v"(acc[a][b][m][1]));
        } else {
#pragma unroll
        for (int a = 0; a < 2; ++a)
#pragma unroll
            for (int b = 0; b < 2; ++b)
#pragma unroll
                for (int m = 0; m < 4; ++m)
#pragma unroll
                    for (int n = 0; n < 2; ++n) acc[a][b][m][n] = (f32x4){0.f, 0.f, 0.f, 0.f};
        }
        cur = nxt; cA = nA; cB = nB; ++ui;
        if (wr == 1) PG8_BAR;
    }
    PG8_WAIT_V(0);
    PG8_BAR;
#undef PG8_SA
#undef PG8_SB
#undef PG8_STAGE
#undef PG8_LDA
#undef PG8_LDB
#undef PG8_MMA
#undef PG8_WAIT_V
#undef PG8_WAIT_L
#undef PG8_BAR
#undef PG8_SCHED
}
}
using pg8::Unit;
typedef f32x4 Acc[2][2][4][2];

#define EPI_ROWS(ai, m) (u.pm * 256 + (ai) * 128 + wr * 64 + (m) * 16 + fr)
__device__ __forceinline__ bool mfence() { asm volatile("" ::: "memory"); return true; }
#define FOR_AI_M _Pragma("unroll") for (int ai = 0; ai < 2; ++ai) _Pragma("unroll") for (int m = 0; m < 4; ++m) if (mfence())
#define FOR_BJ _Pragma("unroll") for (int bj = 0; bj < 2; ++bj)
__device__ __forceinline__ u32x4 pack8(const f32x4 v0, const f32x4 v1) { u32x4 w; w.x = cvt_pk_bf16(v0[0], v0[1]); w.y = cvt_pk_bf16(v0[2], v0[3]); w.z = cvt_pk_bf16(v1[0], v1[1]); w.w = cvt_pk_bf16(v1[2], v1[3]); return w; }

struct EpiZ {
    static constexpr bool PERM = true, ACC_INIT = false;
    bf16_t* ZP; bf16_t* UH; float* out;
    __device__ __forceinline__ void operator()(Acc& acc, const Unit& u, int wr, int wc, int fr, int fq) const {
        FOR_AI_M { const int row = EPI_ROWS(ai, m);
            FOR_BJ { const int col = u.pn * 256 + bj * 128 + wc * 32 + 8 * fq; const f32x4 v0 = acc[ai][bj][m][0], v1 = acc[ai][bj][m][1]; const u32x4 w = pack8(v0, v1);
                if (col < DPOOL) {
                    *(u32x4*)(ZP + (size_t)row * DPOOL + col) = w;
                    float* dst = nullptr;
                    if (row >= SEQ - 15 && row < SEQ) dst = out + O_POOLP + (size_t)(row - (SEQ - 15)) * DPOOL + col;
                    else if (row >= SEQ && ((row & 15) != 0)) dst = out + O_POOLS + ((size_t)((row - SEQ) >> 4) * 15 + ((row & 15) - 1)) * DPOOL + col;
                    if (dst) { *(f32x4*)dst = v0; *(f32x4*)(dst + 4) = v1; }
                } else {
                    const int cc = col - DPOOL, gg = cc >> 4, hh = cc & 15;
                    *(u32x4*)(UH + ((size_t)gg * NCHP + (row >> 4)) * KY + (row & 15) * 16 + hh) = w;
                } } }
    }
};
struct EpiKV {
    static constexpr bool PERM = false, ACC_INIT = false;
    float* out; bf16_t* KB; bf16_t* VT;
    __device__ __forceinline__ void operator()(Acc& acc, const Unit& u, int wr, int wc, int fr, int fq) const {
        FOR_AI_M { const int row = EPI_ROWS(ai, m);
            FOR_BJ {
#pragma unroll
                for (int n = 0; n < 2; ++n) { const int col = u.pn * 256 + bj * 128 + wc * 32 + 16 * n + 4 * fq; const f32x4 v = acc[ai][bj][m][n];
                    if (col < D) { *(f32x4*)(out + O_MK + (size_t)row * D + col) = v; u32x2 w; w.x = cvt_pk_bf16(v[0], v[1]); w.y = cvt_pk_bf16(v[2], v[3]); *(u32x2*)(KB + (size_t)row * D + col) = w; }
                    else { const int c2 = col - D; *(f32x4*)(out + O_MV + (size_t)row * D + c2) = v; } } }
            asm volatile("" ::: "memory"); }
    }
};
struct EpiE {
    static constexpr bool PERM = false, ACC_INIT = false;
    float* E;
    __device__ __forceinline__ void operator()(Acc& acc, const Unit& u, int wr, int wc, int fr, int fq) const {
        FOR_AI_M { const int row = EPI_ROWS(ai, m);
#pragma unroll
            for (int n = 0; n < 2; ++n) { const int col = wc * 32 + 16 * n + 4 * fq; *(f32x4*)(E + ((size_t)u.z * NCHP + row) * 128 + col) = acc[ai][0][m][n]; } }
    }
};
__device__ __forceinline__ float fast_sig_scale(float y, float a) {
    return y * __builtin_amdgcn_rcpf(1.f + __builtin_amdgcn_exp2f(-1.4426950408889634f * a)); }
__device__ __forceinline__ float gelu_tanh(float x) {
    const float t = 0.7978845608028654f * (x + 0.044715f * x * x * x);
    return fast_sig_scale(x, 2.f * t);
}
struct EpiY {
    static constexpr bool PERM = true, ACC_INIT = false;
    bf16_t* MIX;
    __device__ __forceinline__ void operator()(Acc& acc, const Unit& u, int wr, int wc, int fr, int fq) const {
        FOR_AI_M { const int ch = EPI_ROWS(ai, m); if (ch < NCH) {
            FOR_BJ { const int col = bj * 128 + wc * 32 + 8 * fq, t = col >> 4, hh = col & 15; f32x4 v0 = acc[ai][bj][m][0], v1 = acc[ai][bj][m][1];
#pragma unroll
                for (int j = 0; j < 4; ++j) { v0[j] = gelu_tanh(v0[j]); v1[j] = gelu_tanh(v1[j]); }
                *(u32x4*)(MIX + (size_t)(ch * 16 + t) * D + DPOOL + u.z * 16 + hh) = pack8(v0, v1); } } }
    }
};
struct EpiPool {
    static constexpr bool PERM = true, ACC_INIT = false;
    bf16_t* CAT; const float* scale;
    __device__ __forceinline__ void operator()(Acc& acc, const Unit& u, int wr, int wc, int fr, int fq) const {
        FOR_BJ { const int col = u.pn * 256 + bj * 128 + wc * 32 + 8 * fq; const f32x4 s0 = *(const f32x4*)(scale + col), s1 = *(const f32x4*)(scale + col + 4);
            FOR_AI_M { const int row = EPI_ROWS(ai, m); *(u32x4*)(CAT + (size_t)row * D + col) = pack8(acc[ai][bj][m][0] * s0, acc[ai][bj][m][1] * s1); } }
    }
};
struct EpiGlu {
    static constexpr bool PERM = true, ACC_INIT = false;
    bf16_t* CAT; const bf16_t* MIX; const float* bias;
    __device__ __forceinline__ void operator()(Acc& acc, const Unit& u, int wr, int wc, int fr, int fq) const {
        FOR_BJ { const int col = u.pn * 256 + bj * 128 + wc * 32 + 8 * fq; const f32x4 b0 = *(const f32x4*)(bias + col), b1 = *(const f32x4*)(bias + col + 4);
            u32x4 yv[2][4];
#pragma unroll
            for (int ai = 0; ai < 2; ++ai)
#pragma unroll
                for (int m = 0; m < 4; ++m) yv[ai][m] = *(const u32x4*)(MIX + (size_t)EPI_ROWS(ai, m) * D + DPOOL + col);
            FOR_AI_M { const int row = EPI_ROWS(ai, m); float y[8]; unpack8(yv[ai][m], y);
                f32x4 v0 = acc[ai][bj][m][0] + b0, v1 = acc[ai][bj][m][1] + b1;
#pragma unroll
                for (int j = 0; j < 4; ++j) { v0[j] = fast_sig_scale(y[j], v0[j]); v1[j] = fast_sig_scale(y[4 + j], v1[j]); }
                *(u32x4*)(CAT + (size_t)row * D + DPOOL + col) = pack8(v0, v1); } }
    }
};
template <bool BASE_BF16> struct EpiRes {
    static constexpr bool PERM = false, ACC_INIT = true;
    const void* base; bf16_t* Xb; float* SS;
    __device__ __forceinline__ void init(Acc& acc, const Unit& u, int wr, int wc, int fr, int fq) const {
#pragma unroll
        for (int ai = 0; ai < 2; ++ai)
#pragma unroll
            for (int m = 0; m < 4; ++m) { const size_t off = (size_t)EPI_ROWS(ai, m) * D + u.pn * 256 + wc * 32 + 4 * fq;
#pragma unroll
                for (int bj = 0; bj < 2; ++bj)
#pragma unroll
                    for (int n = 0; n < 2; ++n) {
                        if constexpr (BASE_BF16) { const u32x2 w = *(const u32x2*)((const bf16_t*)base + off + bj * 128 + 16 * n); acc[ai][bj][m][n] = (f32x4){bf2f(w.x & 0xffffu), bf2f(w.x >> 16), bf2f(w.y & 0xffffu), bf2f(w.y >> 16)}; }
                        else acc[ai][bj][m][n] = __builtin_nontemporal_load((const f32x4*)((const float*)base + off + bj * 128 + 16 * n)); } }
    }
    __device__ __forceinline__ void operator()(Acc& acc, const Unit& u, int wr, int wc, int fr, int fq) const {
        FOR_AI_M { const int row = EPI_ROWS(ai, m); float ssq = 0.f;
            FOR_BJ {
#pragma unroll
                for (int n = 0; n < 2; ++n) { const int col = u.pn * 256 + bj * 128 + wc * 32 + 16 * n + 4 * fq; const f32x4 v = acc[ai][bj][m][n];
                    ssq += (v[0] * v[0] + v[1] * v[1]) + (v[2] * v[2] + v[3] * v[3]);
                    u32x2 w; w.x = cvt_pk_bf16(v[0], v[1]); w.y = cvt_pk_bf16(v[2], v[3]); *(u32x2*)(Xb + (size_t)row * D + col) = w; } }
            if (SS) { ssq += shfl_x(ssq, fr + 16 * fq, 16); ssq += shfl_x(ssq, fr + 16 * fq, 32);
                if (fq == 0) SS[(size_t)row * 16 + u.pn * 4 + wc] = ssq; } }
    }
};
__device__ __forceinline__ float row_rstd(const float* SS, int row) { const f32x4* p = (const f32x4*)(SS + (size_t)row * 16); const f32x4 a = p[0], b = p[1], c = p[2], d = p[3];
    const float t = ((a[0] + a[1]) + (a[2] + a[3])) + ((b[0] + b[1]) + (b[2] + b[3])) + ((c[0] + c[1]) + (c[2] + c[3])) + ((d[0] + d[1]) + (d[2] + d[3])); return rsqrtf(t * (1.f / D) + EPS); }
__device__ __forceinline__ int prep_rstd(LAS float* tab, const float* SS, const pg8::Order& S, int wv) {
    Unit u0; int pm = -1;
    if (S.next(0, u0)) { pm = u0.pm; const int tid = tidx(wv); if (tid < 256) tab[tid] = row_rstd(SS, pm * 256 + tid); }
    __syncthreads();
    return pm;
}
struct EpiQ {
    static constexpr bool PERM = true, ACC_INIT = false;
    bf16_t* Q; const float* SS; const LAS float* tab; int tab_pm;
    __device__ __forceinline__ void operator()(Acc& acc, const Unit& u, int wr, int wc, int fr, int fq) const {
        FOR_AI_M { const int row = EPI_ROWS(ai, m); const float rs = ((u.pm == tab_pm) ? tab[ai * 128 + wr * 64 + m * 16 + fr] : row_rstd(SS, row)) * QSCALE;
            FOR_BJ { const int col = u.pn * 256 + bj * 128 + wc * 32 + 8 * fq; *(u32x4*)(Q + (size_t)row * D + col) = pack8(acc[ai][bj][m][0] * rs, acc[ai][bj][m][1] * rs); } }
    }
};
struct EpiWqk {
    static constexpr bool PERM = true, ACC_INIT = false;
    bf16_t* W;
    __device__ __forceinline__ void operator()(Acc& acc, const Unit& u, int wr, int wc, int fr, int fq) const {
        FOR_AI_M { const int row = u.z * 256 + ai * 128 + wr * 64 + m * 16 + fr;
            FOR_BJ { const int col = u.pn * 256 + bj * 128 + wc * 32 + 8 * fq; *(u32x4*)(W + (size_t)row * D + col) = pack8(acc[ai][bj][m][0], acc[ai][bj][m][1]); } }
    }
};
struct EpiVWo {
    static constexpr bool PERM = true, ACC_INIT = false;
    bf16_t* W;
    __device__ __forceinline__ void operator()(Acc& acc, const Unit& u, int wr, int wc, int fr, int fq) const {
        FOR_AI_M { const int row = EPI_ROWS(ai, m);
            FOR_BJ { const int col = (u.z + u.pn) * 256 + bj * 128 + wc * 32 + 8 * fq; *(u32x4*)(W + (size_t)row * D + col) = pack8(acc[ai][bj][m][0], acc[ai][bj][m][1]); } }
    }
};
struct EpiSoftmax {
    static constexpr bool PERM = true, ACC_INIT = false;
    bf16_t* P; LAS float* tmax; LAS float* tsum; const LAS float* rs;
    __device__ __forceinline__ void operator()(Acc& acc, const Unit& u, int wr, int wc, int fr, int fq) const {
        if (rs) { FOR_AI_M { const float sc = rs[ai * 128 + wr * 64 + m * 16 + fr] * QSCALE;
            FOR_BJ {
#pragma unroll
                for (int n = 0; n < 2; ++n) acc[ai][bj][m][n] = acc[ai][bj][m][n] * sc; } } }
        FOR_AI_M { float mx = -3.0e38f;
            FOR_BJ {
#pragma unroll
                for (int n = 0; n < 2; ++n) { const f32x4 v = acc[ai][bj][m][n]; mx = fmaxf(mx, fmaxf(fmaxf(v[0], v[1]), fmaxf(v[2], v[3]))); } }
            mx = fmaxf(mx, shfl_x(mx, fr + 16 * fq, 16)); mx = fmaxf(mx, shfl_x(mx, fr + 16 * fq, 32));
            if (fq == 0) tmax[(ai * 128 + wr * 64 + m * 16 + fr) * 4 + wc] = mx; }
        LDS_WAIT(); __builtin_amdgcn_s_barrier(); asm volatile("" ::: "memory");
        FOR_AI_M { const int r = ai * 128 + wr * 64 + m * 16 + fr; const f32x4 t = *(const LAS f32x4*)(tmax + r * 4); const float mx = fmaxf(fmaxf(t[0], t[1]), fmaxf(t[2], t[3])); float s = 0.f;
            FOR_BJ {
#pragma unroll
                for (int n = 0; n < 2; ++n) { f32x4 v = acc[ai][bj][m][n];
#pragma unroll
                    for (int j = 0; j < 4; ++j) { v[j] = __builtin_amdgcn_exp2f(v[j] - mx); s += v[j]; }
                    acc[ai][bj][m][n] = v; } }
            s += shfl_x(s, fr + 16 * fq, 16); s += shfl_x(s, fr + 16 * fq, 32);
            if (fq == 0) tsum[r * 4 + wc] = s; }
        LDS_WAIT(); __builtin_amdgcn_s_barrier(); asm volatile("" ::: "memory");
        FOR_AI_M { const int r = ai * 128 + wr * 64 + m * 16 + fr, row = u.pm * 256 + r; const f32x4 t = *(const LAS f32x4*)(tsum + r * 4); const float inv = 1.f / ((t[0] + t[1]) + (t[2] + t[3]));
            FOR_BJ { const int col = (u.z + u.pn) * 256 + bj * 128 + wc * 32 + 8 * fq; *(u32x4*)(P + (size_t)row * D + col) = pack8(acc[ai][bj][m][0] * inv, acc[ai][bj][m][1] * inv); } }
    }
};
struct EpiO {
    static constexpr bool PERM = true, ACC_INIT = false;
    bf16_t* O;
    __device__ __forceinline__ void operator()(Acc& acc, const Unit& u, int wr, int wc, int fr, int fq) const {
        FOR_AI_M { const int row = EPI_ROWS(ai, m);
            FOR_BJ { const int col = u.z * 256 + bj * 128 + wc * 32 + 8 * fq; *(u32x4*)(O + (size_t)row * D + col) = pack8(acc[ai][bj][m][0], acc[ai][bj][m][1]); } }
    }
};
struct EpiUp {
    static constexpr bool PERM = true, ACC_INIT = false;
    bf16_t* U; const float* SS; const LAS float* tab; int tab_pm;
    __device__ __forceinline__ void operator()(Acc& acc, const Unit& u, int wr, int wc, int fr, int fq) const {
        FOR_AI_M { const int row = EPI_ROWS(ai, m); const float rs = (u.pm == tab_pm) ? tab[ai * 128 + wr * 64 + m * 16 + fr] : row_rstd(SS, row);
            FOR_BJ { const int col = u.pn * 256 + bj * 128 + wc * 32 + 8 * fq; f32x4 v0 = acc[ai][bj][m][0] * rs, v1 = acc[ai][bj][m][1] * rs;
#pragma unroll
                for (int j = 0; j < 4; ++j) { const float a = fmaxf(v0[j], 0.f), b = fmaxf(v1[j], 0.f); v0[j] = a * a; v1[j] = b * b; }
                *(u32x4*)(U + (size_t)row * DFF + col) = pack8(v0, v1); } }
    }
};

struct EpiFinal {
    static constexpr bool PERM = false, ACC_INIT = true;
    const bf16_t* base; float* out; const float* gain; float* xch; unsigned* cnt; LAS float* P; LAS float* Sr; int wv;
    __device__ __forceinline__ void init(Acc& acc, const Unit& u, int wr, int wc, int fr, int fq) const {
#pragma unroll
        for (int ai = 0; ai < 2; ++ai)
#pragma unroll
            for (int m = 0; m < 4; ++m) { const size_t off = (size_t)EPI_ROWS(ai, m) * D + u.pn * 256 + wc * 32 + 4 * fq;
#pragma unroll
                for (int bj = 0; bj < 2; ++bj)
#pragma unroll
                    for (int n = 0; n < 2; ++n) { const u32x2 w = *(const u32x2*)(base + off + bj * 128 + 16 * n); acc[ai][bj][m][n] = (f32x4){bf2f(w.x & 0xffffu), bf2f(w.x >> 16), bf2f(w.y & 0xffffu), bf2f(w.y >> 16)}; } }
    }
    __device__ __forceinline__ void operator()(Acc& acc, const Unit& u, int wr, int wc, int fr, int fq) const {
        FOR_AI_M { float ssq = 0.f;
            FOR_BJ {
#pragma unroll
                for (int n = 0; n < 2; ++n) { const f32x4 v = acc[ai][bj][m][n]; ssq += (v[0] * v[0] + v[1] * v[1]) + (v[2] * v[2] + v[3] * v[3]); } }
            ssq += shfl_x(ssq, fr + 16 * fq, 16); ssq += shfl_x(ssq, fr + 16 * fq, 32);
            if (fq == 0) P[(ai * 128 + wr * 64 + m * 16 + fr) * 4 + wc] = ssq; }
        LDS_WAIT(); __builtin_amdgcn_s_barrier(); asm volatile("" ::: "memory");
        const int tid = tidx(wv);
        if (tid < 256) { const f32x4 t = *(const LAS f32x4*)(P + tid * 4);
            __hip_atomic_store(xch + ((size_t)(u.pm * 256 + tid) * 4 + u.pn), (t[0] + t[1]) + (t[2] + t[3]), __ATOMIC_RELAXED, __HIP_MEMORY_SCOPE_AGENT); }
        asm volatile("s_waitcnt vmcnt(0)" ::: "memory"); __builtin_amdgcn_s_barrier(); asm volatile("" ::: "memory");
        if (tid == 0) { unsigned* c = cnt + 16 * u.pm; (void)at_add(c, 1u); unsigned sp = 0; while (at_ld(c) < 4u) { __builtin_amdgcn_s_sleep(1); if (++sp > SPIN_CAP) break; }
            __builtin_amdgcn_fence(__ATOMIC_ACQUIRE, "agent"); asm volatile("s_waitcnt vmcnt(0)" ::: "memory"); }
        __builtin_amdgcn_s_barrier(); asm volatile("" ::: "memory");
        if (tid < 256) { float* x = xch + (size_t)(u.pm * 256 + tid) * 4; float t = 0.f;
#pragma unroll
            for (int j = 0; j < 4; ++j) t += __hip_atomic_load(x + j, __ATOMIC_RELAXED, __HIP_MEMORY_SCOPE_AGENT);
            Sr[tid] = rsqrtf(t * (1.f / D) + EPS); }
        LDS_WAIT(); __builtin_amdgcn_s_barrier(); asm volatile("" ::: "memory");
        f32x4 gv[2][2];
#pragma unroll
        for (int bj = 0; bj < 2; ++bj)
#pragma unroll
            for (int n = 0; n < 2; ++n) gv[bj][n] = *(const f32x4*)(gain + u.pn * 256 + bj * 128 + wc * 32 + 16 * n + 4 * fq);
        FOR_AI_M { const int r = ai * 128 + wr * 64 + m * 16 + fr; const float rs = Sr[r]; float* orow = out + (size_t)(u.pm * 256 + r) * D + u.pn * 256 + wc * 32 + 4 * fq;
            FOR_BJ {
#pragma unroll
                for (int n = 0; n < 2; ++n) *(f32x4*)(orow + bj * 128 + 16 * n) = acc[ai][bj][m][n] * rs * gv[bj][n]; } }
    }
};

struct Ctx {
    const float* in[33]; float* out; unsigned char* ws;
};
__device__ __forceinline__ float wave_sum(float v, int lane) {
#pragma unroll
    for (int o = 1; o < 64; o <<= 1) v += shfl_x(v, lane, o);
    return v;
}
__device__ __forceinline__ float wave_max(float v, int lane) {
#pragma unroll
    for (int o = 1; o < 64; o <<= 1) v = fmaxf(v, shfl_x(v, lane, o));
    return v;
}
__device__ __forceinline__ void transpose_item(const float* W, int ldw, int nblk, bf16_t* WT, int ldt, int row_off, int col_off, const float* ksc, LAS float* scr, int item, int lane) {
    const int kb = item / nblk, nb = item % nblk, k0 = 64 * kb, n0 = 32 * nb;
#pragma unroll
    for (int i = 0; i < 8; ++i) { const int kk = 8 * i + (lane >> 3), nn = 4 * (lane & 7);
        f32x4 v = __builtin_nontemporal_load((const f32x4*)&W[(size_t)(k0 + kk) * ldw + n0 + nn]); if (ksc) v = v * ksc[k0 + kk];
        scr[kk * 33 + nn] = v[0]; scr[kk * 33 + nn + 1] = v[1]; scr[kk * 33 + nn + 2] = v[2]; scr[kk * 33 + nn + 3] = v[3]; }
    LDS_WAIT(); asm volatile("" ::: "memory");
    const int c = lane & 7;
#pragma unroll
    for (int j = 0; j < 4; ++j) { const int n = (lane >> 3) + 8 * j; const LAS float* s = scr + (8 * c) * 33 + n;
        u32x4 o; o.x = pk2(s[0 * 33], s[1 * 33]); o.y = pk2(s[2 * 33], s[3 * 33]); o.z = pk2(s[4 * 33], s[5 * 33]); o.w = pk2(s[6 * 33], s[7 * 33]);
        *(u32x4*)(WT + (size_t)(row_off + n0 + n) * ldt + col_off + k0 + 8 * c) = o; }
    LDS_WAIT(); asm volatile("" ::: "memory");
}
__device__ __forceinline__ void rms_row_to_bf16(const float* xrow, const float* g, bf16_t* orow, int lane) {
    const f32x4* xr = (const f32x4*)xrow + lane; const f32x4* gr = (const f32x4*)g + lane;
    f32x4 v[4]; float s = 0.f;
#pragma unroll
    for (int j = 0; j < 4; ++j) { v[j] = __builtin_nontemporal_load(&xr[64 * j]); s += (v[j].x * v[j].x + v[j].y * v[j].y) + (v[j].z * v[j].z + v[j].w * v[j].w); }
    const float rs = rsqrtf(wave_sum(s, lane) * (1.f / D) + EPS);
    u32x2* o8 = (u32x2*)orow + lane;
#pragma unroll
    for (int j = 0; j < 4; ++j) { const f32x4 gg = gr[64 * j]; u32x2 w; w.x = pk2(v[j].x * rs * gg.x, v[j].y * rs * gg.y); w.y = pk2(v[j].z * rs * gg.z, v[j].w * rs * gg.w); o8[64 * j] = w; }
}

__device__ __forceinline__ void p0_prologue(const Ctx& C, LAS unsigned char* lds, int G, int bid, int wv) {
    const int tid = tidx(wv), lane = tid & 63, wave = tid >> 6;
    LAS float* scr = (LAS float*)(lds + wave * 16384);
    const int gw = bid * 8 + wave, NGW = G * 8;
    unsigned char* ws = C.ws;
    constexpr int I_SQ = 16 * 32, I_UP = 16 * 128, I_DN = 64 * 32, I_GLU = 8 * 16, I_PL = 8 * 32;
    constexpr int NIT = 6 * I_SQ + I_UP + I_DN + I_GLU + I_PL;
    for (int it = gw; it < NIT; it += NGW) {
        int r = it;
        if (r < I_SQ) { transpose_item(C.in[9], D, 32, (bf16_t*)(ws + WS_WIN), D, 0, 0, nullptr, scr, r, lane); continue; } r -= I_SQ;
        if (r < I_SQ) { transpose_item(C.in[22], D, 32, (bf16_t*)(ws + WS_WOUT), D, 0, 0, nullptr, scr, r, lane); continue; } r -= I_SQ;
        if (r < I_SQ) { transpose_item(C.in[25], D, 32, (bf16_t*)(ws + WS_WQ), D, 0, 0, C.in[23], scr, r, lane); continue; } r -= I_SQ;
        if (r < I_SQ) { transpose_item(C.in[26], D, 32, (bf16_t*)(ws + WS_WKV), D, 0, 0, nullptr, scr, r, lane); continue; } r -= I_SQ;
        if (r < I_SQ) { transpose_item(C.in[27], D, 32, (bf16_t*)(ws + WS_WKV), D, D, 0, nullptr, scr, r, lane); continue; } r -= I_SQ;
        if (r < I_SQ) { transpose_item(C.in[28], D, 32, (bf16_t*)(ws + WS_WO), D, 0, 0, nullptr, scr, r, lane); continue; } r -= I_SQ;
        if (r < I_UP) { transpose_item(C.in[30], DFF, 128, (bf16_t*)(ws + WS_WUP), D, 0, 0, C.in[29], scr, r, lane); continue; } r -= I_UP;
        if (r < I_DN) { transpose_item(C.in[31], D, 32, (bf16_t*)(ws + WS_WDOWN), DFF, 0, 0, nullptr, scr, r, lane); continue; } r -= I_DN;
        if (r < I_GLU) { transpose_item(C.in[20], DSSM, 16, (bf16_t*)(ws + WS_WGLU), DSSM, 0, 0, nullptr, scr, r, lane); continue; } r -= I_GLU;
        transpose_item(C.in[22] + (size_t)DPOOL * D, D, 32, (bf16_t*)(ws + WS_WOUT2), D, 0, DPOOL, nullptr, scr, r, lane);
    }
    const int gt = bid * 512 + tid, NGT = G * 512;
    { bf16_t* WP = (bf16_t*)(ws + WS_WPOOL); const float* wp = C.in[10]; const float* sc = C.in[11];
      for (int i = gt; i < 512 * 512 / 8; i += NGT) { const int c = i / 64, d0 = (i % 64) * 8; u32x4 o = {0u, 0u, 0u, 0u};
          if ((c >> 7) == (d0 >> 7)) { const float* src = wp + ((size_t)(c >> 7) * 128 + (c & 127)) * 128 + (d0 & 127); const f32x4 a = *(const f32x4*)src, b = *(const f32x4*)(src + 4), s0 = *(const f32x4*)(sc + d0), s1 = *(const f32x4*)(sc + d0 + 4);
              o.x = pk2(a[0] * s0[0], a[1] * s0[1]); o.y = pk2(a[2] * s0[2], a[3] * s0[3]); o.z = pk2(b[0] * s1[0], b[1] * s1[1]); o.w = pk2(b[2] * s1[2], b[3] * s1[3]); }
          *(u32x4*)(WP + (size_t)c * DPOOL + d0) = o; }
    }
    { const float* Wq = C.in[25]; const float* gx = C.in[23]; bf16_t* WQN = (bf16_t*)(ws + WS_WQN);
      for (int i = gt; i < D * D / 8; i += NGT) { const int k = i >> 7; const float gk = gx[k]; const f32x4 a = *(const f32x4*)(Wq + (size_t)i * 8), b = *(const f32x4*)(Wq + (size_t)i * 8 + 4);
          u32x4 o; o.x = pk2(a[0] * gk, a[1] * gk); o.y = pk2(a[2] * gk, a[3] * gk); o.z = pk2(b[0] * gk, b[1] * gk); o.w = pk2(b[2] * gk, b[3] * gk); *(u32x4*)(WQN + (size_t)i * 8) = o; } }
    { bf16_t* H1 = (bf16_t*)(ws + WS_T0); bf16_t* MN = (bf16_t*)(ws + WS_MN);
      auto src = [&](int m) -> const f32x4* { return (const f32x4*)(m < SEQ ? C.in[0] + (size_t)m * D : (m < M ? C.in[1] + (size_t)(m - SEQ) * D : C.in[7] + (size_t)(m - M) * D)) + lane; };
      int m = NGW - 1 - gw; f32x4 nx[4];
      if (m < M + NMEM) { const f32x4* xr = src(m);
#pragma unroll
          for (int j = 0; j < 4; ++j) nx[j] = __builtin_nontemporal_load(&xr[64 * j]); }
      for (; m < M + NMEM; m += NGW) { f32x4 v[4];
#pragma unroll
          for (int j = 0; j < 4; ++j) v[j] = nx[j];
          if (m + NGW < M + NMEM) { const f32x4* xr = src(m + NGW);
#pragma unroll
              for (int j = 0; j < 4; ++j) nx[j] = __builtin_nontemporal_load(&xr[64 * j]); }
          float ss = 0.f;
#pragma unroll
          for (int j = 0; j < 4; ++j) ss += (v[j].x * v[j].x + v[j].y * v[j].y) + (v[j].z * v[j].z + v[j].w * v[j].w);
          const float rs = rsqrtf(wave_sum(ss, lane) * (1.f / D) + EPS);
          const f32x4* gr = (const f32x4*)(m < M ? C.in[8] : C.in[24]) + lane; u32x2* o8 = (u32x2*)(m < M ? H1 + (size_t)m * D : MN + (size_t)(m - M) * D) + lane;
#pragma unroll
          for (int j = 0; j < 4; ++j) { const f32x4 gg = gr[64 * j]; u32x2 w; w.x = pk2(v[j].x * rs * gg.x, v[j].y * rs * gg.y); w.y = pk2(v[j].z * rs * gg.z, v[j].w * rs * gg.w); o8[64 * j] = w; } } }
    { float* AP = (float*)(ws + WS_AP); float* BB = (float*)(ws + WS_BB);
      for (int i = gt; i < NG * NP; i += NGT) { const int g = i / NP, p = i % NP;
          const float are = C.in[12][i], aim = C.in[13][i], dt = expf(C.in[19][g]);
          const float mag = expf(are * dt); float sn, cs; sincosf(aim * dt, &sn, &cs);
          const float abr = mag * cs, abi = mag * sn;
          float pr = 1.f, pi = 0.f;
          for (int k = 0; k <= 16; ++k) { AP[((size_t)(g * 17 + k) * NP + p) * 2] = pr; AP[((size_t)(g * 17 + k) * NP + p) * 2 + 1] = pi; const float nr = pr * abr - pi * abi, ni = pr * abi + pi * abr; pr = nr; pi = ni; }
          const float nr = abr - 1.f, ni = abi, den = are * are + aim * aim; const float cr = (nr * are + ni * aim) / den, ci = (ni * are - nr * aim) / den;
          for (int h = 0; h < NH; ++h) { const float br = C.in[14][(size_t)i * NH + h], bi = C.in[15][(size_t)i * NH + h];
              BB[((size_t)i * NH + h) * 2] = cr * br - ci * bi; BB[((size_t)i * NH + h) * 2 + 1] = cr * bi + ci * br; } } }
}
__device__ __forceinline__ void p1_pre(const Ctx& C, int G, int bid, int wv) {
    const int gt = bid * 512 + tidx(wv), NGT = G * 512; unsigned char* ws = C.ws;
    const float* AP = (const float*)(ws + WS_AP); const float* BB = (const float*)(ws + WS_BB); float* KL = (float*)(ws + WS_KLAG); bf16_t* WB = (bf16_t*)(ws + WS_WB);
    for (int i = gt; i < NG * 16 * 16 * 16; i += NGT) { const int hp = i & 15, h = (i >> 4) & 15, k = (i >> 8) & 15, g = i >> 12; float s = 0.f;
        const f32x4* crp = (const f32x4*)(C.in[16] + ((size_t)g * NH + h) * NP); const f32x4* cip = (const f32x4*)(C.in[17] + ((size_t)g * NH + h) * NP);
        const f32x4* app = (const f32x4*)(AP + (size_t)(g * 17 + k) * NP * 2); const f32x2* bbp = (const f32x2*)(BB + ((size_t)g * NP * NH + hp) * 2);
#pragma unroll 4
        for (int p4 = 0; p4 < NP / 4; ++p4) { const f32x4 cr = crp[p4], ci = cip[p4], a0 = app[2 * p4], a1 = app[2 * p4 + 1];
            const f32x2 b0 = bbp[(4 * p4 + 0) * NH], b1 = bbp[(4 * p4 + 1) * NH], b2 = bbp[(4 * p4 + 2) * NH], b3 = bbp[(4 * p4 + 3) * NH];
            s += cr[0] * (a0[0] * b0.x - a0[1] * b0.y) - ci[0] * (a0[0] * b0.y + a0[1] * b0.x);
            s += cr[1] * (a0[2] * b1.x - a0[3] * b1.y) - ci[1] * (a0[2] * b1.y + a0[3] * b1.x);
            s += cr[2] * (a1[0] * b2.x - a1[1] * b2.y) - ci[2] * (a1[0] * b2.y + a1[1] * b2.x);
            s += cr[3] * (a1[2] * b3.x - a1[3] * b3.y) - ci[3] * (a1[2] * b3.y + a1[3] * b3.x); }
        if (k == 0 && h == hp) s += C.in[18][g * NH + h];
        KL[i] = s; }
    for (int it = gt; it < NG * 256 * 32; it += NGT) { const int k8 = it & 31, n = (it >> 5) & 255, g = it >> 13; u32x4 o = {0u, 0u, 0u, 0u};
        if (n < 128) { const int p = n & 63, sidx = k8 >> 1, hp0 = (k8 & 1) * 8; const f32x2 a = *(const f32x2*)(AP + ((size_t)(g * 17 + 15 - sidx) * NP + p) * 2);
            const f32x4* bb = (const f32x4*)(BB + ((size_t)(g * NP + p) * NH + hp0) * 2); const f32x4 q0 = bb[0], q1 = bb[1], q2 = bb[2], q3 = bb[3];
            float v[8];
            if (n < 64) { v[0] = a.x * q0[0] - a.y * q0[1]; v[1] = a.x * q0[2] - a.y * q0[3]; v[2] = a.x * q1[0] - a.y * q1[1]; v[3] = a.x * q1[2] - a.y * q1[3];
                          v[4] = a.x * q2[0] - a.y * q2[1]; v[5] = a.x * q2[2] - a.y * q2[3]; v[6] = a.x * q3[0] - a.y * q3[1]; v[7] = a.x * q3[2] - a.y * q3[3]; }
            else {        v[0] = a.x * q0[1] + a.y * q0[0]; v[1] = a.x * q0[3] + a.y * q0[2]; v[2] = a.x * q1[1] + a.y * q1[0]; v[3] = a.x * q1[3] + a.y * q1[2];
                          v[4] = a.x * q2[1] + a.y * q2[0]; v[5] = a.x * q2[3] + a.y * q2[2]; v[6] = a.x * q3[1] + a.y * q3[0]; v[7] = a.x * q3[3] + a.y * q3[2]; }
            o.x = pk2(v[0], v[1]); o.y = pk2(v[2], v[3]); o.z = pk2(v[4], v[5]); o.w = pk2(v[6], v[7]); }
        *(u32x4*)(WB + (size_t)it * 8) = o; }
}
__device__ __forceinline__ void wy_gen(const Ctx& C, int it0, int it1, int start, int stride) {
    unsigned char* ws = C.ws;
    const float* AP = (const float*)(ws + WS_AP); const float* KL = (const float*)(ws + WS_KLAG); bf16_t* WY = (bf16_t*)(ws + WS_WY);
    for (int it = it0 + start; it < it1; it += stride) { const int k8 = it % (KY / 8), n = (it / (KY / 8)) & 255, g = it / ((KY / 8) * 256), t = n >> 4, h = n & 15, k0 = k8 * 8; float v[8];
        if (k0 < 256) { const int sidx = k0 >> 4, hp0 = k0 & 15; f32x4 q0 = {0.f, 0.f, 0.f, 0.f}, q1 = q0;
            if (sidx <= t) { const f32x4* kp = (const f32x4*)(KL + (((size_t)g * 16 + (t - sidx)) * 16 + h) * 16 + hp0); q0 = kp[0]; q1 = kp[1]; }
            v[0] = q0[0]; v[1] = q0[1]; v[2] = q0[2]; v[3] = q0[3]; v[4] = q1[0]; v[5] = q1[1]; v[6] = q1[2]; v[7] = q1[3]; }
        else { const int p0 = (k0 - 256) & 63; const f32x4* crp = (const f32x4*)(C.in[16] + ((size_t)g * NH + h) * NP + p0); const f32x4* cip = (const f32x4*)(C.in[17] + ((size_t)g * NH + h) * NP + p0);
            const f32x4* app = (const f32x4*)(AP + ((size_t)(g * 17 + t + 1) * NP + p0) * 2);
            const f32x4 cr0 = crp[0], cr1 = crp[1], ci0 = cip[0], ci1 = cip[1], a0 = app[0], a1 = app[1], a2 = app[2], a3 = app[3];
            const float cr[8] = {cr0[0], cr0[1], cr0[2], cr0[3], cr1[0], cr1[1], cr1[2], cr1[3]}, ci[8] = {ci0[0], ci0[1], ci0[2], ci0[3], ci1[0], ci1[1], ci1[2], ci1[3]};
            const float ar[8] = {a0[0], a0[2], a1[0], a1[2], a2[0], a2[2], a3[0], a3[2]}, ai[8] = {a0[1], a0[3], a1[1], a1[3], a2[1], a2[3], a3[1], a3[3]};
#pragma unroll
            for (int e = 0; e < 8; ++e) v[e] = (k0 < 320) ? (cr[e] * ar[e] - ci[e] * ai[e]) : -(cr[e] * ai[e] + ci[e] * ar[e]); }
        u32x4 o; o.x = pk2(v[0], v[1]); o.y = pk2(v[2], v[3]); o.z = pk2(v[4], v[5]); o.w = pk2(v[6], v[7]);
        *(u32x4*)(WY + (size_t)it * 8) = o; }
}
__device__ __forceinline__ void p2b_prefix(const Ctx& C, LAS unsigned char* lds, int g, int tile, int wv) {
    const int p = lane_id(); unsigned char* ws = C.ws;
    const float* AP = (const float*)(ws + WS_AP); const float* E = (const float*)(ws + WS_E) + (size_t)g * NCHP * 128; bf16_t* UH = (bf16_t*)(ws + WS_UH) + (size_t)g * NCHP * KY;
    LAS float* L = (LAS float*)lds;
    const float ar = AP[((size_t)(g * 17 + 16) * NP + p) * 2], ai = AP[((size_t)(g * 17 + 16) * NP + p) * 2 + 1];
    if (tile < 4) {
    float hr[4] = {0.f, 0.f, 0.f, 0.f}, hi[4] = {0.f, 0.f, 0.f, 0.f};
    for (int cc = 0; cc < 32; cc += 8) { float er[4][8], ei[4][8];
#pragma unroll
        for (int ch = 0; ch < 4; ++ch)
#pragma unroll
            for (int j = 0; j < 8; ++j) { const size_t c = (size_t)((wv * 4 + ch) * 32 + cc + j); er[ch][j] = E[c * 128 + p]; ei[ch][j] = E[c * 128 + 64 + p]; }
#pragma unroll
        for (int j = 0; j < 8; ++j)
#pragma unroll
            for (int ch = 0; ch < 4; ++ch) { const float nr = ar * hr[ch] - ai * hi[ch] + er[ch][j], ni = ar * hi[ch] + ai * hr[ch] + ei[ch][j]; hr[ch] = nr; hi[ch] = ni; } }
#pragma unroll
    for (int ch = 0; ch < 4; ++ch) { L[((wv * 4 + ch) * 64 + p) * 2] = hr[ch]; L[((wv * 4 + ch) * 64 + p) * 2 + 1] = hi[ch]; }
    float sr = ar, si = ai;
#pragma unroll
    for (int j = 0; j < 5; ++j) { const float nr = sr * sr - si * si, ni = 2.f * sr * si; sr = nr; si = ni; }
    __syncthreads();
    float Hr = 0.f, Hi = 0.f;
    for (int j = 0; j < wv * 4; ++j) { const float lr = L[(j * 64 + p) * 2], li = L[(j * 64 + p) * 2 + 1]; const float nr = sr * Hr - si * Hi + lr, ni = sr * Hi + si * Hr + li; Hr = nr; Hi = ni; }
#pragma unroll
    for (int ch = 0; ch < 4; ++ch) { hr[ch] = Hr; hi[ch] = Hi; const float lr = L[((wv * 4 + ch) * 64 + p) * 2], li = L[((wv * 4 + ch) * 64 + p) * 2 + 1];
        const float nr = sr * Hr - si * Hi + lr, ni = sr * Hi + si * Hr + li; Hr = nr; Hi = ni; }
    if (wv == 7 && tile == 3) { C.out[O_SREP + g * NP + p] = Hr; C.out[O_SIMP + g * NP + p] = Hi; }
    if ((wv >> 1) == tile)
    for (int cc = 0; cc < 32; cc += 8) { float er[4][8], ei[4][8];
#pragma unroll
        for (int ch = 0; ch < 4; ++ch)
#pragma unroll
            for (int j = 0; j < 8; ++j) { const size_t c = (size_t)((wv * 4 + ch) * 32 + cc + j); er[ch][j] = E[c * 128 + p]; ei[ch][j] = E[c * 128 + 64 + p]; }
#pragma unroll
        for (int j = 0; j < 8; ++j)
#pragma unroll
            for (int ch = 0; ch < 4; ++ch) { const size_t c = (size_t)((wv * 4 + ch) * 32 + cc + j);
                UH[c * KY + 256 + p] = (bf16_t)f2bf(hr[ch]); UH[c * KY + 320 + p] = (bf16_t)f2bf(hi[ch]);
                const float nr = ar * hr[ch] - ai * hi[ch] + er[ch][j], ni = ar * hi[ch] + ai * hr[ch] + ei[ch][j]; hr[ch] = nr; hi[ch] = ni; } }
    } else
    for (int b = wv; b < 16; b += 8) { const float h0r = C.in[5][((size_t)b * NG + g) * NP + p], h0i = C.in[6][((size_t)b * NG + g) * NP + p]; const int c = 1024 + b;
        UH[(size_t)c * KY + 256 + p] = (bf16_t)f2bf(h0r); UH[(size_t)c * KY + 320 + p] = (bf16_t)f2bf(h0i);
        C.out[O_SRES + ((size_t)b * NG + g) * NP + p] = ar * h0r - ai * h0i + E[(size_t)c * 128 + p];
        C.out[O_SIMS + ((size_t)b * NG + g) * NP + p] = ar * h0i + ai * h0r + E[(size_t)c * 128 + 64 + p]; }
    __syncthreads();
}
__device__ __forceinline__ void p2b_pool(const Ctx& C, int worker, int nworkers, int wv) {
    const int cl = lane_id() * 8; unsigned char* ws = C.ws;
    const bf16_t* ZP = (const bf16_t*)(ws + WS_ZP); bf16_t* MIX = (bf16_t*)(ws + WS_T2);
    const int w = 2 << (cl >> 7);
    for (int blk = worker * 8 + wv; blk < M / 8; blk += nworkers * 8) { const int r0 = blk * 8;
        if (r0 < SEQ) {
#pragma unroll 2
            for (int t = 0; t < 8; ++t) { const int row = r0 + t; u32x4 q[16];
#pragma unroll
                for (int j = 0; j < 16; ++j) { const int rr = row - j; q[j] = *(const u32x4*)(ZP + (size_t)(rr < 0 ? 0 : rr) * DPOOL + cl); }
                float s[8], cur[8]; unpack8(q[0], cur);
#pragma unroll
                for (int e = 0; e < 8; ++e) s[e] = cur[e];
#pragma unroll
                for (int j = 1; j < 16; ++j) { float v[8]; unpack8(q[j], v); const float mk = (j < w && row - j >= 0) ? 1.f : 0.f;
#pragma unroll
                    for (int e = 0; e < 8; ++e) s[e] += mk * v[e]; }
                const int cnt = (row + 1 < w) ? row + 1 : w; const float inv = 1.f / (float)cnt;
                u32x4 o; o.x = pk2(s[0] * inv - cur[0], s[1] * inv - cur[1]); o.y = pk2(s[2] * inv - cur[2], s[3] * inv - cur[3]); o.z = pk2(s[4] * inv - cur[4], s[5] * inv - cur[5]); o.w = pk2(s[6] * inv - cur[6], s[7] * inv - cur[7]);
                *(u32x4*)(MIX + (size_t)row * D + cl) = o; }
        } else { const int b = (r0 - SEQ) >> 4, t0 = r0 & 15;
            for (int tt = 0; tt < 8; ++tt) { const int t = t0 + tt, row = r0 + tt; float s[8] = {0.f, 0.f, 0.f, 0.f, 0.f, 0.f, 0.f, 0.f}; float cur[8];
                for (int j = 0; j < w; ++j) { float v[8];
                    if (t - j >= 0) unpack8(*(const u32x4*)(ZP + (size_t)(row - j) * DPOOL + cl), v);
                    else { const float* hp = C.in[4] + ((size_t)b * 15 + (15 + t - j)) * DPOOL + cl; const f32x4 a = *(const f32x4*)hp, bb = *(const f32x4*)(hp + 4);
                        v[0] = a[0]; v[1] = a[1]; v[2] = a[2]; v[3] = a[3]; v[4] = bb[0]; v[5] = bb[1]; v[6] = bb[2]; v[7] = bb[3]; }
#pragma unroll
                    for (int e = 0; e < 8; ++e) { s[e] += v[e]; if (j == 0) cur[e] = v[e]; } }
                const float inv = 1.f / (float)w;
                u32x4 o; o.x = pk2(s[0] * inv - cur[0], s[1] * inv - cur[1]); o.y = pk2(s[2] * inv - cur[2], s[3] * inv - cur[3]); o.z = pk2(s[4] * inv - cur[4], s[5] * inv - cur[5]); o.w = pk2(s[6] * inv - cur[6], s[7] * inv - cur[7]);
                *(u32x4*)(MIX + (size_t)row * D + cl) = o; } } }
}
__device__ __forceinline__ void sample_attn_item(const Ctx& C, LAS unsigned char* lds, int item, int wv) {
    const int lane = lane_id(), fr = lane & 15, fq = lane >> 4; const int b = item >> 4, h = (item >> 2) & 3, dq = item & 3; unsigned char* ws = C.ws;
    const bf16_t* Q = (const bf16_t*)(ws + WS_T1); bf16_t* O = (bf16_t*)(ws + WS_OB);
    const float* Kc = C.in[2] + (size_t)b * NMEM * D + h * HD; const float* Vc = C.in[3] + (size_t)b * NMEM * D + h * HD + dq * 64;
    LAS float* Sl = (LAS float*)lds;
    LAS float* PT = (LAS float*)(lds + 16384);
    LAS float* red = (LAS float*)(lds + 32768);
    float vv[32];
#pragma unroll
    for (int j = 0; j < 32; ++j) vv[j] = __builtin_nontemporal_load(&Vc[(size_t)(wv * 32 + j) * D + lane]);
    bf16x8 qf[8];
#pragma unroll
    for (int kk = 0; kk < 8; ++kk) qf[kk] = *(const bf16x8*)(Q + (size_t)(SEQ + b * 16 + fr) * D + h * HD + kk * 32 + fq * 8);
#pragma unroll
    for (int kbi = 0; kbi < 2; ++kbi) { const int kb = wv + 8 * kbi; f32x4 acc = {0.f, 0.f, 0.f, 0.f}; const float* kr = Kc + (size_t)(kb * 16 + fr) * D + fq * 8;
#pragma unroll
        for (int kk = 0; kk < 8; ++kk) { const f32x4 a = *(const f32x4*)(kr + kk * 32), c = *(const f32x4*)(kr + kk * 32 + 4); const u32x4 w = pack8(a, c);
            acc = __builtin_amdgcn_mfma_f32_16x16x32_bf16(qf[kk], __builtin_bit_cast(bf16x8, w), acc, 0, 0, 0); }
#pragma unroll
        for (int r = 0; r < 4; ++r) Sl[(4 * fq + r) * 256 + kb * 16 + fr] = acc[r]; }
    __syncthreads();
#pragma unroll
    for (int rr = 0; rr < 2; ++rr) { const int s = wv * 2 + rr; float v[4]; float mx = -3.0e38f;
#pragma unroll
        for (int j = 0; j < 4; ++j) { v[j] = Sl[s * 256 + lane + 64 * j]; mx = fmaxf(mx, v[j]); }
        mx = wave_max(mx, lane); float sum = 0.f;
#pragma unroll
        for (int j = 0; j < 4; ++j) { v[j] = __builtin_amdgcn_exp2f(v[j] - mx); sum += v[j]; }
        const float inv = 1.f / wave_sum(sum, lane);
#pragma unroll
        for (int j = 0; j < 4; ++j) PT[(lane + 64 * j) * 16 + s] = v[j] * inv; }
    __syncthreads();
    { float o[16];
#pragma unroll
      for (int s = 0; s < 16; ++s) o[s] = 0.f;
#pragma unroll
      for (int j = 0; j < 32; ++j) { const LAS f32x4* pp = (const LAS f32x4*)(PT + (wv * 32 + j) * 16);
#pragma unroll
          for (int q4 = 0; q4 < 4; ++q4) { const f32x4 pv = pp[q4]; o[4 * q4 + 0] += pv[0] * vv[j]; o[4 * q4 + 1] += pv[1] * vv[j]; o[4 * q4 + 2] += pv[2] * vv[j]; o[4 * q4 + 3] += pv[3] * vv[j]; } }
#pragma unroll
      for (int s = 0; s < 16; ++s) red[(wv * 16 + s) * 64 + lane] = o[s]; }
    __syncthreads();
    { const int tid = wv * 64 + lane, s = tid >> 5, dp = (tid & 31) * 2; float o0 = 0.f, o1 = 0.f;
#pragma unroll
      for (int w = 0; w < 8; ++w) { const f32x2 t = *(const LAS f32x2*)(red + (w * 16 + s) * 64 + dp); o0 += t.x; o1 += t.y; }
      *(unsigned*)(O + (size_t)(SEQ + b * 16 + s) * D + h * HD + dq * 64 + dp) = pk2(o0, o1); }
    __syncthreads();
}

template <class Epi8>
__device__ __forceinline__ void skinny_gemm(LAS unsigned char* lds, const bf16_t* A, int lda, const bf16_t* Bt, int ldb, int N, int K, int ksplit, const Epi8& E, int G, int bid, int wv) {
    const int lane = lane_id(), fr = lane & 15, fq = lane >> 4;
    const int ntn = N / 64, per = 4 * ntn, ntiles = per * ksplit, kw = K / ksplit / 8;
    LAS float* red = (LAS float*)lds;
    for (int t = bid; t < ntiles; t += G) {
        const int ks = t / per, tt = t % per, tm = tt & 3, tn = tt >> 2, kbeg = ks * (K / ksplit) + wv * kw;
        f32x4 acc[4][4];
#pragma unroll
        for (int i = 0; i < 4; ++i)
#pragma unroll
            for (int j = 0; j < 4; ++j) acc[i][j] = (f32x4){0.f, 0.f, 0.f, 0.f};
        const bf16_t* ap = A + (size_t)(tm * 64 + fr) * lda + kbeg + fq * 8;
        const bf16_t* bp = Bt + (size_t)(tn * 64 + fr) * ldb + kbeg + fq * 8;
#pragma unroll 4
        for (int k = 0; k < kw; k += 32) { bf16x8 af[4], bfr[4];
#pragma unroll
            for (int i = 0; i < 4; ++i) { af[i] = *(const bf16x8*)(ap + (size_t)i * 16 * lda + k); bfr[i] = *(const bf16x8*)(bp + (size_t)i * 16 * ldb + k); }
#pragma unroll
            for (int i = 0; i < 4; ++i)
#pragma unroll
                for (int j = 0; j < 4; ++j) acc[i][j] = __builtin_amdgcn_mfma_f32_16x16x32_bf16(bfr[j], af[i], acc[i][j], 0, 0, 0); }
#pragma unroll
        for (int i = 0; i < 4; ++i)
#pragma unroll
            for (int j = 0; j < 4; ++j) *(LAS f32x4*)(red + ((wv * 64 + i * 16 + fr) * 64 + (((j * 4 + fq) ^ fr) << 2))) = acc[i][j];
        __syncthreads();
        { const int tid = wv * 64 + lane, row = tid >> 3, s8 = (tid & 7) * 2; f32x4 s0 = {0.f, 0.f, 0.f, 0.f}, s1 = {0.f, 0.f, 0.f, 0.f};
#pragma unroll
          for (int w = 0; w < 8; ++w) { s0 += *(const LAS f32x4*)(red + ((w * 64 + row) * 64 + ((s8 ^ (row & 15)) << 2))); s1 += *(const LAS f32x4*)(red + ((w * 64 + row) * 64 + (((s8 + 1) ^ (row & 15)) << 2))); }
          E(tm * 64 + row, tn * 64 + s8 * 4, s0, s1, lane, ks); }
        __syncthreads();
    }
}
__device__ __forceinline__ u32x2 pack4(const f32x4 v) { u32x2 w; w.x = cvt_pk_bf16(v[0], v[1]); w.y = cvt_pk_bf16(v[2], v[3]); return w; }
struct SkZ { bf16_t* ZP; bf16_t* UH; float* out;
    __device__ __forceinline__ void operator()(int r, int c, f32x4 v0, f32x4 v1, int, int) const { const int row = SEQ + r; const u32x4 w = pack8(v0, v1);
        if (c < DPOOL) { *(u32x4*)(ZP + (size_t)row * DPOOL + c) = w; if ((r & 15) != 0) { float* dst = out + O_POOLS + ((size_t)(r >> 4) * 15 + ((r & 15) - 1)) * DPOOL + c; *(f32x4*)dst = v0; *(f32x4*)(dst + 4) = v1; } }
        else { const int cc = c - DPOOL, gg = cc >> 4, hh = cc & 15; *(u32x4*)(UH + ((size_t)gg * NCHP + (row >> 4)) * KY + (row & 15) * 16 + hh) = w; } } };
struct SkKV { float* out; bf16_t* KB; bf16_t* VT;
    __device__ __forceinline__ void operator()(int r, int c, f32x4 v0, f32x4 v1, int, int) const {
        if (c < D) { float* dst = out + O_MK + (size_t)r * D + c; *(f32x4*)dst = v0; *(f32x4*)(dst + 4) = v1; *(u32x4*)(KB + (size_t)r * D + c) = pack8(v0, v1); }
        else { const int c2 = c - D; float* dst = out + O_MV + (size_t)r * D + c2; *(f32x4*)dst = v0; *(f32x4*)(dst + 4) = v1;
            *(u32x4*)(VT + (size_t)r * D + c2) = pack8(v0, v1); } } };
struct SkPool { bf16_t* CAT; const float* scale;
    __device__ __forceinline__ void operator()(int r, int c, f32x4 v0, f32x4 v1, int, int) const { *(u32x4*)(CAT + (size_t)(SEQ + r) * D + c) = pack8(v0 * *(const f32x4*)(scale + c), v1 * *(const f32x4*)(scale + c + 4)); } };
struct SkGlu { bf16_t* CAT; const bf16_t* MIX; const float* bias;
    __device__ __forceinline__ void operator()(int r, int c, f32x4 v0, f32x4 v1, int, int) const { float y[8]; unpack8(*(const u32x4*)(MIX + (size_t)(SEQ + r) * D + DPOOL + c), y);
        const f32x4 b0 = *(const f32x4*)(bias + c), b1 = *(const f32x4*)(bias + c + 4);
#pragma unroll
        for (int j = 0; j < 4; ++j) { v0[j] = fast_sig_scale(y[j], v0[j] + b0[j]); v1[j] = fast_sig_scale(y[4 + j], v1[j] + b1[j]); }
        *(u32x4*)(CAT + (size_t)(SEQ + r) * D + DPOOL + c) = pack8(v0, v1); } };
template <bool BASE_BF16> struct SkRes { const void* base; bf16_t* Xb; float* SS;
    __device__ __forceinline__ void operator()(int r, int c, f32x4 v0, f32x4 v1, int lane, int) const { f32x4 x0, x1;
        if constexpr (BASE_BF16) { float y[8]; unpack8(*(const u32x4*)((const bf16_t*)base + (size_t)r * D + c), y); x0 = v0 + (f32x4){y[0], y[1], y[2], y[3]}; x1 = v1 + (f32x4){y[4], y[5], y[6], y[7]}; }
        else { const float* bp = (const float*)base + (size_t)r * D + c; x0 = v0 + *(const f32x4*)bp; x1 = v1 + *(const f32x4*)(bp + 4); }
        *(u32x4*)(Xb + (size_t)r * D + c) = pack8(x0, x1);
        float q = ((x0[0] * x0[0] + x0[1] * x0[1]) + (x0[2] * x0[2] + x0[3] * x0[3])) + ((x1[0] * x1[0] + x1[1] * x1[1]) + (x1[2] * x1[2] + x1[3] * x1[3]));
        q += shfl_x(q, lane, 1); q += shfl_x(q, lane, 2); q += shfl_x(q, lane, 4);
        if ((lane & 7) == 0) SS[(size_t)r * 16 + (c >> 6)] = q; } };
struct SkQ { bf16_t* Q; const float* SS;
    __device__ __forceinline__ void operator()(int r, int c, f32x4 v0, f32x4 v1, int, int) const { const float rs = row_rstd(SS, r) * QSCALE; *(u32x4*)(Q + (size_t)r * D + c) = pack8(v0 * rs, v1 * rs); } };
struct SkUp { bf16_t* U; const float* SS;
    __device__ __forceinline__ void operator()(int r, int c, f32x4 v0, f32x4 v1, int, int) const { const float rs = row_rstd(SS, r);
#pragma unroll
        for (int j = 0; j < 4; ++j) { const float a = fmaxf(v0[j] * rs, 0.f), b = fmaxf(v1[j] * rs, 0.f); v0[j] = a * a; v1[j] = b * b; }
        *(u32x4*)(U + (size_t)r * DFF + c) = pack8(v0, v1); } };
struct SkSlab { float* slab;
    __device__ __forceinline__ void operator()(int r, int c, f32x4 v0, f32x4 v1, int, int ks) const { float* dst = slab + ((size_t)ks * NSAMP + r) * D + c;
        asm volatile("global_store_dwordx4 %0, %1, off sc0 sc1\n\ts_nop 1" :: "v"(dst), "v"(v0) : "memory");
        asm volatile("global_store_dwordx4 %0, %1, off offset:16 sc0 sc1\n\ts_nop 1" :: "v"(dst), "v"(v1) : "memory"); } };
#define XB_TMO      128
#define XB_XCNT(j)  (256  + 64 * (j))
#define XB_XSUB(j)  (1280 + 64 * (j))
#define XB_XGEN(j)  (2304 + 64 * (j))
#define XB_TOP      3328
#define XB_TOPGEN   3392
#define XCD_BAR_WORDS 3456
#define XB_SPIN_CAP (1u << 18)

__device__ __forceinline__ unsigned xb_ld(unsigned* p)              { return __hip_atomic_load(p, __ATOMIC_RELAXED, __HIP_MEMORY_SCOPE_AGENT); }
__device__ __forceinline__ unsigned xb_add(unsigned* p, unsigned v) { return __hip_atomic_fetch_add(p, v, __ATOMIC_RELAXED, __HIP_MEMORY_SCOPE_AGENT); }
__device__ __forceinline__ unsigned xb_xcc_id() { return (unsigned)__builtin_amdgcn_s_getreg((3 << 11) | 20) & 0xFu; }
#define XB_SPIN(cond, bar) do { unsigned _sp = 0; while (cond) { __builtin_amdgcn_s_sleep(1); \
    if ((++_sp & 255u) == 0u) { if (xb_ld(&(bar)[XB_TMO])) break; if (_sp > XB_SPIN_CAP) { atomicAdd(&(bar)[XB_TMO], 1u); break; } } } } while (0)

struct XcdBarrier {
    unsigned* bar; unsigned x;
    volatile LAS unsigned* st;
};

__device__ __forceinline__ XcdBarrier xcd_barrier_post(unsigned* bar, volatile LAS unsigned* st, int wv) {
    XcdBarrier b; b.bar = bar; b.x = xb_xcc_id(); b.st = st;
    if (tidx(wv) == 0) (void)xb_add(&bar[XB_XCNT(b.x)], 1u);
    return b;
}
__device__ __forceinline__ void xcd_barrier_complete(unsigned* bar, unsigned x, unsigned& nloc, unsigned& nx) {
    const unsigned G = gridDim.x * gridDim.y * gridDim.z;
    unsigned sum, cnt, mine, sp = 0u;
    for (;;) {
        sum = 0u; cnt = 0u; mine = 0u;
#pragma unroll
        for (unsigned j = 0; j < 16; ++j) { const unsigned c = xb_ld(&bar[XB_XCNT(j)]); sum += c; cnt += (c > 0u) ? 1u : 0u; mine = (j == x) ? c : mine; }
        if (sum == G) break;
        __builtin_amdgcn_s_sleep(1);
        if ((++sp & 255u) == 0u) { if (xb_ld(&bar[XB_TMO])) break; if (sp > XB_SPIN_CAP) { atomicAdd(&bar[XB_TMO], 1u); break; } }
    }
    nloc = mine > 0u ? mine : 1u; nx = cnt > 0u ? cnt : 1u;
}

__device__ __forceinline__ void xcd_barrier(const XcdBarrier& b, int wv) {
    asm volatile("s_waitcnt vmcnt(0)" ::: "memory");
    __syncthreads();
    if (tidx(wv) == 0) {
        unsigned* bar = b.bar;
        __builtin_amdgcn_s_waitcnt(0);
        unsigned nloc = b.st[0], nx = b.st[1];
        if (nloc == 0u) { xcd_barrier_complete(bar, b.x, nloc, nx); b.st[0] = nloc; b.st[1] = nx; }
        const unsigned old = xb_add(&bar[XB_XSUB(b.x)], 1u);
        const unsigned gen = old / nloc;
        if (old + 1u == (gen + 1u) * nloc) {
            __builtin_amdgcn_fence(__ATOMIC_RELEASE, "agent");
            asm volatile("s_waitcnt vmcnt(0)" ::: "memory");
            const unsigned og = xb_add(&bar[XB_TOP], 1u);
            const unsigned tg = og / nx;
            if (og + 1u == (tg + 1u) * nx) xb_add(&bar[XB_TOPGEN], 1u);
            else XB_SPIN(xb_ld(&bar[XB_TOPGEN]) == tg, bar);
            __builtin_amdgcn_fence(__ATOMIC_ACQUIRE, "agent");
            xb_add(&bar[XB_XGEN(b.x)], 1u);
            asm volatile("s_waitcnt vmcnt(0)" ::: "memory");
        } else {
            XB_SPIN(xb_ld(&bar[XB_XGEN(b.x)]) == gen, bar);
            __builtin_amdgcn_fence(__ATOMIC_ACQUIRE, "agent");
            asm volatile("s_waitcnt vmcnt(0)" ::: "memory");
        }
    }
    __syncthreads();
}

#ifndef PHMASK
#define PHMASK 0xFFFF
#endif
#define PH(k) if constexpr (((PHMASK) >> (k)) & 1)
#ifndef TPROBE
#define TPROBE 0
#endif
#ifndef TP_BASE
#define TP_BASE 0
#endif
#define TSTAMP(k) do { if (TPROBE && bid == 0 && tidx(wv) == 0) ((unsigned long long*)(ws + WS_BAR + 65536))[k] = __builtin_amdgcn_s_memrealtime(); } while (0)
constexpr int LDS_BYTES = 131072 + 8192 + 2048;
__global__ void __launch_bounds__(512, 2) fwd_megakernel(Ctx C) {
    extern __shared__ __attribute__((aligned(16))) unsigned char lds_raw[];
    LAS unsigned char* lds = (LAS unsigned char*)lds_raw;
    const int wv = __builtin_amdgcn_readfirstlane((int)threadIdx.x >> 6);
    const int G = gridDim.x, bid = blockIdx.x; unsigned char* ws = C.ws;
    bf16_t* T0 = (bf16_t*)(ws + WS_T0); bf16_t* T1 = (bf16_t*)(ws + WS_T1); bf16_t* T2 = (bf16_t*)(ws + WS_T2); bf16_t* OB = (bf16_t*)(ws + WS_OB);
    float* SS1 = (float*)(ws + WS_SSP); float* SS2 = SS1 + (size_t)M * 16;
    float* Y = C.out + O_Y;
    pg8::Order S;

    { volatile LAS unsigned* misc = (volatile LAS unsigned*)(lds + 131072 + 8192); if (tidx(wv) < 16) misc[tidx(wv)] = 0u; }
    __syncthreads();
    const XcdBarrier xbar = xcd_barrier_post((unsigned*)(ws + WS_BAR), (volatile LAS unsigned*)(lds + 131072 + 8192), wv);
    TSTAMP(0);
    p0_prologue(C, lds, G, bid, wv);
    xcd_barrier(xbar, wv);
    TSTAMP(1);

    p1_pre(C, G, bid, wv);
    PH(0) { pg8::Gemm g{(const char*)T0, (const char*)(ws + WS_WIN), D, D, 0, 0, D}; S.init(SEQ / 256, 4, 1, G, bid);
      EpiZ E{(bf16_t*)(ws + WS_ZP), (bf16_t*)(ws + WS_UH), C.out}; pg8::gemm_phase(lds, g, S, E, wv); }
    { SkZ E{(bf16_t*)(ws + WS_ZP), (bf16_t*)(ws + WS_UH), C.out}; skinny_gemm(lds, T0 + (size_t)SEQ * D, D, (const bf16_t*)(ws + WS_WIN), D, D, D, 1, E, G, bid, wv); }
    { SkKV E{C.out, (bf16_t*)(ws + WS_KB), (bf16_t*)(ws + WS_VT)};
      skinny_gemm(lds, (const bf16_t*)(ws + WS_MN), D, (const bf16_t*)(ws + WS_WKV), D, 2 * D, D, 1, E, G, (bid + G - 64) % G, wv); }
    xcd_barrier(xbar, wv);
    TSTAMP(2);

    { S.init(NCHP / 256, 1, NG, G, bid); Unit u0;
      if (S.next(0, u0)) { const int grp = u0.z, tile = u0.pm;
        wy_gen(C, grp * 256 * (KY / 8), (grp + 1) * 256 * (KY / 8), tile * 512 + tidx(wv), 5 * 512);
        PH(2) { pg8::Gemm g{(const char*)(ws + WS_UH), (const char*)(ws + WS_WB), KY, 256, (size_t)NCHP * KY * 2, (size_t)256 * 256 * 2, 256};
          EpiE E{(float*)(ws + WS_E)}; pg8::gemm_phase(lds, g, S, E, wv); }
        asm volatile("s_waitcnt vmcnt(0)" ::: "memory"); __syncthreads();
        if (tidx(wv) == 0) { unsigned* cnt = (unsigned*)(ws + WS_BAR + 16384) + 64 * grp;
            __builtin_amdgcn_fence(__ATOMIC_RELEASE, "agent"); asm volatile("s_waitcnt vmcnt(0)" ::: "memory");
            (void)xb_add(cnt, 1u);
            unsigned sp = 0; while (xb_ld(cnt) < 5u) { __builtin_amdgcn_s_sleep(1); if (++sp > XB_SPIN_CAP) break; }
            __builtin_amdgcn_fence(__ATOMIC_ACQUIRE, "agent"); asm volatile("s_waitcnt vmcnt(0)" ::: "memory"); }
        __syncthreads();
        p2b_prefix(C, lds, grp, tile, wv);
        asm volatile("s_waitcnt vmcnt(0)" ::: "memory"); __syncthreads();
        PH(3) { pg8::Gemm g{(const char*)(ws + WS_UH), (const char*)(ws + WS_WY), KY, KY, (size_t)NCHP * KY * 2, (size_t)256 * KY * 2, KY};
          EpiY E{T1}; pg8::gemm_phase(lds, g, S, E, wv); }
      } else {
        if (bid < 176) { PH(1) { pg8::Gemm g{(const char*)(ws + WS_KB), (const char*)(ws + WS_WQN), D, D, (size_t)HD * 2, (size_t)HD * 2, HD}; S.init(1, 4, NHEAD, 16, bid - 160);
            EpiWqk E{(bf16_t*)(ws + WS_WQK)}; pg8::gemm_phase(lds, g, S, E, wv); } }
        else if (bid < 192) { PH(1) { pg8::Gemm g{(const char*)(ws + WS_WO), (const char*)(ws + WS_VT), D, D, (size_t)HD * 2, (size_t)HD * 2, HD}; S.init(4, 1, NHEAD, 16, bid - 176);
            EpiVWo E{(bf16_t*)(ws + WS_VWO)}; pg8::gemm_phase(lds, g, S, E, wv); } }
        else if (bid < 200) { PH(1) { pg8::Gemm g{(const char*)(ws + WS_WOUT), (const char*)(ws + WS_WPOOL), D, DPOOL, 0, 0, DPOOL}; S.init(4, 2, 1, 8, bid - 192);
            EpiVWo E{(bf16_t*)(ws + WS_WOUT2)}; pg8::gemm_phase(lds, g, S, E, wv); } }
        p2b_pool(C, bid - 160, G - 160, wv); }
    }
    xcd_barrier(xbar, wv);
    TSTAMP(3);

    PH(5) { pg8::Gemm g{(const char*)(T1 + DPOOL), (const char*)(ws + WS_WGLU), D, DSSM, 0, 0, DSSM}; S.init(SEQ / 256, 2, 1, G, bid);
      EpiGlu E{T2, T1, C.in[21]}; pg8::gemm_phase(lds, g, S, E, wv); }
    { SkGlu E{T2, T1, C.in[21]}; skinny_gemm(lds, T1 + (size_t)SEQ * D + DPOOL, D, (const bf16_t*)(ws + WS_WGLU), DSSM, DSSM, DSSM, 1, E, G, (bid + G - 128) % G, wv); }
    xcd_barrier(xbar, wv);
    TSTAMP(6);

    PH(6) { pg8::Gemm g{(const char*)T2, (const char*)(ws + WS_WOUT2), D, D, 0, 0, D}; S.init(SEQ / 256, 4, 1, G, bid);
      EpiRes<false> E{C.in[0], T0, SS1}; pg8::gemm_phase(lds, g, S, E, wv); }
    { SkRes<false> E{C.in[1], T0 + (size_t)SEQ * D, SS1 + (size_t)SEQ * 16}; skinny_gemm(lds, T2 + (size_t)SEQ * D, D, (const bf16_t*)(ws + WS_WOUT2), D, D, D, 1, E, G, bid, wv); }
    xcd_barrier(xbar, wv);
    TSTAMP(7);

    { SkQ E{T1 + (size_t)SEQ * D, SS1 + (size_t)SEQ * 16}; skinny_gemm(lds, T0 + (size_t)SEQ * D, D, (const bf16_t*)(ws + WS_WQ), D, D, D, 1, E, G, bid, wv); }
    asm volatile("s_waitcnt vmcnt(0)" ::: "memory"); __syncthreads();
    if (bid < 64 && tidx(wv) == 0) { __builtin_amdgcn_fence(__ATOMIC_RELEASE, "agent"); asm volatile("s_waitcnt vmcnt(0)" ::: "memory"); (void)xb_add((unsigned*)(ws + WS_BAR + 32768), 1u); }
    TSTAMP(8);
    PH(8) { pg8::Gemm g{(const char*)T0, (const char*)(ws + WS_WQK), D, D, 0, 0, D}; S.init(SEQ / 256, 4, 1, G, bid);
      LAS float* tab = (LAS float*)(lds + 131072 + 8192 + 1024); (void)prep_rstd(tab, SS1, S, wv);
      EpiSoftmax E{T1, (LAS float*)(lds + 131072), (LAS float*)(lds + 131072 + 4096), tab}; pg8::gemm_phase(lds, g, S, E, wv); }
    TSTAMP(9);
    if (tidx(wv) == 0) { unsigned* cnt = (unsigned*)(ws + WS_BAR + 32768); unsigned sp = 0; while (xb_ld(cnt) < 64u) { __builtin_amdgcn_s_sleep(1); if (++sp > XB_SPIN_CAP) break; }
        __builtin_amdgcn_fence(__ATOMIC_ACQUIRE, "agent"); asm volatile("s_waitcnt vmcnt(0)" ::: "memory"); }
    __syncthreads();
    for (int it = bid; it < 256; it += G) {
        const int bh = (it & 7) + 8 * (it >> 5), dq = (it >> 3) & 3; sample_attn_item(C, lds, bh * 4 + dq, wv); }
    xcd_barrier(xbar, wv);
    TSTAMP(10);

    PH(10) { pg8::Gemm g{(const char*)T1, (const char*)(ws + WS_VWO), D, D, 0, 0, D}; S.init(SEQ / 256, 4, 1, G, bid);
      EpiRes<true> E{T0, T2, SS2}; pg8::gemm_phase(lds, g, S, E, wv); }
    { SkRes<true> E{T0 + (size_t)SEQ * D, T2 + (size_t)SEQ * D, SS2 + (size_t)SEQ * 16}; skinny_gemm(lds, OB + (size_t)SEQ * D, D, (const bf16_t*)(ws + WS_WO), D, D, D, 1, E, G, bid, wv); }
    xcd_barrier(xbar, wv);
    TSTAMP(11);

    PH(11) { pg8::Gemm g{(const char*)T2, (const char*)(ws + WS_WUP), D, D, 0, 0, D}; S.init(SEQ / 256, DFF / 256, 1, G, bid);
      LAS float* tab = (LAS float*)(lds + 131072); const int tpm = prep_rstd(tab, SS2, S, wv);
      EpiUp E{(bf16_t*)(ws + WS_U), SS2, tab, tpm}; pg8::gemm_phase(lds, g, S, E, wv); }
    { SkUp E{(bf16_t*)(ws + WS_U) + (size_t)SEQ * DFF, SS2 + (size_t)SEQ * 16}; skinny_gemm(lds, T2 + (size_t)SEQ * D, D, (const bf16_t*)(ws + WS_WUP), D, DFF, D, 1, E, G, bid, wv); }
    xcd_barrier(xbar, wv);
    TSTAMP(12);

    PH(12) { pg8::Gemm g{(const char*)(ws + WS_U), (const char*)(ws + WS_WDOWN), DFF, DFF, 0, 0, DFF}; S.init(SEQ / 256, 4, 1, G, bid);
      EpiFinal E{T2, Y, C.in[32], (float*)(ws + WS_XCH), (unsigned*)(ws + WS_BAR + 40960), (LAS float*)(lds + 131072), (LAS float*)(lds + 131072 + 4096), wv}; pg8::gemm_phase(lds, g, S, E, wv); }
    { SkSlab E{(float*)(ws + WS_SLAB)}; skinny_gemm(lds, (const bf16_t*)(ws + WS_U) + (size_t)SEQ * DFF, DFF, (const bf16_t*)(ws + WS_WDOWN), DFF, D, DFF, 4, E, G, bid, wv); }
    asm volatile("s_waitcnt vmcnt(0)" ::: "memory"); __syncthreads();
    { unsigned* cs = (unsigned*)(ws + WS_BAR + 40960) + 16 * 64;
      if (tidx(wv) == 0) { (void)xb_add(cs, 1u); unsigned sp = 0; while (xb_ld(cs) < 256u) { __builtin_amdgcn_s_sleep(1); if (++sp > XB_SPIN_CAP) break; }
          __builtin_amdgcn_fence(__ATOMIC_ACQUIRE, "agent"); asm volatile("s_waitcnt vmcnt(0)" ::: "memory"); }
      __syncthreads();
      if (wv == 0 && bid < NSAMP) { const int lane = lane_id(), m = SEQ + bid; const u32x2* xr = (const u32x2*)(T2 + (size_t)m * D) + lane; f32x4 v[4]; float ss = 0.f;
#pragma unroll
          for (int j = 0; j < 4; ++j) { const u32x2 w = xr[64 * j]; v[j] = (f32x4){bf2f(w.x & 0xffffu), bf2f(w.x >> 16), bf2f(w.y & 0xffffu), bf2f(w.y >> 16)}; }
#pragma unroll
          for (int ks = 0; ks < 4; ++ks) { const f32x4* sp = (const f32x4*)((const float*)(ws + WS_SLAB) + ((size_t)ks * NSAMP + bid) * D) + lane;
#pragma unroll
              for (int j = 0; j < 4; ++j) v[j] += sp[64 * j]; }
#pragma unroll
          for (int j = 0; j < 4; ++j) ss += (v[j].x * v[j].x + v[j].y * v[j].y) + (v[j].z * v[j].z + v[j].w * v[j].w);
          const float rs = rsqrtf(wave_sum(ss, lane) * (1.f / D) + EPS); const f32x4* gr = (const f32x4*)C.in[32] + lane; f32x4* yr = (f32x4*)(Y + (size_t)m * D) + lane;
#pragma unroll
          for (int j = 0; j < 4; ++j) { const f32x4 gg = gr[64 * j]; yr[64 * j] = (f32x4){v[j].x * rs * gg.x, v[j].y * rs * gg.y, v[j].z * rs * gg.z, v[j].w * rs * gg.w}; } } }
#if TPROBE
    __syncthreads();
    if (bid == 0 && tidx(wv) == 0) { asm volatile("s_waitcnt vmcnt(0)" ::: "memory"); const unsigned long long tend = __builtin_amdgcn_s_memrealtime(); volatile unsigned long long* ts = (volatile unsigned long long*)(ws + WS_BAR + 65536);
        const size_t offs[10] = {O_Y, O_Y + (size_t)SEQ * D, O_MK, O_MV, O_POOLP, O_SREP, O_SIMP, O_POOLS, O_SRES, O_SIMS};
        for (int k = 0; k < 10; ++k) { const int ph = TP_BASE + k; const unsigned long long a = ts[ph], b = (ph + 1 <= 13) ? ts[ph + 1] : tend; C.out[offs[k]] += (float)(b - a) * 0.01f; } }
#endif
}

extern "C" void kernel_launch(void* const* d_in, const int* in_sizes, int n_in, void* d_out, int out_size, void* d_ws, size_t ws_size, hipStream_t stream) {
    static int grid = 0;
    if (grid == 0) {
        if (n_in != 33 || (size_t)out_size != O_END || ws_size < WS_END) { fprintf(stderr, "kernel_launch: unexpected shapes n_in %d out %d ws %zu\n", n_in, out_size, ws_size); grid = -1; return; }
        int dev = 0, cus = 0, per_cu = 0;
        hipGetDevice(&dev); hipDeviceGetAttribute(&cus, hipDeviceAttributeMultiprocessorCount, dev);
        if (hipFuncSetAttribute((const void*)fwd_megakernel, hipFuncAttributeMaxDynamicSharedMemorySize, LDS_BYTES) != hipSuccess) { fprintf(stderr, "kernel_launch: hipFuncSetAttribute failed\n"); grid = -1; return; }
        if (hipOccupancyMaxActiveBlocksPerMultiprocessor(&per_cu, (const void*)fwd_megakernel, 512, LDS_BYTES) != hipSuccess || per_cu < 1) { fprintf(stderr, "kernel_launch: occupancy query failed (%d)\n", per_cu); (void)hipGetLastError(); per_cu = 1; }
        if (per_cu > 1) per_cu = 1;
        grid = cus * per_cu; if (grid > 256) grid = 256;
        if (grid != 256) { fprintf(stderr, "kernel_launch: this kernel is laid out for exactly 256 resident workgroups (one per CU of a 256-CU device), got %d\n", grid); grid = -1; return; }
    }
    if (grid < 0) return;
    Ctx c{};
    for (int i = 0; i < 33; ++i) c.in[i] = (const float*)d_in[i];
    c.out = (float*)d_out; c.ws = (unsigned char*)d_ws;
    if (hipMemsetAsync((char*)d_ws + WS_BAR, 0, 65536, stream) != hipSuccess) { fprintf(stderr, "kernel_launch: memset of the barrier words failed\n"); return; }
    void* args[] = {&c};
    hipError_t e = hipLaunchCooperativeKernel((const void*)fwd_megakernel, dim3(grid), dim3(512), args, LDS_BYTES, stream);
    if (e != hipSuccess) fprintf(stderr, "cooperative launch failed: %s (grid %d)\n", hipGetErrorString(e), grid);
}
```

```cpp
#include <hip/hip_runtime.h>
#include <hip/hip_cooperative_groups.h>
#include <cstdio>
#include <cstdint>
namespace cg = cooperative_groups;

#define LAS __attribute__((address_space(3)))
typedef unsigned short bf16_t;
typedef short bf16x8 __attribute__((ext_vector_type(8)));
typedef float f32x4 __attribute__((ext_vector_type(4)));
typedef float f32x2 __attribute__((ext_vector_type(2)));
typedef unsigned u32x4 __attribute__((ext_vector_type(4)));
typedef unsigned u32x2 __attribute__((ext_vector_type(2)));

constexpr int D = 1024, SEQ = 16384, NSAMP = 256, M = SEQ + NSAMP, DFF = 4096, DPOOL = 512, DSSM = 512;
constexpr int NG = 32, NP = 64, NH = 16, TC = 16, NCH = M / TC  , NCHP = 1280, KY = 384;
constexpr int NMEM = 256, HD = 256, NHEAD = 4;
constexpr float EPS = 1e-6f;
constexpr float QSCALE = 0.0625f * 1.4426950408889634f;

constexpr size_t O_Y = 0, O_MK = (size_t)M * D, O_MV = O_MK + 262144, O_POOLP = O_MV + 262144, O_SREP = O_POOLP + 7680, O_SIMP = O_SREP + 2048,
                 O_POOLS = O_SIMP + 2048, O_SRES = O_POOLS + 122880, O_SIMS = O_SRES + 32768, O_END = O_SIMS + 32768;

constexpr size_t MiB = 1u << 20;
constexpr size_t WS_WIN = 0, WS_WOUT = 2 * MiB, WS_WQ = 4 * MiB, WS_WKV = 6 * MiB, WS_WO = 10 * MiB, WS_WUP = 12 * MiB, WS_WDOWN = 20 * MiB,
                 WS_WGLU = 28 * MiB, WS_WPOOL = 28 * MiB + 512 * 1024, WS_MN = 29 * MiB, WS_KB = 29 * MiB + 512 * 1024, WS_VT = 30 * MiB,
                 WS_AP = 30 * MiB + 512 * 1024,
                 WS_BB = WS_AP + 320 * 1024,
                 WS_KLAG = WS_BB + 256 * 1024,
                 WS_SS = WS_KLAG + 512 * 1024,
                 WS_BAR = 32 * MiB - 128 * 1024,
                 WS_WB = 32 * MiB,
                 WS_WY = 36 * MiB,
                 WS_E = 42 * MiB,
                 WS_UH = 62 * MiB,
                 WS_ZP = 92 * MiB,
                 WS_T0 = 109 * MiB, WS_T1 = 142 * MiB, WS_T2 = 175 * MiB, WS_SSP = 208 * MiB  , WS_XCH = 215 * MiB  , WS_WQN = 216 * MiB  , WS_WQK = 218 * MiB  , WS_VWO = 220 * MiB  , WS_WOUT2 = 222 * MiB  , WS_END = 224 * MiB,
                 WS_OB = 62 * MiB,
                 WS_U = 42 * MiB,
                 WS_SLAB = 211 * MiB;
static_assert(WS_SS + 3 * M * 4 <= WS_BAR, "misc region");
static_assert(WS_U + (size_t)M * DFF * 2 <= WS_T2, "U overlay");

__device__ __forceinline__ unsigned f2bf(float f) { unsigned u = __builtin_bit_cast(unsigned, f); return (u + 0x7fffu + ((u >> 16) & 1u)) >> 16; }
__device__ __forceinline__ unsigned pk2(float lo, float hi) { return f2bf(lo) | (f2bf(hi) << 16); }
__device__ __forceinline__ float bf2f(unsigned b) { return __builtin_bit_cast(float, b << 16); }
__device__ __forceinline__ unsigned cvt_pk_bf16(float lo, float hi) { unsigned r; asm volatile("v_cvt_pk_bf16_f32 %0, %1, %2" : "=v"(r) : "v"(lo), "v"(hi)); return r; }
#define LDS_WAIT() asm volatile("s_waitcnt lgkmcnt(0)" ::: "memory")
__device__ __forceinline__ int lane_id() { int l; asm volatile("v_mbcnt_lo_u32_b32 %0, -1, 0\n\tv_mbcnt_hi_u32_b32 %0, -1, %0" : "=v"(l)); return l; }
__device__ __forceinline__ int tidx(int wv) { return wv * 64 + lane_id(); }
#define SPIN_CAP (1u << 18)
__device__ __forceinline__ unsigned at_ld(unsigned* p) { return __hip_atomic_load(p, __ATOMIC_RELAXED, __HIP_MEMORY_SCOPE_AGENT); }
__device__ __forceinline__ unsigned at_add(unsigned* p, unsigned v) { return __hip_atomic_fetch_add(p, v, __ATOMIC_RELAXED, __HIP_MEMORY_SCOPE_AGENT); }
__device__ __forceinline__ float shfl_x(float v, int lane, int mask) { return __builtin_bit_cast(float, __builtin_amdgcn_ds_bpermute((lane ^ mask) << 2, __builtin_bit_cast(int, v))); }

__device__ __forceinline__ void unpack8(const u32x4 q, float* v) { const unsigned qq[4] = {q.x, q.y, q.z, q.w};
#pragma unroll
    for (int e = 0; e < 8; ++e) v[e] = bf2f((qq[e >> 1] >> ((e & 1) * 16)) & 0xffffu); }
namespace pg8 {
constexpr int BM = 256, BK = 64, HALF = 128, HTB = HALF * BK * 2, STAGE_BYTES = 8 * HTB, NXCD = 8, WGM = 8;
__host__ __device__ __forceinline__ int lds_byte(int r, int c) { const int st = (r >> 4) * 2 + (c >> 5), rr = r & 15, cc = c & 31, ob = rr * 64 + cc * 2; return st * 1024 + (ob ^ (((ob >> 9) & 1) << 5)); }
__host__ __device__ __forceinline__ void stage_rc(int b, int& R, int& C) { const int st = b / 1024, sb = b % 1024, swz = sb ^ (((sb >> 9) & 1) << 5); R = (st >> 1) * 16 + swz / 64; C = (st & 1) * 32 + (swz % 64) / 2; }
__host__ __device__ __forceinline__ int perm32(int rho) { const int n = rho >> 4, i = rho & 15; return 8 * (i >> 2) + 4 * n + (i & 3); }

struct Unit { int pm, pn, z; };
struct Gemm { const char* A; const char* B; int lda, ldb; size_t sAz, sBz; int K; };
struct Order {
    int nM, nN, nZ, G, c; bool zpn;
    __device__ __forceinline__ void init(int nM_, int nN_, int nZ_, int G_, int c_, bool zpn_ = false) { nM = nM_; nN = nN_; nZ = nZ_; G = G_; c = c_; zpn = zpn_; }
    __device__ __forceinline__ bool next(int i, Unit& u) const {
        const int per = nM * nN, nwg = per * nZ; const long L = (long)i * G + c; if (L >= nwg) return false;
        int wgid = (int)L; { const int q = nwg / NXCD, r = nwg % NXCD, xcd = wgid % NXCD, off = wgid / NXCD; wgid = (xcd < r ? xcd * (q + 1) : r * (q + 1) + (xcd - r) * q) + off; }
        u.z = wgid / per; const int l = wgid % per;
        const int nig = WGM * nN, gid = l / nig, fm = gid * WGM, gsz = (nM - fm) < WGM ? (nM - fm) : WGM;
        u.pm = fm + ((l % nig) % gsz); u.pn = (l % nig) / gsz; if (zpn) { u.z = u.pn; u.pn = 0; } return true;
    }
};

template <class Epi>
__device__ __forceinline__ void gemm_phase(LAS unsigned char* lds, const Gemm g, const Order& S, Epi& E, int wv) {
    const int tid = tidx(wv), wid = __builtin_amdgcn_readfirstlane(tid >> 6), lane = tid & 63, wr = wid >> 2, wc = wid & 3, fr = lane & 15, fq = lane >> 4;
    const int nt = g.K / BK;
    unsigned voffA[2], voffB[2];
#pragma unroll
    for (int i = 0; i < 2; ++i) { int R, C; stage_rc(tid * 16 + i * 8192, R, C); const int Rb = Epi::PERM ? ((R & ~31) + perm32(R & 31)) : R;
        voffA[i] = (unsigned)(R * g.lda + C) * 2u; voffB[i] = (unsigned)(Rb * g.ldb + C) * 2u; }
    const size_t kstep = (size_t)(BK * 2);
    const size_t hA = (size_t)HALF * g.lda * 2, hB = (size_t)HALF * g.ldb * 2;
    const unsigned ldsw = (unsigned)wid * 1024u;
    const int aoff = lds_byte(wr * 64 + fr, fq * 8), boff = lds_byte(wc * 32 + fr, fq * 8);
#define PG8_SA(b, h) (((b) * 2 + (h)) * HTB)
#define PG8_SB(b, h) ((4 + (b) * 2 + (h)) * HTB)
#define PG8_STAGE(bufoff, gbase, voff) do { _Pragma("unroll") for (int _i = 0; _i < 2; ++_i) \
        __builtin_amdgcn_global_load_lds((const unsigned*)((const char*)(gbase) + (voff)[_i]), (LAS unsigned*)(lds + (bufoff) + ldsw + _i * 8192), 16, 0, 0); } while (0)
#define PG8_LDA(dst, b, h) do { _Pragma("unroll") for (int m = 0; m < 4; ++m) _Pragma("unroll") for (int k = 0; k < 2; ++k) dst[m][k] = *(const LAS bf16x8*)(lds + PG8_SA(b, h) + aoff + m * 2048 + k * 1024); } while (0)
#define PG8_LDB(dst, b, h) do { _Pragma("unroll") for (int n = 0; n < 2; ++n) _Pragma("unroll") for (int k = 0; k < 2; ++k) dst[n][k] = *(const LAS bf16x8*)(lds + PG8_SB(b, h) + boff + n * 2048 + k * 1024); } while (0)
#define PG8_MMA(ai, bj, At, Bt) do { __builtin_amdgcn_s_setprio(1); _Pragma("unroll") for (int m = 0; m < 4; ++m) _Pragma("unroll") for (int n = 0; n < 2; ++n) _Pragma("unroll") for (int k = 0; k < 2; ++k) \
        acc[ai][bj][m][n] = __builtin_amdgcn_mfma_f32_16x16x32_bf16(Bt[n][k], At[m][k], acc[ai][bj][m][n], 0, 0, 0); __builtin_amdgcn_s_setprio(0); } while (0)
#define PG8_WAIT_V(n) asm volatile("s_waitcnt vmcnt(" #n ")" ::: "memory")
#define PG8_WAIT_L(n) asm volatile("s_waitcnt lgkmcnt(" #n ")" ::: "memory")
#define PG8_BAR __builtin_amdgcn_s_barrier()
#define PG8_SCHED __builtin_amdgcn_sched_barrier(0)
    Unit cur, nxt; int ui = 0;
    if (!S.next(0, cur)) return;
    f32x4 acc[2][2][4][2];
    if constexpr (Epi::ACC_INIT) E.init(acc, cur, wr, wc, fr, fq);
    else {
#pragma unroll
    for (int a = 0; a < 2; ++a)
#pragma unroll
        for (int b = 0; b < 2; ++b)
#pragma unroll
            for (int m = 0; m < 4; ++m)
#pragma unroll
                for (int n = 0; n < 2; ++n) acc[a][b][m][n] = (f32x4){0.f, 0.f, 0.f, 0.f};
    }
    bf16x8 At[4][2], B0[2][2], B1[2][2];
    const char* cA = g.A + (size_t)cur.z * g.sAz + (size_t)cur.pm * 2 * hA; const char* cB = g.B + (size_t)cur.z * g.sBz + (size_t)cur.pn * 2 * hB;
    PG8_STAGE(PG8_SB(0, 0), cB, voffB); PG8_STAGE(PG8_SB(0, 1), cB + hB, voffB); PG8_STAGE(PG8_SA(0, 0), cA, voffA); PG8_STAGE(PG8_SA(0, 1), cA + hA, voffA);
    if (wr == 1) PG8_BAR;
    PG8_WAIT_V(2); PG8_BAR;
    PG8_STAGE(PG8_SB(1, 0), cB + kstep, voffB); PG8_STAGE(PG8_SA(1, 0), cA + kstep, voffA); PG8_STAGE(PG8_SB(1, 1), cB + hB + kstep, voffB);
    PG8_WAIT_V(6); PG8_BAR;
    if constexpr (Epi::ACC_INIT) {
#pragma unroll
        for (int a = 0; a < 2; ++a)
#pragma unroll
            for (int b = 0; b < 2; ++b)
#pragma unroll
                for (int m = 0; m < 4; ++m) asm volatile("" : "+v"(acc[a][b][m][0]), "+v"(acc[a][b][m][1]));
    }
    for (;;) {
        const bool has_next = S.next(ui + 1, nxt);
        const char* nA = has_next ? g.A + (size_t)nxt.z * g.sAz + (size_t)nxt.pm * 2 * hA : cA; const char* nB = has_next ? g.B + (size_t)nxt.z * g.sBz + (size_t)nxt.pn * 2 * hB : cB;
        for (int t = 0; t < nt; t += 2) {
            const bool last = (t == nt - 2);
            const char* a1 = cA + (size_t)(t + 1) * kstep;
            const char* a2 = last ? nA : cA + (size_t)(t + 2) * kstep; const char* b2 = last ? nB : cB + (size_t)(t + 2) * kstep;
            const char* a3 = a2 + kstep; const char* b3 = b2 + kstep;
            PG8_LDB(B0, 0, 0); PG8_LDB(B1, 0, 1); PG8_SCHED; PG8_LDA(At, 0, 0); PG8_STAGE(PG8_SA(1, 1), a1 + hA, voffA);
            PG8_WAIT_V(8); PG8_WAIT_L(0); PG8_BAR; PG8_MMA(0, 0, At, B0); PG8_MMA(0, 1, At, B1); PG8_BAR; PG8_SCHED;
            PG8_LDA(At, 0, 1); PG8_STAGE(PG8_SB(0, 0), b2, voffB); PG8_STAGE(PG8_SB(0, 1), b2 + hB, voffB); PG8_STAGE(PG8_SA(0, 0), a2, voffA);
            PG8_WAIT_V(8); PG8_WAIT_L(0); PG8_BAR; PG8_MMA(1, 0, At, B0); PG8_MMA(1, 1, At, B1); PG8_BAR; PG8_SCHED;
            PG8_LDB(B0, 1, 0); PG8_LDB(B1, 1, 1); PG8_SCHED; PG8_LDA(At, 1, 0); PG8_STAGE(PG8_SA(0, 1), a2 + hA, voffA);
            PG8_WAIT_V(8); PG8_WAIT_L(0); PG8_BAR; PG8_MMA(0, 0, At, B0); PG8_MMA(0, 1, At, B1); PG8_BAR; PG8_SCHED;
            PG8_LDA(At, 1, 1); PG8_STAGE(PG8_SB(1, 0), b3, voffB); PG8_STAGE(PG8_SB(1, 1), b3 + hB, voffB); PG8_STAGE(PG8_SA(1, 0), a3, voffA);
            PG8_WAIT_V(8); PG8_WAIT_L(0); PG8_BAR; PG8_MMA(1, 0, At, B0); PG8_MMA(1, 1, At, B1); PG8_BAR; PG8_SCHED;
        }
        if (wr == 0) PG8_BAR;
        { Unit ue; ue.pm = __builtin_amdgcn_readfirstlane(cur.pm); ue.pn = __builtin_amdgcn_readfirstlane(cur.pn); ue.z = __builtin_amdgcn_readfirstlane(cur.z); const int le = lane_id(); int fre = le & 15, fqe = le >> 4;
          asm volatile("" : "+s"(ue.pm), "+s"(ue.pn), "+s"(ue.z));
          E(acc, ue, wr, wc, fre, fqe); }
        if (!has_next) break;
        if constexpr (Epi::ACC_INIT) { E.init(acc, nxt, wr, wc, fr, fq);
#pragma unroll
            for (int a = 0; a < 2; ++a)
#pragma unroll
                for (int b = 0; b < 2; ++b)
#pragma unroll
                    for (int m = 0; m < 4; ++m) asm volatile("" : "+v"(acc[a][b][m][0]), "+v"(acc[a][b][m][1]));
        } else {
#pragma unroll
        for (int a = 0; a < 2; ++a)
#pragma unroll
            for (int b = 0; b < 2; ++b)
#pragma unroll
                for (int m = 0; m < 4; ++m)
#pragma unroll
                    for (int n = 0; n < 2; ++n) acc[a][b][m][n] = (f32x4){0.f, 0.f, 0.f, 0.f};
        }
        cur = nxt; cA = nA; cB = nB; ++ui;
        if (wr == 1) PG8_BAR;
    }
    PG8_WAIT_V(0);
    PG8_BAR;
#undef PG8_SA
#undef PG8_SB
#undef PG8_STAGE
#undef PG8_LDA
#undef PG8_LDB
#undef PG8_MMA
#undef PG8_WAIT_V
#undef PG8_WAIT_L
#undef PG8_BAR
#undef PG8_SCHED
}
}
using pg8::Unit;
typedef f32x4 Acc[2][2][4][2];

#define EPI_ROWS(ai, m) (u.pm * 256 + (ai) * 128 + wr * 64 + (m) * 16 + fr)
__device__ __forceinline__ bool mfence() { asm volatile("" ::: "memory"); return true; }
#define FOR_AI_M _Pragma("unroll") for (int ai = 0; ai < 2; ++ai) _Pragma("unroll") for (int m = 0; m < 4; ++m) if (mfence())
#define FOR_BJ _Pragma("unroll") for (int bj = 0; bj < 2; ++bj)
__device__ __forceinline__ u32x4 pack8(const f32x4 v0, const f32x4 v1) { u32x4 w; w.x = cvt_pk_bf16(v0[0], v0[1]); w.y = cvt_pk_bf16(v0[2], v0[3]); w.z = cvt_pk_bf16(v1[0], v1[1]); w.w = cvt_pk_bf16(v1[2], v1[3]); return w; }

struct EpiZ {
    static constexpr bool PERM = true, ACC_INIT = false;
    bf16_t* ZP; bf16_t* UH; float* out;
    __device__ __forceinline__ void operator()(Acc& acc, const Unit& u, int wr, int wc, int fr, int fq) const {
        FOR_AI_M { const int row = EPI_ROWS(ai, m);
            FOR_BJ { const int col = u.pn * 256 + bj * 128 + wc * 32 + 8 * fq; const f32x4 v0 = acc[ai][bj][m][0], v1 = acc[ai][bj][m][1]; const u32x4 w = pack8(v0, v1);
                if (col < DPOOL) {
                    *(u32x4*)(ZP + (size_t)row * DPOOL + col) = w;
                    float* dst = nullptr;
                    if (row >= SEQ - 15 && row < SEQ) dst = out + O_POOLP + (size_t)(row - (SEQ - 15)) * DPOOL + col;
                    else if (row >= SEQ && ((row & 15) != 0)) dst = out + O_POOLS + ((size_t)((row - SEQ) >> 4) * 15 + ((row & 15) - 1)) * DPOOL + col;
                    if (dst) { *(f32x4*)dst = v0; *(f32x4*)(dst + 4) = v1; }
                } else {
                    const int cc = col - DPOOL, gg = cc >> 4, hh = cc & 15;
                    *(u32x4*)(UH + ((size_t)gg * NCHP + (row >> 4)) * KY + (row & 15) * 16 + hh) = w;
                } } }
    }
};
struct EpiKV {
    static constexpr bool PERM = false, ACC_INIT = false;
    float* out; bf16_t* KB; bf16_t* VT;
    __device__ __forceinline__ void operator()(Acc& acc, const Unit& u, int wr, int wc, int fr, int fq) const {
        FOR_AI_M { const int row = EPI_ROWS(ai, m);
            FOR_BJ {
#pragma unroll
                for (int n = 0; n < 2; ++n) { const int col = u.pn * 256 + bj * 128 + wc * 32 + 16 * n + 4 * fq; const f32x4 v = acc[ai][bj][m][n];
                    if (col < D) { *(f32x4*)(out + O_MK + (size_t)row * D + col) = v; u32x2 w; w.x = cvt_pk_bf16(v[0], v[1]); w.y = cvt_pk_bf16(v[2], v[3]); *(u32x2*)(KB + (size_t)row * D + col) = w; }
                    else { const int c2 = col - D; *(f32x4*)(out + O_MV + (size_t)row * D + c2) = v; } } }
            asm volatile("" ::: "memory"); }
    }
};
struct EpiE {
    static constexpr bool PERM = false, ACC_INIT = false;
    float* E;
    __device__ __forceinline__ void operator()(Acc& acc, const Unit& u, int wr, int wc, int fr, int fq) const {
        FOR_AI_M { const int row = EPI_ROWS(ai, m);
#pragma unroll
            for (int n = 0; n < 2; ++n) { const int col = wc * 32 + 16 * n + 4 * fq; *(f32x4*)(E + ((size_t)u.z * NCHP + row) * 128 + col) = acc[ai][0][m][n]; } }
    }
};
__device__ __forceinline__ float fast_sig_scale(float y, float a) {
    return y * __builtin_amdgcn_rcpf(1.f + __builtin_amdgcn_exp2f(-1.4426950408889634f * a)); }
__device__ __forceinline__ float gelu_tanh(float x) {
    const float t = 0.7978845608028654f * (x + 0.044715f * x * x * x);
    return fast_sig_scale(x, 2.f * t);
}
struct EpiY {
    static constexpr bool PERM = true, ACC_INIT = false;
    bf16_t* MIX;
    __device__ __forceinline__ void operator()(Acc& acc, const Unit& u, int wr, int wc, int fr, int fq) const {
        FOR_AI_M { const int ch = EPI_ROWS(ai, m); if (ch < NCH) {
            FOR_BJ { const int col = bj * 128 + wc * 32 + 8 * fq, t = col >> 4, hh = col & 15; f32x4 v0 = acc[ai][bj][m][0], v1 = acc[ai][bj][m][1];
#pragma unroll
                for (int j = 0; j < 4; ++j) { v0[j] = gelu_tanh(v0[j]); v1[j] = gelu_tanh(v1[j]); }
                *(u32x4*)(MIX + (size_t)(ch * 16 + t) * D + DPOOL + u.z * 16 + hh) = pack8(v0, v1); } } }
    }
};
struct EpiPool {
    static constexpr bool PERM = true, ACC_INIT = false;
    bf16_t* CAT; const float* scale;
    __device__ __forceinline__ void operator()(Acc& acc, const Unit& u, int wr, int wc, int fr, int fq) const {
        FOR_BJ { const int col = u.pn * 256 + bj * 128 + wc * 32 + 8 * fq; const f32x4 s0 = *(const f32x4*)(scale + col), s1 = *(const f32x4*)(scale + col + 4);
            FOR_AI_M { const int row = EPI_ROWS(ai, m); *(u32x4*)(CAT + (size_t)row * D + col) = pack8(acc[ai][bj][m][0] * s0, acc[ai][bj][m][1] * s1); } }
    }
};
struct EpiGlu {
    static constexpr bool PERM = true, ACC_INIT = false;
    bf16_t* CAT; const bf16_t* MIX; const float* bias;
    __device__ __forceinline__ void operator()(Acc& acc, const Unit& u, int wr, int wc, int fr, int fq) const {
        FOR_BJ { const int col = u.pn * 256 + bj * 128 + wc * 32 + 8 * fq; const f32x4 b0 = *(const f32x4*)(bias + col), b1 = *(const f32x4*)(bias + col + 4);
            u32x4 yv[2][4];
#pragma unroll
            for (int ai = 0; ai < 2; ++ai)
#pragma unroll
                for (int m = 0; m < 4; ++m) yv[ai][m] = *(const u32x4*)(MIX + (size_t)EPI_ROWS(ai, m) * D + DPOOL + col);
            FOR_AI_M { const int row = EPI_ROWS(ai, m); float y[8]; unpack8(yv[ai][m], y);
                f32x4 v0 = acc[ai][bj][m][0] + b0, v1 = acc[ai][bj][m][1] + b1;
#pragma unroll
                for (int j = 0; j < 4; ++j) { v0[j] = fast_sig_scale(y[j], v0[j]); v1[j] = fast_sig_scale(y[4 + j], v1[j]); }
                *(u32x4*)(CAT + (size_t)row * D + DPOOL + col) = pack8(v0, v1); } }
    }
};
template <bool BASE_BF16> struct EpiRes {
    static constexpr bool PERM = false, ACC_INIT = true;
    const void* base; bf16_t* Xb; float* SS;
    __device__ __forceinline__ void init(Acc& acc, const Unit& u, int wr, int wc, int fr, int fq) const {
#pragma unroll
        for (int ai = 0; ai < 2; ++ai)
#pragma unroll
            for (int m = 0; m < 4; ++m) { const size_t off = (size_t)EPI_ROWS(ai, m) * D + u.pn * 256 + wc * 32 + 4 * fq;
#pragma unroll
                for (int bj = 0; bj < 2; ++bj)
#pragma unroll
                    for (int n = 0; n < 2; ++n) {
                        if constexpr (BASE_BF16) { const u32x2 w = *(const u32x2*)((const bf16_t*)base + off + bj * 128 + 16 * n); acc[ai][bj][m][n] = (f32x4){bf2f(w.x & 0xffffu), bf2f(w.x >> 16), bf2f(w.y & 0xffffu), bf2f(w.y >> 16)}; }
                        else acc[ai][bj][m][n] = __builtin_nontemporal_load((const f32x4*)((const float*)base + off + bj * 128 + 16 * n)); } }
    }
    __device__ __forceinline__ void operator()(Acc& acc, const Unit& u, int wr, int wc, int fr, int fq) const {
        FOR_AI_M { const int row = EPI_ROWS(ai, m); float ssq = 0.f;
            FOR_BJ {
#pragma unroll
                for (int n = 0; n < 2; ++n) { const int col = u.pn * 256 + bj * 128 + wc * 32 + 16 * n + 4 * fq; const f32x4 v = acc[ai][bj][m][n];
                    ssq += (v[0] * v[0] + v[1] * v[1]) + (v[2] * v[2] + v[3] * v[3]);
                    u32x2 w; w.x = cvt_pk_bf16(v[0], v[1]); w.y = cvt_pk_bf16(v[2], v[3]); *(u32x2*)(Xb + (size_t)row * D + col) = w; } }
            if (SS) { ssq += shfl_x(ssq, fr + 16 * fq, 16); ssq += shfl_x(ssq, fr + 16 * fq, 32);
                if (fq == 0) SS[(size_t)row * 16 + u.pn * 4 + wc] = ssq; } }
    }
};
__device__ __forceinline__ float row_rstd(const float* SS, int row) { const f32x4* p = (const f32x4*)(SS + (size_t)row * 16); const f32x4 a = p[0], b = p[1], c = p[2], d = p[3];
    const float t = ((a[0] + a[1]) + (a[2] + a[3])) + ((b[0] + b[1]) + (b[2] + b[3])) + ((c[0] + c[1]) + (c[2] + c[3])) + ((d[0] + d[1]) + (d[2] + d[3])); return rsqrtf(t * (1.f / D) + EPS); }
__device__ __forceinline__ int prep_rstd(LAS float* tab, const float* SS, const pg8::Order& S, int wv) {
    Unit u0; int pm = -1;
    if (S.next(0, u0)) { pm = u0.pm; const int tid = tidx(wv); if (tid < 256) tab[tid] = row_rstd(SS, pm * 256 + tid); }
    __syncthreads();
    return pm;
}
struct EpiQ {
    static constexpr bool PERM = true, ACC_INIT = false;
    bf16_t* Q; const float* SS; const LAS float* tab; int tab_pm;
    __device__ __forceinline__ void operator()(Acc& acc, const Unit& u, int wr, int wc, int fr, int fq) const {
        FOR_AI_M { const int row = EPI_ROWS(ai, m); const float rs = ((u.pm == tab_pm) ? tab[ai * 128 + wr * 64 + m * 16 + fr] : row_rstd(SS, row)) * QSCALE;
            FOR_BJ { const int col = u.pn * 256 + bj * 128 + wc * 32 + 8 * fq; *(u32x4*)(Q + (size_t)row * D + col) = pack8(acc[ai][bj][m][0] * rs, acc[ai][bj][m][1] * rs); } }
    }
};
struct EpiWqk {
    static constexpr bool PERM = true, ACC_INIT = false;
    bf16_t* W;
    __device__ __forceinline__ void operator()(Acc& acc, const Unit& u, int wr, int wc, int fr, int fq) const {
        FOR_AI_M { const int row = u.z * 256 + ai * 128 + wr * 64 + m * 16 + fr;
            FOR_BJ { const int col = u.pn * 256 + bj * 128 + wc * 32 + 8 * fq; *(u32x4*)(W + (size_t)row * D + col) = pack8(acc[ai][bj][m][0], acc[ai][bj][m][1]); } }
    }
};
struct EpiVWo {
    static constexpr bool PERM = true, ACC_INIT = false;
    bf16_t* W;
    __device__ __forceinline__ void operator()(Acc& acc, const Unit& u, int wr, int wc, int fr, int fq) const {
        FOR_AI_M { const int row = EPI_ROWS(ai, m);
            FOR_BJ { const int col = (u.z + u.pn) * 256 + bj * 128 + wc * 32 + 8 * fq; *(u32x4*)(W + (size_t)row * D + col) = pack8(acc[ai][bj][m][0], acc[ai][bj][m][1]); } }
    }
};
struct EpiSoftmax {
    static constexpr bool PERM = true, ACC_INIT = false;
    bf16_t* P; LAS float* tmax; LAS float* tsum; const LAS float* rs;
    __device__ __forceinline__ void operator()(Acc& acc, const Unit& u, int wr, int wc, int fr, int fq) const {
        if (rs) { FOR_AI_M { const float sc = rs[ai * 128 + wr * 64 + m * 16 + fr] * QSCALE;
            FOR_BJ {
#pragma unroll
                for (int n = 0; n < 2; ++n) acc[ai][bj][m][n] = acc[ai][bj][m][n] * sc; } } }
        FOR_AI_M { float mx = -3.0e38f;
            FOR_BJ {
#pragma unroll
                for (int n = 0; n < 2; ++n) { const f32x4 v = acc[ai][bj][m][n]; mx = fmaxf(mx, fmaxf(fmaxf(v[0], v[1]), fmaxf(v[2], v[3]))); } }
            mx = fmaxf(mx, shfl_x(mx, fr + 16 * fq, 16)); mx = fmaxf(mx, shfl_x(mx, fr + 16 * fq, 32));
            if (fq == 0) tmax[(ai * 128 + wr * 64 + m * 16 + fr) * 4 + wc] = mx; }
        LDS_WAIT(); __builtin_amdgcn_s_barrier(); asm volatile("" ::: "memory");
        FOR_AI_M { const int r = ai * 128 + wr * 64 + m * 16 + fr; const f32x4 t = *(const LAS f32x4*)(tmax + r * 4); const float mx = fmaxf(fmaxf(t[0], t[1]), fmaxf(t[2], t[3])); float s = 0.f;
            FOR_BJ {
#pragma unroll
                for (int n = 0; n < 2; ++n) { f32x4 v = acc[ai][bj][m][n];
#pragma unroll
                    for (int j = 0; j < 4; ++j) { v[j] = __builtin_amdgcn_exp2f(v[j] - mx); s += v[j]; }
                    acc[ai][bj][m][n] = v; } }
            s += shfl_x(s, fr + 16 * fq, 16); s += shfl_x(s, fr + 16 * fq, 32);
            if (fq == 0) tsum[r * 4 + wc] = s; }
        LDS_WAIT(); __builtin_amdgcn_s_barrier(); asm volatile("" ::: "memory");
        FOR_AI_M { const int r = ai * 128 + wr * 64 + m * 16 + fr, row = u.pm * 256 + r; const f32x4 t = *(const LAS f32x4*)(tsum + r * 4); const float inv = 1.f / ((t[0] + t[1]) + (t[2] + t[3]));
            FOR_BJ { const int col = (u.z + u.pn) * 256 + bj * 128 + wc * 32 + 8 * fq; *(u32x4*)(P + (size_t)row * D + col) = pack8(acc[ai][bj][m][0] * inv, acc[ai][bj][m][1] * inv); } }
    }
};
struct EpiO {
    static constexpr bool PERM = true, ACC_INIT = false;
    bf16_t* O;
    __device__ __forceinline__ void operator()(Acc& acc, const Unit& u, int wr, int wc, int fr, int fq) const {
        FOR_AI_M { const int row = EPI_ROWS(ai, m);
            FOR_BJ { const int col = u.z * 256 + bj * 128 + wc * 32 + 8 * fq; *(u32x4*)(O + (size_t)row * D + col) = pack8(acc[ai][bj][m][0], acc[ai][bj][m][1]); } }
    }
};
struct EpiUp {
    static constexpr bool PERM = true, ACC_INIT = false;
    bf16_t* U; const float* SS; const LAS float* tab; int tab_pm;
    __device__ __forceinline__ void operator()(Acc& acc, const Unit& u, int wr, int wc, int fr, int fq) const {
        FOR_AI_M { const int row = EPI_ROWS(ai, m); const float rs = (u.pm == tab_pm) ? tab[ai * 128 + wr * 64 + m * 16 + fr] : row_rstd(SS, row);
            FOR_BJ { const int col = u.pn * 256 + bj * 128 + wc * 32 + 8 * fq; f32x4 v0 = acc[ai][bj][m][0] * rs, v1 = acc[ai][bj][m][1] * rs;
#pragma unroll
                for (int j = 0; j < 4; ++j) { const float a = fmaxf(v0[j], 0.f), b = fmaxf(v1[j], 0.f); v0[j] = a * a; v1[j] = b * b; }
                *(u32x4*)(U + (size_t)row * DFF + col) = pack8(v0, v1); } }
    }
};

struct EpiFinal {
    static constexpr bool PERM = false, ACC_INIT = true;
    const bf16_t* base; float* out; const float* gain; float* xch; unsigned* cnt; LAS float* P; LAS float* Sr; int wv;
    __device__ __forceinline__ void init(Acc& acc, const Unit& u, int wr, int wc, int fr, int fq) const {
#pragma unroll
        for (int ai = 0; ai < 2; ++ai)
#pragma unroll
            for (int m = 0; m < 4; ++m) { const size_t off = (size_t)EPI_ROWS(ai, m) * D + u.pn * 256 + wc * 32 + 4 * fq;
#pragma unroll
                for (int bj = 0; bj < 2; ++bj)
#pragma unroll
                    for (int n = 0; n < 2; ++n) { const u32x2 w = *(const u32x2*)(base + off + bj * 128 + 16 * n); acc[ai][bj][m][n] = (f32x4){bf2f(w.x & 0xffffu), bf2f(w.x >> 16), bf2f(w.y & 0xffffu), bf2f(w.y >> 16)}; } }
    }
    __device__ __forceinline__ void operator()(Acc& acc, const Unit& u, int wr, int wc, int fr, int fq) const {
        FOR_AI_M { float ssq = 0.f;
            FOR_BJ {
#pragma unroll
                for (int n = 0; n < 2; ++n) { const f32x4 v = acc[ai][bj][m][n]; ssq += (v[0] * v[0] + v[1] * v[1]) + (v[2] * v[2] + v[3] * v[3]); } }
            ssq += shfl_x(ssq, fr + 16 * fq, 16); ssq += shfl_x(ssq, fr + 16 * fq, 32);
            if (fq == 0) P[(ai * 128 + wr * 64 + m * 16 + fr) * 4 + wc] = ssq; }
        LDS_WAIT(); __builtin_amdgcn_s_barrier(); asm volatile("" ::: "memory");
        const int tid = tidx(wv);
        if (tid < 256) { const f32x4 t = *(const LAS f32x4*)(P + tid * 4);
            __hip_atomic_store(xch + ((size_t)(u.pm * 256 + tid) * 4 + u.pn), (t[0] + t[1]) + (t[2] + t[3]), __ATOMIC_RELAXED, __HIP_MEMORY_SCOPE_AGENT); }
        asm volatile("s_waitcnt vmcnt(0)" ::: "memory"); __builtin_amdgcn_s_barrier(); asm volatile("" ::: "memory");
        if (tid == 0) { unsigned* c = cnt + 16 * u.pm; (void)at_add(c, 1u); unsigned sp = 0; while (at_ld(c) < 4u) { __builtin_amdgcn_s_sleep(1); if (++sp > SPIN_CAP) break; }
            __builtin_amdgcn_fence(__ATOMIC_ACQUIRE, "agent"); asm volatile("s_waitcnt vmcnt(0)" ::: "memory"); }
        __builtin_amdgcn_s_barrier(); asm volatile("" ::: "memory");
        if (tid < 256) { float* x = xch + (size_t)(u.pm * 256 + tid) * 4; float t = 0.f;
#pragma unroll
            for (int j = 0; j < 4; ++j) t += __hip_atomic_load(x + j, __ATOMIC_RELAXED, __HIP_MEMORY_SCOPE_AGENT);
            Sr[tid] = rsqrtf(t * (1.f / D) + EPS); }
        LDS_WAIT(); __builtin_amdgcn_s_barrier(); asm volatile("" ::: "memory");
        f32x4 gv[2][2];
#pragma unroll
        for (int bj = 0; bj < 2; ++bj)
#pragma unroll
            for (int n = 0; n < 2; ++n) gv[bj][n] = *(const f32x4*)(gain + u.pn * 256 + bj * 128 + wc * 32 + 16 * n + 4 * fq);
        FOR_AI_M { const int r = ai * 128 + wr * 64 + m * 16 + fr; const float rs = Sr[r]; float* orow = out + (size_t)(u.pm * 256 + r) * D + u.pn * 256 + wc * 32 + 4 * fq;
            FOR_BJ {
#pragma unroll
                for (int n = 0; n < 2; ++n) *(f32x4*)(orow + bj * 128 + 16 * n) = acc[ai][bj][m][n] * rs * gv[bj][n]; } }
    }
};

struct Ctx {
    const float* in[33]; float* out; unsigned char* ws;
};
__device__ __forceinline__ float wave_sum(float v, int lane) {
#pragma unroll
    for (int o = 1; o < 64; o <<= 1) v += shfl_x(v, lane, o);
    return v;
}
__device__ __forceinline__ float wave_max(float v, int lane) {
#pragma unroll
    for (int o = 1; o < 64; o <<= 1) v = fmaxf(v, shfl_x(v, lane, o));
    return v;
}
__device__ __forceinline__ void transpose_item(const float* W, int ldw, int nblk, bf16_t* WT, int ldt, int row_off, int col_off, const float* ksc, LAS float* scr, int item, int lane) {
    const int kb = item / nblk, nb = item % nblk, k0 = 64 * kb, n0 = 32 * nb;
#pragma unroll
    for (int i = 0; i < 8; ++i) { const int kk = 8 * i + (lane >> 3), nn = 4 * (lane & 7);
        f32x4 v = __builtin_nontemporal_load((const f32x4*)&W[(size_t)(k0 + kk) * ldw + n0 + nn]); if (ksc) v = v * ksc[k0 + kk];
        scr[kk * 33 + nn] = v[0]; scr[kk * 33 + nn + 1] = v[1]; scr[kk * 33 + nn + 2] = v[2]; scr[kk * 33 + nn + 3] = v[3]; }
    LDS_WAIT(); asm volatile("" ::: "memory");
    const int c = lane & 7;
#pragma unroll
    for (int j = 0; j < 4; ++j) { const int n = (lane >> 3) + 8 * j; const LAS float* s = scr + (8 * c) * 33 + n;
        u32x4 o; o.x = pk2(s[0 * 33], s[1 * 33]); o.y = pk2(s[2 * 33], s[3 * 33]); o.z = pk2(s[4 * 33], s[5 * 33]); o.w = pk2(s[6 * 33], s[7 * 33]);
        *(u32x4*)(WT + (size_t)(row_off + n0 + n) * ldt + col_off + k0 + 8 * c) = o; }
    LDS_WAIT(); asm volatile("" ::: "memory");
}
__device__ __forceinline__ void rms_row_to_bf16(const float* xrow, const float* g, bf16_t* orow, int lane) {
    const f32x4* xr = (const f32x4*)xrow + lane; const f32x4* gr = (const f32x4*)g + lane;
    f32x4 v[4]; float s = 0.f;
#pragma unroll
    for (int j = 0; j < 4; ++j) { v[j] = __builtin_nontemporal_load(&xr[64 * j]); s += (v[j].x * v[j].x + v[j].y * v[j].y) + (v[j].z * v[j].z + v[j].w * v[j].w); }
    const float rs = rsqrtf(wave_sum(s, lane) * (1.f / D) + EPS);
    u32x2* o8 = (u32x2*)orow + lane;
#pragma unroll
    for (int j = 0; j < 4; ++j) { const f32x4 gg = gr[64 * j]; u32x2 w; w.x = pk2(v[j].x * rs * gg.x, v[j].y * rs * gg.y); w.y = pk2(v[j].z * rs * gg.z, v[j].w * rs * gg.w); o8[64 * j] = w; }
}

__device__ __forceinline__ void p0_prologue(const Ctx& C, LAS unsigned char* lds, int G, int bid, int wv) {
    const int tid = tidx(wv), lane = tid & 63, wave = tid >> 6;
    LAS float* scr = (LAS float*)(lds + wave * 16384);
    const int gw = bid * 8 + wave, NGW = G * 8;
    unsigned char* ws = C.ws;
    constexpr int I_SQ = 16 * 32, I_UP = 16 * 128, I_DN = 64 * 32, I_GLU = 8 * 16, I_PL = 8 * 32;
    constexpr int NIT = 6 * I_SQ + I_UP + I_DN + I_GLU + I_PL;
    for (int it = gw; it < NIT; it += NGW) {
        int r = it;
        if (r < I_SQ) { transpose_item(C.in[9], D, 32, (bf16_t*)(ws + WS_WIN), D, 0, 0, nullptr, scr, r, lane); continue; } r -= I_SQ;
        if (r < I_SQ) { transpose_item(C.in[22], D, 32, (bf16_t*)(ws + WS_WOUT), D, 0, 0, nullptr, scr, r, lane); continue; } r -= I_SQ;
        if (r < I_SQ) { transpose_item(C.in[25], D, 32, (bf16_t*)(ws + WS_WQ), D, 0, 0, C.in[23], scr, r, lane); continue; } r -= I_SQ;
        if (r < I_SQ) { transpose_item(C.in[26], D, 32, (bf16_t*)(ws + WS_WKV), D, 0, 0, nullptr, scr, r, lane); continue; } r -= I_SQ;
        if (r < I_SQ) { transpose_item(C.in[27], D, 32, (bf16_t*)(ws + WS_WKV), D, D, 0, nullptr, scr, r, lane); continue; } r -= I_SQ;
        if (r < I_SQ) { transpose_item(C.in[28], D, 32, (bf16_t*)(ws + WS_WO), D, 0, 0, nullptr, scr, r, lane); continue; } r -= I_SQ;
        if (r < I_UP) { transpose_item(C.in[30], DFF, 128, (bf16_t*)(ws + WS_WUP), D, 0, 0, C.in[29], scr, r, lane); continue; } r -= I_UP;
        if (r < I_DN) { transpose_item(C.in[31], D, 32, (bf16_t*)(ws + WS_WDOWN), DFF, 0, 0, nullptr, scr, r, lane); continue; } r -= I_DN;
        if (r < I_GLU) { transpose_item(C.in[20], DSSM, 16, (bf16_t*)(ws + WS_WGLU), DSSM, 0, 0, nullptr, scr, r, lane); continue; } r -= I_GLU;
        transpose_item(C.in[22] + (size_t)DPOOL * D, D, 32, (bf16_t*)(ws + WS_WOUT2), D, 0, DPOOL, nullptr, scr, r, lane);
    }
    const int gt = bid * 512 + tid, NGT = G * 512;
    { bf16_t* WP = (bf16_t*)(ws + WS_WPOOL); const float* wp = C.in[10]; const float* sc = C.in[11];
      for (int i = gt; i < 512 * 512 / 8; i += NGT) { const int c = i / 64, d0 = (i % 64) * 8; u32x4 o = {0u, 0u, 0u, 0u};
          if ((c >> 7) == (d0 >> 7)) { const float* src = wp + ((size_t)(c >> 7) * 128 + (c & 127)) * 128 + (d0 & 127); const f32x4 a = *(const f32x4*)src, b = *(const f32x4*)(src + 4), s0 = *(const f32x4*)(sc + d0), s1 = *(const f32x4*)(sc + d0 + 4);
              o.x = pk2(a[0] * s0[0], a[1] * s0[1]); o.y = pk2(a[2] * s0[2], a[3] * s0[3]); o.z = pk2(b[0] * s1[0], b[1] * s1[1]); o.w = pk2(b[2] * s1[2], b[3] * s1[3]); }
          *(u32x4*)(WP + (size_t)c * DPOOL + d0) = o; }
    }
    { const float* Wq = C.in[25]; const float* gx = C.in[23]; bf16_t* WQN = (bf16_t*)(ws + WS_WQN);
      for (int i = gt; i < D * D / 8; i += NGT) { const int k = i >> 7; const float gk = gx[k]; const f32x4 a = *(const f32x4*)(Wq + (size_t)i * 8), b = *(const f32x4*)(Wq + (size_t)i * 8 + 4);
          u32x4 o; o.x = pk2(a[0] * gk, a[1] * gk); o.y = pk2(a[2] * gk, a[3] * gk); o.z = pk2(b[0] * gk, b[1] * gk); o.w = pk2(b[2] * gk, b[3] * gk); *(u32x4*)(WQN + (size_t)i * 8) = o; } }
    { bf16_t* H1 = (bf16_t*)(ws + WS_T0); bf16_t* MN = (bf16_t*)(ws + WS_MN);
      auto src = [&](int m) -> const f32x4* { return (const f32x4*)(m < SEQ ? C.in[0] + (size_t)m * D : (m < M ? C.in[1] + (size_t)(m - SEQ) * D : C.in[7] + (size_t)(m - M) * D)) + lane; };
      int m = (gw + NGW - 1216) % NGW; f32x4 nx[4];
      if (m < M + NMEM) { const f32x4* xr = src(m);
#pragma unroll
          for (int j = 0; j < 4; ++j) nx[j] = __builtin_nontemporal_load(&xr[64 * j]); }
      for (; m < M + NMEM; m += NGW) { f32x4 v[4];
#pragma unroll
          for (int j = 0; j < 4; ++j) v[j] = nx[j];
          if (m + NGW < M + NMEM) { const f32x4* xr = src(m + NGW);
#pragma unroll
              for (int j = 0; j < 4; ++j) nx[j] = __builtin_nontemporal_load(&xr[64 * j]); }
          float ss = 0.f;
#pragma unroll
          for (int j = 0; j < 4; ++j) ss += (v[j].x * v[j].x + v[j].y * v[j].y) + (v[j].z * v[j].z + v[j].w * v[j].w);
          const float rs = rsqrtf(wave_sum(ss, lane) * (1.f / D) + EPS);
          const f32x4* gr = (const f32x4*)(m < M ? C.in[8] : C.in[24]) + lane; u32x2* o8 = (u32x2*)(m < M ? H1 + (size_t)m * D : MN + (size_t)(m - M) * D) + lane;
#pragma unroll
          for (int j = 0; j < 4; ++j) { const f32x4 gg = gr[64 * j]; u32x2 w; w.x = pk2(v[j].x * rs * gg.x, v[j].y * rs * gg.y); w.y = pk2(v[j].z * rs * gg.z, v[j].w * rs * gg.w); o8[64 * j] = w; } } }
    { float* AP = (float*)(ws + WS_AP); float* BB = (float*)(ws + WS_BB);
      for (int i = gt; i < NG * NP; i += NGT) { const int g = i / NP, p = i % NP;
          const float are = C.in[12][i], aim = C.in[13][i], dt = expf(C.in[19][g]);
          const float mag = expf(are * dt); float sn, cs; sincosf(aim * dt, &sn, &cs);
          const float abr = mag * cs, abi = mag * sn;
          float pr = 1.f, pi = 0.f;
          for (int k = 0; k <= 16; ++k) { AP[((size_t)(g * 17 + k) * NP + p) * 2] = pr; AP[((size_t)(g * 17 + k) * NP + p) * 2 + 1] = pi; const float nr = pr * abr - pi * abi, ni = pr * abi + pi * abr; pr = nr; pi = ni; }
          const float nr = abr - 1.f, ni = abi, den = are * are + aim * aim; const float cr = (nr * are + ni * aim) / den, ci = (ni * are - nr * aim) / den;
          for (int h = 0; h < NH; ++h) { const float br = C.in[14][(size_t)i * NH + h], bi = C.in[15][(size_t)i * NH + h];
              BB[((size_t)i * NH + h) * 2] = cr * br - ci * bi; BB[((size_t)i * NH + h) * 2 + 1] = cr * bi + ci * br; } } }
}
__device__ __forceinline__ void p1_pre(const Ctx& C, int G, int bid, int wv) {
    const int gt = bid * 512 + tidx(wv), NGT = G * 512; unsigned char* ws = C.ws;
    const float* AP = (const float*)(ws + WS_AP); const float* BB = (const float*)(ws + WS_BB); float* KL = (float*)(ws + WS_KLAG); bf16_t* WB = (bf16_t*)(ws + WS_WB);
    for (int i = gt; i < NG * 16 * 16 * 16; i += NGT) { const int hp = i & 15, h = (i >> 4) & 15, k = (i >> 8) & 15, g = i >> 12; float s = 0.f;
        const f32x4* crp = (const f32x4*)(C.in[16] + ((size_t)g * NH + h) * NP); const f32x4* cip = (const f32x4*)(C.in[17] + ((size_t)g * NH + h) * NP);
        const f32x4* app = (const f32x4*)(AP + (size_t)(g * 17 + k) * NP * 2); const f32x2* bbp = (const f32x2*)(BB + ((size_t)g * NP * NH + hp) * 2);
#pragma unroll 4
        for (int p4 = 0; p4 < NP / 4; ++p4) { const f32x4 cr = crp[p4], ci = cip[p4], a0 = app[2 * p4], a1 = app[2 * p4 + 1];
            const f32x2 b0 = bbp[(4 * p4 + 0) * NH], b1 = bbp[(4 * p4 + 1) * NH], b2 = bbp[(4 * p4 + 2) * NH], b3 = bbp[(4 * p4 + 3) * NH];
            s += cr[0] * (a0[0] * b0.x - a0[1] * b0.y) - ci[0] * (a0[0] * b0.y + a0[1] * b0.x);
            s += cr[1] * (a0[2] * b1.x - a0[3] * b1.y) - ci[1] * (a0[2] * b1.y + a0[3] * b1.x);
            s += cr[2] * (a1[0] * b2.x - a1[1] * b2.y) - ci[2] * (a1[0] * b2.y + a1[1] * b2.x);
            s += cr[3] * (a1[2] * b3.x - a1[3] * b3.y) - ci[3] * (a1[2] * b3.y + a1[3] * b3.x); }
        if (k == 0 && h == hp) s += C.in[18][g * NH + h];
        KL[i] = s; }
    for (int it = gt; it < NG * 256 * 32; it += NGT) { const int k8 = it & 31, n = (it >> 5) & 255, g = it >> 13; u32x4 o = {0u, 0u, 0u, 0u};
        if (n < 128) { const int p = n & 63, sidx = k8 >> 1, hp0 = (k8 & 1) * 8; const f32x2 a = *(const f32x2*)(AP + ((size_t)(g * 17 + 15 - sidx) * NP + p) * 2);
            const f32x4* bb = (const f32x4*)(BB + ((size_t)(g * NP + p) * NH + hp0) * 2); const f32x4 q0 = bb[0], q1 = bb[1], q2 = bb[2], q3 = bb[3];
            float v[8];
            if (n < 64) { v[0] = a.x * q0[0] - a.y * q0[1]; v[1] = a.x * q0[2] - a.y * q0[3]; v[2] = a.x * q1[0] - a.y * q1[1]; v[3] = a.x * q1[2] - a.y * q1[3];
                          v[4] = a.x * q2[0] - a.y * q2[1]; v[5] = a.x * q2[2] - a.y * q2[3]; v[6] = a.x * q3[0] - a.y * q3[1]; v[7] = a.x * q3[2] - a.y * q3[3]; }
            else {        v[0] = a.x * q0[1] + a.y * q0[0]; v[1] = a.x * q0[3] + a.y * q0[2]; v[2] = a.x * q1[1] + a.y * q1[0]; v[3] = a.x * q1[3] + a.y * q1[2];
                          v[4] = a.x * q2[1] + a.y * q2[0]; v[5] = a.x * q2[3] + a.y * q2[2]; v[6] = a.x * q3[1] + a.y * q3[0]; v[7] = a.x * q3[3] + a.y * q3[2]; }
            o.x = pk2(v[0], v[1]); o.y = pk2(v[2], v[3]); o.z = pk2(v[4], v[5]); o.w = pk2(v[6], v[7]); }
        *(u32x4*)(WB + (size_t)it * 8) = o; }
}
__device__ __forceinline__ void wy_gen(const Ctx& C, int it0, int it1, int start, int stride) {
    unsigned char* ws = C.ws;
    const float* AP = (const float*)(ws + WS_AP); const float* KL = (const float*)(ws + WS_KLAG); bf16_t* WY = (bf16_t*)(ws + WS_WY);
    for (int it = it0 + start; it < it1; it += stride) { const int k8 = it % (KY / 8), n = (it / (KY / 8)) & 255, g = it / ((KY / 8) * 256), t = n >> 4, h = n & 15, k0 = k8 * 8; float v[8];
        if (k0 < 256) { const int sidx = k0 >> 4, hp0 = k0 & 15; f32x4 q0 = {0.f, 0.f, 0.f, 0.f}, q1 = q0;
            if (sidx <= t) { const f32x4* kp = (const f32x4*)(KL + (((size_t)g * 16 + (t - sidx)) * 16 + h) * 16 + hp0); q0 = kp[0]; q1 = kp[1]; }
            v[0] = q0[0]; v[1] = q0[1]; v[2] = q0[2]; v[3] = q0[3]; v[4] = q1[0]; v[5] = q1[1]; v[6] = q1[2]; v[7] = q1[3]; }
        else { const int p0 = (k0 - 256) & 63; const f32x4* crp = (const f32x4*)(C.in[16] + ((size_t)g * NH + h) * NP + p0); const f32x4* cip = (const f32x4*)(C.in[17] + ((size_t)g * NH + h) * NP + p0);
            const f32x4* app = (const f32x4*)(AP + ((size_t)(g * 17 + t + 1) * NP + p0) * 2);
            const f32x4 cr0 = crp[0], cr1 = crp[1], ci0 = cip[0], ci1 = cip[1], a0 = app[0], a1 = app[1], a2 = app[2], a3 = app[3];
            const float cr[8] = {cr0[0], cr0[1], cr0[2], cr0[3], cr1[0], cr1[1], cr1[2], cr1[3]}, ci[8] = {ci0[0], ci0[1], ci0[2], ci0[3], ci1[0], ci1[1], ci1[2], ci1[3]};
            const float ar[8] = {a0[0], a0[2], a1[0], a1[2], a2[0], a2[2], a3[0], a3[2]}, ai[8] = {a0[1], a0[3], a1[1], a1[3], a2[1], a2[3], a3[1], a3[3]};
#pragma unroll
            for (int e = 0; e < 8; ++e) v[e] = (k0 < 320) ? (cr[e] * ar[e] - ci[e] * ai[e]) : -(cr[e] * ai[e] + ci[e] * ar[e]); }
        u32x4 o; o.x = pk2(v[0], v[1]); o.y = pk2(v[2], v[3]); o.z = pk2(v[4], v[5]); o.w = pk2(v[6], v[7]);
        *(u32x4*)(WY + (size_t)it * 8) = o; }
}
__device__ __forceinline__ void p2b_prefix(const Ctx& C, LAS unsigned char* lds, int g, int tile, int wv) {
    const int p = lane_id(); unsigned char* ws = C.ws;
    const float* AP = (const float*)(ws + WS_AP); const float* E = (const float*)(ws + WS_E) + (size_t)g * NCHP * 128; bf16_t* UH = (bf16_t*)(ws + WS_UH) + (size_t)g * NCHP * KY;
    LAS float* L = (LAS float*)lds;
    const float ar = AP[((size_t)(g * 17 + 16) * NP + p) * 2], ai = AP[((size_t)(g * 17 + 16) * NP + p) * 2 + 1];
    if (tile < 4) {
    float hr[4] = {0.f, 0.f, 0.f, 0.f}, hi[4] = {0.f, 0.f, 0.f, 0.f};
    for (int cc = 0; cc < 32; cc += 8) { float er[4][8], ei[4][8];
#pragma unroll
        for (int ch = 0; ch < 4; ++ch)
#pragma unroll
            for (int j = 0; j < 8; ++j) { const size_t c = (size_t)((wv * 4 + ch) * 32 + cc + j); er[ch][j] = E[c * 128 + p]; ei[ch][j] = E[c * 128 + 64 + p]; }
#pragma unroll
        for (int j = 0; j < 8; ++j)
#pragma unroll
            for (int ch = 0; ch < 4; ++ch) { const float nr = ar * hr[ch] - ai * hi[ch] + er[ch][j], ni = ar * hi[ch] + ai * hr[ch] + ei[ch][j]; hr[ch] = nr; hi[ch] = ni; } }
#pragma unroll
    for (int ch = 0; ch < 4; ++ch) { L[((wv * 4 + ch) * 64 + p) * 2] = hr[ch]; L[((wv * 4 + ch) * 64 + p) * 2 + 1] = hi[ch]; }
    float sr = ar, si = ai;
#pragma unroll
    for (int j = 0; j < 5; ++j) { const float nr = sr * sr - si * si, ni = 2.f * sr * si; sr = nr; si = ni; }
    __syncthreads();
    float Hr = 0.f, Hi = 0.f;
    for (int j = 0; j < wv * 4; ++j) { const float lr = L[(j * 64 + p) * 2], li = L[(j * 64 + p) * 2 + 1]; const float nr = sr * Hr - si * Hi + lr, ni = sr * Hi + si * Hr + li; Hr = nr; Hi = ni; }
#pragma unroll
    for (int ch = 0; ch < 4; ++ch) { hr[ch] = Hr; hi[ch] = Hi; const float lr = L[((wv * 4 + ch) * 64 + p) * 2], li = L[((wv * 4 + ch) * 64 + p) * 2 + 1];
        const float nr = sr * Hr - si * Hi + lr, ni = sr * Hi + si * Hr + li; Hr = nr; Hi = ni; }
    if (wv == 7 && tile == 3) { C.out[O_SREP + g * NP + p] = Hr; C.out[O_SIMP + g * NP + p] = Hi; }
    if ((wv >> 1) == tile)
    for (int cc = 0; cc < 32; cc += 8) { float er[4][8], ei[4][8];
#pragma unroll
        for (int ch = 0; ch < 4; ++ch)
#pragma unroll
            for (int j = 0; j < 8; ++j) { const size_t c = (size_t)((wv * 4 + ch) * 32 + cc + j); er[ch][j] = E[c * 128 + p]; ei[ch][j] = E[c * 128 + 64 + p]; }
#pragma unroll
        for (int j = 0; j < 8; ++j)
#pragma unroll
            for (int ch = 0; ch < 4; ++ch) { const size_t c = (size_t)((wv * 4 + ch) * 32 + cc + j);
                UH[c * KY + 256 + p] = (bf16_t)f2bf(hr[ch]); UH[c * KY + 320 + p] = (bf16_t)f2bf(hi[ch]);
                const float nr = ar * hr[ch] - ai * hi[ch] + er[ch][j], ni = ar * hi[ch] + ai * hr[ch] + ei[ch][j]; hr[ch] = nr; hi[ch] = ni; } }
    } else
    for (int b = wv; b < 16; b += 8) { const float h0r = C.in[5][((size_t)b * NG + g) * NP + p], h0i = C.in[6][((size_t)b * NG + g) * NP + p]; const int c = 1024 + b;
        UH[(size_t)c * KY + 256 + p] = (bf16_t)f2bf(h0r); UH[(size_t)c * KY + 320 + p] = (bf16_t)f2bf(h0i);
        C.out[O_SRES + ((size_t)b * NG + g) * NP + p] = ar * h0r - ai * h0i + E[(size_t)c * 128 + p];
        C.out[O_SIMS + ((size_t)b * NG + g) * NP + p] = ar * h0i + ai * h0r + E[(size_t)c * 128 + 64 + p]; }
    __syncthreads();
}
__device__ __forceinline__ void p2b_pool(const Ctx& C, int worker, int nworkers, int wv) {
    const int cl = lane_id() * 8; unsigned char* ws = C.ws;
    const bf16_t* ZP = (const bf16_t*)(ws + WS_ZP); bf16_t* MIX = (bf16_t*)(ws + WS_T2);
    const int w = 2 << (cl >> 7);
    for (int blk = worker * 8 + wv; blk < M / 8; blk += nworkers * 8) { const int r0 = blk * 8;
        if (r0 < SEQ) {
#pragma unroll 2
            for (int t = 0; t < 8; ++t) { const int row = r0 + t; u32x4 q[16];
#pragma unroll
                for (int j = 0; j < 16; ++j) { const int rr = row - j; q[j] = *(const u32x4*)(ZP + (size_t)(rr < 0 ? 0 : rr) * DPOOL + cl); }
                float s[8], cur[8]; unpack8(q[0], cur);
#pragma unroll
                for (int e = 0; e < 8; ++e) s[e] = cur[e];
#pragma unroll
                for (int j = 1; j < 16; ++j) { float v[8]; unpack8(q[j], v); const float mk = (j < w && row - j >= 0) ? 1.f : 0.f;
#pragma unroll
                    for (int e = 0; e < 8; ++e) s[e] += mk * v[e]; }
                const int cnt = (row + 1 < w) ? row + 1 : w; const float inv = 1.f / (float)cnt;
                u32x4 o; o.x = pk2(s[0] * inv - cur[0], s[1] * inv - cur[1]); o.y = pk2(s[2] * inv - cur[2], s[3] * inv - cur[3]); o.z = pk2(s[4] * inv - cur[4], s[5] * inv - cur[5]); o.w = pk2(s[6] * inv - cur[6], s[7] * inv - cur[7]);
                *(u32x4*)(MIX + (size_t)row * D + cl) = o; }
        } else { const int b = (r0 - SEQ) >> 4, t0 = r0 & 15;
            for (int tt = 0; tt < 8; ++tt) { const int t = t0 + tt, row = r0 + tt; float s[8] = {0.f, 0.f, 0.f, 0.f, 0.f, 0.f, 0.f, 0.f}; float cur[8];
                for (int j = 0; j < w; ++j) { float v[8];
                    if (t - j >= 0) unpack8(*(const u32x4*)(ZP + (size_t)(row - j) * DPOOL + cl), v);
                    else { const float* hp = C.in[4] + ((size_t)b * 15 + (15 + t - j)) * DPOOL + cl; const f32x4 a = *(const f32x4*)hp, bb = *(const f32x4*)(hp + 4);
                        v[0] = a[0]; v[1] = a[1]; v[2] = a[2]; v[3] = a[3]; v[4] = bb[0]; v[5] = bb[1]; v[6] = bb[2]; v[7] = bb[3]; }
#pragma unroll
                    for (int e = 0; e < 8; ++e) { s[e] += v[e]; if (j == 0) cur[e] = v[e]; } }
                const float inv = 1.f / (float)w;
                u32x4 o; o.x = pk2(s[0] * inv - cur[0], s[1] * inv - cur[1]); o.y = pk2(s[2] * inv - cur[2], s[3] * inv - cur[3]); o.z = pk2(s[4] * inv - cur[4], s[5] * inv - cur[5]); o.w = pk2(s[6] * inv - cur[6], s[7] * inv - cur[7]);
                *(u32x4*)(MIX + (size_t)row * D + cl) = o; } } }
}
__device__ __forceinline__ void sample_attn_item(const Ctx& C, LAS unsigned char* lds, int item, int wv) {
    const int lane = lane_id(), fr = lane & 15, fq = lane >> 4; const int b = item >> 4, h = (item >> 2) & 3, dq = item & 3; unsigned char* ws = C.ws;
    const bf16_t* Q = (const bf16_t*)(ws + WS_T1); bf16_t* O = (bf16_t*)(ws + WS_OB);
    const float* Kc = C.in[2] + (size_t)b * NMEM * D + h * HD; const float* Vc = C.in[3] + (size_t)b * NMEM * D + h * HD + dq * 64;
    LAS float* Sl = (LAS float*)lds;
    LAS float* PT = (LAS float*)(lds + 16384);
    LAS float* red = (LAS float*)(lds + 32768);
    float vv[32];
#pragma unroll
    for (int j = 0; j < 32; ++j) vv[j] = __builtin_nontemporal_load(&Vc[(size_t)(wv * 32 + j) * D + lane]);
    bf16x8 qf[8];
#pragma unroll
    for (int kk = 0; kk < 8; ++kk) qf[kk] = *(const bf16x8*)(Q + (size_t)(SEQ + b * 16 + fr) * D + h * HD + kk * 32 + fq * 8);
#pragma unroll
    for (int kbi = 0; kbi < 2; ++kbi) { const int kb = wv + 8 * kbi; f32x4 acc = {0.f, 0.f, 0.f, 0.f}; const float* kr = Kc + (size_t)(kb * 16 + fr) * D + fq * 8;
#pragma unroll
        for (int kk = 0; kk < 8; ++kk) { const f32x4 a = *(const f32x4*)(kr + kk * 32), c = *(const f32x4*)(kr + kk * 32 + 4); const u32x4 w = pack8(a, c);
            acc = __builtin_amdgcn_mfma_f32_16x16x32_bf16(qf[kk], __builtin_bit_cast(bf16x8, w), acc, 0, 0, 0); }
#pragma unroll
        for (int r = 0; r < 4; ++r) Sl[(4 * fq + r) * 256 + kb * 16 + fr] = acc[r]; }
    __syncthreads();
#pragma unroll
    for (int rr = 0; rr < 2; ++rr) { const int s = wv * 2 + rr; float v[4]; float mx = -3.0e38f;
#pragma unroll
        for (int j = 0; j < 4; ++j) { v[j] = Sl[s * 256 + lane + 64 * j]; mx = fmaxf(mx, v[j]); }
        mx = wave_max(mx, lane); float sum = 0.f;
#pragma unroll
        for (int j = 0; j < 4; ++j) { v[j] = __builtin_amdgcn_exp2f(v[j] - mx); sum += v[j]; }
        const float inv = 1.f / wave_sum(sum, lane);
#pragma unroll
        for (int j = 0; j < 4; ++j) PT[(lane + 64 * j) * 16 + s] = v[j] * inv; }
    __syncthreads();
    { float o[16];
#pragma unroll
      for (int s = 0; s < 16; ++s) o[s] = 0.f;
#pragma unroll
      for (int j = 0; j < 32; ++j) { const LAS f32x4* pp = (const LAS f32x4*)(PT + (wv * 32 + j) * 16);
#pragma unroll
          for (int q4 = 0; q4 < 4; ++q4) { const f32x4 pv = pp[q4]; o[4 * q4 + 0] += pv[0] * vv[j]; o[4 * q4 + 1] += pv[1] * vv[j]; o[4 * q4 + 2] += pv[2] * vv[j]; o[4 * q4 + 3] += pv[3] * vv[j]; } }
#pragma unroll
      for (int s = 0; s < 16; ++s) red[(wv * 16 + s) * 64 + lane] = o[s]; }
    __syncthreads();
    { const int tid = wv * 64 + lane, s = tid >> 5, dp = (tid & 31) * 2; float o0 = 0.f, o1 = 0.f;
#pragma unroll
      for (int w = 0; w < 8; ++w) { const f32x2 t = *(const LAS f32x2*)(red + (w * 16 + s) * 64 + dp); o0 += t.x; o1 += t.y; }
      *(unsigned*)(O + (size_t)(SEQ + b * 16 + s) * D + h * HD + dq * 64 + dp) = pk2(o0, o1); }
    __syncthreads();
}

template <class Epi8>
__device__ __forceinline__ void skinny_gemm(LAS unsigned char* lds, const bf16_t* A, int lda, const bf16_t* Bt, int ldb, int N, int K, int ksplit, const Epi8& E, int G, int bid, int wv) {
    const int lane = lane_id(), fr = lane & 15, fq = lane >> 4;
    const int ntn = N / 64, per = 4 * ntn, ntiles = per * ksplit, kw = K / ksplit / 8;
    LAS float* red = (LAS float*)lds;
    for (int t = bid; t < ntiles; t += G) {
        const int ks = t / per, tt = t % per, tm = tt & 3, tn = tt >> 2, kbeg = ks * (K / ksplit) + wv * kw;
        f32x4 acc[4][4];
#pragma unroll
        for (int i = 0; i < 4; ++i)
#pragma unroll
            for (int j = 0; j < 4; ++j) acc[i][j] = (f32x4){0.f, 0.f, 0.f, 0.f};
        const bf16_t* ap = A + (size_t)(tm * 64 + fr) * lda + kbeg + fq * 8;
        const bf16_t* bp = Bt + (size_t)(tn * 64 + fr) * ldb + kbeg + fq * 8;
#pragma unroll 4
        for (int k = 0; k < kw; k += 32) { bf16x8 af[4], bfr[4];
#pragma unroll
            for (int i = 0; i < 4; ++i) { af[i] = *(const bf16x8*)(ap + (size_t)i * 16 * lda + k); bfr[i] = *(const bf16x8*)(bp + (size_t)i * 16 * ldb + k); }
#pragma unroll
            for (int i = 0; i < 4; ++i)
#pragma unroll
                for (int j = 0; j < 4; ++j) acc[i][j] = __builtin_amdgcn_mfma_f32_16x16x32_bf16(bfr[j], af[i], acc[i][j], 0, 0, 0); }
#pragma unroll
        for (int i = 0; i < 4; ++i)
#pragma unroll
            for (int j = 0; j < 4; ++j) *(LAS f32x4*)(red + ((wv * 64 + i * 16 + fr) * 64 + (((j * 4 + fq) ^ fr) << 2))) = acc[i][j];
        __syncthreads();
        { const int tid = wv * 64 + lane, row = tid >> 3, s8 = (tid & 7) * 2; f32x4 s0 = {0.f, 0.f, 0.f, 0.f}, s1 = {0.f, 0.f, 0.f, 0.f};
#pragma unroll
          for (int w = 0; w < 8; ++w) { s0 += *(const LAS f32x4*)(red + ((w * 64 + row) * 64 + ((s8 ^ (row & 15)) << 2))); s1 += *(const LAS f32x4*)(red + ((w * 64 + row) * 64 + (((s8 + 1) ^ (row & 15)) << 2))); }
          E(tm * 64 + row, tn * 64 + s8 * 4, s0, s1, lane, ks); }
        __syncthreads();
    }
}
__device__ __forceinline__ u32x2 pack4(const f32x4 v) { u32x2 w; w.x = cvt_pk_bf16(v[0], v[1]); w.y = cvt_pk_bf16(v[2], v[3]); return w; }
struct SkZ { bf16_t* ZP; bf16_t* UH; float* out;
    __device__ __forceinline__ void operator()(int r, int c, f32x4 v0, f32x4 v1, int, int) const { const int row = SEQ + r; const u32x4 w = pack8(v0, v1);
        if (c < DPOOL) { *(u32x4*)(ZP + (size_t)row * DPOOL + c) = w; if ((r & 15) != 0) { float* dst = out + O_POOLS + ((size_t)(r >> 4) * 15 + ((r & 15) - 1)) * DPOOL + c; *(f32x4*)dst = v0; *(f32x4*)(dst + 4) = v1; } }
        else { const int cc = c - DPOOL, gg = cc >> 4, hh = cc & 15; *(u32x4*)(UH + ((size_t)gg * NCHP + (row >> 4)) * KY + (row & 15) * 16 + hh) = w; } } };
struct SkKV { float* out; bf16_t* KB; bf16_t* VT;
    __device__ __forceinline__ void operator()(int r, int c, f32x4 v0, f32x4 v1, int, int) const {
        if (c < D) { float* dst = out + O_MK + (size_t)r * D + c; *(f32x4*)dst = v0; *(f32x4*)(dst + 4) = v1; *(u32x4*)(KB + (size_t)r * D + c) = pack8(v0, v1); }
        else { const int c2 = c - D; float* dst = out + O_MV + (size_t)r * D + c2; *(f32x4*)dst = v0; *(f32x4*)(dst + 4) = v1;
            *(u32x4*)(VT + (size_t)r * D + c2) = pack8(v0, v1); } } };
struct SkPool { bf16_t* CAT; const float* scale;
    __device__ __forceinline__ void operator()(int r, int c, f32x4 v0, f32x4 v1, int, int) const { *(u32x4*)(CAT + (size_t)(SEQ + r) * D + c) = pack8(v0 * *(const f32x4*)(scale + c), v1 * *(const f32x4*)(scale + c + 4)); } };
struct SkGlu { bf16_t* CAT; const bf16_t* MIX; const float* bias;
    __device__ __forceinline__ void operator()(int r, int c, f32x4 v0, f32x4 v1, int, int) const { float y[8]; unpack8(*(const u32x4*)(MIX + (size_t)(SEQ + r) * D + DPOOL + c), y);
        const f32x4 b0 = *(const f32x4*)(bias + c), b1 = *(const f32x4*)(bias + c + 4);
#pragma unroll
        for (int j = 0; j < 4; ++j) { v0[j] = fast_sig_scale(y[j], v0[j] + b0[j]); v1[j] = fast_sig_scale(y[4 + j], v1[j] + b1[j]); }
        *(u32x4*)(CAT + (size_t)(SEQ + r) * D + DPOOL + c) = pack8(v0, v1); } };
template <bool BASE_BF16> struct SkRes { const void* base; bf16_t* Xb; float* SS;
    __device__ __forceinline__ void operator()(int r, int c, f32x4 v0, f32x4 v1, int lane, int) const { f32x4 x0, x1;
        if constexpr (BASE_BF16) { float y[8]; unpack8(*(const u32x4*)((const bf16_t*)base + (size_t)r * D + c), y); x0 = v0 + (f32x4){y[0], y[1], y[2], y[3]}; x1 = v1 + (f32x4){y[4], y[5], y[6], y[7]}; }
        else { const float* bp = (const float*)base + (size_t)r * D + c; x0 = v0 + *(const f32x4*)bp; x1 = v1 + *(const f32x4*)(bp + 4); }
        *(u32x4*)(Xb + (size_t)r * D + c) = pack8(x0, x1);
        float q = ((x0[0] * x0[0] + x0[1] * x0[1]) + (x0[2] * x0[2] + x0[3] * x0[3])) + ((x1[0] * x1[0] + x1[1] * x1[1]) + (x1[2] * x1[2] + x1[3] * x1[3]));
        q += shfl_x(q, lane, 1); q += shfl_x(q, lane, 2); q += shfl_x(q, lane, 4);
        if ((lane & 7) == 0) SS[(size_t)r * 16 + (c >> 6)] = q; } };
struct SkQ { bf16_t* Q; const float* SS;
    __device__ __forceinline__ void operator()(int r, int c, f32x4 v0, f32x4 v1, int, int) const { const float rs = row_rstd(SS, r) * QSCALE; *(u32x4*)(Q + (size_t)r * D + c) = pack8(v0 * rs, v1 * rs); } };
struct SkUp { bf16_t* U; const float* SS;
    __device__ __forceinline__ void operator()(int r, int c, f32x4 v0, f32x4 v1, int, int) const { const float rs = row_rstd(SS, r);
#pragma unroll
        for (int j = 0; j < 4; ++j) { const float a = fmaxf(v0[j] * rs, 0.f), b = fmaxf(v1[j] * rs, 0.f); v0[j] = a * a; v1[j] = b * b; }
        *(u32x4*)(U + (size_t)r * DFF + c) = pack8(v0, v1); } };
struct SkSlab { float* slab;
    __device__ __forceinline__ void operator()(int r, int c, f32x4 v0, f32x4 v1, int, int ks) const { float* dst = slab + ((size_t)ks * NSAMP + r) * D + c;
        asm volatile("global_store_dwordx4 %0, %1, off sc0 sc1\n\ts_nop 1" :: "v"(dst), "v"(v0) : "memory");
        asm volatile("global_store_dwordx4 %0, %1, off offset:16 sc0 sc1\n\ts_nop 1" :: "v"(dst), "v"(v1) : "memory"); } };
#define XB_TMO      128
#define XB_XCNT(j)  (256  + 64 * (j))
#define XB_XSUB(j)  (1280 + 64 * (j))
#define XB_XGEN(j)  (2304 + 64 * (j))
#define XB_TOP      3328
#define XB_TOPGEN   3392
#define XCD_BAR_WORDS 3456
#define XB_SPIN_CAP (1u << 18)

__device__ __forceinline__ unsigned xb_ld(unsigned* p)              { return __hip_atomic_load(p, __ATOMIC_RELAXED, __HIP_MEMORY_SCOPE_AGENT); }
__device__ __forceinline__ unsigned xb_add(unsigned* p, unsigned v) { return __hip_atomic_fetch_add(p, v, __ATOMIC_RELAXED, __HIP_MEMORY_SCOPE_AGENT); }
__device__ __forceinline__ unsigned xb_xcc_id() { return (unsigned)__builtin_amdgcn_s_getreg((3 << 11) | 20) & 0xFu; }
#define XB_SPIN(cond, bar) do { unsigned _sp = 0; while (cond) { __builtin_amdgcn_s_sleep(1); \
    if ((++_sp & 255u) == 0u) { if (xb_ld(&(bar)[XB_TMO])) break; if (_sp > XB_SPIN_CAP) { atomicAdd(&(bar)[XB_TMO], 1u); break; } } } } while (0)

struct XcdBarrier {
    unsigned* bar; unsigned x;
    volatile LAS unsigned* st;
};

__device__ __forceinline__ XcdBarrier xcd_barrier_post(unsigned* bar, volatile LAS unsigned* st, int wv) {
    XcdBarrier b; b.bar = bar; b.x = xb_xcc_id(); b.st = st;
    if (tidx(wv) == 0) (void)xb_add(&bar[XB_XCNT(b.x)], 1u);
    return b;
}
__device__ __forceinline__ void xcd_barrier_complete(unsigned* bar, unsigned x, unsigned& nloc, unsigned& nx) {
    const unsigned G = gridDim.x * gridDim.y * gridDim.z;
    unsigned sum, cnt, mine, sp = 0u;
    for (;;) {
        sum = 0u; cnt = 0u; mine = 0u;
#pragma unroll
        for (unsigned j = 0; j < 16; ++j) { const unsigned c = xb_ld(&bar[XB_XCNT(j)]); sum += c; cnt += (c > 0u) ? 1u : 0u; mine = (j == x) ? c : mine; }
        if (sum == G) break;
        __builtin_amdgcn_s_sleep(1);
        if ((++sp & 255u) == 0u) { if (xb_ld(&bar[XB_TMO])) break; if (sp > XB_SPIN_CAP) { atomicAdd(&bar[XB_TMO], 1u); break; } }
    }
    nloc = mine > 0u ? mine : 1u; nx = cnt > 0u ? cnt : 1u;
}

__device__ __forceinline__ void xcd_barrier(const XcdBarrier& b, int wv) {
    asm volatile("s_waitcnt vmcnt(0)" ::: "memory");
    __syncthreads();
    if (tidx(wv) == 0) {
        unsigned* bar = b.bar;
        __builtin_amdgcn_s_waitcnt(0);
        unsigned nloc = b.st[0], nx = b.st[1];
        if (nloc == 0u) { xcd_barrier_complete(bar, b.x, nloc, nx); b.st[0] = nloc; b.st[1] = nx; }
        const unsigned old = xb_add(&bar[XB_XSUB(b.x)], 1u);
        const unsigned gen = old / nloc;
        if (old + 1u == (gen + 1u) * nloc) {
            __builtin_amdgcn_fence(__ATOMIC_RELEASE, "agent");
            asm volatile("s_waitcnt vmcnt(0)" ::: "memory");
            const unsigned og = xb_add(&bar[XB_TOP], 1u);
            const unsigned tg = og / nx;
            if (og + 1u == (tg + 1u) * nx) xb_add(&bar[XB_TOPGEN], 1u);
            else XB_SPIN(xb_ld(&bar[XB_TOPGEN]) == tg, bar);
            __builtin_amdgcn_fence(__ATOMIC_ACQUIRE, "agent");
            xb_add(&bar[XB_XGEN(b.x)], 1u);
            asm volatile("s_waitcnt vmcnt(0)" ::: "memory");
        } else {
            XB_SPIN(xb_ld(&bar[XB_XGEN(b.x)]) == gen, bar);
            __builtin_amdgcn_fence(__ATOMIC_ACQUIRE, "agent");
            asm volatile("s_waitcnt vmcnt(0)" ::: "memory");
        }
    }
    __syncthreads();
}

#ifndef PHMASK
#define PHMASK 0xFFFF
#endif
#define PH(k) if constexpr (((PHMASK) >> (k)) & 1)
#ifndef TPROBE
#define TPROBE 0
#endif
#ifndef TP_BASE
#define TP_BASE 0
#endif
#define TSTAMP(k) do { if (TPROBE && bid == 0 && tidx(wv) == 0) ((unsigned long long*)(ws + WS_BAR + 65536))[k] = __builtin_amdgcn_s_memrealtime(); } while (0)
constexpr int LDS_BYTES = 131072 + 8192 + 2048;
__global__ void __launch_bounds__(512, 2) fwd_megakernel(Ctx C) {
    extern __shared__ __attribute__((aligned(16))) unsigned char lds_raw[];
    LAS unsigned char* lds = (LAS unsigned char*)lds_raw;
    const int wv = __builtin_amdgcn_readfirstlane((int)threadIdx.x >> 6);
    const int G = gridDim.x, bid = blockIdx.x; unsigned char* ws = C.ws;
    bf16_t* T0 = (bf16_t*)(ws + WS_T0); bf16_t* T1 = (bf16_t*)(ws + WS_T1); bf16_t* T2 = (bf16_t*)(ws + WS_T2); bf16_t* OB = (bf16_t*)(ws + WS_OB);
    float* SS1 = (float*)(ws + WS_SSP); float* SS2 = SS1 + (size_t)M * 16;
    float* Y = C.out + O_Y;
    pg8::Order S;

    { volatile LAS unsigned* misc = (volatile LAS unsigned*)(lds + 131072 + 8192); if (tidx(wv) < 16) misc[tidx(wv)] = 0u; }
    __syncthreads();
    const XcdBarrier xbar = xcd_barrier_post((unsigned*)(ws + WS_BAR), (volatile LAS unsigned*)(lds + 131072 + 8192), wv);
    TSTAMP(0);
    p0_prologue(C, lds, G, bid, wv);
    xcd_barrier(xbar, wv);
    TSTAMP(1);

    p1_pre(C, G, bid, wv);
    PH(0) { pg8::Gemm g{(const char*)T0, (const char*)(ws + WS_WIN), D, D, 0, 0, D}; S.init(SEQ / 256, 4, 1, G, bid);
      EpiZ E{(bf16_t*)(ws + WS_ZP), (bf16_t*)(ws + WS_UH), C.out}; pg8::gemm_phase(lds, g, S, E, wv); }
    { SkZ E{(bf16_t*)(ws + WS_ZP), (bf16_t*)(ws + WS_UH), C.out}; skinny_gemm(lds, T0 + (size_t)SEQ * D, D, (const bf16_t*)(ws + WS_WIN), D, D, D, 1, E, G, bid, wv); }
    { SkKV E{C.out, (bf16_t*)(ws + WS_KB), (bf16_t*)(ws + WS_VT)};
      skinny_gemm(lds, (const bf16_t*)(ws + WS_MN), D, (const bf16_t*)(ws + WS_WKV), D, 2 * D, D, 1, E, G, (bid + G - 64) % G, wv); }
    xcd_barrier(xbar, wv);
    TSTAMP(2);

    { S.init(NCHP / 256, 1, NG, G, bid); Unit u0;
      if (S.next(0, u0)) { const int grp = u0.z, tile = u0.pm;
        wy_gen(C, grp * 256 * (KY / 8), (grp + 1) * 256 * (KY / 8), tile * 512 + tidx(wv), 5 * 512);
        PH(2) { pg8::Gemm g{(const char*)(ws + WS_UH), (const char*)(ws + WS_WB), KY, 256, (size_t)NCHP * KY * 2, (size_t)256 * 256 * 2, 256};
          EpiE E{(float*)(ws + WS_E)}; pg8::gemm_phase(lds, g, S, E, wv); }
        asm volatile("s_waitcnt vmcnt(0)" ::: "memory"); __syncthreads();
        if (tidx(wv) == 0) { unsigned* cnt = (unsigned*)(ws + WS_BAR + 16384) + 64 * grp;
            __builtin_amdgcn_fence(__ATOMIC_RELEASE, "agent"); asm volatile("s_waitcnt vmcnt(0)" ::: "memory");
            (void)xb_add(cnt, 1u);
            unsigned sp = 0; while (xb_ld(cnt) < 5u) { __builtin_amdgcn_s_sleep(1); if (++sp > XB_SPIN_CAP) break; }
            __builtin_amdgcn_fence(__ATOMIC_ACQUIRE, "agent"); asm volatile("s_waitcnt vmcnt(0)" ::: "memory"); }
        __syncthreads();
        p2b_prefix(C, lds, grp, tile, wv);
        asm volatile("s_waitcnt vmcnt(0)" ::: "memory"); __syncthreads();
        PH(3) { pg8::Gemm g{(const char*)(ws + WS_UH), (const char*)(ws + WS_WY), KY, KY, (size_t)NCHP * KY * 2, (size_t)256 * KY * 2, KY};
          EpiY E{T1}; pg8::gemm_phase(lds, g, S, E, wv); }
      } else {
        if (bid < 176) { PH(1) { pg8::Gemm g{(const char*)(ws + WS_KB), (const char*)(ws + WS_WQN), D, D, (size_t)HD * 2, (size_t)HD * 2, HD}; S.init(1, 4, NHEAD, 16, bid - 160);
            EpiWqk E{(bf16_t*)(ws + WS_WQK)}; pg8::gemm_phase(lds, g, S, E, wv); } }
        else if (bid < 192) { PH(1) { pg8::Gemm g{(const char*)(ws + WS_WO), (const char*)(ws + WS_VT), D, D, (size_t)HD * 2, (size_t)HD * 2, HD}; S.init(4, 1, NHEAD, 16, bid - 176);
            EpiVWo E{(bf16_t*)(ws + WS_VWO)}; pg8::gemm_phase(lds, g, S, E, wv); } }
        else if (bid < 200) { PH(1) { pg8::Gemm g{(const char*)(ws + WS_WOUT), (const char*)(ws + WS_WPOOL), D, DPOOL, 0, 0, DPOOL}; S.init(4, 2, 1, 8, bid - 192);
            EpiVWo E{(bf16_t*)(ws + WS_WOUT2)}; pg8::gemm_phase(lds, g, S, E, wv); } }
        p2b_pool(C, bid - 160, G - 160, wv); }
    }
    xcd_barrier(xbar, wv);
    TSTAMP(3);

    PH(5) { pg8::Gemm g{(const char*)(T1 + DPOOL), (const char*)(ws + WS_WGLU), D, DSSM, 0, 0, DSSM}; S.init(SEQ / 256, 2, 1, G, bid);
      EpiGlu E{T2, T1, C.in[21]}; pg8::gemm_phase(lds, g, S, E, wv); }
    { SkGlu E{T2, T1, C.in[21]}; skinny_gemm(lds, T1 + (size_t)SEQ * D + DPOOL, D, (const bf16_t*)(ws + WS_WGLU), DSSM, DSSM, DSSM, 1, E, G, (bid + G - 128) % G, wv); }
    xcd_barrier(xbar, wv);
    TSTAMP(6);

    PH(6) { pg8::Gemm g{(const char*)T2, (const char*)(ws + WS_WOUT2), D, D, 0, 0, D}; S.init(SEQ / 256, 4, 1, G, bid);
      EpiRes<false> E{C.in[0], T0, SS1}; pg8::gemm_phase(lds, g, S, E, wv); }
    { SkRes<false> E{C.in[1], T0 + (size_t)SEQ * D, SS1 + (size_t)SEQ * 16}; skinny_gemm(lds, T2 + (size_t)SEQ * D, D, (const bf16_t*)(ws + WS_WOUT2), D, D, D, 1, E, G, bid, wv); }
    xcd_barrier(xbar, wv);
    TSTAMP(7);

    { SkQ E{T1 + (size_t)SEQ * D, SS1 + (size_t)SEQ * 16}; skinny_gemm(lds, T0 + (size_t)SEQ * D, D, (const bf16_t*)(ws + WS_WQ), D, D, D, 1, E, G, bid, wv); }
    asm volatile("s_waitcnt vmcnt(0)" ::: "memory"); __syncthreads();
    if (bid < 64 && tidx(wv) == 0) { __builtin_amdgcn_fence(__ATOMIC_RELEASE, "agent"); asm volatile("s_waitcnt vmcnt(0)" ::: "memory"); (void)xb_add((unsigned*)(ws + WS_BAR + 32768), 1u); }
    TSTAMP(8);
    PH(8) { pg8::Gemm g{(const char*)T0, (const char*)(ws + WS_WQK), D, D, 0, 0, D}; S.init(SEQ / 256, 4, 1, G, bid);
      LAS float* tab = (LAS float*)(lds + 131072 + 8192 + 1024); (void)prep_rstd(tab, SS1, S, wv);
      EpiSoftmax E{T1, (LAS float*)(lds + 131072), (LAS float*)(lds + 131072 + 4096), tab}; pg8::gemm_phase(lds, g, S, E, wv); }
    TSTAMP(9);
    if (tidx(wv) == 0) { unsigned* cnt = (unsigned*)(ws + WS_BAR + 32768); unsigned sp = 0; while (xb_ld(cnt) < 64u) { __builtin_amdgcn_s_sleep(1); if (++sp > XB_SPIN_CAP) break; }
        __builtin_amdgcn_fence(__ATOMIC_ACQUIRE, "agent"); asm volatile("s_waitcnt vmcnt(0)" ::: "memory"); }
    __syncthreads();
    for (int it = bid; it < 256; it += G) {
        const int bh = (it & 7) + 8 * (it >> 5), dq = (it >> 3) & 3; sample_attn_item(C, lds, bh * 4 + dq, wv); }
    xcd_barrier(xbar, wv);
    TSTAMP(10);

    PH(10) { pg8::Gemm g{(const char*)T1, (const char*)(ws + WS_VWO), D, D, 0, 0, D}; S.init(SEQ / 256, 4, 1, G, bid);
      EpiRes<true> E{T0, T2, SS2}; pg8::gemm_phase(lds, g, S, E, wv); }
    { SkRes<true> E{T0 + (size_t)SEQ * D, T2 + (size_t)SEQ * D, SS2 + (size_t)SEQ * 16}; skinny_gemm(lds, OB + (size_t)SEQ * D, D, (const bf16_t*)(ws + WS_WO), D, D, D, 1, E, G, bid, wv); }
    xcd_barrier(xbar, wv);
    TSTAMP(11);

    PH(11) { pg8::Gemm g{(const char*)T2, (const char*)(ws + WS_WUP), D, D, 0, 0, D}; S.init(SEQ / 256, DFF / 256, 1, G, bid);
      LAS float* tab = (LAS float*)(lds + 131072); const int tpm = prep_rstd(tab, SS2, S, wv);
      EpiUp E{(bf16_t*)(ws + WS_U), SS2, tab, tpm}; pg8::gemm_phase(lds, g, S, E, wv); }
    { SkUp E{(bf16_t*)(ws + WS_U) + (size_t)SEQ * DFF, SS2 + (size_t)SEQ * 16}; skinny_gemm(lds, T2 + (size_t)SEQ * D, D, (const bf16_t*)(ws + WS_WUP), D, DFF, D, 1, E, G, bid, wv); }
    xcd_barrier(xbar, wv);
    TSTAMP(12);

    PH(12) { pg8::Gemm g{(const char*)(ws + WS_U), (const char*)(ws + WS_WDOWN), DFF, DFF, 0, 0, DFF}; S.init(SEQ / 256, 4, 1, G, bid);
      EpiFinal E{T2, Y, C.in[32], (float*)(ws + WS_XCH), (unsigned*)(ws + WS_BAR + 40960), (LAS float*)(lds + 131072), (LAS float*)(lds + 131072 + 4096), wv}; pg8::gemm_phase(lds, g, S, E, wv); }
    { SkSlab E{(float*)(ws + WS_SLAB)}; skinny_gemm(lds, (const bf16_t*)(ws + WS_U) + (size_t)SEQ * DFF, DFF, (const bf16_t*)(ws + WS_WDOWN), DFF, D, DFF, 4, E, G, bid, wv); }
    asm volatile("s_waitcnt vmcnt(0)" ::: "memory"); __syncthreads();
    { unsigned* cs = (unsigned*)(ws + WS_BAR + 40960) + 16 * 64;
      if (tidx(wv) == 0) { (void)xb_add(cs, 1u); unsigned sp = 0; while (xb_ld(cs) < 256u) { __builtin_amdgcn_s_sleep(1); if (++sp > XB_SPIN_CAP) break; }
          __builtin_amdgcn_fence(__ATOMIC_ACQUIRE, "agent"); asm volatile("s_waitcnt vmcnt(0)" ::: "memory"); }
      __syncthreads();
      if (wv == 0 && bid < NSAMP) { const int lane = lane_id(), m = SEQ + bid; const u32x2* xr = (const u32x2*)(T2 + (size_t)m * D) + lane; f32x4 v[4]; float ss = 0.f;
#pragma unroll
          for (int j = 0; j < 4; ++j) { const u32x2 w = xr[64 * j]; v[j] = (f32x4){bf2f(w.x & 0xffffu), bf2f(w.x >> 16), bf2f(w.y & 0xffffu), bf2f(w.y >> 16)}; }
#pragma unroll
          for (int ks = 0; ks < 4; ++ks) { const f32x4* sp = (const f32x4*)((const float*)(ws + WS_SLAB) + ((size_t)ks * NSAMP + bid) * D) + lane;
#pragma unroll
              for (int j = 0; j < 4; ++j) v[j] += sp[64 * j]; }
#pragma unroll
          for (int j = 0; j < 4; ++j) ss += (v[j].x * v[j].x + v[j].y * v[j].y) + (v[j].z * v[j].z + v[j].w * v[j].w);
          const float rs = rsqrtf(wave_sum(ss, lane) * (1.f / D) + EPS); const f32x4* gr = (const f32x4*)C.in[32] + lane; f32x4* yr = (f32x4*)(Y + (size_t)m * D) + lane;
#pragma unroll
          for (int j = 0; j < 4; ++j) { const f32x4 gg = gr[64 * j]; yr[64 * j] = (f32x4){v[j].x * rs * gg.x, v[j].y * rs * gg.y, v[j].z * rs * gg.z, v[j].w * rs * gg.w}; } } }
#if TPROBE
    __syncthreads();
    if (bid == 0 && tidx(wv) == 0) { asm volatile("s_waitcnt vmcnt(0)" ::: "memory"); const unsigned long long tend = __builtin_amdgcn_s_memrealtime(); volatile unsigned long long* ts = (volatile unsigned long long*)(ws + WS_BAR + 65536);
        const size_t offs[10] = {O_Y, O_Y + (size_t)SEQ * D, O_MK, O_MV, O_POOLP, O_SREP, O_SIMP, O_POOLS, O_SRES, O_SIMS};
        for (int k = 0; k < 10; ++k) { const int ph = TP_BASE + k; const unsigned long long a = ts[ph], b = (ph + 1 <= 13) ? ts[ph + 1] : tend; C.out[offs[k]] += (float)(b - a) * 0.01f; } }
#endif
}

extern "C" void kernel_launch(void* const* d_in, const int* in_sizes, int n_in, void* d_out, int out_size, void* d_ws, size_t ws_size, hipStream_t stream) {
    static int grid = 0;
    if (grid == 0) {
        if (n_in != 33 || (size_t)out_size != O_END || ws_size < WS_END) { fprintf(stderr, "kernel_launch: unexpected shapes n_in %d out %d ws %zu\n", n_in, out_size, ws_size); grid = -1; return; }
        int dev = 0, cus = 0, per_cu = 0;
        hipGetDevice(&dev); hipDeviceGetAttribute(&cus, hipDeviceAttributeMultiprocessorCount, dev);
        if (hipFuncSetAttribute((const void*)fwd_megakernel, hipFuncAttributeMaxDynamicSharedMemorySize, LDS_BYTES) != hipSuccess) { fprintf(stderr, "kernel_launch: hipFuncSetAttribute failed\n"); grid = -1; return; }
        if (hipOccupancyMaxActiveBlocksPerMultiprocessor(&per_cu, (const void*)fwd_megakernel, 512, LDS_BYTES) != hipSuccess || per_cu < 1) { fprintf(stderr, "kernel_launch: occupancy query failed (%d)\n", per_cu); (void)hipGetLastError(); per_cu = 1; }
        if (per_cu > 1) per_cu = 1;
        grid = cus * per_cu; if (grid > 256) grid = 256;
        if (grid != 256) { fprintf(stderr, "kernel_launch: this kernel is laid out for exactly 256 resident workgroups (one per CU of a 256-CU device), got %d\n", grid); grid = -1; return; }
    }
    if (grid < 0) return;
    Ctx c{};
    for (int i = 0; i < 33; ++i) c.in[i] = (const float*)d_in[i];
    c.out = (float*)d_out; c.ws = (unsigned char*)d_ws;
    if (hipMemsetAsync((char*)d_ws + WS_BAR, 0, 65536, stream) != hipSuccess) { fprintf(stderr, "kernel_launch: memset of the barrier words failed\n"); return; }
    void* args[] = {&c};
    hipError_t e = hipLaunchCooperativeKernel((const void*)fwd_megakernel, dim3(grid), dim3(512), args, LDS_BYTES, stream);
    if (e != hipSuccess) fprintf(stderr, "cooperative launch failed: %s (grid %d)\n", hipGetErrorString(e), grid);
}
```
